# Optimizing an MI355X kernel written in HIP

```python
import math
import jax, jax.numpy as jnp
from jax import lax
import numpy as np

D_MODEL = 1024
BATCH = 16
SEQ = 2048
DEPTH = 2

CTX_LEN = 256
GRID_W = 64
ROPE_BASE = 10000.0
Q_BLOCK = 128
EPS = 1e-6

MLA_HEADS = 8
MLA_NOPE = 64
MLA_ROPE = 32
MLA_V = 64
MLA_Q_RANK = 384
MLA_KV_RANK = 256
MLA_WIDTH = MLA_HEADS * MLA_V

POOL_WINDOWS = (2, 4, 8, 16)
POOL_GROUPS = 4
POOL_GROUP_W = 128
POOL_WIDTH = POOL_GROUPS * POOL_GROUP_W

DIFF_HEADS = 4
DIFF_HALF = 64
DIFF_V = 128
DIFF_QK = DIFF_HEADS * 2 * DIFF_HALF
DIFF_WIDTH = DIFF_HEADS * DIFF_V

N_BRANCH = 3

N_EXPERTS = 64
TOP_K = 8
N_GROUPS = 8
TOPK_GROUPS = 4
EXPERT_FF = 256
SHARED_FF = 256
ROUTED_SCALE = 2.5
EXPERT_BLOCK = 256

KV_SPLIT = (MLA_KV_RANK, MLA_KV_RANK + MLA_ROPE, MLA_KV_RANK + MLA_ROPE + DIFF_QK)
KV_COLS = MLA_KV_RANK + MLA_ROPE + DIFF_QK + DIFF_WIDTH
Q_SPLIT = (MLA_Q_RANK, MLA_Q_RANK + DIFF_QK, MLA_Q_RANK + DIFF_QK + POOL_WIDTH)
Q_COLS = MLA_Q_RANK + DIFF_QK + POOL_WIDTH + N_BRANCH * D_MODEL
IN_COLS = KV_COLS + Q_COLS

kernel_name = 'hybrid_mla_pool_diffattn_moe_dit'


def rmsnorm(x, g):
    xf = x.astype(jnp.float32)
    y = xf * lax.rsqrt(jnp.mean(xf * xf, axis=-1, keepdims=True) + EPS)
    return (y * g.astype(jnp.float32)).astype(x.dtype)


def modulate(h, shift, scale):
    return h * (1.0 + scale) + shift


def axial_angles(n_tok, rot_dim):
    rows = n_tok // GRID_W
    pos_row = jnp.repeat(jnp.arange(rows, dtype=jnp.float32), GRID_W)
    pos_col = jnp.tile(jnp.arange(GRID_W, dtype=jnp.float32), rows)
    d_axis = rot_dim // 2
    inv_freq = ROPE_BASE ** (-jnp.arange(0, d_axis, 2, dtype=jnp.float32) / d_axis)
    return pos_row[:, None] * inv_freq, pos_col[:, None] * inv_freq


def rope_axis(x, ang):
    ang = ang.reshape(ang.shape[0], *([1] * (x.ndim - 3)), ang.shape[-1])
    cos = jnp.cos(ang).astype(x.dtype)
    sin = jnp.sin(ang).astype(x.dtype)
    x1, x2 = jnp.split(x, 2, axis=-1)
    return jnp.concatenate([x1 * cos - x2 * sin, x1 * sin + x2 * cos], axis=-1)


def rope_2d(x, ang_row, ang_col):
    xr, xc = jnp.split(x, 2, axis=-1)
    return jnp.concatenate([rope_axis(xr, ang_row), rope_axis(xc, ang_col)], axis=-1)


def kv_streams(p_kv, g_ckv, w_ukv, ang_mla, ang_diff):
    b, n = p_kv.shape[:2]
    c_kv, k_rope, k_diff, v_diff = jnp.split(p_kv, KV_SPLIT, axis=-1)
    kv = (rmsnorm(c_kv, g_ckv) @ w_ukv).reshape(b, n, MLA_HEADS, MLA_NOPE + MLA_V)
    k_nope, v_mla = kv[..., :MLA_NOPE], kv[..., MLA_NOPE:]
    k_diff = k_diff.reshape(b, n, DIFF_HEADS, 2, DIFF_HALF)
    v_diff = v_diff.reshape(b, n, DIFF_HEADS, DIFF_V)
    if ang_mla is not None:
        k_rope = rope_2d(k_rope, *ang_mla)
        k_diff = rope_2d(k_diff, *ang_diff)
    return k_nope, k_rope, v_mla, k_diff, v_diff


def q_streams(p_q, g_cq, w_uq, ang_mla, ang_diff):
    b, n = p_q.shape[:2]
    c_q, q_diff, pool_in, gate_logits = jnp.split(p_q, Q_SPLIT, axis=-1)
    q = (rmsnorm(c_q, g_cq) @ w_uq).reshape(b, n, MLA_HEADS, MLA_NOPE + MLA_ROPE)
    q_nope, q_rope = q[..., :MLA_NOPE], q[..., MLA_NOPE:]
    q_diff = q_diff.reshape(b, n, DIFF_HEADS, 2, DIFF_HALF)
    if ang_mla is not None:
        q_rope = rope_2d(q_rope, *ang_mla)
        q_diff = rope_2d(q_diff, *ang_diff)
    return q_nope, q_rope, q_diff, pool_in, gate_logits


def mla_attend(k_nope, k_rope, v):
    scale = 1.0 / math.sqrt(MLA_NOPE + MLA_ROPE)

    def attend(qs):
        q_nope, q_rope = qs
        s = (jnp.einsum('bqhd,bkhd->bhqk', q_nope, k_nope)
             + jnp.einsum('bqhd,bkd->bhqk', q_rope, k_rope))
        p = jax.nn.softmax(s.astype(jnp.float32) * scale, axis=-1).astype(v.dtype)
        return jnp.einsum('bhqk,bkhd->bqhd', p, v)
    return attend


def diff_attend(k, v, lam):
    scale = 1.0 / math.sqrt(DIFF_HALF)

    def attend(qs):
        (q,) = qs
        s = jnp.einsum('bqhmd,bkhmd->bmhqk', q, k).astype(jnp.float32) * scale
        p = jax.nn.softmax(s, axis=-1)
        a = (p[:, 0] - lam * p[:, 1]).astype(v.dtype)
        return jnp.einsum('bhqk,bkhd->bqhd', a, v)
    return attend


def sweep_queries(attend, qs):
    b, n = qs[0].shape[:2]
    nb = n // Q_BLOCK
    blocks = tuple(jnp.moveaxis(q.reshape(b, nb, Q_BLOCK, *q.shape[2:]), 1, 0) for q in qs)
    o = lax.map(attend, blocks)
    return jnp.moveaxis(o, 0, 1).reshape(b, n, *o.shape[3:])


def pool_mix(u, w_pool, pool_scale):
    b, n, _ = u.shape
    ug = u.reshape(b, n, POOL_GROUPS, POOL_GROUP_W)
    t = jnp.arange(n)
    outs = []
    for g, w in enumerate(POOL_WINDOWS):
        xg = ug[:, :, g].astype(jnp.float32)
        cs = jnp.concatenate([jnp.zeros((b, 1, POOL_GROUP_W), jnp.float32), lax.cumsum(xg, axis=1)], axis=1)
        lo = jnp.clip(t - w // 2, 0, n)
        hi = jnp.clip(t - w // 2 + w, 0, n)
        mean = (cs[:, hi] - cs[:, lo]) / (hi - lo).astype(jnp.float32)[None, :, None]
        outs.append((mean - xg).astype(u.dtype))
    pooled = jnp.stack(outs, axis=2)
    mixed = jnp.einsum('blgc,gcd->blgd', pooled, w_pool)
    return mixed.reshape(b, n, POOL_WIDTH) * pool_scale


def merge_branches(o_mla, o_diff, pool_in, gate_logits, lam_init, w_pool, pool_scale, g_subln,
                   w_b_mla, w_b_pool, w_b_diff, w_out):
    b, n = pool_in.shape[:2]
    o_mla = o_mla.reshape(b, n, MLA_WIDTH)
    o_diff = (rmsnorm(o_diff, g_subln) * (1.0 - lam_init)).reshape(b, n, DIFF_WIDTH)
    o_pool = pool_mix(pool_in, w_pool, pool_scale)
    gates = jax.nn.sigmoid(gate_logits.astype(jnp.float32)).astype(pool_in.dtype)
    gates = gates.reshape(b, n, N_BRANCH, D_MODEL)
    merged = (gates[:, :, 0] * (o_mla @ w_b_mla)
              + gates[:, :, 1] * (o_pool @ w_b_pool)
              + gates[:, :, 2] * (o_diff @ w_b_diff))
    return merged @ w_out


def token_mixing(hx, hc, ctx_out, lam_init, w_in, g_cq, w_uq, g_ckv, w_ukv, w_pool, pool_scale,
                 lam_q1, lam_k1, lam_q2, lam_k2, g_subln, w_b_mla, w_b_pool, w_b_diff, w_out):
    n_lat = hx.shape[1]
    ang_mla = axial_angles(n_lat, MLA_ROPE)
    ang_diff = axial_angles(n_lat, DIFF_HALF)
    px = hx @ w_in
    pc = hc @ w_in if ctx_out else hc @ w_in[:, :KV_COLS]
    kv_x = kv_streams(px[..., :KV_COLS], g_ckv, w_ukv, ang_mla, ang_diff)
    kv_c = kv_streams(pc[..., :KV_COLS], g_ckv, w_ukv, None, None)
    k_nope, k_rope, v_mla, k_diff, v_diff = [jnp.concatenate([kc_, kx_], axis=1) for kc_, kx_ in zip(kv_c, kv_x)]
    lam = (jnp.exp(jnp.sum((lam_q1 * lam_k1).astype(jnp.float32)))
           - jnp.exp(jnp.sum((lam_q2 * lam_k2).astype(jnp.float32))) + lam_init)
    q_nope, q_rope, q_diff, pool_in, gate_logits = q_streams(px[..., KV_COLS:], g_cq, w_uq, ang_mla, ang_diff)
    o_mla = sweep_queries(mla_attend(k_nope, k_rope, v_mla), (q_nope, q_rope))
    o_diff = sweep_queries(diff_attend(k_diff, v_diff, lam), (q_diff,))
    y_x = merge_branches(o_mla, o_diff, pool_in, gate_logits, lam_init, w_pool, pool_scale, g_subln,
                         w_b_mla, w_b_pool, w_b_diff, w_out)
    if not ctx_out:
        return y_x, None
    cq_nope, cq_rope, cq_diff, c_pool_in, c_gate_logits = q_streams(pc[..., KV_COLS:], g_cq, w_uq, None, None)
    oc_mla = mla_attend(kv_c[0], kv_c[1], kv_c[2])((cq_nope, cq_rope))
    oc_diff = diff_attend(kv_c[3], kv_c[4], lam)((cq_diff,))
    y_c = merge_branches(oc_mla, oc_diff, c_pool_in, c_gate_logits, lam_init, w_pool, pool_scale, g_subln,
                         w_b_mla, w_b_pool, w_b_diff, w_out)
    return y_x, y_c


def moe_ffn(h, w_router, b_router, w_e_gate, w_e_up, w_e_down, w_s_gate, w_s_up, w_s_down):
    n = h.shape[0]
    scores = jax.nn.sigmoid((h @ w_router).astype(jnp.float32))
    sel = scores + b_router.astype(jnp.float32)
    grp = sel.reshape(n, N_GROUPS, N_EXPERTS // N_GROUPS)
    grp_score = lax.top_k(grp, 2)[0].sum(-1)
    _, top_grp = lax.top_k(grp_score, TOPK_GROUPS)
    grp_mask = jnp.any(top_grp[:, :, None] == jnp.arange(N_GROUPS)[None, None, :], axis=1)
    exp_mask = jnp.repeat(grp_mask, N_EXPERTS // N_GROUPS, axis=1)
    _, idx = lax.top_k(jnp.where(exp_mask, sel, -jnp.inf), TOP_K)
    wts = jnp.take_along_axis(scores, idx, axis=1)
    wts = wts / jnp.sum(wts, axis=-1, keepdims=True) * ROUTED_SCALE
    nk = n * TOP_K
    flat_e = idx.reshape(-1)
    order = jnp.argsort(flat_e)
    sorted_e = flat_e[order]
    counts = jnp.bincount(flat_e, length=N_EXPERTS)
    padded = (counts + EXPERT_BLOCK - 1) // EXPERT_BLOCK * EXPERT_BLOCK
    pad_end = jnp.cumsum(padded)
    pad_start = pad_end - padded
    raw_start = jnp.cumsum(counts) - counts
    dest = pad_start[sorted_e] + jnp.arange(nk) - raw_start[sorted_e]
    n_rows = (-(-nk // EXPERT_BLOCK)) * EXPERT_BLOCK + N_EXPERTS * EXPERT_BLOCK
    n_blk = n_rows // EXPERT_BLOCK
    row_tok = jnp.zeros((n_rows,), jnp.int32).at[dest].set((order // TOP_K).astype(jnp.int32))
    row_w = jnp.zeros((n_rows,), jnp.float32).at[dest].set(wts.reshape(-1)[order])
    blk_e = jnp.minimum(jnp.searchsorted(pad_end, jnp.arange(n_blk) * EXPERT_BLOCK, side='right'), N_EXPERTS - 1)

    def expert_block(acc, blk):
        tok, w, e = blk
        xb = h[tok]
        y = (jax.nn.silu(xb @ w_e_gate[e]) * (xb @ w_e_up[e])) @ w_e_down[e]
        return acc.at[tok].add(y * w[:, None].astype(y.dtype)), None

    routed, _ = lax.scan(expert_block, jnp.zeros_like(h),
                         (row_tok.reshape(n_blk, EXPERT_BLOCK), row_w.reshape(n_blk, EXPERT_BLOCK), blk_e))
    shared = (jax.nn.silu(h @ w_s_gate) * (h @ w_s_up)) @ w_s_down
    return routed + shared


def setup_inputs(seed: int = 0) -> dict:
    key = jax.random.key(seed)
    ks = iter(jax.random.split(key, 64))

    def nrm(shape, scale):
        return jax.random.normal(next(ks), shape, jnp.float32) * scale

    def gain(shape):
        return 1.0 + nrm(shape, 0.02)

    L, D = DEPTH, D_MODEL
    return {
        'x': nrm((BATCH, SEQ, D), 1.0),
        'c': nrm((BATCH, D), 1.0),
        'ctx': nrm((BATCH, CTX_LEN, D), 1.0),
        'c_ctx': nrm((D,), 1.0),
        'w_mod': nrm((L, D, 6 * D), 0.5 * D ** -0.5),
        'b_mod': nrm((L, 6 * D), 0.02),
        'g_pre_mix': gain((L, D)),
        'g_post_mix': gain((L, D)),
        'g_pre_ffn': gain((L, D)),
        'g_post_ffn': gain((L, D)),
        'w_in': nrm((L, D, IN_COLS), D ** -0.5),
        'g_cq': gain((L, MLA_Q_RANK)),
        'w_uq': nrm((L, MLA_Q_RANK, MLA_HEADS * (MLA_NOPE + MLA_ROPE)), MLA_Q_RANK ** -0.5),
        'g_ckv': gain((L, MLA_KV_RANK)),
        'w_ukv': nrm((L, MLA_KV_RANK, MLA_HEADS * (MLA_NOPE + MLA_V)), MLA_KV_RANK ** -0.5),
        'w_pool': nrm((L, POOL_GROUPS, POOL_GROUP_W, POOL_GROUP_W), POOL_GROUP_W ** -0.5),
        'pool_scale': 1.0 + nrm((L, POOL_WIDTH), 0.1),
        'lam_q1': nrm((L, DIFF_HALF), 0.1),
        'lam_k1': nrm((L, DIFF_HALF), 0.1),
        'lam_q2': nrm((L, DIFF_HALF), 0.1),
        'lam_k2': nrm((L, DIFF_HALF), 0.1),
        'g_subln': gain((L, DIFF_V)),
        'w_b_mla': nrm((L, MLA_WIDTH, D), MLA_WIDTH ** -0.5),
        'w_b_pool': nrm((L, POOL_WIDTH, D), POOL_WIDTH ** -0.5),
        'w_b_diff': nrm((L, DIFF_WIDTH, D), DIFF_WIDTH ** -0.5),
        'w_out': nrm((L, D, D), D ** -0.5),
        'w_router': nrm((L, D, N_EXPERTS), D ** -0.5),
        'b_router': nrm((L, N_EXPERTS), 0.01),
        'w_e_gate': nrm((L, N_EXPERTS, D, EXPERT_FF), D ** -0.5),
        'w_e_up': nrm((L, N_EXPERTS, D, EXPERT_FF), D ** -0.5),
        'w_e_down': nrm((L, N_EXPERTS, EXPERT_FF, D), EXPERT_FF ** -0.5),
        'w_s_gate': nrm((L, D, SHARED_FF), D ** -0.5),
        'w_s_up': nrm((L, D, SHARED_FF), D ** -0.5),
        'w_s_down': nrm((L, SHARED_FF, D), SHARED_FF ** -0.5),
    }


def reference(x, c, ctx, c_ctx, w_mod, b_mod, g_pre_mix, g_post_mix, g_pre_ffn, g_post_ffn, w_in,
              g_cq, w_uq, g_ckv, w_ukv, w_pool, pool_scale, lam_q1, lam_k1, lam_q2, lam_k2, g_subln,
              w_b_mla, w_b_pool, w_b_diff, w_out, w_router, b_router, w_e_gate, w_e_up, w_e_down,
              w_s_gate, w_s_up, w_s_down):
    b, n_lat, d = x.shape
    h_lat, h_ctx = x, ctx
    for l in range(DEPTH):
        ctx_out = l < DEPTH - 1
        lam_init = 0.8 - 0.6 * math.exp(-0.3 * l)
        m_x = [m[:, None, :] for m in jnp.split(jax.nn.silu(c) @ w_mod[l] + b_mod[l], 6, axis=-1)]
        m_c = jnp.split(jax.nn.silu(c_ctx) @ w_mod[l] + b_mod[l], 6, axis=-1)
        hx = modulate(rmsnorm(h_lat, g_pre_mix[l]), m_x[0], m_x[1])
        hc = modulate(rmsnorm(h_ctx, g_pre_mix[l]), m_c[0], m_c[1])
        y_x, y_c = token_mixing(hx, hc, ctx_out, lam_init, w_in[l], g_cq[l], w_uq[l], g_ckv[l], w_ukv[l],
                                w_pool[l], pool_scale[l], lam_q1[l], lam_k1[l], lam_q2[l], lam_k2[l],
                                g_subln[l], w_b_mla[l], w_b_pool[l], w_b_diff[l], w_out[l])
        h_lat = h_lat + m_x[2] * rmsnorm(y_x, g_post_mix[l])
        fx = modulate(rmsnorm(h_lat, g_pre_ffn[l]), m_x[3], m_x[4]).reshape(-1, d)
        moe_args = (w_router[l], b_router[l], w_e_gate[l], w_e_up[l], w_e_down[l],
                    w_s_gate[l], w_s_up[l], w_s_down[l])
        if ctx_out:
            h_ctx = h_ctx + m_c[2] * rmsnorm(y_c, g_post_mix[l])
            fc = modulate(rmsnorm(h_ctx, g_pre_ffn[l]), m_c[3], m_c[4]).reshape(-1, d)
            f_all = moe_ffn(jnp.concatenate([fx, fc], axis=0), *moe_args)
            f_x, f_c = f_all[: fx.shape[0]], f_all[fx.shape[0]:]
            h_ctx = h_ctx + m_c[5] * rmsnorm(f_c.reshape(h_ctx.shape), g_post_ffn[l])
        else:
            f_x = moe_ffn(fx, *moe_args)
        h_lat = h_lat + m_x[5] * rmsnorm(f_x.reshape(b, n_lat, d), g_post_ffn[l])
    return h_lat
```

```cpp
#include <hip/hip_runtime.h>
#include <cstdio>
#include <cstdint>
#include <cmath>

#ifndef PHM
#define PHM 0xFFFF
#endif
#ifndef USE_FAST_ATTN
#define USE_FAST_ATTN 1
#endif
#if USE_FAST_ATTN
#define ATTN_PHASE ph_attn_fast
#else
#define ATTN_PHASE ph_attn_naive
#endif
#ifndef N_LAUNCH_MODE
#define N_LAUNCH_MODE 1
#endif

#define GAS __attribute__((address_space(1)))
#define LAS __attribute__((address_space(3)))
typedef unsigned short bf16_t;
typedef float f32x4 __attribute__((ext_vector_type(4)));
typedef float f32x2 __attribute__((ext_vector_type(2)));
typedef unsigned u32x4 __attribute__((ext_vector_type(4)));
typedef unsigned u32x2 __attribute__((ext_vector_type(2)));
typedef short bf16x8 __attribute__((ext_vector_type(8)));

constexpr int DM = 1024, NB = 16, SEQ = 2048, CTXL = 256, RPB = SEQ + CTXL  ;
constexpr int NR = NB * RPB;
constexpr int NTILE = NR / 256;
constexpr int IN_COLS = 5792, KV_COLS = 1312;
constexpr int NEXP = 64, EFF = 256;
constexpr int NCHUNK = 2, CHROWS = NR / NCHUNK  , CAP = CHROWS;
constexpr float EPSN = 1e-6f;
constexpr float LOG2E = 1.4426950408889634f;
constexpr float C2M = 0.10206207261596577f * LOG2E;
constexpr float C2D = 0.125f * LOG2E;

constexpr size_t WO_IN = 0;
constexpr size_t WO_VD = WO_IN + 2304ull * 1024;
constexpr size_t WO_G  = WO_VD + 512ull * 1024;
constexpr size_t WO_UK = WO_G + 3072ull * 1024;
constexpr size_t WO_UV = WO_UK + 512ull * 256;
constexpr size_t WO_UQ = WO_UV + 512ull * 256;
constexpr size_t WO_BM = WO_UQ + 768ull * 384;
constexpr size_t WO_PP = WO_BM + 1024ull * 512;
constexpr size_t WO_BD = WO_PP + 1024ull * 512;
constexpr size_t WO_O  = WO_BD + 1024ull * 512;
constexpr size_t WO_R  = WO_O + 1024ull * 1024;
constexpr size_t WO_GU = WO_R + 64ull * 1024;
constexpr size_t WO_D  = WO_GU + 65ull * 512 * 1024;
constexpr size_t W_ELEMS = WO_D + 65ull * 1024 * 256;

constexpr size_t WS_CTL = 0, CTL_BYTES = 3u << 20;
constexpr size_t CTL_BAR = 16384;
constexpr size_t CTL_CNT = 65536;
constexpr size_t CTL_SSKV = 131072;
constexpr size_t CTL_SSQ = CTL_SSKV + 2ull * NR * 8;
constexpr size_t CTL_MOD = CTL_SSQ + 2ull * NR * 8;
static_assert(CTL_MOD + 2ull * 17 * 6144 * 4 <= CTL_BYTES, "ctl");
constexpr size_t WS_TAB64 = CTL_BYTES;
constexpr size_t WS_TAB32 = WS_TAB64 + 2048ull * 32 * 8;
constexpr size_t WS_W = WS_TAB32 + 2048ull * 16 * 8;
constexpr size_t WS_HC = WS_W + W_ELEMS * 2;
constexpr size_t WS_REGT = WS_HC + 4096ull * 1024 * 4;
constexpr size_t WS_REGW = WS_REGT + 2ull * 64 * CAP * 4;
constexpr size_t WS_ACT0 = WS_REGW + 2ull * 64 * CAP * 4;
constexpr size_t SZ_ROW2K = (size_t)NR * 2048, SZ_ROW1K = (size_t)NR * 1024;
constexpr size_t A_HX = WS_ACT0;
constexpr size_t A_KD = A_HX + SZ_ROW2K;
constexpr size_t A_VDT = A_KD + SZ_ROW1K;
constexpr size_t A_QD = A_VDT + SZ_ROW1K;
constexpr size_t A_PD = A_QD + SZ_ROW1K;
constexpr size_t A_OM = A_PD + SZ_ROW1K;
constexpr size_t A_PL = A_OM + SZ_ROW1K;
constexpr size_t A_CKV = A_PL + SZ_ROW1K;
constexpr size_t A_CQ = A_CKV + (size_t)NR * 512;
constexpr size_t A_KN = A_CQ + (size_t)NR * 768;
constexpr size_t A_KR = A_KN + SZ_ROW1K;
constexpr size_t A_VMT = A_KR + (size_t)NR * 64;
constexpr size_t A_QM = A_VMT + SZ_ROW1K;
constexpr size_t A_MIXEND = A_QM + (size_t)NR * 1536;
constexpr size_t A_MG = A_PL;
constexpr size_t A_Y1 = A_KN;
constexpr size_t A_SCR = A_KD;
static_assert(A_MG + SZ_ROW2K <= A_KN && A_Y1 + SZ_ROW2K <= A_MIXEND && 256ull * 262144 <= 2 * SZ_ROW1K, "overlays");
constexpr int ACT_TILES = (CHROWS * 8) / 256 + 64 + CHROWS / 256;
constexpr size_t A_ACT = A_KD;
constexpr size_t A_Y = A_ACT + (size_t)ACT_TILES * 256 * 512;
constexpr size_t WS_END = (A_Y + (size_t)CHROWS * 9 * 2048) > A_MIXEND ? (A_Y + (size_t)CHROWS * 9 * 2048) : A_MIXEND;
static_assert(WS_END <= 684360192ull, "workspace budget");

__device__ __forceinline__ unsigned f2bf(float f) { unsigned u = __builtin_bit_cast(unsigned, f); return (u + 0x7fffu + ((u >> 16) & 1u)) >> 16; }
__device__ __forceinline__ unsigned pk2(float lo, float hi) { return f2bf(lo) | (f2bf(hi) << 16); }
__device__ __forceinline__ float bf2f(unsigned short b) { return __builtin_bit_cast(float, (unsigned)b << 16); }
__device__ __forceinline__ float bflo(unsigned w) { return __builtin_bit_cast(float, w << 16); }
__device__ __forceinline__ float bfhi(unsigned w) { return __builtin_bit_cast(float, w & 0xffff0000u); }
__device__ __forceinline__ u32x4 pack8(f32x4 lo, f32x4 hi) { u32x4 w; w.x = pk2(lo[0], lo[1]); w.y = pk2(lo[2], lo[3]); w.z = pk2(hi[0], hi[1]); w.w = pk2(hi[2], hi[3]); return w; }
__device__ __forceinline__ void unpack8(u32x4 w, f32x4& lo, f32x4& hi) { lo = (f32x4){bflo(w.x), bfhi(w.x), bflo(w.y), bfhi(w.y)}; hi = (f32x4){bflo(w.z), bfhi(w.z), bflo(w.w), bfhi(w.w)}; }
__device__ __forceinline__ float wave_sum(float v) {
#pragma unroll
    for (int o = 1; o < 64; o <<= 1) v += __shfl_xor(v, o);
    return v;
}
constexpr float SS_SCALE = 16777216.f, SS_INV = 1.f / 16777216.f;
__device__ __forceinline__ void ss_add(unsigned long long* p, float s) { atomicAdd(p, (unsigned long long)(s * SS_SCALE)); }
__device__ __forceinline__ float ss_get(const unsigned long long* p) { return (float)(*p) * SS_INV; }
__device__ __forceinline__ float sigmoidf_(float x) { return 1.f / (1.f + __expf(-x)); }
__host__ __device__ __forceinline__ int pos2tok(int q) { const int fq = q >> 3, n = (q >> 2) & 1, i = q & 3; return 16 * (fq >> 1) + 4 * (fq & 1) + 8 * n + i; }
__host__ __device__ __forceinline__ int tok2pos(int t) { const int A = t >> 4, n = (t >> 3) & 1, B = (t >> 2) & 1, i = t & 3; return 8 * (2 * A + B) + 4 * n + i; }
__host__ __device__ __forceinline__ int ropedim(int RD, int p) { const int Q = p >> 3, n = (p >> 2) & 1, i = p & 3, P = 4 * Q + i, half = RD / 4; return (P < half ? 0 : RD / 2) + (P % half) + (n ? half : 0); }

#define XB_TMO      128
#define XB_XCNT(j)  (256  + 64 * (j))
#define XB_XSUB(j)  (1280 + 64 * (j))
#define XB_XGEN(j)  (2304 + 64 * (j))
#define XB_TOP      3328
#define XB_TOPGEN   3392
#define XCD_BAR_WORDS 3456
#define XB_SPIN_CAP (1u << 20)
__device__ __forceinline__ unsigned xb_ld(unsigned* p)              { return __hip_atomic_load(p, __ATOMIC_RELAXED, __HIP_MEMORY_SCOPE_AGENT); }
__device__ __forceinline__ unsigned xb_add(unsigned* p, unsigned v) { return __hip_atomic_fetch_add(p, v, __ATOMIC_RELAXED, __HIP_MEMORY_SCOPE_AGENT); }
__device__ __forceinline__ unsigned xb_xcc_id() { return (unsigned)__builtin_amdgcn_s_getreg((3 << 11) | 20) & 0xFu; }
#define XB_SPIN(cond, bar) do { unsigned _sp = 0; while (cond) { __builtin_amdgcn_s_sleep(1); \
    if ((++_sp & 255u) == 0u) { if (xb_ld(&(bar)[XB_TMO])) break; if (_sp > XB_SPIN_CAP) { atomicAdd(&(bar)[XB_TMO], 1u); break; } } } } while (0)
struct XcdBarrier { unsigned* bar; unsigned x; volatile LAS unsigned* st; };
__device__ __forceinline__ XcdBarrier xcd_barrier_post(unsigned* bar, volatile LAS unsigned* st) {
    XcdBarrier b; b.bar = bar; b.x = xb_xcc_id(); b.st = st;
    if (threadIdx.x == 0) (void)xb_add(&bar[XB_XCNT(b.x)], 1u);
    return b;
}
__device__ __forceinline__ void xcd_barrier_complete(unsigned* bar, unsigned x, unsigned& nloc, unsigned& nx) {
    const unsigned G = gridDim.x * gridDim.y * gridDim.z;
    unsigned sum, cnt, mine, sp = 0u;
    for (;;) {
        sum = 0u; cnt = 0u; mine = 0u;
#pragma unroll
        for (unsigned j = 0; j < 16; ++j) { const unsigned c = xb_ld(&bar[XB_XCNT(j)]); sum += c; cnt += (c > 0u) ? 1u : 0u; mine = (j == x) ? c : mine; }
        if (sum == G) break;
        __builtin_amdgcn_s_sleep(1);
        if ((++sp & 255u) == 0u) { if (xb_ld(&bar[XB_TMO])) break; if (sp > XB_SPIN_CAP) { atomicAdd(&bar[XB_TMO], 1u); break; } }
    }
    nloc = mine > 0u ? mine : 1u; nx = cnt > 0u ? cnt : 1u;
}
__device__ __forceinline__ void xcd_barrier(const XcdBarrier& b) {
    asm volatile("s_waitcnt vmcnt(0)" ::: "memory");
    __syncthreads();
    if (threadIdx.x == 0) {
        unsigned* bar = b.bar;
        __builtin_amdgcn_s_waitcnt(0);
        unsigned nloc = b.st[0], nx = b.st[1];
        if (nloc == 0u) { xcd_barrier_complete(bar, b.x, nloc, nx); b.st[0] = nloc; b.st[1] = nx; }
        const unsigned old = xb_add(&bar[XB_XSUB(b.x)], 1u);
        const unsigned gen = old / nloc;
        if (old + 1u == (gen + 1u) * nloc) {
            __builtin_amdgcn_fence(__ATOMIC_RELEASE, "agent");
            asm volatile("s_waitcnt vmcnt(0)" ::: "memory");
            const unsigned og = xb_add(&bar[XB_TOP], 1u);
            const unsigned tg = og / nx;
            if (og + 1u == (tg + 1u) * nx) xb_add(&bar[XB_TOPGEN], 1u);
            else XB_SPIN(xb_ld(&bar[XB_TOPGEN]) == tg, bar);
            __builtin_amdgcn_fence(__ATOMIC_ACQUIRE, "agent");
            xb_add(&bar[XB_XGEN(b.x)], 1u);
            asm volatile("s_waitcnt vmcnt(0)" ::: "memory");
        } else {
            XB_SPIN(xb_ld(&bar[XB_XGEN(b.x)]) == gen, bar);
            __builtin_amdgcn_fence(__ATOMIC_ACQUIRE, "agent");
            asm volatile("s_waitcnt vmcnt(0)" ::: "memory");
        }
    }
    __syncthreads();
}

struct Params {
    const float* in[34];
    float* out; unsigned char* ws;
    int step_lo, step_hi;
};
enum { I_X = 0, I_C, I_CTX, I_CCTX, I_WMOD, I_BMOD, I_GPREMIX, I_GPOSTMIX, I_GPREFFN, I_GPOSTFFN, I_WIN, I_GCQ, I_WUQ, I_GCKV, I_WUKV, I_WPOOL, I_PSCALE,
       I_LQ1, I_LK1, I_LQ2, I_LK2, I_GSUBLN, I_WBMLA, I_WBPOOL, I_WBDIFF, I_WOUT, I_WROUTER, I_BROUTER, I_WEGATE, I_WEUP, I_WEDOWN, I_WSGATE, I_WSUP, I_WSDOWN };

typedef const __attribute__((address_space(4))) Params* ParamsK;
struct Ctx {
    ParamsK p;
    LAS unsigned char* lds;
    int tid, lane, wave, G, blk;
    unsigned char* ws;
    size_t z;
};
#define INP(cx, I) ((cx).p->in[I] + (cx).z)
__device__ __forceinline__ unsigned long long rfl64(unsigned long long v) { return ((unsigned long long)(unsigned)__builtin_amdgcn_readfirstlane((int)(unsigned)(v >> 32)) << 32) | (unsigned)__builtin_amdgcn_readfirstlane((int)(unsigned)v); }
#define PHASE_CTX(cl) Ctx cl = c; asm volatile("" : "+s"(cl.ws), "+s"(cl.z), "+s"(cl.blk), "+s"(cl.G), "+s"(cl.wave)); cl.wave = __builtin_amdgcn_readfirstlane(cl.wave); \
    cl.lane = (int)__builtin_amdgcn_mbcnt_hi(~0u, __builtin_amdgcn_mbcnt_lo(~0u, 0u)); asm volatile("" : "+v"(cl.lane)); cl.tid = cl.wave * 64 + cl.lane; \
    cl.blk = __builtin_amdgcn_readfirstlane(cl.blk); cl.G = __builtin_amdgcn_readfirstlane(cl.G); cl.ws = (unsigned char*)rfl64((unsigned long long)cl.ws); cl.z = (size_t)rfl64((unsigned long long)cl.z)
constexpr int LDS_RING = 131072;
constexpr int LDS_BYTES = 163840;
constexpr int LDS_MISC = LDS_BYTES - 256;

__device__ __forceinline__ bf16_t* wsb(const Ctx& c, size_t off) { return (bf16_t*)(c.ws + off); }
__device__ __forceinline__ bf16_t* wt(const Ctx& c, size_t eoff) { return (bf16_t*)(c.ws + WS_W) + eoff; }

__device__ __forceinline__ const float* res_rd(const Ctx& c, int l, int R) {
    const int b = R / RPB, j = R % RPB;
    if (j < CTXL) return (l == 0 ? INP(c, I_CTX) : (const float*)(c.ws + WS_HC)) + (size_t)(b * CTXL + j) * DM;
    return (l == 0 ? INP(c, I_X) : (const float*)c.p->out) + (size_t)(b * SEQ + (j - CTXL)) * DM;
}
__device__ __forceinline__ float* res_wr(const Ctx& c, int R) {
    const int b = R / RPB, j = R % RPB;
    if (j < CTXL) return (float*)(c.ws + WS_HC) + (size_t)(b * CTXL + j) * DM;
    return c.p->out + (size_t)(b * SEQ + (j - CTXL)) * DM;
}
__device__ __forceinline__ const float* modvec(const Ctx& c, int l, int R, int which) {
    const int b = R / RPB, j = R % RPB; const int bb = (j < CTXL) ? 16 : b;
    return (const float*)(c.ws + CTL_MOD) + ((size_t)(l * 17 + bb) * 6144 + which * 1024);
}

struct SrcCol { const float* p; int ld; bool ok; };
template <class Map>
__device__ __forceinline__ void cvt_item(const Map& map, const float* kscale, int K, bf16_t* Dst, int nblk_n, LAS float* scr, int item, int lane) {
    const int kb = item / nblk_n, nb = item % nblk_n, k0 = 64 * kb, n0 = 32 * nb;
    const SrcCol s = map(n0 + (lane & 31));
#pragma unroll 8
    for (int i = 0; i < 32; ++i) { const int kk = 2 * i + (lane >> 5); float v = 0.f; if (s.ok) { v = s.p[(size_t)(k0 + kk) * s.ld]; if (kscale) v *= kscale[k0 + kk]; } scr[kk * 33 + (lane & 31)] = v; }
    asm volatile("s_waitcnt lgkmcnt(0)" ::: "memory");
    const int cch = lane & 7;
#pragma unroll
    for (int j = 0; j < 4; ++j) { const int n = (lane >> 3) + 8 * j; const LAS float* sp = scr + (8 * cch) * 33 + n;
        u32x4 o; o.x = pk2(sp[0 * 33], sp[1 * 33]); o.y = pk2(sp[2 * 33], sp[3 * 33]); o.z = pk2(sp[4 * 33], sp[5 * 33]); o.w = pk2(sp[6 * 33], sp[7 * 33]);
        *(u32x4*)(Dst + (size_t)(n0 + n) * K + k0 + 8 * cch) = o; }
    asm volatile("s_waitcnt lgkmcnt(0)" ::: "memory");
}
struct MapLin { const float* W; int ld; int off; __device__ SrcCol operator()(int n) const { return SrcCol{W + off + n, ld, true}; } };
struct MapWin { const float* W; __device__ SrcCol operator()(int n) const {
    int col; bool ok = true;
    if (n < 512) col = 288 + (n & ~63) + ropedim(64, n & 63);
    else if (n < 1024) { const int m = n - 512; col = KV_COLS + 384 + (m & ~63) + ropedim(64, m & 63); }
    else if (n < 1536) col = KV_COLS + 896 + (n - 1024);
    else if (n < 1792) col = n - 1536;
    else if (n < 2176) col = KV_COLS + (n - 1792);
    else if (n < 2208) col = 256 + ropedim(32, n - 2176);
    else { col = 0; ok = false; }
    return SrcCol{W + col, IN_COLS, ok}; } };
struct MapUkv { const float* W; int voff; __device__ SrcCol operator()(int n) const { return SrcCol{W + (n >> 6) * 128 + voff + (n & 63), 1024, true}; } };
struct MapUq { const float* W; __device__ SrcCol operator()(int n) const { const int h = n / 96, p = n % 96; return SrcCol{W + h * 96 + (p < 64 ? p : 64 + ropedim(32, p - 64)), 768, true}; } };
struct MapGU { const float* Wg; const float* Wu; __device__ SrcCol operator()(int n) const { const int pn = n >> 8, r = n & 255; return SrcCol{(r < 128 ? Wg + pn * 128 + r : Wu + pn * 128 + (r - 128)), 256, true}; } };

__device__ __forceinline__ void ph_prologue(const Ctx& c, int l) {
    LAS float* scr = (LAS float*)(c.lds + c.wave * 16384);
    const int gw = c.blk * 8 + c.wave, NGW = c.G * 8;
    const float* w_in = INP(c, I_WIN) + (size_t)l * DM * IN_COLS;
    constexpr int IT0 = 72 * 16, IT1 = 16 * 16, IT2 = 96 * 16, IT3 = 16 * 4, IT4 = 16 * 4, IT5 = 24 * 6, IT6 = 32 * 8, IT7 = 32 * 8, IT8 = 32 * 16, IT9 = 2 * 16;
    constexpr int IT10 = 65 * 16 * 16, IT11 = 65 * 32 * 4, IT12 = 4 * 16 * 16;
    constexpr int NIT = IT0 + IT1 + IT2 + IT3 + IT4 + IT5 + IT6 + IT7 + IT8 + IT9 + IT10 + IT11 + IT12;
    for (int it = gw; it < NIT; it += NGW) {
        int r = it;
        if (r < IT0) { cvt_item(MapWin{w_in}, nullptr, 1024, wt(c, WO_IN), 72, scr, r, c.lane); continue; } r -= IT0;
        if (r < IT1) { cvt_item(MapLin{w_in, IN_COLS, 800}, nullptr, 1024, wt(c, WO_VD), 16, scr, r, c.lane); continue; } r -= IT1;
        if (r < IT2) { cvt_item(MapLin{w_in, IN_COLS, KV_COLS + 1408}, nullptr, 1024, wt(c, WO_G), 96, scr, r, c.lane); continue; } r -= IT2;
        if (r < IT3) { cvt_item(MapUkv{INP(c, I_WUKV) + (size_t)l * 256 * 1024, 0}, INP(c, I_GCKV) + l * 256, 256, wt(c, WO_UK), 16, scr, r, c.lane); continue; } r -= IT3;
        if (r < IT4) { cvt_item(MapUkv{INP(c, I_WUKV) + (size_t)l * 256 * 1024, 64}, INP(c, I_GCKV) + l * 256, 256, wt(c, WO_UV), 16, scr, r, c.lane); continue; } r -= IT4;
        if (r < IT5) { cvt_item(MapUq{INP(c, I_WUQ) + (size_t)l * 384 * 768}, INP(c, I_GCQ) + l * 384, 384, wt(c, WO_UQ), 24, scr, r, c.lane); continue; } r -= IT5;
        if (r < IT6) { cvt_item(MapLin{INP(c, I_WBMLA) + (size_t)l * 512 * 1024, 1024, 0}, nullptr, 512, wt(c, WO_BM), 32, scr, r, c.lane); continue; } r -= IT6;
        if (r < IT7) { cvt_item(MapLin{INP(c, I_WBDIFF) + (size_t)l * 512 * 1024, 1024, 0}, nullptr, 512, wt(c, WO_BD), 32, scr, r, c.lane); continue; } r -= IT7;
        if (r < IT8) { cvt_item(MapLin{INP(c, I_WOUT) + (size_t)l * 1024 * 1024, 1024, 0}, nullptr, 1024, wt(c, WO_O), 32, scr, r, c.lane); continue; } r -= IT8;
        if (r < IT9) { cvt_item(MapLin{INP(c, I_WROUTER) + (size_t)l * 1024 * 64, 64, 0}, nullptr, 1024, wt(c, WO_R), 2, scr, r, c.lane); continue; } r -= IT9;
        if (r < IT10) { const int e = r / 256, ri = r % 256;
            const float* wg = (e < 64) ? INP(c, I_WEGATE) + ((size_t)l * 64 + e) * 262144 : INP(c, I_WSGATE) + (size_t)l * 262144;
            const float* wu = (e < 64) ? INP(c, I_WEUP) + ((size_t)l * 64 + e) * 262144 : INP(c, I_WSUP) + (size_t)l * 262144;
            cvt_item(MapGU{wg, wu}, nullptr, 1024, wt(c, WO_GU) + (size_t)e * 524288, 16, scr, ri, c.lane); continue; } r -= IT10;
        if (r < IT11) { const int e = r / 128, ri = r % 128;
            const float* wd = (e < 64) ? INP(c, I_WEDOWN) + ((size_t)l * 64 + e) * 262144 : INP(c, I_WSDOWN) + (size_t)l * 262144;
            cvt_item(MapLin{wd, 1024, 0}, nullptr, 256, wt(c, WO_D) + (size_t)e * 262144, 32, scr, ri, c.lane); continue; } r -= IT11;
        {
            const int g = r / 256, cb = (r / 16) % 16, db = r % 16, d = db * 64 + c.lane;
            const float* wp = INP(c, I_WPOOL) + ((size_t)l * 4 + g) * 16384 + (size_t)(cb * 8) * 128;
            const float* ps = INP(c, I_PSCALE) + l * 512 + g * 128;
            const float* wb = INP(c, I_WBPOOL) + (size_t)l * 512 * 1024 + (size_t)(g * 128) * 1024 + d;
            float acc[8];
#pragma unroll
            for (int q = 0; q < 8; ++q) acc[q] = 0.f;
            for (int j = 0; j < 128; ++j) { const float bv = wb[(size_t)j * 1024] * ps[j];
#pragma unroll
                for (int q = 0; q < 8; ++q) acc[q] += wp[q * 128 + j] * bv; }
            u32x4 o; o.x = pk2(acc[0], acc[1]); o.y = pk2(acc[2], acc[3]); o.z = pk2(acc[4], acc[5]); o.w = pk2(acc[6], acc[7]);
            *(u32x4*)(wt(c, WO_PP) + (size_t)d * 512 + g * 128 + cb * 8) = o;
        }
    }
    if (l == 0) {
        const int gt = c.blk * 512 + c.tid, NT = c.G * 512;
        f32x2* t64 = (f32x2*)(c.ws + WS_TAB64); f32x2* t32 = (f32x2*)(c.ws + WS_TAB32);
        for (int i = gt; i < 2048 * 32; i += NT) { const int t = i >> 5, Pp = i & 31; const float pos = (float)(Pp < 16 ? (t >> 6) : (t & 63));
            const float inv = powf(10000.f, -(float)(2 * (Pp & 15)) / 32.f); const float a = pos * inv; t64[i] = (f32x2){cosf(a), sinf(a)}; }
        for (int i = gt; i < 2048 * 16; i += NT) { const int t = i >> 4, Pp = i & 15; const float pos = (float)(Pp < 8 ? (t >> 6) : (t & 63));
            const float inv = powf(10000.f, -(float)(2 * (Pp & 7)) / 16.f); const float a = pos * inv; t32[i] = (f32x2){cosf(a), sinf(a)}; }
        __syncthreads();
        if (c.blk < 24) {
            LAS float* sb = (LAS float*)c.lds;
            for (int q = c.tid; q < 17 * 1024; q += 512) { const int b = q >> 10, k = q & 1023; const float v = (b < 16) ? INP(c, I_C)[b * 1024 + k] : INP(c, I_CCTX)[k]; sb[k * 20 + b] = v / (1.f + __expf(-v)); }
            __syncthreads();
            float* MOD = (float*)(c.ws + CTL_MOD);
            const int it = c.blk * 8 + c.wave, ll = it / 96, cb = it % 96, col = cb * 64 + c.lane;
            float acc[17];
#pragma unroll
            for (int b = 0; b < 17; ++b) acc[b] = 0.f;
            const float* wm = INP(c, I_WMOD) + (size_t)ll * 1024 * 6144 + col;
#pragma unroll 8
            for (int k = 0; k < 1024; ++k) { const float w = wm[(size_t)k * 6144];
#pragma unroll
                for (int b = 0; b < 17; ++b) acc[b] += sb[k * 20 + b] * w; }
            const float bias = INP(c, I_BMOD)[ll * 6144 + col];
#pragma unroll
            for (int b = 0; b < 17; ++b) MOD[(size_t)(ll * 17 + b) * 6144 + col] = acc[b] + bias;
        }
    }
}

__device__ __forceinline__ void load_row_f32(const float* row, int lane, f32x4 (&v)[4]) {
#pragma unroll
    for (int j = 0; j < 4; ++j) v[j] = *((const f32x4*)row + lane + 64 * j);
}
__device__ __forceinline__ float row_sumsq(const f32x4 (&v)[4]) {
    float s = 0.f;
#pragma unroll
    for (int j = 0; j < 4; ++j) s += (v[j].x * v[j].x + v[j].y * v[j].y) + (v[j].z * v[j].z + v[j].w * v[j].w);
    return wave_sum(s);
}
__device__ __forceinline__ void norm_mod_store(const f32x4 (&v)[4], float rstd, const float* g, const float* shift, const float* scale, bf16_t* orow, int lane) {
#pragma unroll
    for (int j = 0; j < 4; ++j) { const int o = lane + 64 * j; const f32x4 gg = *((const f32x4*)g + o), sh = *((const f32x4*)shift + o), sc = *((const f32x4*)scale + o);
        const f32x4 y = (v[j] * rstd * gg) * (sc + 1.0f) + sh;
        u32x2 w; w.x = pk2(y.x, y.y); w.y = pk2(y.z, y.w); *((u32x2*)orow + o) = w; }
}
__device__ __forceinline__ void ph_t1(const Ctx& c, int l) {
    const int gw = c.blk * 8 + c.wave, NGW = c.G * 8;
    for (int R = gw; R < NR; R += NGW) {
        f32x4 v[4]; load_row_f32(res_rd(c, l, R), c.lane, v);
        const float rstd = 1.f / sqrtf(row_sumsq(v) * (1.f / DM) + EPSN);
        norm_mod_store(v, rstd, INP(c, I_GPREMIX) + l * DM, modvec(c, l, R, 0), modvec(c, l, R, 1), wsb(c, A_HX) + (size_t)R * DM, c.lane);
    }
}

struct Unit {
    const bf16_t* a;
    const bf16_t* b;
    const unsigned* rows;
    int K, kind, pm, pn, bperm, nrows, aux, aux2;
};
__device__ __forceinline__ int b_srcrow(int q, int bperm) { return (q & ~31) + (bperm ? pos2tok(q & 31) : (q & 31)); }

template <class Sched, class Epi>
__device__ __forceinline__ void gemm_units_naive(const Ctx& c, const Sched& S, const Epi& E) {
    Unit u;
    for (int i = 0; S.next(i, u); ++i) {
        for (int it = c.tid; it < 256 * 16; it += 512) {
            const int row = it >> 4, c8 = (it & 15) * 8;
            const bf16_t* ar;
            if (u.rows) { const int rr = (row < u.nrows) ? (int)(u.rows[row] >> 4) : u.aux2; ar = u.a + (size_t)rr * u.K; } else ar = u.a + (size_t)row * u.K;
            float acc[16];
#pragma unroll
            for (int q = 0; q < 16; ++q) acc[q] = 0.f;
            const bf16_t* br[16];
#pragma unroll
            for (int q = 0; q < 16; ++q) br[q] = u.b + (size_t)b_srcrow((q < 8 ? c8 + q : 128 + c8 + (q - 8)), u.bperm) * u.K;
            for (int k = 0; k < u.K; k += 8) {
                f32x4 alo, ahi; unpack8(*(const u32x4*)(ar + k), alo, ahi);
#pragma unroll
                for (int q = 0; q < 16; ++q) { f32x4 blo, bhi; unpack8(*(const u32x4*)(br[q] + k), blo, bhi);
                    acc[q] += (alo.x * blo.x + alo.y * blo.y) + (alo.z * blo.z + alo.w * blo.w) + (ahi.x * bhi.x + ahi.y * bhi.y) + (ahi.z * bhi.z + ahi.w * bhi.w); }
            }
            E.apply(u, row, c8, (f32x4){acc[0], acc[1], acc[2], acc[3]}, (f32x4){acc[4], acc[5], acc[6], acc[7]}, (f32x4){acc[8], acc[9], acc[10], acc[11]}, (f32x4){acc[12], acc[13], acc[14], acc[15]});
        }
        asm volatile("s_waitcnt vmcnt(0)" ::: "memory");
        __syncthreads();
    }
}

namespace mm {
constexpr int BK = 64, HALF = 128, HTB = HALF * BK * 2;
__device__ __forceinline__ int lds_byte(int r, int c) { const int st = (r >> 4) * 2 + (c >> 5), rr = r & 15, cc = c & 31, ob = rr * 64 + cc * 2; return st * 1024 + (ob ^ (((ob >> 9) & 1) << 5)); }
__device__ __forceinline__ void stage_rc(int b, int& R, int& C) { const int st = b / 1024, sb = b % 1024, swz = sb ^ (((sb >> 9) & 1) << 5); R = (st >> 1) * 16 + swz / 64; C = (st & 1) * 32 + (swz % 64) / 2; }
__device__ __forceinline__ int perm32(int rho) { const int n = rho >> 4, i = rho & 15; return 8 * (i >> 2) + 4 * n + (i & 3); }
__device__ __forceinline__ int permtau(int rho) { const int n = rho >> 4, fq = (rho >> 2) & 3, i = rho & 3; return 16 * (fq >> 1) + 4 * (fq & 1) + 8 * n + i; }
struct LaneOff { unsigned a0[2], a1[2], b[2]; };
__device__ __forceinline__ void lane_offsets(const Unit& u, const unsigned char* ws, int tid, LaneOff& o) {
    int Rl[2], Cl[2];
#pragma unroll
    for (int i = 0; i < 2; ++i) stage_rc(tid * 16 + i * 8192, Rl[i], Cl[i]);
    const unsigned K2 = (unsigned)u.K * 2u; const unsigned ab = (unsigned)((const unsigned char*)u.a - ws), bb = (unsigned)((const unsigned char*)u.b - ws);
#pragma unroll
    for (int i = 0; i < 2; ++i) {
        if (u.rows) { const int r0 = Rl[i], r1 = 128 + Rl[i];
            const unsigned t0 = (r0 < u.nrows) ? (u.rows[r0] >> 4) : (unsigned)u.aux2, t1 = (r1 < u.nrows) ? (u.rows[r1] >> 4) : (unsigned)u.aux2;
            o.a0[i] = ab + t0 * K2 + (unsigned)Cl[i] * 2u; o.a1[i] = ab + t1 * K2 + (unsigned)Cl[i] * 2u; }
        else { o.a0[i] = ab + (unsigned)Rl[i] * K2 + (unsigned)Cl[i] * 2u; o.a1[i] = o.a0[i] + 128u * K2; }
        const int Rb = (Rl[i] & ~31) + (u.bperm ? permtau(Rl[i] & 31) : perm32(Rl[i] & 31));
        o.b[i] = bb + (unsigned)Rb * K2 + (unsigned)Cl[i] * 2u;
    }
}
}

template <class Sched, class Epi>
__device__ __forceinline__ void gemm_units_mfma(const Ctx& c, const Sched& S, const Epi& E) {
    using namespace mm;
    LAS unsigned char* lds = c.lds;
    const int tid = c.tid, wid = c.wave, lane = c.lane, wr = wid >> 2, wc = wid & 3, fr = lane & 15, fq = lane >> 4;
    const unsigned ldsw = (unsigned)wid * 1024u;
    const int aoff = lds_byte(wr * 64 + fr, fq * 8), boff = lds_byte(wc * 32 + fr, fq * 8);
    const unsigned char* wsb_ = c.ws;
#define MM_SA(b, h) (((b) * 2 + (h)) * HTB)
#define MM_SB(b, h) ((4 + (b) * 2 + (h)) * HTB)
#define MM_STAGE(bufoff, o0, o1, kofs) do { const unsigned char* kb_ = wsb_ + (size_t)(kofs);   \
        __builtin_amdgcn_global_load_lds((const unsigned*)(kb_ + (o0)), (LAS unsigned*)(lds + (bufoff) + ldsw), 16, 0, 0); \
        __builtin_amdgcn_global_load_lds((const unsigned*)(kb_ + (o1)), (LAS unsigned*)(lds + (bufoff) + ldsw + 8192), 16, 0, 0); } while (0)
#define MM_LDA(dst, b, h) do { _Pragma("unroll") for (int m = 0; m < 4; ++m) _Pragma("unroll") for (int k = 0; k < 2; ++k) dst[m][k] = *(const LAS bf16x8*)(lds + MM_SA(b, h) + aoff + m * 2048 + k * 1024); } while (0)
#define MM_LDB(dst, b, h) do { _Pragma("unroll") for (int n = 0; n < 2; ++n) _Pragma("unroll") for (int k = 0; k < 2; ++k) dst[n][k] = *(const LAS bf16x8*)(lds + MM_SB(b, h) + boff + n * 2048 + k * 1024); } while (0)
#define MM_MMA(ai, bj, At, Bt) do { __builtin_amdgcn_s_setprio(1); _Pragma("unroll") for (int m = 0; m < 4; ++m) _Pragma("unroll") for (int n = 0; n < 2; ++n) _Pragma("unroll") for (int k = 0; k < 2; ++k) \
        acc[ai][bj][m][n] = __builtin_amdgcn_mfma_f32_16x16x32_bf16(Bt[n][k], At[m][k], acc[ai][bj][m][n], 0, 0, 0); __builtin_amdgcn_s_setprio(0); } while (0)
#define MM_WAIT_V(n) asm volatile("s_waitcnt vmcnt(" #n ")" ::: "memory")
#define MM_WAIT_L(n) asm volatile("s_waitcnt lgkmcnt(" #n ")" ::: "memory")
#define MM_BAR __builtin_amdgcn_s_barrier()
#define MM_SCHED __builtin_amdgcn_sched_barrier(0)
    Unit cur, nxt; int ui = 0;
    if (!S.next(0, cur)) return;
    LaneOff co; lane_offsets(cur, wsb_, tid, co);
    f32x4 acc[2][2][4][2];
#pragma unroll
    for (int a = 0; a < 2; ++a)
#pragma unroll
        for (int b = 0; b < 2; ++b)
#pragma unroll
            for (int m = 0; m < 4; ++m)
#pragma unroll
                for (int n = 0; n < 2; ++n) acc[a][b][m][n] = (f32x4){0.f, 0.f, 0.f, 0.f};
    bf16x8 At[4][2], B0[2][2], B1[2][2];
    {
        const unsigned hs = 256u * (unsigned)cur.K;
        MM_STAGE(MM_SB(0, 0), co.b[0], co.b[1], 0); MM_STAGE(MM_SB(0, 1), co.b[0] + hs, co.b[1] + hs, 0); MM_STAGE(MM_SA(0, 0), co.a0[0], co.a0[1], 0); MM_STAGE(MM_SA(0, 1), co.a1[0], co.a1[1], 0);
        if (wr == 1) MM_BAR;
        MM_WAIT_V(2); MM_BAR;
        MM_STAGE(MM_SB(1, 0), co.b[0], co.b[1], 128); MM_STAGE(MM_SA(1, 0), co.a0[0], co.a0[1], 128); MM_STAGE(MM_SB(1, 1), co.b[0] + hs, co.b[1] + hs, 128);
        MM_WAIT_V(6); MM_BAR;
    }
    for (;;) {
        const bool has_next = S.next(ui + 1, nxt);
        if (!has_next) nxt = cur;
        const int nt = cur.K / BK; unsigned hs = 256u * (unsigned)cur.K;
        for (int t = 0; t < nt; t += 2) {
            const bool last = (t == nt - 2);
            const unsigned k1 = (unsigned)(t + 1) * 128u, k2 = last ? 0u : (unsigned)(t + 2) * 128u; unsigned k3 = k2 + 128u;
            asm volatile("" : "+s"(k3)); k3 = (unsigned)__builtin_amdgcn_readfirstlane((int)k3);
            MM_LDB(B0, 0, 0); MM_LDB(B1, 0, 1); MM_SCHED; MM_LDA(At, 0, 0); MM_STAGE(MM_SA(1, 1), co.a1[0], co.a1[1], k1);
            MM_WAIT_V(8); MM_WAIT_L(0); MM_BAR; MM_MMA(0, 0, At, B0); MM_MMA(0, 1, At, B1); MM_BAR; MM_SCHED;
            if (last) { lane_offsets(nxt, wsb_, tid, co); hs = 256u * (unsigned)nxt.K; }
            MM_LDA(At, 0, 1); MM_STAGE(MM_SB(0, 0), co.b[0], co.b[1], k2); MM_STAGE(MM_SB(0, 1), co.b[0] + hs, co.b[1] + hs, k2); MM_STAGE(MM_SA(0, 0), co.a0[0], co.a0[1], k2);
            MM_WAIT_V(8); MM_WAIT_L(0); MM_BAR; MM_MMA(1, 0, At, B0); MM_MMA(1, 1, At, B1); MM_BAR; MM_SCHED;
            MM_LDB(B0, 1, 0); MM_LDB(B1, 1, 1); MM_SCHED; MM_LDA(At, 1, 0); MM_STAGE(MM_SA(0, 1), co.a1[0], co.a1[1], k2);
            MM_WAIT_V(8); MM_WAIT_L(0); MM_BAR; MM_MMA(0, 0, At, B0); MM_MMA(0, 1, At, B1); MM_BAR; MM_SCHED;
            MM_LDA(At, 1, 1); MM_STAGE(MM_SB(1, 0), co.b[0], co.b[1], k3); MM_STAGE(MM_SB(1, 1), co.b[0] + hs, co.b[1] + hs, k3); MM_STAGE(MM_SA(1, 0), co.a0[0], co.a0[1], k3);
            MM_WAIT_V(8); MM_WAIT_L(0); MM_BAR; MM_MMA(1, 0, At, B0); MM_MMA(1, 1, At, B1); MM_BAR; MM_SCHED;
        }
        if (wr == 0) MM_BAR;
#pragma unroll
        for (int ai = 0; ai < 2; ++ai)
#pragma unroll
            for (int m = 0; m < 4; ++m)
            { int row_ = ai * 128 + wr * 64 + m * 16 + fr, c8_ = wc * 32 + fq * 8; asm volatile("" : "+v"(row_), "+v"(c8_));
              E.apply(cur, row_, c8_, acc[ai][0][m][0], acc[ai][0][m][1], acc[ai][1][m][0], acc[ai][1][m][1]); MM_SCHED; }
        if (!has_next) break;
#pragma unroll
        for (int a = 0; a < 2; ++a)
#pragma unroll
            for (int b = 0; b < 2; ++b)
#pragma unroll
                for (int m = 0; m < 4; ++m)
#pragma unroll
                    for (int n = 0; n < 2; ++n) acc[a][b][m][n] = (f32x4){0.f, 0.f, 0.f, 0.f};
        cur = nxt; ++ui;
        if (wr == 1) MM_BAR;
    }
    MM_WAIT_V(0);
    MM_BAR;
#undef MM_SA
#undef MM_SB
#undef MM_STAGE
#undef MM_LDA
#undef MM_LDB
#undef MM_MMA
#undef MM_WAIT_V
#undef MM_WAIT_L
#undef MM_BAR
#undef MM_SCHED
}

#ifndef USE_MFMA_GEMM
#define USE_MFMA_GEMM 1
#endif
#if USE_MFMA_GEMM
#define GEMM_UNITS gemm_units_mfma
#else
#define GEMM_UNITS gemm_units_naive
#endif

__device__ __forceinline__ void rope4(f32x4& lo, f32x4& hi, const f32x2* cs) {
#pragma unroll
    for (int i = 0; i < 4; ++i) { const f32x2 t = cs[i]; const float a = lo[i], b = hi[i]; lo[i] = a * t.x - b * t.y; hi[i] = a * t.y + b * t.x; }
}

struct SchedProj {
    const Ctx* c; int l, n_main, n_ctx, n_tot;
    __device__ void init(const Ctx* cc, int ll) { c = cc; l = ll; n_main = 128 * 9; n_ctx = 16 * (l == 0 ? 9 : 4); n_tot = n_main + n_ctx + 288; }
    __device__ bool next(int i, Unit& u) const {
        const int L = i * c->G + c->blk; if (L >= n_tot) return false;
        u.rows = nullptr; u.nrows = 256; u.aux = l; u.aux2 = 0; u.K = 1024;
        if (L < n_main + n_ctx) {
            int pm, pn;
            if (L < n_main) { const int lt = L / 9; pn = L % 9; pm = (lt >> 3) * 9 + 1 + (lt & 7); }
            else { const int q = L - n_main; if (l == 0) { pm = (q / 9) * 9; pn = q % 9; } else { pm = (q >> 2) * 9; const int s = q & 3; pn = (s < 2) ? s : (s == 2 ? 6 : 8); } }
            u.pm = pm; u.pn = pn; u.kind = 0; u.bperm = 0;
            u.a = wsb(*c, A_HX) + (size_t)pm * 256 * 1024; u.b = wt(*c, WO_IN) + (size_t)pn * 256 * 1024;
        } else {
            const int q = L - n_main - n_ctx; u.pm = q / 144; u.pn = q % 144; u.kind = 1; u.bperm = 1;
            u.a = wt(*c, WO_VD) + (size_t)u.pm * 256 * 1024; u.b = wsb(*c, A_HX) + (size_t)u.pn * 256 * 1024;
        }
        return true;
    }
};
struct EpiProj {
    const Ctx* c; int l;
    __device__ __forceinline__ void one(const Unit& u, int R, bool lat, int t, int colp, f32x4 lo, f32x4 hi) const {
        const Ctx& C = *c;
        switch (u.pn) {
        case 0: case 1: case 2: case 3: {
            const int col = (u.pn & 1) * 256 + colp;
            if (lat) rope4(lo, hi, (const f32x2*)(C.ws + WS_TAB64) + t * 32 + ((col & 63) >> 3) * 4);
            if (u.pn >= 2) { lo *= C2D; hi *= C2D; }
            *(u32x4*)(wsb(C, u.pn < 2 ? A_KD : A_QD) + (size_t)R * 512 + col) = pack8(lo, hi); break; }
        case 4: case 5: *(u32x4*)(wsb(C, A_PL) + (size_t)R * 512 + (u.pn - 4) * 256 + colp) = pack8(lo, hi); break;
        case 6: { *(u32x4*)(wsb(C, A_CKV) + (size_t)R * 256 + colp) = pack8(lo, hi);
            const float s = (lo.x * lo.x + lo.y * lo.y) + (lo.z * lo.z + lo.w * lo.w) + (hi.x * hi.x + hi.y * hi.y) + (hi.z * hi.z + hi.w * hi.w);
            ss_add((unsigned long long*)(C.ws + CTL_SSKV) + (size_t)l * NR + R, s); break; }
        case 7: { *(u32x4*)(wsb(C, A_CQ) + (size_t)R * 384 + colp) = pack8(lo, hi);
            const float s = (lo.x * lo.x + lo.y * lo.y) + (lo.z * lo.z + lo.w * lo.w) + (hi.x * hi.x + hi.y * hi.y) + (hi.z * hi.z + hi.w * hi.w);
            ss_add((unsigned long long*)(C.ws + CTL_SSQ) + (size_t)l * NR + R, s); break; }
        default: {
            if (colp < 128) { *(u32x4*)(wsb(C, A_CQ) + (size_t)R * 384 + 256 + colp) = pack8(lo, hi);
                const float s = (lo.x * lo.x + lo.y * lo.y) + (lo.z * lo.z + lo.w * lo.w) + (hi.x * hi.x + hi.y * hi.y) + (hi.z * hi.z + hi.w * hi.w);
                ss_add((unsigned long long*)(C.ws + CTL_SSQ) + (size_t)l * NR + R, s); }
            else if (colp < 160) { const int p = colp - 128;
                if (lat) rope4(lo, hi, (const f32x2*)(C.ws + WS_TAB32) + t * 16 + (p >> 3) * 4);
                *(u32x4*)(wsb(C, A_KR) + (size_t)R * 32 + p) = pack8(lo, hi); }
            break; }
        }
    }
    __device__ __forceinline__ void apply(const Unit& u, int row, int c8, f32x4 v0l, f32x4 v0h, f32x4 v1l, f32x4 v1h) const {
        const Ctx& C = *c;
        if (u.kind == 1) {
            bf16_t* o = wsb(C, A_VDT) + (size_t)(u.pm * 256 + row) * NR + (size_t)u.pn * 256;
            *(u32x4*)(o + c8) = pack8(v0l, v0h); *(u32x4*)(o + 128 + c8) = pack8(v1l, v1h); return; }
        const int R = u.pm * 256 + row; const bool lat = (u.pm % 9) != 0; const int t = (R % RPB) - CTXL;
        one(u, R, lat, t, c8, v0l, v0h); one(u, R, lat, t, 128 + c8, v1l, v1h);
    }
};

struct SchedUp {
    const Ctx* c; int l, n_kn, n_vm, n_uq, n_tot;
    __device__ void init(const Ctx* cc, int ll) { c = cc; l = ll; n_kn = 144 * 2; n_vm = 2 * 144; n_uq = (l == 0 ? 144 : 128) * 3; n_tot = n_kn + n_vm + n_uq; }
    __device__ bool next(int i, Unit& u) const {
        const int L = i * c->G + c->blk; if (L >= n_tot) return false;
        u.rows = nullptr; u.nrows = 256; u.aux = l; u.aux2 = 0;
        if (L < n_kn) { u.pm = L >> 1; u.pn = L & 1; u.kind = 0; u.bperm = 0; u.K = 256; u.a = wsb(*c, A_CKV) + (size_t)u.pm * 256 * 256; u.b = wt(*c, WO_UK) + (size_t)u.pn * 256 * 256; }
        else if (L < n_kn + n_vm) { const int q = L - n_kn; u.pm = q / 144; u.pn = q % 144; u.kind = 1; u.bperm = 1; u.K = 256; u.a = wt(*c, WO_UV) + (size_t)u.pm * 256 * 256; u.b = wsb(*c, A_CKV) + (size_t)u.pn * 256 * 256; }
        else { const int q = L - n_kn - n_vm; const int rt = q / 3; u.pn = q % 3; u.pm = (l == 0) ? rt : ((rt >> 3) * 9 + 1 + (rt & 7)); u.kind = 2; u.bperm = 0; u.K = 384;
            u.a = wsb(*c, A_CQ) + (size_t)u.pm * 256 * 384; u.b = wt(*c, WO_UQ) + (size_t)u.pn * 256 * 384; }
        return true;
    }
};
struct EpiUp {
    const Ctx* c; int l;
    __device__ __forceinline__ float rstd_kv(int R) const { return 1.f / sqrtf(ss_get((const unsigned long long*)(c->ws + CTL_SSKV) + (size_t)l * NR + R) * (1.f / 256.f) + EPSN); }
    __device__ __forceinline__ void apply(const Unit& u, int row, int c8, f32x4 v0l, f32x4 v0h, f32x4 v1l, f32x4 v1h) const {
        const Ctx& C = *c;
        if (u.kind == 0) { const int R = u.pm * 256 + row; const float rs = rstd_kv(R);
            bf16_t* o = wsb(C, A_KN) + (size_t)R * 512 + u.pn * 256;
            *(u32x4*)(o + c8) = pack8(v0l * rs, v0h * rs); *(u32x4*)(o + 128 + c8) = pack8(v1l * rs, v1h * rs); }
        else if (u.kind == 1) {
            bf16_t* o = wsb(C, A_VMT) + (size_t)(u.pm * 256 + row) * NR + (size_t)u.pn * 256;
#pragma unroll
            for (int h = 0; h < 2; ++h) { const int q0 = h * 128 + c8; f32x4 lo = h ? v1l : v0l, hi = h ? v1h : v0h;
#pragma unroll
                for (int i = 0; i < 4; ++i) { lo[i] *= rstd_kv(u.pn * 256 + (q0 & ~31) + pos2tok((q0 & 31) + i)); hi[i] *= rstd_kv(u.pn * 256 + (q0 & ~31) + pos2tok((q0 & 31) + 4 + i)); }
                *(u32x4*)(o + q0) = pack8(lo, hi); } }
        else { const int R = u.pm * 256 + row; const bool lat = (u.pm % 9) != 0; const int t = (R % RPB) - CTXL;
            const float rs = C2M / sqrtf(ss_get((const unsigned long long*)(C.ws + CTL_SSQ) + (size_t)l * NR + R) * (1.f / 384.f) + EPSN);
#pragma unroll
            for (int h = 0; h < 2; ++h) { const int col = u.pn * 256 + h * 128 + c8; const int p = col % 96; f32x4 lo = h ? v1l : v0l, hi = h ? v1h : v0h;
                if (lat && p >= 64) rope4(lo, hi, (const f32x2*)(C.ws + WS_TAB32) + t * 16 + ((p - 64) >> 3) * 4);
                *(u32x4*)(wsb(C, A_QM) + (size_t)R * 768 + col) = pack8(lo * rs, hi * rs); } }
    }
};
__device__ __forceinline__ void ph_pool(const Ctx& c, int l) {
    LAS bf16_t* tile = (LAS bf16_t*)c.lds;
    const int nitems = 16 * 32 + (l == 0 ? 16 * 4 : 0);
    for (int it = c.blk; it < nitems; it += c.G) {
        int b, s0, n, rbase;
        if (it < 512) { b = it >> 5; s0 = (it & 31) * 64; n = SEQ; rbase = b * RPB + CTXL; } else { const int q = it - 512; b = q >> 2; s0 = (q & 3) * 64; n = CTXL; rbase = b * RPB; }
        __syncthreads();
        for (int q = c.tid; q < 80 * 64; q += 512) { const int rr = q >> 6, ch = q & 63; const int t = s0 - 8 + rr;
            u32x4 v = (u32x4){0u, 0u, 0u, 0u}; if (t >= 0 && t < n) v = *(const u32x4*)(wsb(c, A_PL) + (size_t)(rbase + t) * 512 + ch * 8);
            *(LAS u32x4*)(tile + rr * 512 + ch * 8) = v; }
        __syncthreads();
        const int ch = c.tid & 63, g = ch >> 4, w = 2 << g;
        for (int rr = c.tid >> 6; rr < 64; rr += 8) { const int t = s0 + rr; const int lo = max(t - w / 2, 0), hi = min(t + w / 2, n);
            float acc[8];
#pragma unroll
            for (int q = 0; q < 8; ++q) acc[q] = 0.f;
            for (int j = lo; j < hi; ++j) { f32x4 a, bq; unpack8(*(const LAS u32x4*)(tile + (j - s0 + 8) * 512 + ch * 8), a, bq);
                acc[0] += a.x; acc[1] += a.y; acc[2] += a.z; acc[3] += a.w; acc[4] += bq.x; acc[5] += bq.y; acc[6] += bq.z; acc[7] += bq.w; }
            f32x4 xa, xb; unpack8(*(const LAS u32x4*)(tile + (rr + 8) * 512 + ch * 8), xa, xb);
            const float inv = 1.f / (float)(hi - lo);
            const f32x4 oa = (f32x4){acc[0], acc[1], acc[2], acc[3]} * inv - xa, ob = (f32x4){acc[4], acc[5], acc[6], acc[7]} * inv - xb;
            *(u32x4*)(wsb(c, A_PD) + (size_t)(rbase + t) * 512 + ch * 8) = pack8(oa, ob); }
    }
    __syncthreads();
}

__device__ __forceinline__ float lam_of(const Ctx& c, int l) {
    float s1 = 0.f, s2 = 0.f;
    for (int i = 0; i < 64; ++i) { s1 += INP(c, I_LQ1)[l * 64 + i] * INP(c, I_LK1)[l * 64 + i]; s2 += INP(c, I_LQ2)[l * 64 + i] * INP(c, I_LK2)[l * 64 + i]; }
    const float lam_init = 0.8f - 0.6f * expf(-0.3f * (float)l);
    return expf(s1) - expf(s2) + lam_init;
}
__device__ __forceinline__ void ph_attn_naive(const Ctx& c, int l) {
    const long gt = (long)c.blk * 512 + c.tid, NT = (long)c.G * 512;
    for (long it = gt; it < (long)NR * 16; it += NT) {
        const int dc = (int)(it & 1), h = (int)((it >> 1) & 7), R = (int)(it >> 4);
        const int b = R / RPB, j = R % RPB; const bool lat = j >= CTXL;
        if (!lat && l != 0) continue;
        const int nk = lat ? RPB : CTXL; const int kb = b * RPB;
        const bf16_t* qp = wsb(c, A_QM) + (size_t)R * 768 + h * 96;
        float m = -INFINITY, ls = 0.f, o[32];
#pragma unroll
        for (int i = 0; i < 32; ++i) o[i] = 0.f;
        for (int k = 0; k < nk; ++k) {
            const int Rk = kb + k; const bf16_t* kp = wsb(c, A_KN) + (size_t)Rk * 512 + h * 64; const bf16_t* rp = wsb(c, A_KR) + (size_t)Rk * 32;
            float s = 0.f;
            for (int i = 0; i < 96; i += 8) { f32x4 qa, qb, ka, kbb; unpack8(*(const u32x4*)(qp + i), qa, qb); unpack8(*(const u32x4*)(i < 64 ? kp + i : rp + (i - 64)), ka, kbb);
                s += (qa.x * ka.x + qa.y * ka.y) + (qa.z * ka.z + qa.w * ka.w) + (qb.x * kbb.x + qb.y * kbb.y) + (qb.z * kbb.z + qb.w * kbb.w); }
            const float mn = fmaxf(m, s), f = exp2f(m - mn), pv = exp2f(s - mn);
            ls = ls * f + pv; m = mn;
            const size_t vcol = (size_t)(Rk & ~31) + tok2pos(Rk & 31);
            const float pb = bf2f((unsigned short)f2bf(pv));
#pragma unroll
            for (int i = 0; i < 32; ++i) o[i] = o[i] * f + pb * bf2f(wsb(c, A_VMT)[(size_t)(h * 64 + dc * 32 + i) * NR + vcol]);
        }
        const float inv = 1.f / ls;
        bf16_t* op = wsb(c, A_OM) + (size_t)R * 512 + h * 64 + dc * 32;
#pragma unroll
        for (int i = 0; i < 32; i += 2) *(unsigned*)(op + i) = pk2(o[i] * inv, o[i + 1] * inv);
    }
    const float lam = lam_of(c, l); const float lam_init = 0.8f - 0.6f * expf(-0.3f * (float)l);
    for (long it = gt; it < (long)NR * 32; it += NT) {
        const int dc = (int)(it & 7), h = (int)((it >> 3) & 3), R = (int)(it >> 5);
        const int b = R / RPB, j = R % RPB; const bool lat = j >= CTXL;
        const bool act = lat || l == 0;
        const int nk = act ? (lat ? RPB : CTXL) : 0; const int kb = b * RPB;
        const bf16_t* qp = wsb(c, A_QD) + (size_t)R * 512 + h * 128;
        float m0 = -INFINITY, m1 = -INFINITY, l0 = 0.f, l1 = 0.f, o0[16], o1[16];
#pragma unroll
        for (int i = 0; i < 16; ++i) { o0[i] = 0.f; o1[i] = 0.f; }
        for (int k = 0; k < nk; ++k) {
            const int Rk = kb + k; const bf16_t* kp = wsb(c, A_KD) + (size_t)Rk * 512 + h * 128;
            float s0 = 0.f, s1 = 0.f;
#pragma unroll 2
            for (int i = 0; i < 64; i += 8) { f32x4 qa, qb, ka, kbb; unpack8(*(const u32x4*)(qp + i), qa, qb); unpack8(*(const u32x4*)(kp + i), ka, kbb);
                s0 += (qa.x * ka.x + qa.y * ka.y) + (qa.z * ka.z + qa.w * ka.w) + (qb.x * kbb.x + qb.y * kbb.y) + (qb.z * kbb.z + qb.w * kbb.w);
                unpack8(*(const u32x4*)(qp + 64 + i), qa, qb); unpack8(*(const u32x4*)(kp + 64 + i), ka, kbb);
                s1 += (qa.x * ka.x + qa.y * ka.y) + (qa.z * ka.z + qa.w * ka.w) + (qb.x * kbb.x + qb.y * kbb.y) + (qb.z * kbb.z + qb.w * kbb.w); }
            const float mn0 = fmaxf(m0, s0), f0 = exp2f(m0 - mn0), p0 = exp2f(s0 - mn0); l0 = l0 * f0 + p0; m0 = mn0;
            const float mn1 = fmaxf(m1, s1), f1 = exp2f(m1 - mn1), p1 = exp2f(s1 - mn1); l1 = l1 * f1 + p1; m1 = mn1;
            const size_t vcol = (size_t)(Rk & ~31) + tok2pos(Rk & 31);
            const float pb0 = bf2f((unsigned short)f2bf(p0)), pb1 = bf2f((unsigned short)f2bf(p1));
#pragma unroll
            for (int i = 0; i < 16; ++i) { const float v = bf2f(wsb(c, A_VDT)[(size_t)(h * 128 + dc * 16 + i) * NR + vcol]); o0[i] = o0[i] * f0 + pb0 * v; o1[i] = o1[i] * f1 + pb1 * v; }
        }
        float ss = 0.f; const float i0 = act ? 1.f / l0 : 0.f, i1 = act ? lam / l1 : 0.f;
#pragma unroll
        for (int i = 0; i < 16; ++i) { o0[i] = o0[i] * i0 - o1[i] * i1; ss += o0[i] * o0[i]; }
        ss += __shfl_xor(ss, 1); ss += __shfl_xor(ss, 2); ss += __shfl_xor(ss, 4);
        const float rs = (1.f - lam_init) / sqrtf(ss * (1.f / 128.f) + EPSN);
        if (act) { bf16_t* op = wsb(c, A_QD) + (size_t)R * 512 + h * 128 + dc * 16; const float* g = INP(c, I_GSUBLN) + l * 128 + dc * 16;
#pragma unroll
            for (int i = 0; i < 16; i += 2) *(unsigned*)(op + i) = pk2(o0[i] * rs * g[i], o0[i + 1] * rs * g[i + 1]); }
    }
}


typedef float f32x16 __attribute__((ext_vector_type(16)));
template <bool DIFF>
__device__ __forceinline__ void attn_unit(const Ctx& c, int l, int b, int h, int q0  , int nk  , float lam, float lam_init) {
    constexpr int DQ = DIFF ? 64 : 96, DV = DIFF ? 128 : 64, NCK = DIFF ? 16 : 12  , KB = NCK * 1024, VB = 8 * DV * 16, SLOT = KB + VB;
    constexpr int NDS = DQ / 16, NDB = DV / 32;
    static_assert(3 * SLOT + 8 * 512 + (DIFF ? 0 : 32768) <= LDS_MISC && (!DIFF || 65536 <= 3 * SLOT), "attention LDS map");
    LAS unsigned char* lds = c.lds;
    const int lane = c.lane, wid = c.wave, r32 = lane & 31, hi = lane >> 5;
    const int map = DIFF ? (wid >> 2) : 0, wq = DIFF ? (wid & 3) : wid;
    const int kb = b * RPB, NT = nk / 64;
    LAS float* wsf = (LAS float*)(lds + 3 * SLOT + wid * 512);
    const bf16_t* ksrc0; const bf16_t* ksrc1; const bf16_t* vsrc0; const bf16_t* vsrc1; size_t kstep0, kstep1; unsigned kd0, kd1, vd0, vd1; bool has_k1;
    if constexpr (DIFF) {
        ksrc0 = wsb(c, A_KD) + (size_t)(kb + lane) * 512 + h * 128 + wid * 8; ksrc1 = ksrc0 + 64; kstep0 = kstep1 = (size_t)64 * 512; kd0 = wid * 1024; kd1 = (wid + 8) * 1024; has_k1 = true;
        vsrc0 = wsb(c, A_VDT) + (size_t)(h * 128 + lane) * NR + kb + wid * 8; vsrc1 = vsrc0 + (size_t)64 * NR; vd0 = KB + (wid * DV + lane) * 16; vd1 = KB + (wid * DV + 64 + lane) * 16;
    } else {
        ksrc0 = wsb(c, A_KN) + (size_t)(kb + lane) * 512 + h * 64 + wid * 8; kstep0 = (size_t)64 * 512; kd0 = wid * 1024;
        ksrc1 = wsb(c, A_KR) + (size_t)(kb + lane) * 32 + (wid & 3) * 8; kstep1 = (size_t)64 * 32; kd1 = (8 + (wid & 3)) * 1024; has_k1 = wid < 4;
        vsrc0 = wsb(c, A_VMT) + (size_t)(h * 64 + lane) * NR + kb + wid * 8; vsrc1 = vsrc0; vd0 = KB + (wid * DV + lane) * 16; vd1 = vd0;
    }
    const unsigned kdb0 = kd0, kdb1 = kd1, vdb0 = DIFF ? (KB + wid * DV * 16) : (KB + wid * DV * 16), vdb1 = KB + (wid * DV + 64) * 16;
    (void)vd0; (void)vd1;
#define AT_DMA(t, slot) do { const unsigned so_ = (unsigned)(slot) * SLOT; \
        __builtin_amdgcn_global_load_lds((const unsigned*)(ksrc0 + (size_t)(t) * kstep0), (LAS unsigned*)(lds + so_ + kdb0), 16, 0, 0); \
        if (has_k1) __builtin_amdgcn_global_load_lds((const unsigned*)(ksrc1 + (size_t)(t) * kstep1), (LAS unsigned*)(lds + so_ + kdb1), 16, 0, 0); \
        __builtin_amdgcn_global_load_lds((const unsigned*)(vsrc0 + (size_t)(t) * 64), (LAS unsigned*)(lds + so_ + vdb0), 16, 0, 0); \
        if (DIFF) __builtin_amdgcn_global_load_lds((const unsigned*)(vsrc1 + (size_t)(t) * 64), (LAS unsigned*)(lds + so_ + vdb1), 16, 0, 0); } while (0)
#define AT_WAIT1() do { if (DIFF) asm volatile("s_waitcnt vmcnt(4)" ::: "memory"); else if (has_k1) asm volatile("s_waitcnt vmcnt(3)" ::: "memory"); else asm volatile("s_waitcnt vmcnt(2)" ::: "memory"); } while (0)
    const int qrow = q0 + wq * 32 + r32;
    const bf16_t* qp = DIFF ? (wsb(c, A_QD) + (size_t)qrow * 512 + h * 128 + map * 64) : (wsb(c, A_QM) + (size_t)qrow * 768 + h * 96);
    bf16x8 qr[NDS];
#pragma unroll
    for (int ds = 0; ds < NDS; ++ds) qr[ds] = *(const bf16x8*)(qp + ds * 16 + hi * 8);
    AT_DMA(0, 0); if (NT > 1) AT_DMA(1, 1);
    f32x16 o[NDB];
#pragma unroll
    for (int d = 0; d < NDB; ++d) o[d] = f32x16{};
    float mhat = 0.f, lsum = 0.f; f32x16 negm = f32x16{};
    const int kchunk0 = DIFF ? map * 8 : 0;
    int slot = 0;
    for (int t = 0; t < NT; ++t) {
        if (t + 1 < NT) AT_WAIT1(); else asm volatile("s_waitcnt vmcnt(0)" ::: "memory");
        asm volatile("s_barrier" ::: "memory");
        if (t + 2 < NT) { const int s2 = (slot >= 1) ? slot - 1 : 2; AT_DMA(t + 2, s2); }
        const LAS unsigned char* ks = lds + slot * SLOT; const LAS unsigned char* vs = ks + KB;
        f32x16 p0 = negm, p1 = negm;
#pragma unroll
        for (int ds = 0; ds < NDS; ++ds) {
            const bf16x8 k0 = *(const LAS bf16x8*)(ks + ((kchunk0 + 2 * ds + hi) * 64 + r32) * 16);
            const bf16x8 k1 = *(const LAS bf16x8*)(ks + ((kchunk0 + 2 * ds + hi) * 64 + 32 + r32) * 16);
            p0 = __builtin_amdgcn_mfma_f32_32x32x16_bf16(k0, qr[ds], p0, 0, 0, 0);
            p1 = __builtin_amdgcn_mfma_f32_32x32x16_bf16(k1, qr[ds], p1, 0, 0, 0);
        }
        float rm = fmaxf(p0[0], p1[0]);
#pragma unroll
        for (int r = 1; r < 16; ++r) rm = fmaxf(rm, fmaxf(p0[r], p1[r]));
        rm = fmaxf(rm, __shfl_xor(rm, 32));
        const bool first = (t == 0);
        if (first || __any(rm > 8.0f)) {
            const float dl = first ? rm : fmaxf(rm, 0.f);
            mhat += dl;
#pragma unroll
            for (int r = 0; r < 16; ++r) { p0[r] -= dl; p1[r] -= dl; negm[r] = -mhat; }
            if (!first) {
                const float f = __builtin_amdgcn_exp2f(-dl); lsum *= f;
                if (hi == 0) wsf[r32] = f;
                asm volatile("s_waitcnt lgkmcnt(0)" ::: "memory");
#pragma unroll
                for (int r = 0; r < 16; ++r) { const float fr_ = wsf[(r & 3) + 8 * (r >> 2) + 4 * hi];
#pragma unroll
                    for (int d = 0; d < NDB; ++d) o[d][r] *= fr_; }
            }
        }
        float sacc = 0.f;
#pragma unroll
        for (int r = 0; r < 16; ++r) { p0[r] = __builtin_amdgcn_exp2f(p0[r]); p1[r] = __builtin_amdgcn_exp2f(p1[r]); sacc += p0[r] + p1[r]; }
        lsum += sacc;
        bf16x8 pa[4];
        { u32x4 w;
          w.x = pk2(p0[0], p0[1]); w.y = pk2(p0[2], p0[3]); w.z = pk2(p0[4], p0[5]); w.w = pk2(p0[6], p0[7]); pa[0] = __builtin_bit_cast(bf16x8, w);
          w.x = pk2(p0[8], p0[9]); w.y = pk2(p0[10], p0[11]); w.z = pk2(p0[12], p0[13]); w.w = pk2(p0[14], p0[15]); pa[1] = __builtin_bit_cast(bf16x8, w);
          w.x = pk2(p1[0], p1[1]); w.y = pk2(p1[2], p1[3]); w.z = pk2(p1[4], p1[5]); w.w = pk2(p1[6], p1[7]); pa[2] = __builtin_bit_cast(bf16x8, w);
          w.x = pk2(p1[8], p1[9]); w.y = pk2(p1[10], p1[11]); w.z = pk2(p1[12], p1[13]); w.w = pk2(p1[14], p1[15]); pa[3] = __builtin_bit_cast(bf16x8, w); }
#pragma unroll
        for (int d = 0; d < NDB; ++d)
#pragma unroll
            for (int s4 = 0; s4 < 4; ++s4) {
                const bf16x8 vf = *(const LAS bf16x8*)(vs + ((2 * s4 + hi) * DV + d * 32 + r32) * 16);
                o[d] = __builtin_amdgcn_mfma_f32_32x32x16_bf16(pa[s4], vf, o[d], 0, 0, 0);
            }
        slot = (slot == 2) ? 0 : slot + 1;
    }
    lsum += __shfl_xor(lsum, 32);
    if (hi == 0) wsf[32 + r32] = lsum;
    asm volatile("s_waitcnt lgkmcnt(0)" ::: "memory");
    float rl[16];
#pragma unroll
    for (int r = 0; r < 16; ++r) rl[r] = 1.f / wsf[32 + (r & 3) + 8 * (r >> 2) + 4 * hi];
    LAS unsigned char* xch = DIFF ? lds : lds + 3 * SLOT + 8 * 512;
    asm volatile("s_barrier" ::: "memory");
    if constexpr (DIFF) {
        LAS float* x1 = (LAS float*)xch + wq * 4096;
        if (map == 1) {
#pragma unroll
            for (int d = 0; d < NDB; ++d)
#pragma unroll
                for (int r = 0; r < 16; ++r) x1[((r & 3) + 8 * (r >> 2) + 4 * hi) * 128 + d * 32 + r32] = o[d][r] * rl[r] * lam;
        }
        asm volatile("s_waitcnt lgkmcnt(0)\n\ts_barrier" ::: "memory");
        if (map == 0) {
            float ss[16];
#pragma unroll
            for (int r = 0; r < 16; ++r) ss[r] = 0.f;
#pragma unroll
            for (int d = 0; d < NDB; ++d)
#pragma unroll
                for (int r = 0; r < 16; ++r) { const float v = o[d][r] * rl[r] - x1[((r & 3) + 8 * (r >> 2) + 4 * hi) * 128 + d * 32 + r32]; o[d][r] = v; ss[r] += v * v; }
#pragma unroll
            for (int r = 0; r < 16; ++r) { float v = ss[r]; v += __shfl_xor(v, 1); v += __shfl_xor(v, 2); v += __shfl_xor(v, 4); v += __shfl_xor(v, 8); v += __shfl_xor(v, 16); ss[r] = (1.f - lam_init) / sqrtf(v * (1.f / 128.f) + EPSN); }
            float g[NDB];
#pragma unroll
            for (int d = 0; d < NDB; ++d) g[d] = INP(c, I_GSUBLN)[l * 128 + d * 32 + r32];
            asm volatile("s_waitcnt lgkmcnt(0)" ::: "memory");
            LAS bf16_t* stg = (LAS bf16_t*)x1;
#pragma unroll
            for (int d = 0; d < NDB; ++d)
#pragma unroll
                for (int r = 0; r < 16; ++r) stg[((r & 3) + 8 * (r >> 2) + 4 * hi) * 128 + d * 32 + r32] = (bf16_t)f2bf(o[d][r] * ss[r] * g[d]);
            asm volatile("s_waitcnt lgkmcnt(0)" ::: "memory");
            bf16_t* op = wsb(c, A_QD) + (size_t)(q0 + wq * 32) * 512 + h * 128;
#pragma unroll
            for (int i = 0; i < 8; ++i) { const int row = i * 4 + (lane >> 4), ch = lane & 15; *(u32x4*)(op + (size_t)row * 512 + ch * 8) = *(const LAS u32x4*)(stg + row * 128 + ch * 8); }
        }
        asm volatile("s_waitcnt lgkmcnt(0)\n\ts_barrier" ::: "memory");
    } else {
        LAS bf16_t* stg = (LAS bf16_t*)xch + wid * 2048;
#pragma unroll
        for (int d = 0; d < NDB; ++d)
#pragma unroll
            for (int r = 0; r < 16; ++r) stg[((r & 3) + 8 * (r >> 2) + 4 * hi) * 64 + d * 32 + r32] = (bf16_t)f2bf(o[d][r] * rl[r]);
        asm volatile("s_waitcnt lgkmcnt(0)" ::: "memory");
        bf16_t* op = wsb(c, A_OM) + (size_t)(q0 + wid * 32) * 512 + h * 64;
#pragma unroll
        for (int i = 0; i < 4; ++i) { const int row = i * 8 + (lane >> 3), ch = lane & 7; *(u32x4*)(op + (size_t)row * 512 + ch * 8) = *(const LAS u32x4*)(stg + row * 64 + ch * 8); }
        asm volatile("s_waitcnt lgkmcnt(0)" ::: "memory");
    }
#undef AT_DMA
#undef AT_WAIT1
}
__device__ __forceinline__ void ph_attn_fast(const Ctx& c, int l) {
    const float lam = lam_of(c, l), lam_init = 0.8f - 0.6f * expf(-0.3f * (float)l);
    const int n_mla = 1024 + (l == 0 ? 128 : 0);
    for (int u = c.blk; u < n_mla; u += c.G) {
        if (u < 1024) { const int b = u >> 6, h = (u >> 3) & 7, qt = u & 7; attn_unit<false>(c, l, b, h, b * RPB + CTXL + qt * 256, RPB, lam, lam_init); }
        else { const int q = u - 1024, b = q >> 3, h = q & 7; attn_unit<false>(c, l, b, h, b * RPB, CTXL, lam, lam_init); }
    }
    const int n_diff = 1024 + (l == 0 ? 128 : 0);
    for (int u = c.blk; u < n_diff; u += c.G) {
        if (u < 1024) { const int b = u >> 6, h = (u >> 4) & 3, qt = u & 15; attn_unit<true>(c, l, b, h, b * RPB + CTXL + qt * 128, RPB, lam, lam_init); }
        else { const int q = u - 1024, b = q >> 3, h = (q >> 1) & 3, qt = q & 1; attn_unit<true>(c, l, b, h, b * RPB + qt * 128, CTXL, lam, lam_init); }
    }
}

struct SchedMerge1 {
    const Ctx* c; int l, n_units;
    __device__ void init(const Ctx* cc, int ll) { c = cc; l = ll; n_units = (l == 0 ? 144 : 128) * 4; }
    __device__ bool next(int i, Unit& u) const {
        const int U = (i / 6) * c->G + c->blk, pass = i % 6; if (U >= n_units) return false;
        const int rt = U >> 2; u.pn = U & 3; u.pm = (l == 0) ? rt : ((rt >> 3) * 9 + 1 + (rt & 7));
        u.rows = nullptr; u.nrows = 256; u.aux = l; u.aux2 = 0; u.bperm = 0; u.kind = pass;
        const int br = pass >> 1;
        if ((pass & 1) == 0) { u.K = 1024; u.a = wsb(*c, A_HX) + (size_t)u.pm * 256 * 1024; u.b = wt(*c, WO_G) + (size_t)(br * 1024 + u.pn * 256) * 1024; }
        else { u.K = 512; u.a = wsb(*c, br == 0 ? A_OM : (br == 1 ? A_PD : A_QD)) + (size_t)u.pm * 256 * 512;
               u.b = wt(*c, br == 0 ? WO_BM : (br == 1 ? WO_PP : WO_BD)) + (size_t)u.pn * 256 * 512; }
        return true;
    }
};
struct EpiMerge1 {
    const Ctx* c;
    __device__ __forceinline__ void apply(const Unit& u, int row, int c8, f32x4 v0l, f32x4 v0h, f32x4 v1l, f32x4 v1h) const {
        const Ctx& C = *c;
        bf16_t* sg = (bf16_t*)(C.ws + A_SCR + (size_t)C.blk * 262144); bf16_t* st = sg + 65536;
#pragma unroll
        for (int h = 0; h < 2; ++h) { const int q0 = h * 128 + c8; f32x4 lo = h ? v1l : v0l, hi = h ? v1h : v0h; const size_t so = (size_t)row * 256 + q0;
            if ((u.kind & 1) == 0) {
#pragma unroll
                for (int i = 0; i < 4; ++i) { lo[i] = sigmoidf_(lo[i]); hi[i] = sigmoidf_(hi[i]); }
                *(u32x4*)(sg + so) = pack8(lo, hi);
            } else {
                f32x4 gl, gh; unpack8(*(const u32x4*)(sg + so), gl, gh); lo *= gl; hi *= gh;
                if (u.kind > 1) { f32x4 tl, th; unpack8(*(const u32x4*)(st + so), tl, th); lo += tl; hi += th; }
                if (u.kind < 5) *(u32x4*)(st + so) = pack8(lo, hi);
                else *(u32x4*)(wsb(C, A_MG) + (size_t)(u.pm * 256 + row) * 1024 + u.pn * 256 + q0) = pack8(lo, hi);
            } }
    }
};
struct SchedMerge2 {
    const Ctx* c; int l, n_units;
    __device__ void init(const Ctx* cc, int ll) { c = cc; l = ll; n_units = (l == 0 ? 144 : 128) * 4; }
    __device__ bool next(int i, Unit& u) const {
        const int U = i * c->G + c->blk; if (U >= n_units) return false;
        const int rt = U >> 2; u.pn = U & 3; u.pm = (l == 0) ? rt : ((rt >> 3) * 9 + 1 + (rt & 7));
        u.rows = nullptr; u.nrows = 256; u.aux = l; u.aux2 = 0; u.bperm = 0; u.kind = 0; u.K = 1024;
        u.a = wsb(*c, A_MG) + (size_t)u.pm * 256 * 1024; u.b = wt(*c, WO_O) + (size_t)u.pn * 256 * 1024; return true;
    }
};
struct EpiMerge2 {
    const Ctx* c;
    __device__ __forceinline__ void apply(const Unit& u, int row, int c8, f32x4 v0l, f32x4 v0h, f32x4 v1l, f32x4 v1h) const {
        bf16_t* o = wsb(*c, A_Y1) + (size_t)(u.pm * 256 + row) * 1024 + u.pn * 256;
        *(u32x4*)(o + c8) = pack8(v0l, v0h); *(u32x4*)(o + 128 + c8) = pack8(v1l, v1h);
    }
};

__device__ __forceinline__ void ph_t4_router(const Ctx& c, int l) {
    LAS bf16_t* wr = (LAS bf16_t*)c.lds; constexpr int WRP = 1032;
    for (int q = c.tid; q < 64 * 128; q += 512) { const int e = q >> 7, ch = q & 127; *(LAS u32x4*)(wr + e * WRP + ch * 8) = *(const u32x4*)(wt(c, WO_R) + (size_t)e * 1024 + ch * 8); }
    LAS unsigned* hist = (LAS unsigned*)(c.lds + 64 * WRP * 2 + c.wave * 512);
    LAS unsigned* stash = (LAS unsigned*)(c.lds + 64 * WRP * 2 + 4096 + c.wave * 2048);
    static_assert(64 * WRP * 2 + 4096 + 8 * 2048 <= LDS_MISC, "router LDS map");
    __syncthreads();
    const int gw = c.blk * 8 + c.wave, NGW = c.G * 8;
    const int r32 = c.lane & 31, hi = c.lane >> 5;
    unsigned* CNT = (unsigned*)(c.ws + CTL_CNT);
    for (int g = gw; g < NR / 32; g += NGW) {
        const int R0 = g * 32; const bool lat = (R0 % RPB) >= CTXL;
        if (!lat && l != 0) continue;
#pragma unroll 1
        for (int rr = 0; rr < 32; ++rr) { const int R = R0 + rr;
            u32x2 yw[4]; const bf16_t* yp = wsb(c, A_Y1) + (size_t)R * 1024;
#pragma unroll
            for (int j = 0; j < 4; ++j) yw[j] = *((const u32x2*)yp + c.lane + 64 * j);
            f32x4 y[4];
#pragma unroll
            for (int j = 0; j < 4; ++j) y[j] = (f32x4){bflo(yw[j].x), bfhi(yw[j].x), bflo(yw[j].y), bfhi(yw[j].y)};
            const float rs1 = 1.f / sqrtf(row_sumsq(y) * (1.f / DM) + EPSN);
            f32x4 h[4]; load_row_f32(res_rd(c, l, R), c.lane, h);
            const float* g1 = INP(c, I_GPOSTMIX) + l * DM; const float* m2 = modvec(c, l, R, 2);
#pragma unroll
            for (int j = 0; j < 4; ++j) { const int o = c.lane + 64 * j; h[j] += *((const f32x4*)m2 + o) * (y[j] * rs1 * *((const f32x4*)g1 + o)); }
            float* hw = res_wr(c, R);
#pragma unroll
            for (int j = 0; j < 4; ++j) *((f32x4*)hw + c.lane + 64 * j) = h[j];
            const float rs2 = 1.f / sqrtf(row_sumsq(h) * (1.f / DM) + EPSN);
            norm_mod_store(h, rs2, INP(c, I_GPREFFN) + l * DM, modvec(c, l, R, 3), modvec(c, l, R, 4), wsb(c, A_HX) + (size_t)R * DM, c.lane);
        }
        asm volatile("s_waitcnt vmcnt(0)" ::: "memory");
        typedef float f32x16 __attribute__((ext_vector_type(16)));
        f32x16 a0 = {}, a1 = {};
        const bf16_t* fxp = wsb(c, A_HX) + (size_t)(R0 + r32) * 1024 + hi * 8;
#pragma unroll 4
        for (int s = 0; s < 64; ++s) {
            const bf16x8 bq = *(const bf16x8*)(fxp + s * 16);
            const bf16x8 w0 = *(const LAS bf16x8*)(wr + r32 * WRP + s * 16 + hi * 8), w1 = *(const LAS bf16x8*)(wr + (32 + r32) * WRP + s * 16 + hi * 8);
            a0 = __builtin_amdgcn_mfma_f32_32x32x16_bf16(w0, bq, a0, 0, 0, 0); a1 = __builtin_amdgcn_mfma_f32_32x32x16_bf16(w1, bq, a1, 0, 0, 0);
        }
        float sel[64];
        const float* br = INP(c, I_BROUTER) + l * 64;
#pragma unroll
        for (int blk = 0; blk < 2; ++blk)
#pragma unroll
            for (int r = 0; r < 16; ++r) { const float own = blk ? a1[r] : a0[r]; const float oth = __shfl_xor(own, 32);
                const int eA = blk * 32 + (r & 3) + 8 * (r >> 2);
                const float xa = hi ? oth : own, xb = hi ? own : oth;
                sel[eA] = 1.f / (1.f + expf(-xa)) + br[eA]; sel[eA + 4] = 1.f / (1.f + expf(-xb)) + br[eA + 4]; }
        float gs[8];
#pragma unroll
        for (int G = 0; G < 8; ++G) { float m1 = -INFINITY, m2 = -INFINITY;
#pragma unroll
            for (int q = 0; q < 8; ++q) { const float v = sel[G * 8 + q]; if (v > m1) { m2 = m1; m1 = v; } else if (v > m2) m2 = v; }
            gs[G] = m1 + m2; }
#pragma unroll
        for (int G = 0; G < 8; ++G) { int rank = 0;
#pragma unroll
            for (int q = 0; q < 8; ++q) rank += (gs[q] > gs[G] || (gs[q] == gs[G] && q < G)) ? 1 : 0;
#pragma unroll
            for (int q = 0; q < 8; ++q) { const int e = G * 8 + q; const float key = __builtin_bit_cast(float, (__builtin_bit_cast(unsigned, sel[e]) & ~63u) | (unsigned)(63 - e)); sel[e] = (rank >= 4) ? -1e30f : key; } }
        float wsum = 0.f;
#pragma unroll 1
        for (int k = 0; k < 8; ++k) { float best = sel[0];
#pragma unroll
            for (int e = 1; e < 64; ++e) best = fmaxf(best, sel[e]);
#pragma unroll
            for (int e = 0; e < 64; ++e) sel[e] = (sel[e] == best) ? -1e30f : sel[e];
            const int bi = 63 - (int)(__builtin_bit_cast(unsigned, best) & 63u); const float bs = best - br[bi];
            stash[k * 64 + c.lane] = (__builtin_bit_cast(unsigned, bs) & ~63u) | (unsigned)bi; wsum += bs; }
        asm volatile("s_waitcnt lgkmcnt(0)" ::: "memory");
        int ei[8]; float ew[8];
#pragma unroll
        for (int k = 0; k < 8; ++k) { const unsigned w_ = stash[k * 64 + c.lane]; ei[k] = (int)(w_ & 63u); ew[k] = __builtin_bit_cast(float, w_ & ~63u); }
        const float wn = 2.5f / wsum;
        const int R = R0 + r32; const int ch = R0 / CHROWS;
        hist[c.lane] = 0u; asm volatile("s_waitcnt lgkmcnt(0)" ::: "memory");
        unsigned rk[8];
#pragma unroll
        for (int k = 0; k < 8; ++k) { rk[k] = 0u; if (hi == 0) rk[k] = atomicAdd((unsigned*)&hist[ei[k]], 1u); }
        asm volatile("s_waitcnt lgkmcnt(0)" ::: "memory");
        { const unsigned cnt = hist[c.lane]; unsigned base = 0u; if (cnt) base = atomicAdd(CNT + (l * 2 + ch) * 128 + c.lane, cnt); hist[64 + c.lane] = base; }
        asm volatile("s_waitcnt vmcnt(0) lgkmcnt(0)" ::: "memory");
        if (hi == 0) {
            unsigned* rt_ = (unsigned*)(c.ws + WS_REGT); float* rw_ = (float*)(c.ws + WS_REGW);
#pragma unroll
            for (int k = 0; k < 8; ++k) { const unsigned pos = hist[64 + ei[k]] + rk[k]; const size_t o = ((size_t)ch * 64 + ei[k]) * CAP + pos;
                rt_[o] = ((unsigned)R << 4) | (unsigned)k; rw_[o] = ew[k] * wn; }
        }
        asm volatile("s_waitcnt lgkmcnt(0)" ::: "memory");
    }
    __syncthreads();
}

struct MoeTab { LAS int* tstart; int TR, nsh, ch, l; };
__device__ __forceinline__ MoeTab moe_table(const Ctx& c, int l, int ch) {
    MoeTab T; T.tstart = (LAS int*)(c.lds + LDS_RING + 1024); T.ch = ch; T.l = l;
    __syncthreads();
    if (c.tid == 0) { unsigned* CNT = (unsigned*)(c.ws + CTL_CNT) + (l * 2 + ch) * 128; int acc = 0;
        for (int e = 0; e < 64; ++e) { const int n = (int)__hip_atomic_load(CNT + e, __ATOMIC_RELAXED, __HIP_MEMORY_SCOPE_AGENT); T.tstart[e] = acc; T.tstart[65 + e] = n; acc += (n + 255) >> 8; }
        T.tstart[64] = acc; }
    __syncthreads();
    T.TR = T.tstart[64]; T.nsh = (l == 0) ? 72 : 64;
    return T;
}
__device__ __forceinline__ void moe_tile(const Ctx& c, const MoeTab& T, int t, int& e, int& j, int& nrows, const unsigned*& rows, int& pm_sh) {
    if (t < T.TR) { int lo = 0;
        for (int q = 1; q < 64; ++q) if (T.tstart[q] <= t) lo = q;
        e = lo; j = t - T.tstart[e]; const int n = T.tstart[65 + e]; nrows = min(256, n - 256 * j);
        rows = (const unsigned*)(c.ws + WS_REGT) + ((size_t)T.ch * 64 + e) * CAP + 256 * j; pm_sh = 0; }
    else { const int s = t - T.TR; e = 64; j = s; nrows = 256; rows = nullptr;
        const int bl = (T.l == 0) ? s / 9 : s / 8, r9 = (T.l == 0) ? s % 9 : 1 + (s % 8); pm_sh = (T.ch * 8 + bl) * 9 + r9; }
}
struct SchedGU {
    const Ctx* c; MoeTab T;
    __device__ bool next(int i, Unit& u) const {
        const int L = i * c->G + c->blk; const int t = L >> 1; if (t >= T.TR + T.nsh) return false;
        int e, j, nrows, pm_sh; const unsigned* rows; moe_tile(*c, T, t, e, j, nrows, rows, pm_sh);
        u.pn = L & 1; u.pm = t; u.kind = (e < 64) ? 0 : 1; u.bperm = 0; u.K = 1024; u.rows = rows; u.nrows = nrows; u.aux = e; u.aux2 = T.ch * CHROWS + CTXL;
        u.a = (e < 64) ? wsb(*c, A_HX) : wsb(*c, A_HX) + (size_t)pm_sh * 256 * 1024;
        u.b = wt(*c, WO_GU) + (size_t)e * 524288 + (size_t)u.pn * 256 * 1024; return true;
    }
};
struct EpiGU {
    const Ctx* c; int ch;
    __device__ __forceinline__ void apply(const Unit& u, int row, int c8, f32x4 gl, f32x4 gh, f32x4 ul, f32x4 uh) const {
        float w = 1.f;
        if (u.kind == 0) { w = 0.f; if (row < u.nrows) w = ((const float*)(c->ws + WS_REGW))[(u.rows - (const unsigned*)(c->ws + WS_REGT)) + row]; }
#pragma unroll
        for (int i = 0; i < 4; ++i) { gl[i] = gl[i] / (1.f + __expf(-gl[i])) * ul[i] * w; gh[i] = gh[i] / (1.f + __expf(-gh[i])) * uh[i] * w; }
        *(u32x4*)(wsb(*c, A_ACT) + ((size_t)u.pm * 256 + row) * 256 + u.pn * 128 + c8) = pack8(gl, gh);
    }
};
struct SchedD {
    const Ctx* c; MoeTab T;
    __device__ bool next(int i, Unit& u) const {
        const int L = i * c->G + c->blk; const int t = L >> 2; if (t >= T.TR + T.nsh) return false;
        int e, j, nrows, pm_sh; const unsigned* rows; moe_tile(*c, T, t, e, j, nrows, rows, pm_sh);
        u.pn = L & 3; u.pm = t; u.kind = (e < 64) ? 0 : 1; u.bperm = 0; u.K = 256; u.rows = nullptr; u.nrows = nrows; u.aux = pm_sh;
        u.a = wsb(*c, A_ACT) + (size_t)t * 256 * 256; u.b = wt(*c, WO_D) + (size_t)e * 262144 + (size_t)u.pn * 256 * 256;
        u.aux2 = (e < 64) ? (int)(rows - (const unsigned*)(c->ws + WS_REGT)) : -1;
        return true;
    }
};
struct EpiD {
    const Ctx* c; int ch;
    __device__ __forceinline__ void apply(const Unit& u, int row, int c8, f32x4 v0l, f32x4 v0h, f32x4 v1l, f32x4 v1h) const {
        if (row >= u.nrows) return;
        size_t slot;
        if (u.kind == 0) { const unsigned ent = ((const unsigned*)(c->ws + WS_REGT))[(size_t)u.aux2 + row]; slot = (size_t)((int)(ent >> 4) - ch * CHROWS) * 9 + (ent & 15u); }
        else slot = (size_t)(u.aux * 256 + row - ch * CHROWS) * 9 + 8;
        bf16_t* o = wsb(*c, A_Y) + slot * 1024 + u.pn * 256;
        *(u32x4*)(o + c8) = pack8(v0l, v0h); *(u32x4*)(o + 128 + c8) = pack8(v1l, v1h);
    }
};
__device__ __forceinline__ void ph_combine(const Ctx& c, int l, int ch) {
    const int gw = c.blk * 8 + c.wave, NGW = c.G * 8;
    for (int rr = gw; rr < CHROWS; rr += NGW) {
        const int R = ch * CHROWS + rr; const bool lat = (R % RPB) >= CTXL;
        if (!lat && l != 0) continue;
        f32x4 f[4];
#pragma unroll
        for (int j = 0; j < 4; ++j) f[j] = (f32x4){0.f, 0.f, 0.f, 0.f};
        const bf16_t* yp = wsb(c, A_Y) + (size_t)rr * 9 * 1024;
#pragma unroll
        for (int k = 0; k < 9; ++k)
#pragma unroll
            for (int j = 0; j < 4; ++j) { const u32x2 w = *((const u32x2*)(yp + k * 1024) + c.lane + 64 * j); f[j] += (f32x4){bflo(w.x), bfhi(w.x), bflo(w.y), bfhi(w.y)}; }
        const float rs = 1.f / sqrtf(row_sumsq(f) * (1.f / DM) + EPSN);
        f32x4 h[4]; load_row_f32(res_wr(c, R), c.lane, h);
        const float* g = INP(c, I_GPOSTFFN) + l * DM; const float* m5 = modvec(c, l, R, 5);
#pragma unroll
        for (int j = 0; j < 4; ++j) { const int o = c.lane + 64 * j; h[j] += *((const f32x4*)m5 + o) * (f[j] * rs * *((const f32x4*)g + o)); }
        float* hw = res_wr(c, R);
#pragma unroll
        for (int j = 0; j < 4; ++j) *((f32x4*)hw + c.lane + 64 * j) = h[j];
        if (l == 0) { const float rs2 = 1.f / sqrtf(row_sumsq(h) * (1.f / DM) + EPSN);
            norm_mod_store(h, rs2, INP(c, I_GPREMIX) + 1 * DM, modvec(c, 1, R, 0), modvec(c, 1, R, 1), wsb(c, A_HX) + (size_t)R * DM, c.lane); }
    }
}

__global__ void __launch_bounds__(512, 2) fwd_kernel(Params prm) {
    extern __shared__ __attribute__((aligned(16))) unsigned char lds_raw[];
    Ctx c; c.p = (ParamsK)__builtin_amdgcn_kernarg_segment_ptr(); c.lds = (LAS unsigned char*)lds_raw; c.tid = threadIdx.x; c.lane = c.tid & 63; c.wave = __builtin_amdgcn_readfirstlane(c.tid >> 6);
    c.G = gridDim.x; c.blk = blockIdx.x; c.ws = prm.ws; c.z = 0;
    volatile LAS unsigned* MISC = (volatile LAS unsigned*)(c.lds + LDS_MISC);
    if (c.tid < 16) MISC[c.tid] = 0u;
    __syncthreads();
    XcdBarrier bar; bar.bar = (unsigned*)(c.ws + CTL_BAR); bar.x = 0; bar.st = nullptr;
    const int lo = prm.step_lo, hi = prm.step_hi;
    if (hi - lo > 1) bar = xcd_barrier_post((unsigned*)(c.ws + CTL_BAR), MISC + 8);
    int step = 0;
#define RUN() (step >= lo && step < hi)
#define SEAM() do { if (step >= lo && step + 1 < hi) xcd_barrier(bar); ++step; } while (0)
    for (int l_ = 0; l_ < 2; ++l_) {
        int l = l_; asm volatile("" : "+s"(l)); l = __builtin_amdgcn_readfirstlane(l);
        if (RUN()) { if (PHM & 1) { PHASE_CTX(cl); ph_prologue(cl, l); } }
        SEAM();
        if (l == 0) { if (RUN()) { if (PHM & 2) { PHASE_CTX(cl); ph_t1(cl, 0); } } SEAM(); }
        if (RUN()) { if (PHM & 4) { PHASE_CTX(cl); SchedProj S; S.init(&cl, l); EpiProj E{&cl, l}; GEMM_UNITS(cl, S, E); } }
        SEAM();
        if (RUN()) { if (PHM & 8) { PHASE_CTX(cl); SchedUp S; S.init(&cl, l); EpiUp E{&cl, l}; GEMM_UNITS(cl, S, E); ph_pool(cl, l); } }
        SEAM();
        if (RUN()) { if (PHM & 16) { PHASE_CTX(cl); ATTN_PHASE(cl, l); } }
        SEAM();
        if (RUN()) { if (PHM & 32) { PHASE_CTX(cl); SchedMerge1 S; S.init(&cl, l); EpiMerge1 E{&cl}; GEMM_UNITS(cl, S, E); } }
        SEAM();
        if (RUN()) { if (PHM & 64) { PHASE_CTX(cl); SchedMerge2 S; S.init(&cl, l); EpiMerge2 E{&cl}; GEMM_UNITS(cl, S, E); } }
        SEAM();
        if (RUN()) { if (PHM & 128) { PHASE_CTX(cl); ph_t4_router(cl, l); } }
        SEAM();
        for (int ch = 0; ch < NCHUNK; ++ch) {
            if (RUN()) { if (PHM & 256) { PHASE_CTX(cl); SchedGU S; S.c = &cl; S.T = moe_table(cl, l, ch); EpiGU E{&cl, ch}; GEMM_UNITS(cl, S, E); } }
            SEAM();
            if (RUN()) { if (PHM & 512) { PHASE_CTX(cl); SchedD S; S.c = &cl; S.T = moe_table(cl, l, ch); EpiD E{&cl, ch}; GEMM_UNITS(cl, S, E); } }
            SEAM();
            if (RUN()) { if (PHM & 1024) { PHASE_CTX(cl); ph_combine(cl, l, ch); } }
            SEAM();
        }
    }
#undef RUN
#undef SEAM
}
constexpr int N_STEPS = 2 * (7 + 3 * NCHUNK) + 1;

extern "C" void kernel_launch(void* const* d_in, const int* in_sizes, int n_in, void* d_out, int out_size, void* d_ws, size_t ws_size, hipStream_t stream) {
    static int grid = 0;
    if (grid == 0) {
        if (n_in != 34 || out_size != NB * SEQ * DM || ws_size < WS_END) { fprintf(stderr, "kernel_launch: unexpected shapes (n_in %d out %d ws %zu need %zu)\n", n_in, out_size, ws_size, (size_t)WS_END); grid = -1; return; }
        int dev = 0, cus = 0;
        if (hipGetDevice(&dev) != hipSuccess || hipDeviceGetAttribute(&cus, hipDeviceAttributeMultiprocessorCount, dev) != hipSuccess) { grid = -1; return; }
        if (hipFuncSetAttribute((const void*)fwd_kernel, hipFuncAttributeMaxDynamicSharedMemorySize, LDS_BYTES) != hipSuccess) { fprintf(stderr, "kernel_launch: hipFuncSetAttribute failed\n"); grid = -1; return; }
        int per_cu = 0; (void)hipOccupancyMaxActiveBlocksPerMultiprocessor(&per_cu, (const void*)fwd_kernel, 512, LDS_BYTES); (void)hipGetLastError();
        if (per_cu < 1) fprintf(stderr, "kernel_launch: occupancy query says %d\n", per_cu);
        grid = cus;
    }
    if (grid < 0) return;
    (void)hipMemsetAsync((char*)d_ws + WS_CTL, 0, CTL_BYTES, stream);
    Params p{};
    for (int i = 0; i < 34; ++i) p.in[i] = (const float*)d_in[i];
    p.out = (float*)d_out; p.ws = (unsigned char*)d_ws;
#if N_LAUNCH_MODE == 1
    p.step_lo = 0; p.step_hi = N_STEPS;
    hipLaunchKernelGGL(fwd_kernel, dim3(grid), dim3(512), LDS_BYTES, stream, p);
#else
    for (int s = 0; s < N_STEPS; ++s) { p.step_lo = s; p.step_hi = s + 1; hipLaunchKernelGGL(fwd_kernel, dim3(grid), dim3(512), LDS_BYTES, stream, p); }
#endif
}
```

```cpp
#include <hip/hip_runtime.h>
#include <cstdio>
#include <cstdint>
#include <cmath>

#ifndef PHM
#define PHM 0xFFFF
#endif
#ifndef USE_FAST_ATTN
#define USE_FAST_ATTN 1
#endif
#if USE_FAST_ATTN
#define ATTN_PHASE ph_attn_fast
#else
#define ATTN_PHASE ph_attn_naive
#endif
#ifndef REP
#define REP 0
#endif
#define NREP(bit) (((REP) & (bit)) ? 2 : 1)
#ifndef N_LAUNCH_MODE
#define N_LAUNCH_MODE 1
#endif

#define GAS __attribute__((address_space(1)))
#define LAS __attribute__((address_space(3)))
typedef unsigned short bf16_t;
typedef float f32x4 __attribute__((ext_vector_type(4)));
typedef float f32x2 __attribute__((ext_vector_type(2)));
typedef unsigned u32x4 __attribute__((ext_vector_type(4)));
typedef unsigned u32x2 __attribute__((ext_vector_type(2)));
typedef short bf16x8 __attribute__((ext_vector_type(8)));

constexpr int DM = 1024, NB = 16, SEQ = 2048, CTXL = 256, RPB = SEQ + CTXL  ;
constexpr int NR = NB * RPB;
constexpr int NTILE = NR / 256;
constexpr int IN_COLS = 5792, KV_COLS = 1312;
constexpr int NEXP = 64, EFF = 256;
constexpr int NCHUNK = 2, CHROWS = NR / NCHUNK  , CAP = CHROWS;
constexpr float EPSN = 1e-6f;
constexpr float LOG2E = 1.4426950408889634f;
constexpr float C2M = 0.10206207261596577f * LOG2E;
constexpr float C2D = 0.125f * LOG2E;

constexpr size_t WO_IN = 0;
constexpr size_t WO_VD = WO_IN + 2304ull * 1024;
constexpr size_t WO_G  = WO_VD + 512ull * 1024;
constexpr size_t WO_UK = WO_G + 3072ull * 1024;
constexpr size_t WO_UV = WO_UK + 512ull * 256;
constexpr size_t WO_UQ = WO_UV + 512ull * 256;
constexpr size_t WO_BM = WO_UQ + 768ull * 384;
constexpr size_t WO_PP = WO_BM + 1024ull * 512;
constexpr size_t WO_BD = WO_PP + 1024ull * 512;
constexpr size_t WO_O  = WO_BD + 1024ull * 512;
constexpr size_t WO_R  = WO_O + 1024ull * 1024;
constexpr size_t WO_GU = WO_R + 64ull * 1024;
constexpr size_t WO_D  = WO_GU + 65ull * 512 * 1024;
constexpr size_t W_ELEMS = WO_D + 65ull * 1024 * 256;

constexpr size_t WS_CTL = 0, CTL_BYTES = 3u << 20;
constexpr size_t CTL_BAR = 16384;
constexpr size_t CTL_CNT = 65536;
constexpr size_t CTL_SSKV = 131072;
constexpr size_t CTL_SSQ = CTL_SSKV + 2ull * NR * 8;
constexpr size_t CTL_MOD = CTL_SSQ + 2ull * NR * 8;
static_assert(CTL_MOD + 2ull * 17 * 6144 * 4 <= CTL_BYTES, "ctl");
constexpr size_t WS_TAB64 = CTL_BYTES;
constexpr size_t WS_TAB32 = WS_TAB64 + 2048ull * 32 * 8;
constexpr size_t WS_W = WS_TAB32 + 2048ull * 16 * 8;
constexpr size_t WS_HC = WS_W + W_ELEMS * 2;
constexpr size_t WS_REGT = WS_HC + 4096ull * 1024 * 4;
constexpr size_t WS_REGW = WS_REGT + 2ull * 64 * CAP * 4;
constexpr size_t WS_ACT0 = WS_REGW + 2ull * 64 * CAP * 4;
constexpr size_t SZ_ROW2K = (size_t)NR * 2048, SZ_ROW1K = (size_t)NR * 1024;
constexpr size_t A_HX = WS_ACT0;
constexpr size_t A_KD = A_HX + SZ_ROW2K;
constexpr size_t A_VDT = A_KD + SZ_ROW1K;
constexpr size_t A_QD = A_VDT + SZ_ROW1K;
constexpr size_t A_PD = A_QD + SZ_ROW1K;
constexpr size_t A_OM = A_PD + SZ_ROW1K;
constexpr size_t A_PL = A_OM + SZ_ROW1K;
constexpr size_t A_CKV = A_PL + SZ_ROW1K;
constexpr size_t A_CQ = A_CKV + (size_t)NR * 512;
constexpr size_t A_KN = A_CQ + (size_t)NR * 768;
constexpr size_t A_KR = A_KN + SZ_ROW1K;
constexpr size_t A_VMT = A_KR + (size_t)NR * 64;
constexpr size_t A_QM = A_VMT + SZ_ROW1K;
constexpr size_t A_MIXEND = A_QM + (size_t)NR * 1536;
constexpr size_t A_MG = A_PL;
constexpr size_t A_Y1 = A_KN;
constexpr size_t A_SCR = A_KD;
static_assert(A_MG + SZ_ROW2K <= A_KN && A_Y1 + SZ_ROW2K <= A_MIXEND && 256ull * 262144 <= 2 * SZ_ROW1K, "overlays");
constexpr int ACT_TILES = (CHROWS * 8) / 256 + 64 + CHROWS / 256;
constexpr size_t A_ACT = A_KD;
constexpr size_t A_Y = A_ACT + (size_t)ACT_TILES * 256 * 512;
constexpr size_t WS_END = (A_Y + (size_t)CHROWS * 9 * 2048) > A_MIXEND ? (A_Y + (size_t)CHROWS * 9 * 2048) : A_MIXEND;
static_assert(WS_END <= 684360192ull, "workspace budget");

__device__ __forceinline__ unsigned f2bf(float f) { unsigned u = __builtin_bit_cast(unsigned, f); return (u + 0x7fffu + ((u >> 16) & 1u)) >> 16; }
__device__ __forceinline__ unsigned pk2(float lo, float hi) { return f2bf(lo) | (f2bf(hi) << 16); }
__device__ __forceinline__ float bf2f(unsigned short b) { return __builtin_bit_cast(float, (unsigned)b << 16); }
__device__ __forceinline__ float bflo(unsigned w) { return __builtin_bit_cast(float, w << 16); }
__device__ __forceinline__ float bfhi(unsigned w) { return __builtin_bit_cast(float, w & 0xffff0000u); }
__device__ __forceinline__ u32x4 pack8(f32x4 lo, f32x4 hi) { u32x4 w; w.x = pk2(lo[0], lo[1]); w.y = pk2(lo[2], lo[3]); w.z = pk2(hi[0], hi[1]); w.w = pk2(hi[2], hi[3]); return w; }
__device__ __forceinline__ void unpack8(u32x4 w, f32x4& lo, f32x4& hi) { lo = (f32x4){bflo(w.x), bfhi(w.x), bflo(w.y), bfhi(w.y)}; hi = (f32x4){bflo(w.z), bfhi(w.z), bflo(w.w), bfhi(w.w)}; }
__device__ __forceinline__ float wave_sum(float v) {
#pragma unroll
    for (int o = 1; o < 64; o <<= 1) v += __shfl_xor(v, o);
    return v;
}
constexpr float SS_SCALE = 16777216.f, SS_INV = 1.f / 16777216.f;
__device__ __forceinline__ void ss_add(unsigned long long* p, float s) { atomicAdd(p, (unsigned long long)(s * SS_SCALE)); }
__device__ __forceinline__ float ss_get(const unsigned long long* p) { return (float)(*p) * SS_INV; }
__device__ __forceinline__ float sigmoidf_(float x) { return 1.f / (1.f + __expf(-x)); }
__host__ __device__ __forceinline__ int pos2tok(int q) { const int fq = q >> 3, n = (q >> 2) & 1, i = q & 3; return 16 * (fq >> 1) + 4 * (fq & 1) + 8 * n + i; }
__host__ __device__ __forceinline__ int tok2pos(int t) { const int A = t >> 4, n = (t >> 3) & 1, B = (t >> 2) & 1, i = t & 3; return 8 * (2 * A + B) + 4 * n + i; }
__host__ __device__ __forceinline__ int ropedim(int RD, int p) { const int Q = p >> 3, n = (p >> 2) & 1, i = p & 3, P = 4 * Q + i, half = RD / 4; return (P < half ? 0 : RD / 2) + (P % half) + (n ? half : 0); }

#define XB_TMO      128
#define XB_XCNT(j)  (256  + 64 * (j))
#define XB_XSUB(j)  (1280 + 64 * (j))
#define XB_XGEN(j)  (2304 + 64 * (j))
#define XB_TOP      3328
#define XB_TOPGEN   3392
#define XCD_BAR_WORDS 3456
#define XB_SPIN_CAP (1u << 20)
__device__ __forceinline__ unsigned xb_ld(unsigned* p)              { return __hip_atomic_load(p, __ATOMIC_RELAXED, __HIP_MEMORY_SCOPE_AGENT); }
__device__ __forceinline__ unsigned xb_add(unsigned* p, unsigned v) { return __hip_atomic_fetch_add(p, v, __ATOMIC_RELAXED, __HIP_MEMORY_SCOPE_AGENT); }
__device__ __forceinline__ unsigned xb_xcc_id() { return (unsigned)__builtin_amdgcn_s_getreg((3 << 11) | 20) & 0xFu; }
#define XB_SPIN(cond, bar) do { unsigned _sp = 0; while (cond) { __builtin_amdgcn_s_sleep(1); \
    if ((++_sp & 255u) == 0u) { if (xb_ld(&(bar)[XB_TMO])) break; if (_sp > XB_SPIN_CAP) { atomicAdd(&(bar)[XB_TMO], 1u); break; } } } } while (0)
struct XcdBarrier { unsigned* bar; unsigned x; volatile LAS unsigned* st; };
__device__ __forceinline__ XcdBarrier xcd_barrier_post(unsigned* bar, volatile LAS unsigned* st) {
    XcdBarrier b; b.bar = bar; b.x = xb_xcc_id(); b.st = st;
    if (threadIdx.x == 0) (void)xb_add(&bar[XB_XCNT(b.x)], 1u);
    return b;
}
__device__ __forceinline__ void xcd_barrier_complete(unsigned* bar, unsigned x, unsigned& nloc, unsigned& nx) {
    const unsigned G = gridDim.x * gridDim.y * gridDim.z;
    unsigned sum, cnt, mine, sp = 0u;
    for (;;) {
        sum = 0u; cnt = 0u; mine = 0u;
#pragma unroll
        for (unsigned j = 0; j < 16; ++j) { const unsigned c = xb_ld(&bar[XB_XCNT(j)]); sum += c; cnt += (c > 0u) ? 1u : 0u; mine = (j == x) ? c : mine; }
        if (sum == G) break;
        __builtin_amdgcn_s_sleep(1);
        if ((++sp & 255u) == 0u) { if (xb_ld(&bar[XB_TMO])) break; if (sp > XB_SPIN_CAP) { atomicAdd(&bar[XB_TMO], 1u); break; } }
    }
    nloc = mine > 0u ? mine : 1u; nx = cnt > 0u ? cnt : 1u;
}
__device__ __forceinline__ void xcd_barrier(const XcdBarrier& b) {
    asm volatile("s_waitcnt vmcnt(0)" ::: "memory");
    __syncthreads();
    if (threadIdx.x == 0) {
        unsigned* bar = b.bar;
        __builtin_amdgcn_s_waitcnt(0);
        unsigned nloc = b.st[0], nx = b.st[1];
        if (nloc == 0u) { xcd_barrier_complete(bar, b.x, nloc, nx); b.st[0] = nloc; b.st[1] = nx; }
        const unsigned old = xb_add(&bar[XB_XSUB(b.x)], 1u);
        const unsigned gen = old / nloc;
        if (old + 1u == (gen + 1u) * nloc) {
            __builtin_amdgcn_fence(__ATOMIC_RELEASE, "agent");
            asm volatile("s_waitcnt vmcnt(0)" ::: "memory");
            const unsigned og = xb_add(&bar[XB_TOP], 1u);
            const unsigned tg = og / nx;
            if (og + 1u == (tg + 1u) * nx) xb_add(&bar[XB_TOPGEN], 1u);
            else XB_SPIN(xb_ld(&bar[XB_TOPGEN]) == tg, bar);
            __builtin_amdgcn_fence(__ATOMIC_ACQUIRE, "agent");
            xb_add(&bar[XB_XGEN(b.x)], 1u);
            asm volatile("s_waitcnt vmcnt(0)" ::: "memory");
        } else {
            XB_SPIN(xb_ld(&bar[XB_XGEN(b.x)]) == gen, bar);
            __builtin_amdgcn_fence(__ATOMIC_ACQUIRE, "agent");
            asm volatile("s_waitcnt vmcnt(0)" ::: "memory");
        }
    }
    __syncthreads();
}

struct Params {
    const float* in[34];
    float* out; unsigned char* ws;
    int step_lo, step_hi;
};
enum { I_X = 0, I_C, I_CTX, I_CCTX, I_WMOD, I_BMOD, I_GPREMIX, I_GPOSTMIX, I_GPREFFN, I_GPOSTFFN, I_WIN, I_GCQ, I_WUQ, I_GCKV, I_WUKV, I_WPOOL, I_PSCALE,
       I_LQ1, I_LK1, I_LQ2, I_LK2, I_GSUBLN, I_WBMLA, I_WBPOOL, I_WBDIFF, I_WOUT, I_WROUTER, I_BROUTER, I_WEGATE, I_WEUP, I_WEDOWN, I_WSGATE, I_WSUP, I_WSDOWN };

typedef const __attribute__((address_space(4))) Params* ParamsK;
struct Ctx {
    ParamsK p;
    LAS unsigned char* lds;
    int tid, lane, wave, G, blk;
    GAS unsigned char* ws;
    size_t z;
};
#define INP(cx, I) ((const float*)((const GAS float*)(cx).p->in[I] + (cx).z))
__device__ __forceinline__ unsigned long long rfl64(unsigned long long v) { return ((unsigned long long)(unsigned)__builtin_amdgcn_readfirstlane((int)(unsigned)(v >> 32)) << 32) | (unsigned)__builtin_amdgcn_readfirstlane((int)(unsigned)v); }
#define PHASE_CTX(cl) Ctx cl = c; asm volatile("" : "+s"(cl.ws), "+s"(cl.z), "+s"(cl.blk), "+s"(cl.G), "+s"(cl.wave)); cl.wave = __builtin_amdgcn_readfirstlane(cl.wave); \
    { unsigned ones_ = ~0u; asm volatile("" : "+s"(ones_)); cl.lane = (int)__builtin_amdgcn_mbcnt_hi(ones_, __builtin_amdgcn_mbcnt_lo(ones_, 0u)); } cl.tid = cl.wave * 64 + cl.lane; \
    cl.blk = __builtin_amdgcn_readfirstlane(cl.blk); cl.G = __builtin_amdgcn_readfirstlane(cl.G); cl.ws = (GAS unsigned char*)rfl64((unsigned long long)cl.ws); cl.z = (size_t)rfl64((unsigned long long)cl.z)
constexpr int LDS_RING = 131072;
constexpr int LDS_BYTES = 163840;
constexpr int LDS_MISC = LDS_BYTES - 256;

__device__ __forceinline__ bf16_t* wsb(const Ctx& c, size_t off) { return (bf16_t*)(c.ws + off); }
__device__ __forceinline__ bf16_t* wt(const Ctx& c, size_t eoff) { return (bf16_t*)(c.ws + WS_W) + eoff; }

__device__ __forceinline__ const float* res_rd(const Ctx& c, int l, int R) {
    const int b = R / RPB, j = R % RPB;
    if (j < CTXL) return (l == 0 ? INP(c, I_CTX) : (const float*)(c.ws + WS_HC)) + (size_t)(b * CTXL + j) * DM;
    return (l == 0 ? INP(c, I_X) : (const float*)c.p->out) + (size_t)(b * SEQ + (j - CTXL)) * DM;
}
__device__ __forceinline__ float* res_wr(const Ctx& c, int R) {
    const int b = R / RPB, j = R % RPB;
    if (j < CTXL) return (float*)(c.ws + WS_HC) + (size_t)(b * CTXL + j) * DM;
    return c.p->out + (size_t)(b * SEQ + (j - CTXL)) * DM;
}
__device__ __forceinline__ const float* modvec(const Ctx& c, int l, int R, int which) {
    const int b = R / RPB, j = R % RPB; const int bb = (j < CTXL) ? 16 : b;
    return (const float*)(c.ws + CTL_MOD) + ((size_t)(l * 17 + bb) * 6144 + which * 1024);
}

struct SrcCol { const float* p; int ld; bool ok; };
template <class Map>
__device__ __forceinline__ void cvt_item(const Map& map, const float* kscale, int K, bf16_t* Dst, int nblk_n, LAS float* scr, int item, int lane) {
    const int kb = item / nblk_n, nb = item % nblk_n, k0 = 64 * kb, n0 = 32 * nb;
    const SrcCol s = map(n0 + (lane & 31));
#pragma unroll 8
    for (int i = 0; i < 32; ++i) { const int kk = 2 * i + (lane >> 5); float v = 0.f; if (s.ok) { v = s.p[(size_t)(k0 + kk) * s.ld]; if (kscale) v *= kscale[k0 + kk]; } scr[kk * 33 + (lane & 31)] = v; }
    asm volatile("s_waitcnt lgkmcnt(0)" ::: "memory");
    const int cch = lane & 7;
#pragma unroll
    for (int j = 0; j < 4; ++j) { const int n = (lane >> 3) + 8 * j; const LAS float* sp = scr + (8 * cch) * 33 + n;
        u32x4 o; o.x = pk2(sp[0 * 33], sp[1 * 33]); o.y = pk2(sp[2 * 33], sp[3 * 33]); o.z = pk2(sp[4 * 33], sp[5 * 33]); o.w = pk2(sp[6 * 33], sp[7 * 33]);
        *(u32x4*)(Dst + (size_t)(n0 + n) * K + k0 + 8 * cch) = o; }
    asm volatile("s_waitcnt lgkmcnt(0)" ::: "memory");
}
struct MapLin { const float* W; int ld; int off; __device__ SrcCol operator()(int n) const { return SrcCol{W + off + n, ld, true}; } };
struct MapWin { const float* W; __device__ SrcCol operator()(int n) const {
    int col; bool ok = true;
    if (n < 512) col = 288 + (n & ~63) + ropedim(64, n & 63);
    else if (n < 1024) { const int m = n - 512; col = KV_COLS + 384 + (m & ~63) + ropedim(64, m & 63); }
    else if (n < 1536) col = KV_COLS + 896 + (n - 1024);
    else if (n < 1792) col = n - 1536;
    else if (n < 2176) col = KV_COLS + (n - 1792);
    else if (n < 2208) col = 256 + ropedim(32, n - 2176);
    else { col = 0; ok = false; }
    return SrcCol{W + col, IN_COLS, ok}; } };
struct MapUkv { const float* W; int voff; __device__ SrcCol operator()(int n) const { return SrcCol{W + (n >> 6) * 128 + voff + (n & 63), 1024, true}; } };
struct MapUq { const float* W; __device__ SrcCol operator()(int n) const { const int h = n / 96, p = n % 96; return SrcCol{W + h * 96 + (p < 64 ? p : 64 + ropedim(32, p - 64)), 768, true}; } };
struct MapGU { const float* Wg; const float* Wu; __device__ SrcCol operator()(int n) const { const int pn = n >> 8, r = n & 255; return SrcCol{(r < 128 ? Wg + pn * 128 + r : Wu + pn * 128 + (r - 128)), 256, true}; } };

__device__ __forceinline__ void ph_prologue(const Ctx& c, int l) {
    LAS float* scr = (LAS float*)(c.lds + c.wave * 16384);
    const int gw = c.blk * 8 + c.wave, NGW = c.G * 8;
    const float* w_in = INP(c, I_WIN) + (size_t)l * DM * IN_COLS;
    constexpr int IT0 = 72 * 16, IT1 = 16 * 16, IT2 = 96 * 16, IT3 = 16 * 4, IT4 = 16 * 4, IT5 = 24 * 6, IT6 = 32 * 8, IT7 = 32 * 8, IT8 = 32 * 16, IT9 = 2 * 16;
    constexpr int IT10 = 65 * 16 * 16, IT11 = 65 * 32 * 4, IT12 = 4 * 16 * 16;
    constexpr int NIT = IT0 + IT1 + IT2 + IT3 + IT4 + IT5 + IT6 + IT7 + IT8 + IT9 + IT10 + IT11 + IT12;
    for (int it = gw; it < NIT; it += NGW) {
        int r = it;
        if (r < IT0) { cvt_item(MapWin{w_in}, nullptr, 1024, wt(c, WO_IN), 72, scr, r, c.lane); continue; } r -= IT0;
        if (r < IT1) { cvt_item(MapLin{w_in, IN_COLS, 800}, nullptr, 1024, wt(c, WO_VD), 16, scr, r, c.lane); continue; } r -= IT1;
        if (r < IT2) { cvt_item(MapLin{w_in, IN_COLS, KV_COLS + 1408}, nullptr, 1024, wt(c, WO_G), 96, scr, r, c.lane); continue; } r -= IT2;
        if (r < IT3) { cvt_item(MapUkv{INP(c, I_WUKV) + (size_t)l * 256 * 1024, 0}, INP(c, I_GCKV) + l * 256, 256, wt(c, WO_UK), 16, scr, r, c.lane); continue; } r -= IT3;
        if (r < IT4) { cvt_item(MapUkv{INP(c, I_WUKV) + (size_t)l * 256 * 1024, 64}, INP(c, I_GCKV) + l * 256, 256, wt(c, WO_UV), 16, scr, r, c.lane); continue; } r -= IT4;
        if (r < IT5) { cvt_item(MapUq{INP(c, I_WUQ) + (size_t)l * 384 * 768}, INP(c, I_GCQ) + l * 384, 384, wt(c, WO_UQ), 24, scr, r, c.lane); continue; } r -= IT5;
        if (r < IT6) { cvt_item(MapLin{INP(c, I_WBMLA) + (size_t)l * 512 * 1024, 1024, 0}, nullptr, 512, wt(c, WO_BM), 32, scr, r, c.lane); continue; } r -= IT6;
        if (r < IT7) { cvt_item(MapLin{INP(c, I_WBDIFF) + (size_t)l * 512 * 1024, 1024, 0}, nullptr, 512, wt(c, WO_BD), 32, scr, r, c.lane); continue; } r -= IT7;
        if (r < IT8) { cvt_item(MapLin{INP(c, I_WOUT) + (size_t)l * 1024 * 1024, 1024, 0}, nullptr, 1024, wt(c, WO_O), 32, scr, r, c.lane); continue; } r -= IT8;
        if (r < IT9) { cvt_item(MapLin{INP(c, I_WROUTER) + (size_t)l * 1024 * 64, 64, 0}, nullptr, 1024, wt(c, WO_R), 2, scr, r, c.lane); continue; } r -= IT9;
        if (r < IT10) { const int e = r / 256, ri = r % 256;
            const float* wg = (e < 64) ? INP(c, I_WEGATE) + ((size_t)l * 64 + e) * 262144 : INP(c, I_WSGATE) + (size_t)l * 262144;
            const float* wu = (e < 64) ? INP(c, I_WEUP) + ((size_t)l * 64 + e) * 262144 : INP(c, I_WSUP) + (size_t)l * 262144;
            cvt_item(MapGU{wg, wu}, nullptr, 1024, wt(c, WO_GU) + (size_t)e * 524288, 16, scr, ri, c.lane); continue; } r -= IT10;
        if (r < IT11) { const int e = r / 128, ri = r % 128;
            const float* wd = (e < 64) ? INP(c, I_WEDOWN) + ((size_t)l * 64 + e) * 262144 : INP(c, I_WSDOWN) + (size_t)l * 262144;
            cvt_item(MapLin{wd, 1024, 0}, nullptr, 256, wt(c, WO_D) + (size_t)e * 262144, 32, scr, ri, c.lane); continue; } r -= IT11;
        {
            const int g = r / 256, cb = (r / 16) % 16, db = r % 16, d = db * 64 + c.lane;
            const float* wp = INP(c, I_WPOOL) + ((size_t)l * 4 + g) * 16384 + (size_t)(cb * 8) * 128;
            const float* ps = INP(c, I_PSCALE) + l * 512 + g * 128;
            const float* wb = INP(c, I_WBPOOL) + (size_t)l * 512 * 1024 + (size_t)(g * 128) * 1024 + d;
            float acc[8];
#pragma unroll
            for (int q = 0; q < 8; ++q) acc[q] = 0.f;
            for (int j = 0; j < 128; ++j) { const float bv = wb[(size_t)j * 1024] * ps[j];
#pragma unroll
                for (int q = 0; q < 8; ++q) acc[q] += wp[q * 128 + j] * bv; }
            u32x4 o; o.x = pk2(acc[0], acc[1]); o.y = pk2(acc[2], acc[3]); o.z = pk2(acc[4], acc[5]); o.w = pk2(acc[6], acc[7]);
            *(u32x4*)(wt(c, WO_PP) + (size_t)d * 512 + g * 128 + cb * 8) = o;
        }
    }
    if (l == 0) {
        const int gt = c.blk * 512 + c.tid, NT = c.G * 512;
        f32x2* t64 = (f32x2*)(c.ws + WS_TAB64); f32x2* t32 = (f32x2*)(c.ws + WS_TAB32);
        for (int i = gt; i < 2048 * 32; i += NT) { const int t = i >> 5, Pp = i & 31; const float pos = (float)(Pp < 16 ? (t >> 6) : (t & 63));
            const float inv = powf(10000.f, -(float)(2 * (Pp & 15)) / 32.f); const float a = pos * inv; t64[i] = (f32x2){cosf(a), sinf(a)}; }
        for (int i = gt; i < 2048 * 16; i += NT) { const int t = i >> 4, Pp = i & 15; const float pos = (float)(Pp < 8 ? (t >> 6) : (t & 63));
            const float inv = powf(10000.f, -(float)(2 * (Pp & 7)) / 16.f); const float a = pos * inv; t32[i] = (f32x2){cosf(a), sinf(a)}; }
        __syncthreads();
        if (c.blk < 24) {
            LAS float* sb = (LAS float*)c.lds;
            for (int q = c.tid; q < 17 * 1024; q += 512) { const int b = q >> 10, k = q & 1023; const float v = (b < 16) ? INP(c, I_C)[b * 1024 + k] : INP(c, I_CCTX)[k]; sb[k * 20 + b] = v / (1.f + __expf(-v)); }
            __syncthreads();
            float* MOD = (float*)(c.ws + CTL_MOD);
            const int it = c.blk * 8 + c.wave, ll = it / 96, cb = it % 96, col = cb * 64 + c.lane;
            float acc[17];
#pragma unroll
            for (int b = 0; b < 17; ++b) acc[b] = 0.f;
            const float* wm = INP(c, I_WMOD) + (size_t)ll * 1024 * 6144 + col;
#pragma unroll 8
            for (int k = 0; k < 1024; ++k) { const float w = wm[(size_t)k * 6144];
#pragma unroll
                for (int b = 0; b < 17; ++b) acc[b] += sb[k * 20 + b] * w; }
            const float bias = INP(c, I_BMOD)[ll * 6144 + col];
#pragma unroll
            for (int b = 0; b < 17; ++b) MOD[(size_t)(ll * 17 + b) * 6144 + col] = acc[b] + bias;
        }
    }
}

__device__ __forceinline__ void load_row_f32(const float* row, int lane, f32x4 (&v)[4]) {
#pragma unroll
    for (int j = 0; j < 4; ++j) v[j] = *((const f32x4*)row + lane + 64 * j);
}
__device__ __forceinline__ float row_sumsq(const f32x4 (&v)[4]) {
    float s = 0.f;
#pragma unroll
    for (int j = 0; j < 4; ++j) s += (v[j].x * v[j].x + v[j].y * v[j].y) + (v[j].z * v[j].z + v[j].w * v[j].w);
    return wave_sum(s);
}
__device__ __forceinline__ void norm_mod_store(const f32x4 (&v)[4], float rstd, const float* g, const float* shift, const float* scale, bf16_t* orow, int lane) {
#pragma unroll
    for (int j = 0; j < 4; ++j) { const int o = lane + 64 * j; const f32x4 gg = *((const f32x4*)g + o), sh = *((const f32x4*)shift + o), sc = *((const f32x4*)scale + o);
        const f32x4 y = (v[j] * rstd * gg) * (sc + 1.0f) + sh;
        u32x2 w; w.x = pk2(y.x, y.y); w.y = pk2(y.z, y.w); *((u32x2*)orow + o) = w; }
}
__device__ __forceinline__ void ph_t1(const Ctx& c, int l) {
    const int gw = c.blk * 8 + c.wave, NGW = c.G * 8;
    for (int R = gw; R < NR; R += NGW) {
        f32x4 v[4]; load_row_f32(res_rd(c, l, R), c.lane, v);
        const float rstd = 1.f / sqrtf(row_sumsq(v) * (1.f / DM) + EPSN);
        norm_mod_store(v, rstd, INP(c, I_GPREMIX) + l * DM, modvec(c, l, R, 0), modvec(c, l, R, 1), wsb(c, A_HX) + (size_t)R * DM, c.lane);
    }
}

struct Unit {
    const bf16_t* a;
    const bf16_t* b;
    const unsigned* rows;
    int K, kind, pm, pn, bperm, nrows, aux, aux2;
};
__device__ __forceinline__ int b_srcrow(int q, int bperm) { return (q & ~31) + (bperm ? pos2tok(q & 31) : (q & 31)); }

template <class Sched, class Epi>
__device__ __forceinline__ void gemm_units_naive(const Ctx& c, const Sched& S, const Epi& E) {
    Unit u;
    for (int i = 0; S.next(i, u); ++i) {
        for (int it = c.tid; it < 256 * 16; it += 512) {
            const int row = it >> 4, c8 = (it & 15) * 8;
            const bf16_t* ar;
            if (u.rows) { const int rr = (row < u.nrows) ? (int)(u.rows[row] >> 4) : u.aux2; ar = u.a + (size_t)rr * u.K; } else ar = u.a + (size_t)row * u.K;
            float acc[16];
#pragma unroll
            for (int q = 0; q < 16; ++q) acc[q] = 0.f;
            const bf16_t* br[16];
#pragma unroll
            for (int q = 0; q < 16; ++q) br[q] = u.b + (size_t)b_srcrow((q < 8 ? c8 + q : 128 + c8 + (q - 8)), u.bperm) * u.K;
            for (int k = 0; k < u.K; k += 8) {
                f32x4 alo, ahi; unpack8(*(const u32x4*)(ar + k), alo, ahi);
#pragma unroll
                for (int q = 0; q < 16; ++q) { f32x4 blo, bhi; unpack8(*(const u32x4*)(br[q] + k), blo, bhi);
                    acc[q] += (alo.x * blo.x + alo.y * blo.y) + (alo.z * blo.z + alo.w * blo.w) + (ahi.x * bhi.x + ahi.y * bhi.y) + (ahi.z * bhi.z + ahi.w * bhi.w); }
            }
            { E.unit_begin(u, c8); typename Epi::Pre pre_; E.pre(u, row, c8, pre_);
              E.apply(u, row, c8, pre_, (f32x4){acc[0], acc[1], acc[2], acc[3]}, (f32x4){acc[4], acc[5], acc[6], acc[7]}, (f32x4){acc[8], acc[9], acc[10], acc[11]}, (f32x4){acc[12], acc[13], acc[14], acc[15]}); }
        }
        asm volatile("s_waitcnt vmcnt(0)" ::: "memory");
        __syncthreads();
    }
}

namespace mm {
constexpr int BK = 64, HALF = 128, HTB = HALF * BK * 2;
__device__ __forceinline__ int lds_byte(int r, int c) { const int st = (r >> 4) * 2 + (c >> 5), rr = r & 15, cc = c & 31, ob = rr * 64 + cc * 2; return st * 1024 + (ob ^ (((ob >> 9) & 1) << 5)); }
__device__ __forceinline__ void stage_rc(int b, int& R, int& C) { const int st = b / 1024, sb = b % 1024, swz = sb ^ (((sb >> 9) & 1) << 5); R = (st >> 1) * 16 + swz / 64; C = (st & 1) * 32 + (swz % 64) / 2; }
__device__ __forceinline__ int perm32(int rho) { const int n = rho >> 4, i = rho & 15; return 8 * (i >> 2) + 4 * n + (i & 3); }
__device__ __forceinline__ int permtau(int rho) { const int n = rho >> 4, fq = (rho >> 2) & 3, i = rho & 3; return 16 * (fq >> 1) + 4 * (fq & 1) + 8 * n + i; }
struct LaneOff { unsigned a0[2], a1[2], b[2]; };
__device__ __forceinline__ void lane_offsets(const Unit& u, const GAS unsigned char* ws, int tid, LaneOff& o) {
    int Rl[2], Cl[2];
#pragma unroll
    for (int i = 0; i < 2; ++i) stage_rc(tid * 16 + i * 8192, Rl[i], Cl[i]);
    const unsigned K2 = (unsigned)u.K * 2u; const unsigned ab = (unsigned)((unsigned long long)u.a - (unsigned long long)ws), bb = (unsigned)((unsigned long long)u.b - (unsigned long long)ws);
#pragma unroll
    for (int i = 0; i < 2; ++i) {
        if (u.rows) { const int r0 = Rl[i], r1 = 128 + Rl[i];
            const unsigned t0 = (r0 < u.nrows) ? (u.rows[r0] >> 4) : (unsigned)u.aux2, t1 = (r1 < u.nrows) ? (u.rows[r1] >> 4) : (unsigned)u.aux2;
            o.a0[i] = ab + t0 * K2 + (unsigned)Cl[i] * 2u; o.a1[i] = ab + t1 * K2 + (unsigned)Cl[i] * 2u; }
        else { o.a0[i] = ab + (unsigned)Rl[i] * K2 + (unsigned)Cl[i] * 2u; o.a1[i] = o.a0[i] + 128u * K2; }
        const int Rb = (Rl[i] & ~31) + (u.bperm ? permtau(Rl[i] & 31) : perm32(Rl[i] & 31));
        o.b[i] = bb + (unsigned)Rb * K2 + (unsigned)Cl[i] * 2u;
    }
}
}

template <class Sched, class Epi>
__device__ __forceinline__ void gemm_units_mfma(const Ctx& c, const Sched& S, const Epi& E) {
    using namespace mm;
    LAS unsigned char* lds = c.lds;
    const int tid = c.tid, wid = c.wave, lane = c.lane, wr = wid >> 2, wc = wid & 3, fr = lane & 15, fq = lane >> 4;
    const unsigned ldsw = (unsigned)wid * 1024u;
    const int aoff = lds_byte(wr * 64 + fr, fq * 8), boff = lds_byte(wc * 32 + fr, fq * 8);
    const GAS unsigned char* wsb_ = c.ws;
#define MM_SA(b, h) (((b) * 2 + (h)) * HTB)
#define MM_SB(b, h) ((4 + (b) * 2 + (h)) * HTB)
#define MM_STAGE(bufoff, o0, o1, kofs) do { const GAS unsigned char* kb_ = wsb_ + (size_t)(kofs);   \
        __builtin_amdgcn_global_load_lds((const GAS unsigned*)(kb_ + (o0)), (LAS unsigned*)(lds + (bufoff) + ldsw), 16, 0, 0); \
        __builtin_amdgcn_global_load_lds((const GAS unsigned*)(kb_ + (o1)), (LAS unsigned*)(lds + (bufoff) + ldsw + 8192), 16, 0, 0); } while (0)
#define MM_LDA(dst, b, h) do { _Pragma("unroll") for (int m = 0; m < 4; ++m) _Pragma("unroll") for (int k = 0; k < 2; ++k) dst[m][k] = *(const LAS bf16x8*)(lds + MM_SA(b, h) + aoff + m * 2048 + k * 1024); } while (0)
#define MM_LDB(dst, b, h) do { _Pragma("unroll") for (int n = 0; n < 2; ++n) _Pragma("unroll") for (int k = 0; k < 2; ++k) dst[n][k] = *(const LAS bf16x8*)(lds + MM_SB(b, h) + boff + n * 2048 + k * 1024); } while (0)
#define MM_MMA(ai, bj, At, Bt) do { __builtin_amdgcn_s_setprio(1); _Pragma("unroll") for (int m = 0; m < 4; ++m) _Pragma("unroll") for (int n = 0; n < 2; ++n) _Pragma("unroll") for (int k = 0; k < 2; ++k) \
        acc[ai][bj][m][n] = __builtin_amdgcn_mfma_f32_16x16x32_bf16(Bt[n][k], At[m][k], acc[ai][bj][m][n], 0, 0, 0); __builtin_amdgcn_s_setprio(0); } while (0)
#define MM_WAIT_V(n) asm volatile("s_waitcnt vmcnt(" #n ")" ::: "memory")
#define MM_WAIT_L(n) asm volatile("s_waitcnt lgkmcnt(" #n ")" ::: "memory")
#define MM_BAR __builtin_amdgcn_s_barrier()
#define MM_SCHED __builtin_amdgcn_sched_barrier(0)
    Unit cur, nxt; int ui = 0;
    if (!S.next(0, cur)) return;
    LaneOff co; lane_offsets(cur, wsb_, tid, co);
    f32x4 acc[2][2][4][2];
#pragma unroll
    for (int a = 0; a < 2; ++a)
#pragma unroll
        for (int b = 0; b < 2; ++b)
#pragma unroll
            for (int m = 0; m < 4; ++m)
#pragma unroll
                for (int n = 0; n < 2; ++n) acc[a][b][m][n] = (f32x4){0.f, 0.f, 0.f, 0.f};
    bf16x8 At[4][2], B0[2][2], B1[2][2];
    {
        const unsigned hs = 256u * (unsigned)cur.K;
        MM_STAGE(MM_SB(0, 0), co.b[0], co.b[1], 0); MM_STAGE(MM_SB(0, 1), co.b[0] + hs, co.b[1] + hs, 0); MM_STAGE(MM_SA(0, 0), co.a0[0], co.a0[1], 0); MM_STAGE(MM_SA(0, 1), co.a1[0], co.a1[1], 0);
        if (wr == 1) MM_BAR;
        MM_WAIT_V(2); MM_BAR;
        MM_STAGE(MM_SB(1, 0), co.b[0], co.b[1], 128); MM_STAGE(MM_SA(1, 0), co.a0[0], co.a0[1], 128); MM_STAGE(MM_SB(1, 1), co.b[0] + hs, co.b[1] + hs, 128);
        MM_WAIT_V(6); MM_BAR;
    }
    for (;;) {
        const bool has_next = S.next(ui + 1, nxt);
        if (!has_next) nxt = cur;
        const int nt = cur.K / BK; unsigned hs = 256u * (unsigned)cur.K;
        for (int t = 0; t < nt; t += 2) {
            const bool last = (t == nt - 2);
            const unsigned k1 = (unsigned)(t + 1) * 128u, k2 = last ? 0u : (unsigned)(t + 2) * 128u; unsigned k3 = k2 + 128u;
            asm volatile("" : "+s"(k3)); k3 = (unsigned)__builtin_amdgcn_readfirstlane((int)k3);
            MM_LDB(B0, 0, 0); MM_LDB(B1, 0, 1); MM_SCHED; MM_LDA(At, 0, 0); MM_STAGE(MM_SA(1, 1), co.a1[0], co.a1[1], k1);
            MM_WAIT_V(8); MM_WAIT_L(0); MM_BAR; MM_MMA(0, 0, At, B0); MM_MMA(0, 1, At, B1); MM_BAR; MM_SCHED;
            if (last) { lane_offsets(nxt, wsb_, tid, co); hs = 256u * (unsigned)nxt.K; }
            MM_LDA(At, 0, 1); MM_STAGE(MM_SB(0, 0), co.b[0], co.b[1], k2); MM_STAGE(MM_SB(0, 1), co.b[0] + hs, co.b[1] + hs, k2); MM_STAGE(MM_SA(0, 0), co.a0[0], co.a0[1], k2);
            MM_WAIT_V(8); MM_WAIT_L(0); MM_BAR; MM_MMA(1, 0, At, B0); MM_MMA(1, 1, At, B1); MM_BAR; MM_SCHED;
            MM_LDB(B0, 1, 0); MM_LDB(B1, 1, 1); MM_SCHED; MM_LDA(At, 1, 0); MM_STAGE(MM_SA(0, 1), co.a1[0], co.a1[1], k2);
            MM_WAIT_V(8); MM_WAIT_L(0); MM_BAR; MM_MMA(0, 0, At, B0); MM_MMA(0, 1, At, B1); MM_BAR; MM_SCHED;
            MM_LDA(At, 1, 1); MM_STAGE(MM_SB(1, 0), co.b[0], co.b[1], k3); MM_STAGE(MM_SB(1, 1), co.b[0] + hs, co.b[1] + hs, k3); MM_STAGE(MM_SA(1, 0), co.a0[0], co.a0[1], k3);
            MM_WAIT_V(8); MM_WAIT_L(0); MM_BAR; MM_MMA(1, 0, At, B0); MM_MMA(1, 1, At, B1); MM_BAR; MM_SCHED;
        }
        if (wr == 0) MM_BAR;
        E.unit_begin(cur, wc * 32 + fq * 8);
        constexpr int GRP = Epi::GROUP;
#pragma unroll
        for (int g0 = 0; g0 < 8; g0 += GRP) {
            int rows_[GRP]; typename Epi::Pre pre_[GRP]; int c8_ = wc * 32 + fq * 8; asm volatile("" : "+v"(c8_));
#pragma unroll
            for (int q = 0; q < GRP; ++q) { const int ai = (g0 + q) >> 2, m = (g0 + q) & 3; rows_[q] = ai * 128 + wr * 64 + m * 16 + fr; asm volatile("" : "+v"(rows_[q]));
                E.pre(cur, rows_[q], c8_, pre_[q]); }
            MM_SCHED;
#pragma unroll
            for (int q = 0; q < GRP; ++q) { const int ai = (g0 + q) >> 2, m = (g0 + q) & 3; E.apply(cur, rows_[q], c8_, pre_[q], acc[ai][0][m][0], acc[ai][0][m][1], acc[ai][1][m][0], acc[ai][1][m][1]); }
            MM_SCHED;
        }
        if (!has_next) break;
#pragma unroll
        for (int a = 0; a < 2; ++a)
#pragma unroll
            for (int b = 0; b < 2; ++b)
#pragma unroll
                for (int m = 0; m < 4; ++m)
#pragma unroll
                    for (int n = 0; n < 2; ++n) acc[a][b][m][n] = (f32x4){0.f, 0.f, 0.f, 0.f};
        cur = nxt; ++ui;
        if (wr == 1) MM_BAR;
    }
    MM_WAIT_V(0);
    MM_BAR;
#undef MM_SA
#undef MM_SB
#undef MM_STAGE
#undef MM_LDA
#undef MM_LDB
#undef MM_MMA
#undef MM_WAIT_V
#undef MM_WAIT_L
#undef MM_BAR
#undef MM_SCHED
}

#ifndef USE_MFMA_GEMM
#define USE_MFMA_GEMM 1
#endif
#if USE_MFMA_GEMM
#define GEMM_UNITS gemm_units_mfma
#else
#define GEMM_UNITS gemm_units_naive
#endif

__device__ __forceinline__ void rope4(f32x4& lo, f32x4& hi, const f32x2* cs) {
#pragma unroll
    for (int i = 0; i < 4; ++i) { const f32x2 t = cs[i]; const float a = lo[i], b = hi[i]; lo[i] = a * t.x - b * t.y; hi[i] = a * t.y + b * t.x; }
}

struct SchedProj {
    const Ctx* c; int l, n_main, n_ctx, n_tot;
    __device__ void init(const Ctx* cc, int ll) { c = cc; l = ll; n_main = 128 * 9; n_ctx = 16 * (l == 0 ? 9 : 4); n_tot = n_main + n_ctx + 288; }
    __device__ bool next(int i, Unit& u) const {
        const int L = i * c->G + c->blk; if (L >= n_tot) return false;
        u.rows = nullptr; u.nrows = 256; u.aux = l; u.aux2 = 0; u.K = 1024;
        if (L < n_main + n_ctx) {
            int pm, pn;
            if (L < n_main) { const int lt = L / 9; pn = L % 9; pm = (lt >> 3) * 9 + 1 + (lt & 7); }
            else { const int q = L - n_main; if (l == 0) { pm = (q / 9) * 9; pn = q % 9; } else { pm = (q >> 2) * 9; const int s = q & 3; pn = (s < 2) ? s : (s == 2 ? 6 : 8); } }
            u.pm = pm; u.pn = pn; u.kind = 0; u.bperm = 0;
            u.a = wsb(*c, A_HX) + (size_t)pm * 256 * 1024; u.b = wt(*c, WO_IN) + (size_t)pn * 256 * 1024;
        } else {
            const int q = L - n_main - n_ctx; u.pm = q / 144; u.pn = q % 144; u.kind = 1; u.bperm = 1;
            u.a = wt(*c, WO_VD) + (size_t)u.pm * 256 * 1024; u.b = wsb(*c, A_HX) + (size_t)u.pn * 256 * 1024;
        }
        return true;
    }
};
struct EpiProj {
    const Ctx* c; int l;
    __device__ __forceinline__ void one(const Unit& u, int R, bool lat, int t, int colp, f32x4 lo, f32x4 hi) const {
        const Ctx& C = *c;
        switch (u.pn) {
        case 0: case 1: case 2: case 3: {
            const int col = (u.pn & 1) * 256 + colp;
            if (lat) rope4(lo, hi, (const f32x2*)(C.ws + WS_TAB64) + t * 32 + ((col & 63) >> 3) * 4);
            if (u.pn >= 2) { lo *= C2D; hi *= C2D; }
            *(u32x4*)(wsb(C, u.pn < 2 ? A_KD : A_QD) + (size_t)R * 512 + col) = pack8(lo, hi); break; }
        case 4: case 5: *(u32x4*)(wsb(C, A_PL) + (size_t)R * 512 + (u.pn - 4) * 256 + colp) = pack8(lo, hi); break;
        case 6: { *(u32x4*)(wsb(C, A_CKV) + (size_t)R * 256 + colp) = pack8(lo, hi);
            const float s = (lo.x * lo.x + lo.y * lo.y) + (lo.z * lo.z + lo.w * lo.w) + (hi.x * hi.x + hi.y * hi.y) + (hi.z * hi.z + hi.w * hi.w);
            ss_add((unsigned long long*)(C.ws + CTL_SSKV) + (size_t)l * NR + R, s); break; }
        case 7: { *(u32x4*)(wsb(C, A_CQ) + (size_t)R * 384 + colp) = pack8(lo, hi);
            const float s = (lo.x * lo.x + lo.y * lo.y) + (lo.z * lo.z + lo.w * lo.w) + (hi.x * hi.x + hi.y * hi.y) + (hi.z * hi.z + hi.w * hi.w);
            ss_add((unsigned long long*)(C.ws + CTL_SSQ) + (size_t)l * NR + R, s); break; }
        default: {
            if (colp < 128) { *(u32x4*)(wsb(C, A_CQ) + (size_t)R * 384 + 256 + colp) = pack8(lo, hi);
                const float s = (lo.x * lo.x + lo.y * lo.y) + (lo.z * lo.z + lo.w * lo.w) + (hi.x * hi.x + hi.y * hi.y) + (hi.z * hi.z + hi.w * hi.w);
                ss_add((unsigned long long*)(C.ws + CTL_SSQ) + (size_t)l * NR + R, s); }
            else if (colp < 160) { const int p = colp - 128;
                if (lat) rope4(lo, hi, (const f32x2*)(C.ws + WS_TAB32) + t * 16 + (p >> 3) * 4);
                *(u32x4*)(wsb(C, A_KR) + (size_t)R * 32 + p) = pack8(lo, hi); }
            break; }
        }
    }
    static constexpr int GROUP = 4; struct Pre {}; __device__ __forceinline__ void unit_begin(const Unit&, int) const {} __device__ __forceinline__ void pre(const Unit&, int, int, Pre&) const {}
    __device__ __forceinline__ void apply(const Unit& u, int row, int c8, const Pre&, f32x4 v0l, f32x4 v0h, f32x4 v1l, f32x4 v1h) const {
        const Ctx& C = *c;
        if (u.kind == 1) {
            bf16_t* o = wsb(C, A_VDT) + (size_t)(u.pm * 256 + row) * NR + (size_t)u.pn * 256;
            *(u32x4*)(o + c8) = pack8(v0l, v0h); *(u32x4*)(o + 128 + c8) = pack8(v1l, v1h); return; }
        const int R = u.pm * 256 + row; const bool lat = (u.pm % 9) != 0; const int t = (R % RPB) - CTXL;
        one(u, R, lat, t, c8, v0l, v0h); one(u, R, lat, t, 128 + c8, v1l, v1h);
    }
};

struct SchedUp {
    const Ctx* c; int l, n_kn, n_vm, n_uq, n_tot;
    __device__ void init(const Ctx* cc, int ll) { c = cc; l = ll; n_kn = 144 * 2; n_vm = 2 * 144; n_uq = (l == 0 ? 144 : 128) * 3; n_tot = n_kn + n_vm + n_uq; }
    __device__ bool next(int i, Unit& u) const {
        const int L = i * c->G + c->blk; if (L >= n_tot) return false;
        u.rows = nullptr; u.nrows = 256; u.aux = l; u.aux2 = 0;
        if (L < n_kn) { u.pm = L >> 1; u.pn = L & 1; u.kind = 0; u.bperm = 0; u.K = 256; u.a = wsb(*c, A_CKV) + (size_t)u.pm * 256 * 256; u.b = wt(*c, WO_UK) + (size_t)u.pn * 256 * 256; }
        else if (L < n_kn + n_vm) { const int q = L - n_kn; u.pm = q / 144; u.pn = q % 144; u.kind = 1; u.bperm = 1; u.K = 256; u.a = wt(*c, WO_UV) + (size_t)u.pm * 256 * 256; u.b = wsb(*c, A_CKV) + (size_t)u.pn * 256 * 256; }
        else { const int q = L - n_kn - n_vm; const int rt = q / 3; u.pn = q % 3; u.pm = (l == 0) ? rt : ((rt >> 3) * 9 + 1 + (rt & 7)); u.kind = 2; u.bperm = 0; u.K = 384;
            u.a = wsb(*c, A_CQ) + (size_t)u.pm * 256 * 384; u.b = wt(*c, WO_UQ) + (size_t)u.pn * 256 * 384; }
        return true;
    }
};
struct EpiUp {
    const Ctx* c; int l; mutable float rsv[16];
    __device__ __forceinline__ float rstd_kv(int R) const { return 1.f / sqrtf(ss_get((const unsigned long long*)(c->ws + CTL_SSKV) + (size_t)l * NR + R) * (1.f / 256.f) + EPSN); }
    static constexpr int GROUP = 4; struct Pre { unsigned long long ss; };
    __device__ __forceinline__ void unit_begin(const Unit& u, int c8) const {
        if (u.kind == 1) {
#pragma unroll
            for (int h = 0; h < 2; ++h) { const int q0 = h * 128 + c8;
#pragma unroll
                for (int i = 0; i < 8; ++i) rsv[h * 8 + i] = rstd_kv(u.pn * 256 + (q0 & ~31) + pos2tok((q0 & 31) + i)); } }
    }
    __device__ __forceinline__ void pre(const Unit& u, int row, int c8, Pre& p) const {
        p.ss = 0ull;
        if (u.kind == 0) p.ss = *((const unsigned long long*)(c->ws + CTL_SSKV) + (size_t)l * NR + u.pm * 256 + row);
        else if (u.kind == 2) p.ss = *((const unsigned long long*)(c->ws + CTL_SSQ) + (size_t)l * NR + u.pm * 256 + row);
    }
    __device__ __forceinline__ void apply(const Unit& u, int row, int c8, const Pre& p, f32x4 v0l, f32x4 v0h, f32x4 v1l, f32x4 v1h) const {
        const Ctx& C = *c;
        if (u.kind == 0) { const int R = u.pm * 256 + row; const float rs = 1.f / sqrtf((float)p.ss * SS_INV * (1.f / 256.f) + EPSN);
            bf16_t* o = wsb(C, A_KN) + (size_t)R * 512 + u.pn * 256;
            *(u32x4*)(o + c8) = pack8(v0l * rs, v0h * rs); *(u32x4*)(o + 128 + c8) = pack8(v1l * rs, v1h * rs); }
        else if (u.kind == 1) {
            bf16_t* o = wsb(C, A_VMT) + (size_t)(u.pm * 256 + row) * NR + (size_t)u.pn * 256;
#pragma unroll
            for (int h = 0; h < 2; ++h) { const int q0 = h * 128 + c8; f32x4 lo = h ? v1l : v0l, hi = h ? v1h : v0h;
#pragma unroll
                for (int i = 0; i < 4; ++i) { lo[i] *= rsv[h * 8 + i]; hi[i] *= rsv[h * 8 + 4 + i]; }
                *(u32x4*)(o + q0) = pack8(lo, hi); } }
        else { const int R = u.pm * 256 + row; const bool lat = (u.pm % 9) != 0; const int t = (R % RPB) - CTXL;
            const float rs = C2M / sqrtf((float)p.ss * SS_INV * (1.f / 384.f) + EPSN);
#pragma unroll
            for (int h = 0; h < 2; ++h) { const int col = u.pn * 256 + h * 128 + c8; const int pp = col % 96; f32x4 lo = h ? v1l : v0l, hi = h ? v1h : v0h;
                if (lat && pp >= 64) rope4(lo, hi, (const f32x2*)(C.ws + WS_TAB32) + t * 16 + ((pp - 64) >> 3) * 4);
                *(u32x4*)(wsb(C, A_QM) + (size_t)R * 768 + col) = pack8(lo * rs, hi * rs); } }
    }
};
__device__ __forceinline__ void ph_pool(const Ctx& c, int l) {
    LAS bf16_t* tile = (LAS bf16_t*)c.lds;
    const int nitems = 16 * 32 + (l == 0 ? 16 * 4 : 0);
    for (int it = c.blk; it < nitems; it += c.G) {
        int b, s0, n, rbase;
        if (it < 512) { b = it >> 5; s0 = (it & 31) * 64; n = SEQ; rbase = b * RPB + CTXL; } else { const int q = it - 512; b = q >> 2; s0 = (q & 3) * 64; n = CTXL; rbase = b * RPB; }
        __syncthreads();
        for (int q = c.tid; q < 80 * 64; q += 512) { const int rr = q >> 6, ch = q & 63; const int t = s0 - 8 + rr;
            u32x4 v = (u32x4){0u, 0u, 0u, 0u}; if (t >= 0 && t < n) v = *(const u32x4*)(wsb(c, A_PL) + (size_t)(rbase + t) * 512 + ch * 8);
            *(LAS u32x4*)(tile + rr * 512 + ch * 8) = v; }
        __syncthreads();
        const int ch = c.tid & 63, g = ch >> 4, w = 2 << g;
        for (int rr = c.tid >> 6; rr < 64; rr += 8) { const int t = s0 + rr; const int lo = max(t - w / 2, 0), hi = min(t + w / 2, n);
            float acc[8];
#pragma unroll
            for (int q = 0; q < 8; ++q) acc[q] = 0.f;
            for (int j = lo; j < hi; ++j) { f32x4 a, bq; unpack8(*(const LAS u32x4*)(tile + (j - s0 + 8) * 512 + ch * 8), a, bq);
                acc[0] += a.x; acc[1] += a.y; acc[2] += a.z; acc[3] += a.w; acc[4] += bq.x; acc[5] += bq.y; acc[6] += bq.z; acc[7] += bq.w; }
            f32x4 xa, xb; unpack8(*(const LAS u32x4*)(tile + (rr + 8) * 512 + ch * 8), xa, xb);
            const float inv = 1.f / (float)(hi - lo);
            const f32x4 oa = (f32x4){acc[0], acc[1], acc[2], acc[3]} * inv - xa, ob = (f32x4){acc[4], acc[5], acc[6], acc[7]} * inv - xb;
            *(u32x4*)(wsb(c, A_PD) + (size_t)(rbase + t) * 512 + ch * 8) = pack8(oa, ob); }
    }
    __syncthreads();
}

__device__ __forceinline__ float lam_of(const Ctx& c, int l) {
    float s1 = 0.f, s2 = 0.f;
    for (int i = 0; i < 64; ++i) { s1 += INP(c, I_LQ1)[l * 64 + i] * INP(c, I_LK1)[l * 64 + i]; s2 += INP(c, I_LQ2)[l * 64 + i] * INP(c, I_LK2)[l * 64 + i]; }
    const float lam_init = 0.8f - 0.6f * expf(-0.3f * (float)l);
    return expf(s1) - expf(s2) + lam_init;
}
__device__ __forceinline__ void ph_attn_naive(const Ctx& c, int l) {
    const long gt = (long)c.blk * 512 + c.tid, NT = (long)c.G * 512;
    for (long it = gt; it < (long)NR * 16; it += NT) {
        const int dc = (int)(it & 1), h = (int)((it >> 1) & 7), R = (int)(it >> 4);
        const int b = R / RPB, j = R % RPB; const bool lat = j >= CTXL;
        if (!lat && l != 0) continue;
        const int nk = lat ? RPB : CTXL; const int kb = b * RPB;
        const bf16_t* qp = wsb(c, A_QM) + (size_t)R * 768 + h * 96;
        float m = -INFINITY, ls = 0.f, o[32];
#pragma unroll
        for (int i = 0; i < 32; ++i) o[i] = 0.f;
        for (int k = 0; k < nk; ++k) {
            const int Rk = kb + k; const bf16_t* kp = wsb(c, A_KN) + (size_t)Rk * 512 + h * 64; const bf16_t* rp = wsb(c, A_KR) + (size_t)Rk * 32;
            float s = 0.f;
            for (int i = 0; i < 96; i += 8) { f32x4 qa, qb, ka, kbb; unpack8(*(const u32x4*)(qp + i), qa, qb); unpack8(*(const u32x4*)(i < 64 ? kp + i : rp + (i - 64)), ka, kbb);
                s += (qa.x * ka.x + qa.y * ka.y) + (qa.z * ka.z + qa.w * ka.w) + (qb.x * kbb.x + qb.y * kbb.y) + (qb.z * kbb.z + qb.w * kbb.w); }
            const float mn = fmaxf(m, s), f = exp2f(m - mn), pv = exp2f(s - mn);
            ls = ls * f + pv; m = mn;
            const size_t vcol = (size_t)(Rk & ~31) + tok2pos(Rk & 31);
            const float pb = bf2f((unsigned short)f2bf(pv));
#pragma unroll
            for (int i = 0; i < 32; ++i) o[i] = o[i] * f + pb * bf2f(wsb(c, A_VMT)[(size_t)(h * 64 + dc * 32 + i) * NR + vcol]);
        }
        const float inv = 1.f / ls;
        bf16_t* op = wsb(c, A_OM) + (size_t)R * 512 + h * 64 + dc * 32;
#pragma unroll
        for (int i = 0; i < 32; i += 2) *(unsigned*)(op + i) = pk2(o[i] * inv, o[i + 1] * inv);
    }
    const float lam = lam_of(c, l); const float lam_init = 0.8f - 0.6f * expf(-0.3f * (float)l);
    for (long it = gt; it < (long)NR * 32; it += NT) {
        const int dc = (int)(it & 7), h = (int)((it >> 3) & 3), R = (int)(it >> 5);
        const int b = R / RPB, j = R % RPB; const bool lat = j >= CTXL;
        const bool act = lat || l == 0;
        const int nk = act ? (lat ? RPB : CTXL) : 0; const int kb = b * RPB;
        const bf16_t* qp = wsb(c, A_QD) + (size_t)R * 512 + h * 128;
        float m0 = -INFINITY, m1 = -INFINITY, l0 = 0.f, l1 = 0.f, o0[16], o1[16];
#pragma unroll
        for (int i = 0; i < 16; ++i) { o0[i] = 0.f; o1[i] = 0.f; }
        for (int k = 0; k < nk; ++k) {
            const int Rk = kb + k; const bf16_t* kp = wsb(c, A_KD) + (size_t)Rk * 512 + h * 128;
            float s0 = 0.f, s1 = 0.f;
#pragma unroll 2
            for (int i = 0; i < 64; i += 8) { f32x4 qa, qb, ka, kbb; unpack8(*(const u32x4*)(qp + i), qa, qb); unpack8(*(const u32x4*)(kp + i), ka, kbb);
                s0 += (qa.x * ka.x + qa.y * ka.y) + (qa.z * ka.z + qa.w * ka.w) + (qb.x * kbb.x + qb.y * kbb.y) + (qb.z * kbb.z + qb.w * kbb.w);
                unpack8(*(const u32x4*)(qp + 64 + i), qa, qb); unpack8(*(const u32x4*)(kp + 64 + i), ka, kbb);
                s1 += (qa.x * ka.x + qa.y * ka.y) + (qa.z * ka.z + qa.w * ka.w) + (qb.x * kbb.x + qb.y * kbb.y) + (qb.z * kbb.z + qb.w * kbb.w); }
            const float mn0 = fmaxf(m0, s0), f0 = exp2f(m0 - mn0), p0 = exp2f(s0 - mn0); l0 = l0 * f0 + p0; m0 = mn0;
            const float mn1 = fmaxf(m1, s1), f1 = exp2f(m1 - mn1), p1 = exp2f(s1 - mn1); l1 = l1 * f1 + p1; m1 = mn1;
            const size_t vcol = (size_t)(Rk & ~31) + tok2pos(Rk & 31);
            const float pb0 = bf2f((unsigned short)f2bf(p0)), pb1 = bf2f((unsigned short)f2bf(p1));
#pragma unroll
            for (int i = 0; i < 16; ++i) { const float v = bf2f(wsb(c, A_VDT)[(size_t)(h * 128 + dc * 16 + i) * NR + vcol]); o0[i] = o0[i] * f0 + pb0 * v; o1[i] = o1[i] * f1 + pb1 * v; }
        }
        float ss = 0.f; const float i0 = act ? 1.f / l0 : 0.f, i1 = act ? lam / l1 : 0.f;
#pragma unroll
        for (int i = 0; i < 16; ++i) { o0[i] = o0[i] * i0 - o1[i] * i1; ss += o0[i] * o0[i]; }
        ss += __shfl_xor(ss, 1); ss += __shfl_xor(ss, 2); ss += __shfl_xor(ss, 4);
        const float rs = (1.f - lam_init) / sqrtf(ss * (1.f / 128.f) + EPSN);
        if (act) { bf16_t* op = wsb(c, A_QD) + (size_t)R * 512 + h * 128 + dc * 16; const float* g = INP(c, I_GSUBLN) + l * 128 + dc * 16;
#pragma unroll
            for (int i = 0; i < 16; i += 2) *(unsigned*)(op + i) = pk2(o0[i] * rs * g[i], o0[i + 1] * rs * g[i + 1]); }
    }
}


typedef float f32x16 __attribute__((ext_vector_type(16)));
template <bool DIFF>
__device__ __forceinline__ void attn_unit(const Ctx& c, int l, int b, int h, int q0  , int nk  , float lam, float lam_init) {
    constexpr int DQ = DIFF ? 64 : 96, DV = DIFF ? 128 : 64, NCK = DIFF ? 16 : 12  , KB = NCK * 1024, VB = 8 * DV * 16, SLOT = KB + VB;
    constexpr int NDS = DQ / 16, NDB = DV / 32;
    static_assert(3 * SLOT + 8 * 512 + (DIFF ? 0 : 32768) <= LDS_MISC && (!DIFF || 65536 <= 3 * SLOT), "attention LDS map");
    LAS unsigned char* lds = c.lds;
    const int lane = c.lane, wid = c.wave, r32 = lane & 31, hi = lane >> 5;
    const int map = DIFF ? (wid >> 2) : 0, wq = DIFF ? (wid & 3) : wid;
    const int kb = b * RPB, NT = nk / 64;
    LAS float* wsf = (LAS float*)(lds + 3 * SLOT + wid * 512);
    const bf16_t* ksrc0; const bf16_t* ksrc1; const bf16_t* vsrc0; const bf16_t* vsrc1; size_t kstep0, kstep1; unsigned kd0, kd1, vd0, vd1; bool has_k1;
    if constexpr (DIFF) {
        ksrc0 = wsb(c, A_KD) + (size_t)(kb + lane) * 512 + h * 128 + wid * 8; ksrc1 = ksrc0 + 64; kstep0 = kstep1 = (size_t)64 * 512; kd0 = wid * 1024; kd1 = (wid + 8) * 1024; has_k1 = true;
        vsrc0 = wsb(c, A_VDT) + (size_t)(h * 128 + lane) * NR + kb + wid * 8; vsrc1 = vsrc0 + (size_t)64 * NR; vd0 = KB + (wid * DV + lane) * 16; vd1 = KB + (wid * DV + 64 + lane) * 16;
    } else {
        ksrc0 = wsb(c, A_KN) + (size_t)(kb + lane) * 512 + h * 64 + wid * 8; kstep0 = (size_t)64 * 512; kd0 = wid * 1024;
        ksrc1 = wsb(c, A_KR) + (size_t)(kb + lane) * 32 + (wid & 3) * 8; kstep1 = (size_t)64 * 32; kd1 = (8 + (wid & 3)) * 1024; has_k1 = wid < 4;
        vsrc0 = wsb(c, A_VMT) + (size_t)(h * 64 + lane) * NR + kb + wid * 8; vsrc1 = vsrc0; vd0 = KB + (wid * DV + lane) * 16; vd1 = vd0;
    }
    const unsigned kdb0 = kd0, kdb1 = kd1, vdb0 = DIFF ? (KB + wid * DV * 16) : (KB + wid * DV * 16), vdb1 = KB + (wid * DV + 64) * 16;
    (void)vd0; (void)vd1;
#define AT_DMA(t, slot) do { const unsigned so_ = (unsigned)(slot) * SLOT; \
        __builtin_amdgcn_global_load_lds((const unsigned*)(ksrc0 + (size_t)(t) * kstep0), (LAS unsigned*)(lds + so_ + kdb0), 16, 0, 0); \
        if (has_k1) __builtin_amdgcn_global_load_lds((const unsigned*)(ksrc1 + (size_t)(t) * kstep1), (LAS unsigned*)(lds + so_ + kdb1), 16, 0, 0); \
        __builtin_amdgcn_global_load_lds((const unsigned*)(vsrc0 + (size_t)(t) * 64), (LAS unsigned*)(lds + so_ + vdb0), 16, 0, 0); \
        if (DIFF) __builtin_amdgcn_global_load_lds((const unsigned*)(vsrc1 + (size_t)(t) * 64), (LAS unsigned*)(lds + so_ + vdb1), 16, 0, 0); } while (0)
#define AT_WAIT1() do { if (DIFF) asm volatile("s_waitcnt vmcnt(4)" ::: "memory"); else if (has_k1) asm volatile("s_waitcnt vmcnt(3)" ::: "memory"); else asm volatile("s_waitcnt vmcnt(2)" ::: "memory"); } while (0)
    const int qrow = q0 + wq * 32 + r32;
    const bf16_t* qp = DIFF ? (wsb(c, A_QD) + (size_t)qrow * 512 + h * 128 + map * 64) : (wsb(c, A_QM) + (size_t)qrow * 768 + h * 96);
    bf16x8 qr[NDS];
#pragma unroll
    for (int ds = 0; ds < NDS; ++ds) qr[ds] = *(const bf16x8*)(qp + ds * 16 + hi * 8);
    AT_DMA(0, 0); if (NT > 1) AT_DMA(1, 1);
    f32x16 o[NDB];
#pragma unroll
    for (int d = 0; d < NDB; ++d) o[d] = f32x16{};
    float mhat = 0.f, lsum = 0.f; f32x16 negm = f32x16{};
    const int kchunk0 = DIFF ? map * 8 : 0;
    int slot = 0;
    for (int t = 0; t < NT; ++t) {
        if (t + 1 < NT) AT_WAIT1(); else asm volatile("s_waitcnt vmcnt(0)" ::: "memory");
        asm volatile("s_barrier" ::: "memory");
        if (t + 2 < NT) { const int s2 = (slot >= 1) ? slot - 1 : 2; AT_DMA(t + 2, s2); }
        const LAS unsigned char* ks = lds + slot * SLOT; const LAS unsigned char* vs = ks + KB;
        f32x16 p0 = negm, p1 = negm;
#pragma unroll
        for (int ds = 0; ds < NDS; ++ds) {
            const bf16x8 k0 = *(const LAS bf16x8*)(ks + ((kchunk0 + 2 * ds + hi) * 64 + r32) * 16);
            const bf16x8 k1 = *(const LAS bf16x8*)(ks + ((kchunk0 + 2 * ds + hi) * 64 + 32 + r32) * 16);
            p0 = __builtin_amdgcn_mfma_f32_32x32x16_bf16(k0, qr[ds], p0, 0, 0, 0);
            p1 = __builtin_amdgcn_mfma_f32_32x32x16_bf16(k1, qr[ds], p1, 0, 0, 0);
        }
        float rm = fmaxf(p0[0], p1[0]);
#pragma unroll
        for (int r = 1; r < 16; ++r) rm = fmaxf(rm, fmaxf(p0[r], p1[r]));
        rm = fmaxf(rm, __shfl_xor(rm, 32));
        const bool first = (t == 0);
        if (first || __any(rm > 8.0f)) {
            const float dl = first ? rm : fmaxf(rm, 0.f);
            mhat += dl;
#pragma unroll
            for (int r = 0; r < 16; ++r) { p0[r] -= dl; p1[r] -= dl; negm[r] = -mhat; }
            if (!first) {
                const float f = __builtin_amdgcn_exp2f(-dl); lsum *= f;
                if (hi == 0) wsf[r32] = f;
                asm volatile("s_waitcnt lgkmcnt(0)" ::: "memory");
#pragma unroll
                for (int r = 0; r < 16; ++r) { const float fr_ = wsf[(r & 3) + 8 * (r >> 2) + 4 * hi];
#pragma unroll
                    for (int d = 0; d < NDB; ++d) o[d][r] *= fr_; }
            }
        }
        float sacc = 0.f;
#pragma unroll
        for (int r = 0; r < 16; ++r) { p0[r] = __builtin_amdgcn_exp2f(p0[r]); p1[r] = __builtin_amdgcn_exp2f(p1[r]); sacc += p0[r] + p1[r]; }
        lsum += sacc;
        bf16x8 pa[4];
        { u32x4 w;
          w.x = pk2(p0[0], p0[1]); w.y = pk2(p0[2], p0[3]); w.z = pk2(p0[4], p0[5]); w.w = pk2(p0[6], p0[7]); pa[0] = __builtin_bit_cast(bf16x8, w);
          w.x = pk2(p0[8], p0[9]); w.y = pk2(p0[10], p0[11]); w.z = pk2(p0[12], p0[13]); w.w = pk2(p0[14], p0[15]); pa[1] = __builtin_bit_cast(bf16x8, w);
          w.x = pk2(p1[0], p1[1]); w.y = pk2(p1[2], p1[3]); w.z = pk2(p1[4], p1[5]); w.w = pk2(p1[6], p1[7]); pa[2] = __builtin_bit_cast(bf16x8, w);
          w.x = pk2(p1[8], p1[9]); w.y = pk2(p1[10], p1[11]); w.z = pk2(p1[12], p1[13]); w.w = pk2(p1[14], p1[15]); pa[3] = __builtin_bit_cast(bf16x8, w); }
#pragma unroll
        for (int d = 0; d < NDB; ++d)
#pragma unroll
            for (int s4 = 0; s4 < 4; ++s4) {
                const bf16x8 vf = *(const LAS bf16x8*)(vs + ((2 * s4 + hi) * DV + d * 32 + r32) * 16);
                o[d] = __builtin_amdgcn_mfma_f32_32x32x16_bf16(pa[s4], vf, o[d], 0, 0, 0);
            }
        slot = (slot == 2) ? 0 : slot + 1;
    }
    lsum += __shfl_xor(lsum, 32);
    if (hi == 0) wsf[32 + r32] = lsum;
    asm volatile("s_waitcnt lgkmcnt(0)" ::: "memory");
    float rl[16];
#pragma unroll
    for (int r = 0; r < 16; ++r) rl[r] = 1.f / wsf[32 + (r & 3) + 8 * (r >> 2) + 4 * hi];
    LAS unsigned char* xch = DIFF ? lds : lds + 3 * SLOT + 8 * 512;
    asm volatile("s_barrier" ::: "memory");
    if constexpr (DIFF) {
        LAS float* x1 = (LAS float*)xch + wq * 4096;
        if (map == 1) {
#pragma unroll
            for (int d = 0; d < NDB; ++d)
#pragma unroll
                for (int r = 0; r < 16; ++r) x1[((r & 3) + 8 * (r >> 2) + 4 * hi) * 128 + d * 32 + r32] = o[d][r] * rl[r] * lam;
        }
        asm volatile("s_waitcnt lgkmcnt(0)\n\ts_barrier" ::: "memory");
        if (map == 0) {
            float ss[16];
#pragma unroll
            for (int r = 0; r < 16; ++r) ss[r] = 0.f;
#pragma unroll
            for (int d = 0; d < NDB; ++d)
#pragma unroll
                for (int r = 0; r < 16; ++r) { const float v = o[d][r] * rl[r] - x1[((r & 3) + 8 * (r >> 2) + 4 * hi) * 128 + d * 32 + r32]; o[d][r] = v; ss[r] += v * v; }
#pragma unroll
            for (int r = 0; r < 16; ++r) { float v = ss[r]; v += __shfl_xor(v, 1); v += __shfl_xor(v, 2); v += __shfl_xor(v, 4); v += __shfl_xor(v, 8); v += __shfl_xor(v, 16); ss[r] = (1.f - lam_init) / sqrtf(v * (1.f / 128.f) + EPSN); }
            float g[NDB];
#pragma unroll
            for (int d = 0; d < NDB; ++d) g[d] = INP(c, I_GSUBLN)[l * 128 + d * 32 + r32];
            asm volatile("s_waitcnt lgkmcnt(0)" ::: "memory");
            LAS bf16_t* stg = (LAS bf16_t*)x1;
#pragma unroll
            for (int d = 0; d < NDB; ++d)
#pragma unroll
                for (int r = 0; r < 16; ++r) stg[((r & 3) + 8 * (r >> 2) + 4 * hi) * 128 + d * 32 + r32] = (bf16_t)f2bf(o[d][r] * ss[r] * g[d]);
            asm volatile("s_waitcnt lgkmcnt(0)" ::: "memory");
            bf16_t* op = wsb(c, A_QD) + (size_t)(q0 + wq * 32) * 512 + h * 128;
#pragma unroll
            for (int i = 0; i < 8; ++i) { const int row = i * 4 + (lane >> 4), ch = lane & 15; *(u32x4*)(op + (size_t)row * 512 + ch * 8) = *(const LAS u32x4*)(stg + row * 128 + ch * 8); }
        }
        asm volatile("s_waitcnt lgkmcnt(0)\n\ts_barrier" ::: "memory");
    } else {
        LAS bf16_t* stg = (LAS bf16_t*)xch + wid * 2048;
#pragma unroll
        for (int d = 0; d < NDB; ++d)
#pragma unroll
            for (int r = 0; r < 16; ++r) stg[((r & 3) + 8 * (r >> 2) + 4 * hi) * 64 + d * 32 + r32] = (bf16_t)f2bf(o[d][r] * rl[r]);
        asm volatile("s_waitcnt lgkmcnt(0)" ::: "memory");
        bf16_t* op = wsb(c, A_OM) + (size_t)(q0 + wid * 32) * 512 + h * 64;
#pragma unroll
        for (int i = 0; i < 4; ++i) { const int row = i * 8 + (lane >> 3), ch = lane & 7; *(u32x4*)(op + (size_t)row * 512 + ch * 8) = *(const LAS u32x4*)(stg + row * 64 + ch * 8); }
        asm volatile("s_waitcnt lgkmcnt(0)" ::: "memory");
    }
#undef AT_DMA
#undef AT_WAIT1
}
__device__ __forceinline__ void ph_attn_fast(const Ctx& c, int l) {
    const float lam = lam_of(c, l), lam_init = 0.8f - 0.6f * expf(-0.3f * (float)l);
    const int n_mla = 1024 + (l == 0 ? 128 : 0);
    for (int rep = 0; rep < NREP(16); ++rep)
    for (int u = c.blk; u < n_mla; u += c.G) {
        if (u < 1024) { const int b = u >> 6, h = (u >> 3) & 7, qt = u & 7; attn_unit<false>(c, l, b, h, b * RPB + CTXL + qt * 256, RPB, lam, lam_init); }
        else { const int q = u - 1024, b = q >> 3, h = q & 7; attn_unit<false>(c, l, b, h, b * RPB, CTXL, lam, lam_init); }
    }
    const int n_diff = 1024 + (l == 0 ? 128 : 0);
    for (int u = c.blk; u < n_diff; u += c.G) {
        if (u < 1024) { const int b = u >> 6, h = (u >> 4) & 3, qt = u & 15; attn_unit<true>(c, l, b, h, b * RPB + CTXL + qt * 128, RPB, lam, lam_init); }
        else { const int q = u - 1024, b = q >> 3, h = (q >> 1) & 3, qt = q & 1; attn_unit<true>(c, l, b, h, b * RPB + qt * 128, CTXL, lam, lam_init); }
    }
}

struct SchedMerge1 {
    const Ctx* c; int l, n_units;
    __device__ void init(const Ctx* cc, int ll) { c = cc; l = ll; n_units = (l == 0 ? 144 : 128) * 4; }
    __device__ bool next(int i, Unit& u) const {
        const int U = (i / 6) * c->G + c->blk, pass = i % 6; if (U >= n_units) return false;
        const int rt = U >> 2; u.pn = U & 3; u.pm = (l == 0) ? rt : ((rt >> 3) * 9 + 1 + (rt & 7));
        u.rows = nullptr; u.nrows = 256; u.aux = l; u.aux2 = 0; u.bperm = 0; u.kind = pass;
        const int br = pass >> 1;
        if ((pass & 1) == 0) { u.K = 1024; u.a = wsb(*c, A_HX) + (size_t)u.pm * 256 * 1024; u.b = wt(*c, WO_G) + (size_t)(br * 1024 + u.pn * 256) * 1024; }
        else { u.K = 512; u.a = wsb(*c, br == 0 ? A_OM : (br == 1 ? A_PD : A_QD)) + (size_t)u.pm * 256 * 512;
               u.b = wt(*c, br == 0 ? WO_BM : (br == 1 ? WO_PP : WO_BD)) + (size_t)u.pn * 256 * 512; }
        return true;
    }
};
struct EpiMerge1 {
    const Ctx* c;
    static constexpr int GROUP = 2; struct Pre { u32x4 g0, g1, t0, t1; };
    __device__ __forceinline__ void unit_begin(const Unit&, int) const {}
    __device__ __forceinline__ void pre(const Unit& u, int row, int c8, Pre& p) const {
        p.g0 = p.g1 = p.t0 = p.t1 = (u32x4){0u, 0u, 0u, 0u};
        if (u.kind & 1) { const bf16_t* sg = (const bf16_t*)(c->ws + A_SCR + (size_t)c->blk * 262144); const bf16_t* st = sg + 65536; const size_t so = (size_t)row * 256 + c8;
            p.g0 = *(const u32x4*)(sg + so); p.g1 = *(const u32x4*)(sg + so + 128);
            p.t0 = *(const u32x4*)(st + so); p.t1 = *(const u32x4*)(st + so + 128); }
    }
    __device__ __forceinline__ void apply(const Unit& u, int row, int c8, const Pre& p, f32x4 v0l, f32x4 v0h, f32x4 v1l, f32x4 v1h) const {
        const Ctx& C = *c;
        bf16_t* sg = (bf16_t*)(C.ws + A_SCR + (size_t)C.blk * 262144); bf16_t* st = sg + 65536;
#pragma unroll
        for (int h = 0; h < 2; ++h) { const int q0 = h * 128 + c8; f32x4 lo = h ? v1l : v0l, hi = h ? v1h : v0h; const size_t so = (size_t)row * 256 + q0;
            if ((u.kind & 1) == 0) {
#pragma unroll
                for (int i = 0; i < 4; ++i) { lo[i] = sigmoidf_(lo[i]); hi[i] = sigmoidf_(hi[i]); }
                *(u32x4*)(sg + so) = pack8(lo, hi);
            } else {
                f32x4 gl, gh; unpack8(h ? p.g1 : p.g0, gl, gh); lo *= gl; hi *= gh;
                if (u.kind > 1) { f32x4 tl, th; unpack8(h ? p.t1 : p.t0, tl, th); lo += tl; hi += th; }
                if (u.kind < 5) *(u32x4*)(st + so) = pack8(lo, hi);
                else *(u32x4*)(wsb(C, A_MG) + (size_t)(u.pm * 256 + row) * 1024 + u.pn * 256 + q0) = pack8(lo, hi);
            } }
    }
};
struct SchedMerge2 {
    const Ctx* c; int l, n_units;
    __device__ void init(const Ctx* cc, int ll) { c = cc; l = ll; n_units = (l == 0 ? 144 : 128) * 4; }
    __device__ bool next(int i, Unit& u) const {
        const int U = i * c->G + c->blk; if (U >= n_units) return false;
        const int rt = U >> 2; u.pn = U & 3; u.pm = (l == 0) ? rt : ((rt >> 3) * 9 + 1 + (rt & 7));
        u.rows = nullptr; u.nrows = 256; u.aux = l; u.aux2 = 0; u.bperm = 0; u.kind = 0; u.K = 1024;
        u.a = wsb(*c, A_MG) + (size_t)u.pm * 256 * 1024; u.b = wt(*c, WO_O) + (size_t)u.pn * 256 * 1024; return true;
    }
};
struct EpiMerge2 {
    const Ctx* c;
    static constexpr int GROUP = 4; struct Pre {}; __device__ __forceinline__ void unit_begin(const Unit&, int) const {} __device__ __forceinline__ void pre(const Unit&, int, int, Pre&) const {}
    __device__ __forceinline__ void apply(const Unit& u, int row, int c8, const Pre&, f32x4 v0l, f32x4 v0h, f32x4 v1l, f32x4 v1h) const {
        bf16_t* o = wsb(*c, A_Y1) + (size_t)(u.pm * 256 + row) * 1024 + u.pn * 256;
        *(u32x4*)(o + c8) = pack8(v0l, v0h); *(u32x4*)(o + 128 + c8) = pack8(v1l, v1h);
    }
};

__device__ __forceinline__ void ph_t4_router(const Ctx& c, int l) {
    LAS bf16_t* wr = (LAS bf16_t*)c.lds; constexpr int WRP = 1032;
    for (int q = c.tid; q < 64 * 128; q += 512) { const int e = q >> 7, ch = q & 127; *(LAS u32x4*)(wr + e * WRP + ch * 8) = *(const u32x4*)(wt(c, WO_R) + (size_t)e * 1024 + ch * 8); }
    LAS unsigned* hist = (LAS unsigned*)(c.lds + 64 * WRP * 2 + c.wave * 512);
    LAS unsigned* stash = (LAS unsigned*)(c.lds + 64 * WRP * 2 + 4096 + c.wave * 2048);
    static_assert(64 * WRP * 2 + 4096 + 8 * 2048 <= LDS_MISC, "router LDS map");
    __syncthreads();
    const int gw = c.blk * 8 + c.wave, NGW = c.G * 8;
    const int r32 = c.lane & 31, hi = c.lane >> 5;
    unsigned* CNT = (unsigned*)(c.ws + CTL_CNT);
    for (int g = gw; g < NR / 32; g += NGW) {
        const int R0 = g * 32; const bool lat = (R0 % RPB) >= CTXL;
        if (!lat && l != 0) continue;
#pragma unroll 1
        for (int rr = 0; rr < 32; ++rr) { const int R = R0 + rr;
            u32x2 yw[4]; const bf16_t* yp = wsb(c, A_Y1) + (size_t)R * 1024;
#pragma unroll
            for (int j = 0; j < 4; ++j) yw[j] = *((const u32x2*)yp + c.lane + 64 * j);
            f32x4 y[4];
#pragma unroll
            for (int j = 0; j < 4; ++j) y[j] = (f32x4){bflo(yw[j].x), bfhi(yw[j].x), bflo(yw[j].y), bfhi(yw[j].y)};
            const float rs1 = 1.f / sqrtf(row_sumsq(y) * (1.f / DM) + EPSN);
            f32x4 h[4]; load_row_f32(res_rd(c, l, R), c.lane, h);
            const float* g1 = INP(c, I_GPOSTMIX) + l * DM; const float* m2 = modvec(c, l, R, 2);
#pragma unroll
            for (int j = 0; j < 4; ++j) { const int o = c.lane + 64 * j; h[j] += *((const f32x4*)m2 + o) * (y[j] * rs1 * *((const f32x4*)g1 + o)); }
            float* hw = res_wr(c, R);
#pragma unroll
            for (int j = 0; j < 4; ++j) *((f32x4*)hw + c.lane + 64 * j) = h[j];
            const float rs2 = 1.f / sqrtf(row_sumsq(h) * (1.f / DM) + EPSN);
            norm_mod_store(h, rs2, INP(c, I_GPREFFN) + l * DM, modvec(c, l, R, 3), modvec(c, l, R, 4), wsb(c, A_HX) + (size_t)R * DM, c.lane);
        }
        asm volatile("s_waitcnt vmcnt(0)" ::: "memory");
        typedef float f32x16 __attribute__((ext_vector_type(16)));
        f32x16 a0 = {}, a1 = {};
        const bf16_t* fxp = wsb(c, A_HX) + (size_t)(R0 + r32) * 1024 + hi * 8;
#pragma unroll 4
        for (int s = 0; s < 64; ++s) {
            const bf16x8 bq = *(const bf16x8*)(fxp + s * 16);
            const bf16x8 w0 = *(const LAS bf16x8*)(wr + r32 * WRP + s * 16 + hi * 8), w1 = *(const LAS bf16x8*)(wr + (32 + r32) * WRP + s * 16 + hi * 8);
            a0 = __builtin_amdgcn_mfma_f32_32x32x16_bf16(w0, bq, a0, 0, 0, 0); a1 = __builtin_amdgcn_mfma_f32_32x32x16_bf16(w1, bq, a1, 0, 0, 0);
        }
        float sel[64];
        const float* br = INP(c, I_BROUTER) + l * 64;
#pragma unroll
        for (int blk = 0; blk < 2; ++blk)
#pragma unroll
            for (int r = 0; r < 16; ++r) { const float own = blk ? a1[r] : a0[r]; const float oth = __shfl_xor(own, 32);
                const int eA = blk * 32 + (r & 3) + 8 * (r >> 2);
                const float xa = hi ? oth : own, xb = hi ? own : oth;
                sel[eA] = 1.f / (1.f + expf(-xa)) + br[eA]; sel[eA + 4] = 1.f / (1.f + expf(-xb)) + br[eA + 4]; }
        float gs[8];
#pragma unroll
        for (int G = 0; G < 8; ++G) { float m1 = -INFINITY, m2 = -INFINITY;
#pragma unroll
            for (int q = 0; q < 8; ++q) { const float v = sel[G * 8 + q]; if (v > m1) { m2 = m1; m1 = v; } else if (v > m2) m2 = v; }
            gs[G] = m1 + m2; }
#pragma unroll
        for (int G = 0; G < 8; ++G) { int rank = 0;
#pragma unroll
            for (int q = 0; q < 8; ++q) rank += (gs[q] > gs[G] || (gs[q] == gs[G] && q < G)) ? 1 : 0;
#pragma unroll
            for (int q = 0; q < 8; ++q) { const int e = G * 8 + q; const float key = __builtin_bit_cast(float, (__builtin_bit_cast(unsigned, sel[e]) & ~63u) | (unsigned)(63 - e)); sel[e] = (rank >= 4) ? -1e30f : key; } }
        float wsum = 0.f;
#pragma unroll 1
        for (int k = 0; k < 8; ++k) { float best = sel[0];
#pragma unroll
            for (int e = 1; e < 64; ++e) best = fmaxf(best, sel[e]);
#pragma unroll
            for (int e = 0; e < 64; ++e) sel[e] = (sel[e] == best) ? -1e30f : sel[e];
            const int bi = 63 - (int)(__builtin_bit_cast(unsigned, best) & 63u); const float bs = best - br[bi];
            stash[k * 64 + c.lane] = (__builtin_bit_cast(unsigned, bs) & ~63u) | (unsigned)bi; wsum += bs; }
        asm volatile("s_waitcnt lgkmcnt(0)" ::: "memory");
        int ei[8]; float ew[8];
#pragma unroll
        for (int k = 0; k < 8; ++k) { const unsigned w_ = stash[k * 64 + c.lane]; ei[k] = (int)(w_ & 63u); ew[k] = __builtin_bit_cast(float, w_ & ~63u); }
        const float wn = 2.5f / wsum;
        const int R = R0 + r32; const int ch = R0 / CHROWS;
        hist[c.lane] = 0u; asm volatile("s_waitcnt lgkmcnt(0)" ::: "memory");
        unsigned rk[8];
#pragma unroll
        for (int k = 0; k < 8; ++k) { rk[k] = 0u; if (hi == 0) rk[k] = atomicAdd((unsigned*)&hist[ei[k]], 1u); }
        asm volatile("s_waitcnt lgkmcnt(0)" ::: "memory");
        { const unsigned cnt = hist[c.lane]; unsigned base = 0u; if (cnt) base = atomicAdd(CNT + (l * 2 + ch) * 128 + c.lane, cnt); hist[64 + c.lane] = base; }
        asm volatile("s_waitcnt vmcnt(0) lgkmcnt(0)" ::: "memory");
        if (hi == 0) {
            unsigned* rt_ = (unsigned*)(c.ws + WS_REGT); float* rw_ = (float*)(c.ws + WS_REGW);
#pragma unroll
            for (int k = 0; k < 8; ++k) { const unsigned pos = hist[64 + ei[k]] + rk[k]; const size_t o = ((size_t)ch * 64 + ei[k]) * CAP + pos;
                rt_[o] = ((unsigned)R << 4) | (unsigned)k; rw_[o] = ew[k] * wn; }
        }
        asm volatile("s_waitcnt lgkmcnt(0)" ::: "memory");
    }
    __syncthreads();
}

struct MoeTab { LAS int* tstart; int TR, nsh, ch, l; };
__device__ __forceinline__ MoeTab moe_table(const Ctx& c, int l, int ch) {
    MoeTab T; T.tstart = (LAS int*)(c.lds + LDS_RING + 1024); T.ch = ch; T.l = l;
    __syncthreads();
    if (c.tid == 0) { unsigned* CNT = (unsigned*)(c.ws + CTL_CNT) + (l * 2 + ch) * 128; int acc = 0;
        for (int e = 0; e < 64; ++e) { const int n = (int)__hip_atomic_load(CNT + e, __ATOMIC_RELAXED, __HIP_MEMORY_SCOPE_AGENT); T.tstart[e] = acc; T.tstart[65 + e] = n; acc += (n + 255) >> 8; }
        T.tstart[64] = acc; }
    __syncthreads();
    T.TR = T.tstart[64]; T.nsh = (l == 0) ? 72 : 64;
    return T;
}
__device__ __forceinline__ void moe_tile(const Ctx& c, const MoeTab& T, int t, int& e, int& j, int& nrows, const unsigned*& rows, int& pm_sh) {
    if (t < T.TR) { int lo = 0;
        for (int q = 1; q < 64; ++q) if (T.tstart[q] <= t) lo = q;
        e = lo; j = t - T.tstart[e]; const int n = T.tstart[65 + e]; nrows = min(256, n - 256 * j);
        rows = (const unsigned*)(c.ws + WS_REGT) + ((size_t)T.ch * 64 + e) * CAP + 256 * j; pm_sh = 0; }
    else { const int s = t - T.TR; e = 64; j = s; nrows = 256; rows = nullptr;
        const int bl = (T.l == 0) ? s / 9 : s / 8, r9 = (T.l == 0) ? s % 9 : 1 + (s % 8); pm_sh = (T.ch * 8 + bl) * 9 + r9; }
}
struct SchedGU {
    const Ctx* c; MoeTab T;
    __device__ bool next(int i, Unit& u) const {
        const int L = i * c->G + c->blk; const int t = L >> 1; if (t >= T.TR + T.nsh) return false;
        int e, j, nrows, pm_sh; const unsigned* rows; moe_tile(*c, T, t, e, j, nrows, rows, pm_sh);
        u.pn = L & 1; u.pm = t; u.kind = (e < 64) ? 0 : 1; u.bperm = 0; u.K = 1024; u.rows = rows; u.nrows = nrows; u.aux = e; u.aux2 = T.ch * CHROWS + CTXL;
        u.a = (e < 64) ? wsb(*c, A_HX) : wsb(*c, A_HX) + (size_t)pm_sh * 256 * 1024;
        u.b = wt(*c, WO_GU) + (size_t)e * 524288 + (size_t)u.pn * 256 * 1024; return true;
    }
};
struct EpiGU {
    const Ctx* c; int ch;
    static constexpr int GROUP = 4; struct Pre { float w; };
    __device__ __forceinline__ void unit_begin(const Unit&, int) const {}
    __device__ __forceinline__ void pre(const Unit& u, int row, int c8, Pre& p) const {
        p.w = 1.f;
        if (u.kind == 0) { p.w = 0.f; if (row < u.nrows) p.w = ((const float*)(c->ws + WS_REGW))[(u.rows - (const unsigned*)(c->ws + WS_REGT)) + row]; }
    }
    __device__ __forceinline__ void apply(const Unit& u, int row, int c8, const Pre& p, f32x4 gl, f32x4 gh, f32x4 ul, f32x4 uh) const {
        const float w = p.w;
#pragma unroll
        for (int i = 0; i < 4; ++i) { gl[i] = gl[i] / (1.f + __expf(-gl[i])) * ul[i] * w; gh[i] = gh[i] / (1.f + __expf(-gh[i])) * uh[i] * w; }
        *(u32x4*)(wsb(*c, A_ACT) + ((size_t)u.pm * 256 + row) * 256 + u.pn * 128 + c8) = pack8(gl, gh);
    }
};
struct SchedD {
    const Ctx* c; MoeTab T;
    __device__ bool next(int i, Unit& u) const {
        const int L = i * c->G + c->blk; const int t = L >> 2; if (t >= T.TR + T.nsh) return false;
        int e, j, nrows, pm_sh; const unsigned* rows; moe_tile(*c, T, t, e, j, nrows, rows, pm_sh);
        u.pn = L & 3; u.pm = t; u.kind = (e < 64) ? 0 : 1; u.bperm = 0; u.K = 256; u.rows = nullptr; u.nrows = nrows; u.aux = pm_sh;
        u.a = wsb(*c, A_ACT) + (size_t)t * 256 * 256; u.b = wt(*c, WO_D) + (size_t)e * 262144 + (size_t)u.pn * 256 * 256;
        u.aux2 = (e < 64) ? (int)(rows - (const unsigned*)(c->ws + WS_REGT)) : -1;
        return true;
    }
};
struct EpiD {
    const Ctx* c; int ch;
    static constexpr int GROUP = 8; struct Pre { unsigned ent; };
    __device__ __forceinline__ void unit_begin(const Unit&, int) const {}
    __device__ __forceinline__ void pre(const Unit& u, int row, int c8, Pre& p) const {
        p.ent = 0u; if (u.kind == 0 && row < u.nrows) p.ent = ((const unsigned*)(c->ws + WS_REGT))[(size_t)u.aux2 + row];
    }
    __device__ __forceinline__ void apply(const Unit& u, int row, int c8, const Pre& p, f32x4 v0l, f32x4 v0h, f32x4 v1l, f32x4 v1h) const {
        if (row >= u.nrows) return;
        size_t slot;
        if (u.kind == 0) { const unsigned ent = p.ent; slot = (size_t)((int)(ent >> 4) - ch * CHROWS) * 9 + (ent & 15u); }
        else slot = (size_t)(u.aux * 256 + row - ch * CHROWS) * 9 + 8;
        bf16_t* o = wsb(*c, A_Y) + slot * 1024 + u.pn * 256;
        *(u32x4*)(o + c8) = pack8(v0l, v0h); *(u32x4*)(o + 128 + c8) = pack8(v1l, v1h);
    }
};
__device__ __forceinline__ void ph_combine(const Ctx& c, int l, int ch) {
    const int gw = c.blk * 8 + c.wave, NGW = c.G * 8;
    for (int rr = gw; rr < CHROWS; rr += NGW) {
        const int R = ch * CHROWS + rr; const bool lat = (R % RPB) >= CTXL;
        if (!lat && l != 0) continue;
        f32x4 f[4];
#pragma unroll
        for (int j = 0; j < 4; ++j) f[j] = (f32x4){0.f, 0.f, 0.f, 0.f};
        const bf16_t* yp = wsb(c, A_Y) + (size_t)rr * 9 * 1024;
#pragma unroll
        for (int k = 0; k < 9; ++k)
#pragma unroll
            for (int j = 0; j < 4; ++j) { const u32x2 w = *((const u32x2*)(yp + k * 1024) + c.lane + 64 * j); f[j] += (f32x4){bflo(w.x), bfhi(w.x), bflo(w.y), bfhi(w.y)}; }
        const float rs = 1.f / sqrtf(row_sumsq(f) * (1.f / DM) + EPSN);
        f32x4 h[4]; load_row_f32(res_wr(c, R), c.lane, h);
        const float* g = INP(c, I_GPOSTFFN) + l * DM; const float* m5 = modvec(c, l, R, 5);
#pragma unroll
        for (int j = 0; j < 4; ++j) { const int o = c.lane + 64 * j; h[j] += *((const f32x4*)m5 + o) * (f[j] * rs * *((const f32x4*)g + o)); }
        float* hw = res_wr(c, R);
#pragma unroll
        for (int j = 0; j < 4; ++j) *((f32x4*)hw + c.lane + 64 * j) = h[j];
        if (l == 0) { const float rs2 = 1.f / sqrtf(row_sumsq(h) * (1.f / DM) + EPSN);
            norm_mod_store(h, rs2, INP(c, I_GPREMIX) + 1 * DM, modvec(c, 1, R, 0), modvec(c, 1, R, 1), wsb(c, A_HX) + (size_t)R * DM, c.lane); }
    }
}

__global__ void __launch_bounds__(512, 2) fwd_kernel(Params prm) {
    extern __shared__ __attribute__((aligned(16))) unsigned char lds_raw[];
    Ctx c; c.p = (ParamsK)__builtin_amdgcn_kernarg_segment_ptr(); c.lds = (LAS unsigned char*)lds_raw; c.tid = threadIdx.x; c.lane = c.tid & 63; c.wave = __builtin_amdgcn_readfirstlane(c.tid >> 6);
    c.G = gridDim.x; c.blk = blockIdx.x; c.ws = (GAS unsigned char*)prm.ws; c.z = 0;
    volatile LAS unsigned* MISC = (volatile LAS unsigned*)(c.lds + LDS_MISC);
    if (c.tid < 16) MISC[c.tid] = 0u;
    __syncthreads();
    XcdBarrier bar; bar.bar = (unsigned*)(c.ws + CTL_BAR); bar.x = 0; bar.st = nullptr;
    const int lo = prm.step_lo, hi = prm.step_hi;
    if (hi - lo > 1) bar = xcd_barrier_post((unsigned*)(c.ws + CTL_BAR), MISC + 8);
    int step = 0;
#define RUN() (step >= lo && step < hi)
#define SEAM() do { if (step >= lo && step + 1 < hi) { XcdBarrier b2_ = bar; asm volatile("" : "+s"(b2_.bar), "+s"(b2_.x)); b2_.bar = (unsigned*)rfl64((unsigned long long)b2_.bar); b2_.x = (unsigned)__builtin_amdgcn_readfirstlane((int)b2_.x); xcd_barrier(b2_); } ++step; } while (0)
    for (int l_ = 0; l_ < 2; ++l_) {
        int l = l_; asm volatile("" : "+s"(l)); l = __builtin_amdgcn_readfirstlane(l);
        if (RUN()) { if (PHM & 1) for (int rep = 0; rep < NREP(1); ++rep) { PHASE_CTX(cl); ph_prologue(cl, l); } }
        SEAM();
        if (l == 0) { if (RUN()) { if (PHM & 2) { PHASE_CTX(cl); ph_t1(cl, 0); } } SEAM(); }
        if (RUN()) { if (PHM & 4) { PHASE_CTX(cl); SchedProj S; S.init(&cl, l); EpiProj E{&cl, l}; GEMM_UNITS(cl, S, E); } }
        SEAM();
        if (RUN()) { if (PHM & 8) for (int rep = 0; rep < NREP(8); ++rep) { { PHASE_CTX(cl); SchedUp S; S.init(&cl, l); EpiUp E{&cl, l}; GEMM_UNITS(cl, S, E); } { PHASE_CTX(cl); ph_pool(cl, l); } } }
        SEAM();
        if (RUN()) { if (PHM & 16) { PHASE_CTX(cl); ATTN_PHASE(cl, l); } }
        SEAM();
        if (RUN()) { if (PHM & 32) for (int rep = 0; rep < NREP(32); ++rep) { PHASE_CTX(cl); SchedMerge1 S; S.init(&cl, l); EpiMerge1 E{&cl}; GEMM_UNITS(cl, S, E); } }
        SEAM();
        if (RUN()) { if (PHM & 64) for (int rep = 0; rep < NREP(64); ++rep) { PHASE_CTX(cl); SchedMerge2 S; S.init(&cl, l); EpiMerge2 E{&cl}; GEMM_UNITS(cl, S, E); } }
        SEAM();
        if (RUN()) { if (PHM & 128) { PHASE_CTX(cl); ph_t4_router(cl, l); } }
        SEAM();
        for (int ch = 0; ch < NCHUNK; ++ch) {
            if (RUN()) { if (PHM & 256) for (int rep = 0; rep < NREP(256); ++rep) { PHASE_CTX(cl); SchedGU S; S.c = &cl; S.T = moe_table(cl, l, ch); EpiGU E{&cl, ch}; GEMM_UNITS(cl, S, E); } }
            SEAM();
            if (RUN()) { if (PHM & 512) for (int rep = 0; rep < NREP(512); ++rep) { PHASE_CTX(cl); SchedD S; S.c = &cl; S.T = moe_table(cl, l, ch); EpiD E{&cl, ch}; GEMM_UNITS(cl, S, E); } }
            SEAM();
            if (RUN()) { if (PHM & 1024) { PHASE_CTX(cl); ph_combine(cl, l, ch); } }
            SEAM();
        }
    }
#undef RUN
#undef SEAM
}
constexpr int N_STEPS = 2 * (7 + 3 * NCHUNK) + 1;

extern "C" void kernel_launch(void* const* d_in, const int* in_sizes, int n_in, void* d_out, int out_size, void* d_ws, size_t ws_size, hipStream_t stream) {
    static int grid = 0;
    if (grid == 0) {
        if (n_in != 34 || out_size != NB * SEQ * DM || ws_size < WS_END) { fprintf(stderr, "kernel_launch: unexpected shapes (n_in %d out %d ws %zu need %zu)\n", n_in, out_size, ws_size, (size_t)WS_END); grid = -1; return; }
        int dev = 0, cus = 0;
        if (hipGetDevice(&dev) != hipSuccess || hipDeviceGetAttribute(&cus, hipDeviceAttributeMultiprocessorCount, dev) != hipSuccess) { grid = -1; return; }
        if (hipFuncSetAttribute((const void*)fwd_kernel, hipFuncAttributeMaxDynamicSharedMemorySize, LDS_BYTES) != hipSuccess) { fprintf(stderr, "kernel_launch: hipFuncSetAttribute failed\n"); grid = -1; return; }
        int per_cu = 0; (void)hipOccupancyMaxActiveBlocksPerMultiprocessor(&per_cu, (const void*)fwd_kernel, 512, LDS_BYTES); (void)hipGetLastError();
        if (per_cu < 1) fprintf(stderr, "kernel_launch: occupancy query says %d\n", per_cu);
        grid = cus;
    }
    if (grid < 0) return;
    (void)hipMemsetAsync((char*)d_ws + WS_CTL, 0, CTL_BYTES, stream);
    Params p{};
    for (int i = 0; i < 34; ++i) p.in[i] = (const float*)d_in[i];
    p.out = (float*)d_out; p.ws = (unsigned char*)d_ws;
#if N_LAUNCH_MODE == 1
    p.step_lo = 0; p.step_hi = N_STEPS;
    hipLaunchKernelGGL(fwd_kernel, dim3(grid), dim3(512), LDS_BYTES, stream, p);
#else
    for (int s = 0; s < N_STEPS; ++s) { p.step_lo = s; p.step_hi = s + 1; hipLaunchKernelGGL(fwd_kernel, dim3(grid), dim3(512), LDS_BYTES, stream, p); }
#endif
}
```

```cpp
#include <hip/hip_runtime.h>
#include <cstdio>
#include <cstdint>
#include <cmath>

#ifndef PHM
#define PHM 0xFFFF
#endif
#ifndef USE_FAST_ATTN
#define USE_FAST_ATTN 1
#endif
#if USE_FAST_ATTN
#define ATTN_PHASE ph_attn_fast
#else
#define ATTN_PHASE ph_attn_naive
#endif
#ifndef REP
#define REP 0
#endif
#define NREP(bit) (((REP) & (bit)) ? 2 : 1)
#ifndef TMASK
#define TMASK 0
#endif
#ifndef ATT_TEST_NODIFF
#define ATT_TEST_NODIFF 0
#endif
#ifndef ATT_TEST_NOMLA
#define ATT_TEST_NOMLA 0
#endif
#ifndef N_LAUNCH_MODE
#define N_LAUNCH_MODE 1
#endif

#define GAS __attribute__((address_space(1)))
#define LAS __attribute__((address_space(3)))
typedef unsigned short bf16_t;
typedef float f32x4 __attribute__((ext_vector_type(4)));
typedef float f32x2 __attribute__((ext_vector_type(2)));
typedef unsigned u32x4 __attribute__((ext_vector_type(4)));
typedef unsigned u32x2 __attribute__((ext_vector_type(2)));
typedef short bf16x8 __attribute__((ext_vector_type(8)));

constexpr int DM = 1024, NB = 16, SEQ = 2048, CTXL = 256, RPB = SEQ + CTXL  ;
constexpr int NR = NB * RPB;
constexpr int NTILE = NR / 256;
constexpr int IN_COLS = 5792, KV_COLS = 1312;
constexpr int NEXP = 64, EFF = 256;
constexpr int NCHUNK = 1, CHROWS = NR / NCHUNK, CAP = CHROWS;
constexpr float EPSN = 1e-6f;
constexpr float LOG2E = 1.4426950408889634f;
constexpr float C2M = 0.10206207261596577f * LOG2E;
constexpr float C2D = 0.125f * LOG2E;

constexpr size_t WO_IN = 0;
constexpr size_t WO_VD = WO_IN + 2304ull * 1024 / 2;
constexpr size_t WO_G  = WO_VD + 512ull * 1024 / 2;
constexpr size_t WO_UK = WO_G + 3072ull * 1024 / 2;
constexpr size_t WO_UV = WO_UK + 512ull * 256;
constexpr size_t WO_UQ = WO_UV + 512ull * 256;
constexpr size_t WO_BM = WO_UQ + 768ull * 384;
constexpr size_t WO_PP = WO_BM + 1024ull * 512 / 2;
constexpr size_t WO_BD = WO_PP + 1024ull * 512 / 2;
constexpr size_t WO_O  = WO_BD + 1024ull * 512 / 2;
constexpr size_t WO_R  = WO_O + 1024ull * 1024 / 2;
constexpr size_t WO_GU = WO_R + 64ull * 1024;
constexpr size_t WO_D  = WO_GU + 65ull * 512 * 1024 / 2;
constexpr size_t W_ELEMS = WO_D + 65ull * 1024 * 256 / 2;

constexpr size_t WS_CTL = 0, CTL_BYTES = 3u << 20;
constexpr size_t CTL_BAR = 16384;
constexpr size_t CTL_CNT = 65536;
constexpr size_t CTL_SSKV = 131072;
constexpr size_t CTL_SSQ = CTL_SSKV + 2ull * NR * 8;
constexpr size_t CTL_MOD = CTL_SSQ + 2ull * NR * 8;
static_assert(CTL_MOD + 2ull * 17 * 6144 * 4 <= CTL_BYTES, "ctl");
constexpr size_t WS_TAB64 = CTL_BYTES;
constexpr size_t WS_TAB32 = WS_TAB64 + 2048ull * 32 * 8;
constexpr size_t WS_W = WS_TAB32 + 2048ull * 16 * 8;
constexpr size_t WS_REGT = WS_W + W_ELEMS * 2;
constexpr size_t WS_REGW = WS_REGT + (size_t)NCHUNK * 64 * CAP * 4;
constexpr size_t WS_ACT0 = WS_REGW + (size_t)NCHUNK * 64 * CAP * 4;
constexpr size_t SZ_ROW2K = (size_t)NR * 2048, SZ_ROW1K = (size_t)NR * 1024;
constexpr size_t A_HB = WS_ACT0;
constexpr size_t A_HX = A_HB + SZ_ROW2K;
constexpr size_t A_PD = A_HX;
constexpr size_t A_VMT = A_HX + SZ_ROW1K;
constexpr size_t A_KD = A_HX + SZ_ROW2K;
constexpr size_t A_VDT = A_KD + SZ_ROW1K;
constexpr size_t A_QD = A_VDT + SZ_ROW1K;
constexpr size_t A_OM = A_QD + SZ_ROW1K;
constexpr size_t A_PL = A_OM + SZ_ROW1K;
constexpr size_t A_CKV = A_PL + SZ_ROW1K;
constexpr size_t A_CQ = A_CKV + (size_t)NR * 512;
constexpr size_t A_KN = A_CQ + (size_t)NR * 768;
constexpr size_t A_KR = A_KN + SZ_ROW1K;
constexpr size_t A_QM = A_KR + (size_t)NR * 64;
constexpr size_t A_MIXEND = A_QM + (size_t)NR * 1536;
static_assert((size_t)NR * 3072 <= (size_t)NB * SEQ * DM * 4, "gates fit in d_out");
constexpr size_t A_MG = A_PL;
constexpr size_t A_Y1 = A_KN;
constexpr size_t A_SCR = A_KD;
static_assert(A_MG + SZ_ROW2K <= A_KN && A_Y1 + SZ_ROW2K <= A_MIXEND && 256ull * 131072 <= 2 * SZ_ROW1K, "overlays");
constexpr int ACT_TILES = (CHROWS * 8) / 256 + 64 + CHROWS / 256;
constexpr size_t A_ACT = A_KD;
constexpr size_t A_Y = A_ACT + (size_t)NCHUNK * ACT_TILES * 256 * 256;
constexpr size_t A_FXR = A_KD;
constexpr size_t A_YEND = (A_Y + (size_t)CHROWS * 9 * 1024) > A_MIXEND ? (A_Y + (size_t)CHROWS * 9 * 1024) : A_MIXEND;
constexpr size_t A_OD8 = A_HX + (size_t)NR * 512;
constexpr size_t WS_END = A_YEND;
static_assert(WS_END <= 684360192ull, "workspace budget");

__device__ __forceinline__ unsigned f2bf(float f) { unsigned u = __builtin_bit_cast(unsigned, f); return (u + 0x7fffu + ((u >> 16) & 1u)) >> 16; }
typedef __bf16 bf16x2_hw __attribute__((ext_vector_type(2)));
__device__ __forceinline__ unsigned pk2(float lo, float hi) { const f32x2 v = {lo, hi}; return __builtin_bit_cast(unsigned, __builtin_convertvector(v, bf16x2_hw)); }
__device__ __forceinline__ float bf2f(unsigned short b) { return __builtin_bit_cast(float, (unsigned)b << 16); }
__device__ __forceinline__ float bflo(unsigned w) { return __builtin_bit_cast(float, w << 16); }
__device__ __forceinline__ float bfhi(unsigned w) { return __builtin_bit_cast(float, w & 0xffff0000u); }
__device__ __forceinline__ u32x4 pack8(f32x4 lo, f32x4 hi) { u32x4 w; w.x = pk2(lo[0], lo[1]); w.y = pk2(lo[2], lo[3]); w.z = pk2(hi[0], hi[1]); w.w = pk2(hi[2], hi[3]); return w; }
__device__ __forceinline__ void unpack8(u32x4 w, f32x4& lo, f32x4& hi) { lo = (f32x4){bflo(w.x), bfhi(w.x), bflo(w.y), bfhi(w.y)}; hi = (f32x4){bflo(w.z), bfhi(w.z), bflo(w.w), bfhi(w.w)}; }
constexpr float Y_SCALE = 16.f, Y_INV = 1.f / 16.f;
constexpr float BR8_SCALE = 8.f, BR8_INV = 0.125f;
constexpr float MG8_SCALE = 4.f, MG8_INV = 0.25f;
constexpr float ACT8_SCALE = 2.f, ACT8_INV = 0.5f;
constexpr float W8_SCALE = 32.f, W8_INV = 1.f / 32.f;
__device__ __forceinline__ unsigned pack4_fp8s(float a, float b, float c_, float d, float sc) { int p = __builtin_amdgcn_cvt_pk_fp8_f32(a * sc, b * sc, 0, false); p = __builtin_amdgcn_cvt_pk_fp8_f32(c_ * sc, d * sc, p, true); return (unsigned)p; }
__device__ __forceinline__ unsigned pack4_fp8c(f32x4 v, float sc) { return pack4_fp8s(__builtin_amdgcn_fmed3f(v.x * sc, -448.f, 448.f), __builtin_amdgcn_fmed3f(v.y * sc, -448.f, 448.f), __builtin_amdgcn_fmed3f(v.z * sc, -448.f, 448.f), __builtin_amdgcn_fmed3f(v.w * sc, -448.f, 448.f), 1.f); }
typedef int i32x4 __attribute__((ext_vector_type(4)));
typedef int i32x8 __attribute__((ext_vector_type(8)));

__device__ __forceinline__ u32x2 pack8_fp8(f32x4 lo, f32x4 hi) {
    u32x2 w; int p = __builtin_amdgcn_cvt_pk_fp8_f32(lo[0] * Y_SCALE, lo[1] * Y_SCALE, 0, false); p = __builtin_amdgcn_cvt_pk_fp8_f32(lo[2] * Y_SCALE, lo[3] * Y_SCALE, p, true); w.x = (unsigned)p;
    p = __builtin_amdgcn_cvt_pk_fp8_f32(hi[0] * Y_SCALE, hi[1] * Y_SCALE, 0, false); p = __builtin_amdgcn_cvt_pk_fp8_f32(hi[2] * Y_SCALE, hi[3] * Y_SCALE, p, true); w.y = (unsigned)p; return w; }
__device__ __forceinline__ f32x4 unpack4_fp8(unsigned w) { const f32x2 a = __builtin_amdgcn_cvt_pk_f32_fp8((int)w, false), b = __builtin_amdgcn_cvt_pk_f32_fp8((int)w, true); return (f32x4){a.x, a.y, b.x, b.y}; }
__device__ __forceinline__ float wave_sum(float v) {
#pragma unroll
    for (int o = 1; o < 64; o <<= 1) v += __shfl_xor(v, o);
    return v;
}
constexpr float SS_SCALE = 16777216.f, SS_INV = 1.f / 16777216.f;
__device__ __forceinline__ void ss_add(unsigned long long* p, float s) { atomicAdd(p, (unsigned long long)(s * SS_SCALE)); }
__device__ __forceinline__ float ss_get(const unsigned long long* p) { return (float)(*p) * SS_INV; }
__device__ __forceinline__ float sigmoidf_(float x) { return __builtin_amdgcn_rcpf(1.f + __builtin_amdgcn_exp2f(x * -LOG2E)); }
__host__ __device__ __forceinline__ int pos2tok(int q) { const int fq = q >> 3, n = (q >> 2) & 1, i = q & 3; return 16 * (fq >> 1) + 4 * (fq & 1) + 8 * n + i; }
__host__ __device__ __forceinline__ int tok2pos(int t) { const int A = t >> 4, n = (t >> 3) & 1, B = (t >> 2) & 1, i = t & 3; return 8 * (2 * A + B) + 4 * n + i; }
__host__ __device__ __forceinline__ int ropedim(int RD, int p) { const int Q = p >> 3, n = (p >> 2) & 1, i = p & 3, P = 4 * Q + i, half = RD / 4; return (P < half ? 0 : RD / 2) + (P % half) + (n ? half : 0); }

#define XB_TMO      128
#define XB_XCNT(j)  (256  + 64 * (j))
#define XB_XSUB(j)  (1280 + 64 * (j))
#define XB_XGEN(j)  (2304 + 64 * (j))
#define XB_TOP      3328
#define XB_TOPGEN   3392
#define XCD_BAR_WORDS 3456
#define XB_SPIN_CAP (1u << 20)
__device__ __forceinline__ unsigned xb_ld(unsigned* p)              { return __hip_atomic_load(p, __ATOMIC_RELAXED, __HIP_MEMORY_SCOPE_AGENT); }
__device__ __forceinline__ unsigned xb_add(unsigned* p, unsigned v) { return __hip_atomic_fetch_add(p, v, __ATOMIC_RELAXED, __HIP_MEMORY_SCOPE_AGENT); }
__device__ __forceinline__ unsigned xb_xcc_id() { return (unsigned)__builtin_amdgcn_s_getreg((3 << 11) | 20) & 0xFu; }
#define XB_SPIN(cond, bar) do { unsigned _sp = 0; while (cond) { __builtin_amdgcn_s_sleep(1); \
    if ((++_sp & 255u) == 0u) { if (xb_ld(&(bar)[XB_TMO])) break; if (_sp > XB_SPIN_CAP) { atomicAdd(&(bar)[XB_TMO], 1u); break; } } } } while (0)
struct XcdBarrier { unsigned* bar; unsigned x; volatile LAS unsigned* st; };
__device__ __forceinline__ XcdBarrier xcd_barrier_post(unsigned* bar, volatile LAS unsigned* st) {
    XcdBarrier b; b.bar = bar; b.x = xb_xcc_id(); b.st = st;
    if (threadIdx.x == 0) (void)xb_add(&bar[XB_XCNT(b.x)], 1u);
    return b;
}
__device__ __forceinline__ void xcd_barrier_complete(unsigned* bar, unsigned x, unsigned& nloc, unsigned& nx) {
    const unsigned G = gridDim.x * gridDim.y * gridDim.z;
    unsigned sum, cnt, mine, sp = 0u;
    for (;;) {
        sum = 0u; cnt = 0u; mine = 0u;
#pragma unroll
        for (unsigned j = 0; j < 16; ++j) { const unsigned c = xb_ld(&bar[XB_XCNT(j)]); sum += c; cnt += (c > 0u) ? 1u : 0u; mine = (j == x) ? c : mine; }
        if (sum == G) break;
        __builtin_amdgcn_s_sleep(1);
        if ((++sp & 255u) == 0u) { if (xb_ld(&bar[XB_TMO])) break; if (sp > XB_SPIN_CAP) { atomicAdd(&bar[XB_TMO], 1u); break; } }
    }
    nloc = mine > 0u ? mine : 1u; nx = cnt > 0u ? cnt : 1u;
}
__device__ __forceinline__ void xcd_barrier(const XcdBarrier& b, bool leader  ) {
    asm volatile("s_waitcnt vmcnt(0)" ::: "memory");
    __syncthreads();
    if (leader) {
        unsigned* bar = b.bar;
        __builtin_amdgcn_s_waitcnt(0);
        unsigned nloc = b.st[0], nx = b.st[1];
        if (nloc == 0u) { xcd_barrier_complete(bar, b.x, nloc, nx); b.st[0] = nloc; b.st[1] = nx; }
        const unsigned old = xb_add(&bar[XB_XSUB(b.x)], 1u);
        const unsigned gen = old / nloc;
        if (old + 1u == (gen + 1u) * nloc) {
            __builtin_amdgcn_fence(__ATOMIC_RELEASE, "agent");
            asm volatile("s_waitcnt vmcnt(0)" ::: "memory");
            const unsigned og = xb_add(&bar[XB_TOP], 1u);
            const unsigned tg = og / nx;
            if (og + 1u == (tg + 1u) * nx) xb_add(&bar[XB_TOPGEN], 1u);
            else XB_SPIN(xb_ld(&bar[XB_TOPGEN]) == tg, bar);
            __builtin_amdgcn_fence(__ATOMIC_ACQUIRE, "agent");
            xb_add(&bar[XB_XGEN(b.x)], 1u);
            asm volatile("s_waitcnt vmcnt(0)" ::: "memory");
        } else {
            XB_SPIN(xb_ld(&bar[XB_XGEN(b.x)]) == gen, bar);
            __builtin_amdgcn_fence(__ATOMIC_ACQUIRE, "agent");
            asm volatile("s_waitcnt vmcnt(0)" ::: "memory");
        }
    }
    __syncthreads();
}

struct Params {
    const float* in[34];
    float* out; unsigned char* ws;
    int step_lo, step_hi;
};
enum { I_X = 0, I_C, I_CTX, I_CCTX, I_WMOD, I_BMOD, I_GPREMIX, I_GPOSTMIX, I_GPREFFN, I_GPOSTFFN, I_WIN, I_GCQ, I_WUQ, I_GCKV, I_WUKV, I_WPOOL, I_PSCALE,
       I_LQ1, I_LK1, I_LQ2, I_LK2, I_GSUBLN, I_WBMLA, I_WBPOOL, I_WBDIFF, I_WOUT, I_WROUTER, I_BROUTER, I_WEGATE, I_WEUP, I_WEDOWN, I_WSGATE, I_WSUP, I_WSDOWN };

typedef const __attribute__((address_space(4))) Params* ParamsK;
struct Ctx {
    ParamsK p;
    LAS unsigned char* lds;
    int tid, lane, wave, G, blk;
    GAS unsigned char* ws;
    size_t z;
};
#define INP(cx, I) ((const float*)((const GAS float*)(cx).p->in[I] + (cx).z))
__device__ __forceinline__ unsigned long long rfl64(unsigned long long v) { return ((unsigned long long)(unsigned)__builtin_amdgcn_readfirstlane((int)(unsigned)(v >> 32)) << 32) | (unsigned)__builtin_amdgcn_readfirstlane((int)(unsigned)v); }
#define PHASE_CTX(cl) Ctx cl = c; asm volatile("" : "+s"(cl.ws), "+s"(cl.z), "+s"(cl.blk), "+s"(cl.G), "+s"(cl.wave)); cl.wave = __builtin_amdgcn_readfirstlane(cl.wave); \
    { unsigned ones_ = ~0u; asm volatile("" : "+s"(ones_)); cl.lane = (int)__builtin_amdgcn_mbcnt_hi(ones_, __builtin_amdgcn_mbcnt_lo(ones_, 0u)); } cl.tid = cl.wave * 64 + cl.lane; \
    cl.blk = __builtin_amdgcn_readfirstlane(cl.blk); cl.G = __builtin_amdgcn_readfirstlane(cl.G); cl.ws = (GAS unsigned char*)rfl64((unsigned long long)cl.ws); cl.z = (size_t)rfl64((unsigned long long)cl.z)
constexpr int LDS_RING = 131072;
constexpr int LDS_BYTES = 163840;
constexpr int LDS_MISC = LDS_BYTES - 1024;

__device__ __forceinline__ bf16_t* wsb(const Ctx& c, size_t off) { return (bf16_t*)(c.ws + off); }
__device__ __forceinline__ bf16_t* wt(const Ctx& c, size_t eoff) { return (bf16_t*)(c.ws + WS_W) + eoff; }

__device__ __forceinline__ const float* res_rd(const Ctx& c, int l, int R) {
    const int b = R / RPB, j = R % RPB;
    if (j < CTXL) return INP(c, I_CTX) + (size_t)(b * CTXL + j) * DM;
    return INP(c, I_X) + (size_t)(b * SEQ + (j - CTXL)) * DM;
}
__device__ __forceinline__ bf16_t* hb_row(const Ctx& c, int R) { return (bf16_t*)(c.ws + A_HB) + (size_t)R * DM; }
__device__ __forceinline__ float* out_row(const Ctx& c, int R) { const int b = R / RPB, j = R % RPB; return c.p->out + (size_t)(b * SEQ + (j - CTXL)) * DM; }
__device__ __forceinline__ void load_res(const Ctx& c, int l, int R, int lane, f32x4 (&v)[4]) {
    if (l == 0) {
#pragma unroll
        for (int j = 0; j < 4; ++j) v[j] = *((const f32x4*)res_rd(c, 0, R) + lane + 64 * j);
    } else {
#pragma unroll
        for (int j = 0; j < 4; ++j) { const u32x2 w = *((const u32x2*)hb_row(c, R) + lane + 64 * j); v[j] = (f32x4){__builtin_bit_cast(float, w.x << 16), __builtin_bit_cast(float, w.x & 0xffff0000u), __builtin_bit_cast(float, w.y << 16), __builtin_bit_cast(float, w.y & 0xffff0000u)}; }
    }
}
__device__ __forceinline__ const float* modvec(const Ctx& c, int l, int R, int which) {
    const int b = R / RPB, j = R % RPB; const int bb = (j < CTXL) ? 16 : b;
    return (const float*)(c.ws + CTL_MOD) + ((size_t)(l * 17 + bb) * 6144 + which * 1024);
}

struct SrcCol { const float* p; int ld; bool ok; };
template <class Map>
__device__ __forceinline__ void cvt_item(const Map& map, const float* kscale, int K, bf16_t* Dst, int nblk_n, LAS float* scr, int item, int lane, bool q8 = false  ) {
    const int kb = item / nblk_n, nb = item % nblk_n, k0 = 64 * kb, n0 = 32 * nb;
    const SrcCol s = map(n0 + (lane & 31));
    float vv[32];
#pragma unroll
    for (int i = 0; i < 32; ++i) { const int kk = 2 * i + (lane >> 5); vv[i] = s.ok ? s.p[(size_t)(k0 + kk) * s.ld] : 0.f; }
#pragma unroll
    for (int i = 0; i < 32; ++i) { const int kk = 2 * i + (lane >> 5); float v = vv[i]; if (kscale) v *= kscale[k0 + kk]; scr[kk * 33 + (lane & 31)] = v; }
    asm volatile("s_waitcnt lgkmcnt(0)" ::: "memory");
    const int cch = lane & 7;
#pragma unroll
    for (int j = 0; j < 4; ++j) { const int n = (lane >> 3) + 8 * j; const LAS float* sp = scr + (8 * cch) * 33 + n;
        if (q8) { u32x2 o8; o8.x = pack4_fp8s(sp[0 * 33], sp[1 * 33], sp[2 * 33], sp[3 * 33], W8_SCALE); o8.y = pack4_fp8s(sp[4 * 33], sp[5 * 33], sp[6 * 33], sp[7 * 33], W8_SCALE);
            *(u32x2*)((unsigned char*)Dst + (size_t)(n0 + n) * K + k0 + 8 * cch) = o8; continue; }
        u32x4 o; o.x = pk2(sp[0 * 33], sp[1 * 33]); o.y = pk2(sp[2 * 33], sp[3 * 33]); o.z = pk2(sp[4 * 33], sp[5 * 33]); o.w = pk2(sp[6 * 33], sp[7 * 33]);
        *(u32x4*)(Dst + (size_t)(n0 + n) * K + k0 + 8 * cch) = o; }
    asm volatile("s_waitcnt lgkmcnt(0)" ::: "memory");
}
struct MapLin { const float* W; int ld; int off; __device__ SrcCol operator()(int n) const { return SrcCol{W + off + n, ld, true}; } };
struct MapWin { const float* W; __device__ SrcCol operator()(int n) const {
    int col; bool ok = true;
    if (n < 512) col = 288 + (n & ~63) + ropedim(64, n & 63);
    else if (n < 1024) { const int m = n - 512; col = KV_COLS + 384 + (m & ~63) + ropedim(64, m & 63); }
    else if (n < 1536) col = KV_COLS + 896 + (n - 1024);
    else if (n < 1792) col = n - 1536;
    else if (n < 2176) col = KV_COLS + (n - 1792);
    else if (n < 2208) col = 256 + ropedim(32, n - 2176);
    else { col = 0; ok = false; }
    return SrcCol{W + col, IN_COLS, ok}; } };
struct MapUkv { const float* W; int voff; __device__ SrcCol operator()(int n) const { return SrcCol{W + (n >> 6) * 128 + voff + (n & 63), 1024, true}; } };
struct MapUq { const float* W; __device__ SrcCol operator()(int n) const { const int h = n / 96, p = n % 96; return SrcCol{W + h * 96 + (p < 64 ? p : 64 + ropedim(32, p - 64)), 768, true}; } };
struct MapGU { const float* Wg; const float* Wu; __device__ SrcCol operator()(int n) const { const int pn = n >> 8, r = n & 255; return SrcCol{(r < 128 ? Wg + pn * 128 + r : Wu + pn * 128 + (r - 128)), 256, true}; } };


struct EItem { const float* p; int ld; bf16_t* dst; int K, k0, n0; bool q8; };
__device__ __forceinline__ EItem eitem_decode(const Ctx& ci, int l, int x, int lane) {
    constexpr int IT10 = 65 * 16 * 16;
    EItem it;
    if (x < IT10) { const int e = x / 256, ri = x % 256, kb = ri / 16, nb = ri % 16; it.k0 = 64 * kb; it.n0 = 32 * nb; it.K = 1024; it.ld = 256;
        const float* wg = (e < 64) ? INP(ci, I_WEGATE) + ((size_t)l * 64 + e) * 262144 : INP(ci, I_WSGATE) + (size_t)l * 262144;
        const float* wu = (e < 64) ? INP(ci, I_WEUP) + ((size_t)l * 64 + e) * 262144 : INP(ci, I_WSUP) + (size_t)l * 262144;
        const int n = it.n0 + (lane & 31), pn = n >> 8, r = n & 255; it.p = (r < 128 ? wg + pn * 128 + r : wu + pn * 128 + (r - 128));
        it.dst = wt(ci, WO_GU) + (size_t)e * 262144; it.q8 = true; }
    else { const int y = x - IT10, e = y / 128, ri = y % 128, kb = ri / 32, nb = ri % 32; it.k0 = 64 * kb; it.n0 = 32 * nb; it.K = 256; it.ld = 1024;
        const float* wd = (e < 64) ? INP(ci, I_WEDOWN) + ((size_t)l * 64 + e) * 262144 : INP(ci, I_WSDOWN) + (size_t)l * 262144;
        it.p = wd + it.n0 + (lane & 31); it.dst = wt(ci, WO_D) + (size_t)e * 131072; it.q8 = true; }
    return it;
}
__device__ __forceinline__ void eitem_load(const EItem& it, int lane, float (&vv)[32]) {
#pragma unroll
    for (int i = 0; i < 32; ++i) { const int kk = 2 * i + (lane >> 5); vv[i] = it.p[(size_t)(it.k0 + kk) * it.ld]; }
}
__device__ __forceinline__ void eitem_finish(const EItem& it, int lane, const float (&vv)[32], LAS float* scr) {
#pragma unroll
    for (int i = 0; i < 32; ++i) { const int kk = 2 * i + (lane >> 5); scr[kk * 33 + (lane & 31)] = vv[i]; }
    asm volatile("s_waitcnt lgkmcnt(0)" ::: "memory");
    const int cch = lane & 7;
#pragma unroll
    for (int j = 0; j < 4; ++j) { const int n = (lane >> 3) + 8 * j; const LAS float* sp = scr + (8 * cch) * 33 + n;
        if (it.q8) { u32x2 o8; o8.x = pack4_fp8s(sp[0 * 33], sp[1 * 33], sp[2 * 33], sp[3 * 33], W8_SCALE); o8.y = pack4_fp8s(sp[4 * 33], sp[5 * 33], sp[6 * 33], sp[7 * 33], W8_SCALE);
            *(u32x2*)((unsigned char*)it.dst + (size_t)(it.n0 + n) * it.K + it.k0 + 8 * cch) = o8; continue; }
        u32x4 o; o.x = pk2(sp[0 * 33], sp[1 * 33]); o.y = pk2(sp[2 * 33], sp[3 * 33]); o.z = pk2(sp[4 * 33], sp[5 * 33]); o.w = pk2(sp[6 * 33], sp[7 * 33]);
        *(u32x4*)(it.dst + (size_t)(it.n0 + n) * it.K + it.k0 + 8 * cch) = o; }
    asm volatile("s_waitcnt lgkmcnt(0)" ::: "memory");
}
__device__ __forceinline__ void ph_prologue(const Ctx& c, int l) {
    LAS float* scr = (LAS float*)(c.lds + c.wave * 16384);
    const int gw = c.blk * 8 + c.wave, NGW = c.G * 8;
    constexpr int IT0 = 72 * 16, IT1 = 16 * 16, IT2 = 96 * 16, IT3 = 16 * 4, IT4 = 16 * 4, IT5 = 24 * 6, IT6 = 32 * 8, IT7 = 32 * 8, IT8 = 32 * 16, IT9 = 2 * 16;
    constexpr int IT10 = 65 * 16 * 16, IT11 = 65 * 32 * 4, IT12 = 4 * 16 * 16;
    constexpr int NIT = IT0 + IT1 + IT2 + IT3 + IT4 + IT5 + IT6 + IT7 + IT8 + IT9 + IT12;
    for (int it = gw; it < NIT; it += NGW) {
        Ctx ci = c; asm volatile("" : "+s"(ci.z)); ci.z = (size_t)rfl64((unsigned long long)ci.z);
        int r = it; const float* w_in = INP(ci, I_WIN) + (size_t)l * DM * IN_COLS;
        if (r < IT0) { cvt_item(MapWin{w_in}, nullptr, 1024, wt(c, WO_IN), 72, scr, r, c.lane, true); continue; } r -= IT0;
        if (r < IT1) { cvt_item(MapLin{w_in, IN_COLS, 800}, nullptr, 1024, wt(c, WO_VD), 16, scr, r, c.lane, true); continue; } r -= IT1;
        if (r < IT2) { cvt_item(MapLin{w_in, IN_COLS, KV_COLS + 1408}, nullptr, 1024, wt(c, WO_G), 96, scr, r, c.lane, true); continue; } r -= IT2;
        if (r < IT3) { cvt_item(MapUkv{INP(ci, I_WUKV) + (size_t)l * 256 * 1024, 0}, INP(ci, I_GCKV) + l * 256, 256, wt(c, WO_UK), 16, scr, r, c.lane); continue; } r -= IT3;
        if (r < IT4) { cvt_item(MapUkv{INP(ci, I_WUKV) + (size_t)l * 256 * 1024, 64}, INP(ci, I_GCKV) + l * 256, 256, wt(c, WO_UV), 16, scr, r, c.lane); continue; } r -= IT4;
        if (r < IT5) { cvt_item(MapUq{INP(ci, I_WUQ) + (size_t)l * 384 * 768}, INP(ci, I_GCQ) + l * 384, 384, wt(c, WO_UQ), 24, scr, r, c.lane); continue; } r -= IT5;
        if (r < IT6) { cvt_item(MapLin{INP(ci, I_WBMLA) + (size_t)l * 512 * 1024, 1024, 0}, nullptr, 512, wt(c, WO_BM), 32, scr, r, c.lane, true); continue; } r -= IT6;
        if (r < IT7) { cvt_item(MapLin{INP(ci, I_WBDIFF) + (size_t)l * 512 * 1024, 1024, 0}, nullptr, 512, wt(c, WO_BD), 32, scr, r, c.lane, true); continue; } r -= IT7;
        if (r < IT8) { cvt_item(MapLin{INP(ci, I_WOUT) + (size_t)l * 1024 * 1024, 1024, 0}, nullptr, 1024, wt(c, WO_O), 32, scr, r, c.lane, true); continue; } r -= IT8;
        if (r < IT9) { cvt_item(MapLin{INP(ci, I_WROUTER) + (size_t)l * 1024 * 64, 64, 0}, nullptr, 1024, wt(c, WO_R), 2, scr, r, c.lane); continue; } r -= IT9;
        {
            const int g = r / 256, cb = (r / 16) % 16, db = r % 16, d = db * 64 + c.lane;
            const float* wp = INP(ci, I_WPOOL) + ((size_t)l * 4 + g) * 16384 + (size_t)(cb * 8) * 128;
            const float* ps = INP(ci, I_PSCALE) + l * 512 + g * 128;
            const float* wb = INP(ci, I_WBPOOL) + (size_t)l * 512 * 1024 + (size_t)(g * 128) * 1024 + d;
            float acc[8];
#pragma unroll
            for (int q = 0; q < 8; ++q) acc[q] = 0.f;
            for (int j = 0; j < 128; ++j) { const float bv = wb[(size_t)j * 1024] * ps[j];
#pragma unroll
                for (int q = 0; q < 8; ++q) acc[q] += wp[q * 128 + j] * bv; }
            *(u32x2*)((unsigned char*)wt(c, WO_PP) + (size_t)d * 512 + g * 128 + cb * 8) = (u32x2){pack4_fp8s(acc[0], acc[1], acc[2], acc[3], W8_SCALE), pack4_fp8s(acc[4], acc[5], acc[6], acc[7], W8_SCALE)};
        }
    }
    {
        constexpr int NE = IT10 + IT11;
        Ctx ci = c; asm volatile("" : "+s"(ci.z)); ci.z = (size_t)rfl64((unsigned long long)ci.z);
        float va[32], vb[32];
        int x = gw;
        EItem cur{}; if (x < NE) { cur = eitem_decode(ci, l, x, c.lane); eitem_load(cur, c.lane, va); }
        for (; x < NE; x += NGW) {
            EItem nxt{}; const bool hn = x + NGW < NE;
            if (hn) { nxt = eitem_decode(ci, l, x + NGW, c.lane); eitem_load(nxt, c.lane, vb); }
            eitem_finish(cur, c.lane, va, scr);
            if (hn) { cur = nxt;
#pragma unroll
                for (int i = 0; i < 32; ++i) va[i] = vb[i]; }
        }
    }
    if (l == 0) {
        const int gt = c.blk * 512 + c.tid, NT = c.G * 512;
        f32x2* t64 = (f32x2*)(c.ws + WS_TAB64); f32x2* t32 = (f32x2*)(c.ws + WS_TAB32);
        for (int i = gt; i < 2048 * 32; i += NT) { const int t = i >> 5, Pp = i & 31; const float pos = (float)(Pp < 16 ? (t >> 6) : (t & 63));
            const float inv = powf(10000.f, -(float)(2 * (Pp & 15)) / 32.f); const float a = pos * inv; t64[i] = (f32x2){cosf(a), sinf(a)}; }
        for (int i = gt; i < 2048 * 16; i += NT) { const int t = i >> 4, Pp = i & 15; const float pos = (float)(Pp < 8 ? (t >> 6) : (t & 63));
            const float inv = powf(10000.f, -(float)(2 * (Pp & 7)) / 16.f); const float a = pos * inv; t32[i] = (f32x2){cosf(a), sinf(a)}; }
        __syncthreads();
        if (c.blk < 192) {
            LAS float* sb = (LAS float*)(c.lds + c.wave * 10240);
            LAS float* part = (LAS float*)(c.lds + 81920);
            const int ll = c.blk / 96, cb = c.blk % 96, col = cb * 64 + c.lane, k0 = c.wave * 128;
#pragma unroll
            for (int qi = 0; qi < 34; ++qi) { const int q = c.lane + 64 * qi; const int b = q >> 7, k = q & 127; const float v = (b < 16) ? INP(c, I_C)[b * 1024 + k0 + k] : INP(c, I_CCTX)[k0 + k]; sb[k * 20 + b] = v / (1.f + __expf(-v)); }
            asm volatile("s_waitcnt lgkmcnt(0)" ::: "memory");
            float acc[17];
#pragma unroll
            for (int b = 0; b < 17; ++b) acc[b] = 0.f;
            const float* wm = INP(c, I_WMOD) + (size_t)ll * 1024 * 6144 + (size_t)k0 * 6144 + col;
#pragma unroll 32
            for (int k = 0; k < 128; ++k) { const float w = wm[(size_t)k * 6144];
#pragma unroll
                for (int b = 0; b < 17; ++b) acc[b] += sb[k * 20 + b] * w; }
#pragma unroll
            for (int b = 0; b < 17; ++b) part[(c.wave * 17 + b) * 64 + c.lane] = acc[b];
            __syncthreads();
            float* MOD = (float*)(c.ws + CTL_MOD);
            for (int q = c.tid; q < 17 * 64; q += 512) { const int b = q >> 6, cc = q & 63; float sum = INP(c, I_BMOD)[ll * 6144 + cb * 64 + cc];
#pragma unroll
                for (int w = 0; w < 8; ++w) sum += part[(w * 17 + b) * 64 + cc];
                MOD[(size_t)(ll * 17 + b) * 6144 + cb * 64 + cc] = sum; }
        }
    }
}

__device__ __forceinline__ void load_row_f32(const float* row, int lane, f32x4 (&v)[4]) {
#pragma unroll
    for (int j = 0; j < 4; ++j) v[j] = *((const f32x4*)row + lane + 64 * j);
}
__device__ __forceinline__ float row_sumsq(const f32x4 (&v)[4]) {
    float s = 0.f;
#pragma unroll
    for (int j = 0; j < 4; ++j) s += (v[j].x * v[j].x + v[j].y * v[j].y) + (v[j].z * v[j].z + v[j].w * v[j].w);
    return wave_sum(s);
}
__device__ __forceinline__ void norm_mod_store(const f32x4 (&v)[4], float rstd, const float* g, const float* shift, const float* scale, bf16_t* orow, int lane) {
#pragma unroll
    for (int j = 0; j < 4; ++j) { const int o = lane + 64 * j; const f32x4 gg = *((const f32x4*)g + o), sh = *((const f32x4*)shift + o), sc = *((const f32x4*)scale + o);
        const f32x4 y = (v[j] * rstd * gg) * (sc + 1.0f) + sh;
        u32x2 w; w.x = pk2(y.x, y.y); w.y = pk2(y.z, y.w); *((u32x2*)orow + o) = w; }
}
__device__ __forceinline__ void mod_fold(const Ctx& c, const float* g, int l, int R, int w_shift, int w_scale, int lane, f32x4 (&mul)[4], f32x4 (&add)[4]) {
    const float* sh = modvec(c, l, R, w_shift); const float* sc = modvec(c, l, R, w_scale);
#pragma unroll
    for (int j = 0; j < 4; ++j) { const int o = lane + 64 * j; mul[j] = *((const f32x4*)g + o) * (*((const f32x4*)sc + o) + 1.0f); add[j] = *((const f32x4*)sh + o); }
}
__device__ __forceinline__ int batch_key(int R) { return (R % RPB) < CTXL ? 16 + 32 * (R / RPB) : R / RPB; }
__device__ __forceinline__ void ph_t1(const Ctx& c, int l) {
    const int gw = c.blk * 8 + c.wave, NGW = c.G * 8;
    const int per = (NR + NGW - 1) / NGW, r0 = gw * per, r1 = min(NR, r0 + per);
    f32x4 v[4], vn[4], vn2[4], mul[4], add[4]; int key = -1;
#pragma unroll
    for (int j = 0; j < 4; ++j) { v[j] = (f32x4){0.f, 0.f, 0.f, 0.f}; vn[j] = v[j]; vn2[j] = v[j]; }
    int R = r0;
    if (R < r1) load_row_f32(res_rd(c, l, R), c.lane, v);
    if (R + 1 < r1) load_row_f32(res_rd(c, l, R + 1), c.lane, vn);
    for (; R < r1; ++R) {
        if (R + 2 < r1) load_row_f32(res_rd(c, l, R + 2), c.lane, vn2);
        if (batch_key(R) != key) { key = batch_key(R); mod_fold(c, INP(c, I_GPREMIX) + l * DM, l, R, 0, 1, c.lane, mul, add); }
        const float rstd = 1.f / sqrtf(row_sumsq(v) * (1.f / DM) + EPSN);
        unsigned char* orow = (unsigned char*)(c.ws + A_HX) + (size_t)R * DM;
#pragma unroll
        for (int j = 0; j < 4; ++j) { const f32x4 y = (v[j] * rstd) * mul[j] + add[j]; *((unsigned*)orow + c.lane + 64 * j) = pack4_fp8c(y, 1.f); }
#pragma unroll
        for (int j = 0; j < 4; ++j) { v[j] = vn[j]; vn[j] = vn2[j]; }
    }
}

struct Unit {
    const bf16_t* a;
    const bf16_t* b;
    const unsigned* rows;
    int K, kind, pm, pn, bperm, nrows, aux, aux2;
};
__device__ __forceinline__ int b_srcrow(int q, int bperm) { return (q & ~31) + (bperm ? pos2tok(q & 31) : (q & 31)); }

template <class Sched, class Epi>
__device__ __forceinline__ void gemm_units_naive(const Ctx& c, const Sched& S, const Epi& E) {
    Unit u;
    for (int i = 0; S.next(i, u); ++i) {
        for (int it = c.tid; it < 256 * 16; it += 512) {
            const int row = it >> 4, c8 = (it & 15) * 8;
            const bf16_t* ar;
            if (u.rows) { const int rr = (row < u.nrows) ? (int)(u.rows[row] >> 4) : u.aux2; ar = u.a + (size_t)rr * u.K; } else ar = u.a + (size_t)row * u.K;
            float acc[16];
#pragma unroll
            for (int q = 0; q < 16; ++q) acc[q] = 0.f;
            const bf16_t* br[16];
#pragma unroll
            for (int q = 0; q < 16; ++q) br[q] = u.b + (size_t)b_srcrow((q < 8 ? c8 + q : 128 + c8 + (q - 8)), u.bperm) * u.K;
            for (int k = 0; k < u.K; k += 8) {
                f32x4 alo, ahi; unpack8(*(const u32x4*)(ar + k), alo, ahi);
#pragma unroll
                for (int q = 0; q < 16; ++q) { f32x4 blo, bhi; unpack8(*(const u32x4*)(br[q] + k), blo, bhi);
                    acc[q] += (alo.x * blo.x + alo.y * blo.y) + (alo.z * blo.z + alo.w * blo.w) + (ahi.x * bhi.x + ahi.y * bhi.y) + (ahi.z * bhi.z + ahi.w * bhi.w); }
            }
            { typename Epi::UState ust_; E.unit_begin(u, c8, ust_); typename Epi::Pre pre_; E.pre(u, row, c8, pre_);
              E.apply(u, row, c8, pre_, ust_, (f32x4){acc[0], acc[1], acc[2], acc[3]}, (f32x4){acc[4], acc[5], acc[6], acc[7]}, (f32x4){acc[8], acc[9], acc[10], acc[11]}, (f32x4){acc[12], acc[13], acc[14], acc[15]}); }
        }
        asm volatile("s_waitcnt vmcnt(0)" ::: "memory");
        __syncthreads();
    }
}

namespace mm {
constexpr int BK = 64, HALF = 128, HTB = HALF * BK * 2;
__device__ __forceinline__ int lds_byte(int r, int c) { const int st = (r >> 4) * 2 + (c >> 5), rr = r & 15, cc = c & 31, ob = rr * 64 + cc * 2; return st * 1024 + (ob ^ (((ob >> 9) & 1) << 5)); }
__device__ __forceinline__ void stage_rc(int b, int& R, int& C) { const int st = b / 1024, sb = b % 1024, swz = sb ^ (((sb >> 9) & 1) << 5); R = (st >> 1) * 16 + swz / 64; C = (st & 1) * 32 + (swz % 64) / 2; }
__device__ __forceinline__ int perm32(int rho) { const int n = rho >> 4, i = rho & 15; return 8 * (i >> 2) + 4 * n + (i & 3); }
__device__ __forceinline__ int permtau(int rho) { const int n = rho >> 4, fq = (rho >> 2) & 3, i = rho & 3; return 16 * (fq >> 1) + 4 * (fq & 1) + 8 * n + i; }
template <bool GATHER> struct LaneOffT { unsigned a0[2], a1[GATHER ? 2 : 1], b[2]; };
template <bool GATHER> __device__ __forceinline__ void lane_offsets(const Unit& u, const GAS unsigned char* ws, int tid, LaneOffT<GATHER>& o) {
    int Rl[2], Cl[2]; asm volatile("" : "+v"(tid));
#pragma unroll
    for (int i = 0; i < 2; ++i) stage_rc(tid * 16 + i * 8192, Rl[i], Cl[i]);
    const unsigned K2 = (unsigned)u.K * 2u; const unsigned ab = (unsigned)((unsigned long long)u.a - (unsigned long long)ws), bb = (unsigned)((unsigned long long)u.b - (unsigned long long)ws);
#pragma unroll
    for (int i = 0; i < 2; ++i) {
        if constexpr (GATHER) {
            if (u.rows) { const int r0 = Rl[i], r1 = 128 + Rl[i];
                const unsigned t0 = (r0 < u.nrows) ? (u.rows[r0] >> 4) : (unsigned)u.aux2, t1 = (r1 < u.nrows) ? (u.rows[r1] >> 4) : (unsigned)u.aux2;
                o.a0[i] = ab + t0 * K2 + (unsigned)Cl[i] * 2u; o.a1[i] = ab + t1 * K2 + (unsigned)Cl[i] * 2u; }
            else { o.a0[i] = ab + (unsigned)Rl[i] * K2 + (unsigned)Cl[i] * 2u; o.a1[i] = o.a0[i] + 128u * K2; }
        } else o.a0[i] = ab + (unsigned)Rl[i] * K2 + (unsigned)Cl[i] * 2u;
        const int rho_ = Rl[i] & 31; const int Rb = (u.bperm == 2) ? (64 * (Rl[i] >> 5) + 16 * ((rho_ >> 2) & 3) + 4 * (rho_ >> 4) + (rho_ & 3)) : ((Rl[i] & ~31) + (u.bperm ? permtau(rho_) : perm32(rho_)));
        o.b[i] = bb + (unsigned)Rb * K2 + (unsigned)Cl[i] * 2u;
    }
}
}

template <class Sched, class Epi>
__device__ __forceinline__ void gemm_units_mfma(const Ctx& c, const Sched& S, const Epi& E) {
    constexpr bool GATHER = Sched::GATHER;
    using namespace mm;
    LAS unsigned char* lds = c.lds;
    const int tid = c.tid, wid = c.wave, lane = c.lane, wr = wid >> 2, wc = wid & 3, fr = lane & 15, fq = lane >> 4;
    const unsigned ldsw = (unsigned)wid * 1024u;
    const int aoff = lds_byte(wr * 64 + fr, fq * 8), boff = lds_byte(wc * 32 + fr, fq * 8);
    const GAS unsigned char* wsb_ = c.ws;
#define MM_SA(b, h) (((b) * 2 + (h)) * HTB)
#define MM_SB(b, h) ((4 + (b) * 2 + (h)) * HTB)
#define MM_STAGE(bufoff, o0, o1, kofs) do { const GAS unsigned char* kb_ = wsb_ + (size_t)(kofs);   \
        __builtin_amdgcn_global_load_lds((const GAS unsigned*)(kb_ + (o0)), (LAS unsigned*)(lds + (bufoff) + ldsw), 16, 0, 0); \
        __builtin_amdgcn_global_load_lds((const GAS unsigned*)(kb_ + (o1)), (LAS unsigned*)(lds + (bufoff) + ldsw + 8192), 16, 0, 0); } while (0)
#define MM_LDA(dst, b, h) do { _Pragma("unroll") for (int m = 0; m < 4; ++m) _Pragma("unroll") for (int k = 0; k < 2; ++k) dst[m][k] = *(const LAS bf16x8*)(lds + MM_SA(b, h) + aoff + m * 2048 + k * 1024); } while (0)
#define MM_LDB(dst, b, h) do { _Pragma("unroll") for (int n = 0; n < 2; ++n) _Pragma("unroll") for (int k = 0; k < 2; ++k) dst[n][k] = *(const LAS bf16x8*)(lds + MM_SB(b, h) + boff + n * 2048 + k * 1024); } while (0)
#define MM_CAT8(x) __builtin_shufflevector(__builtin_bit_cast(i32x4, (x)[0]), __builtin_bit_cast(i32x4, (x)[1]), 0, 1, 2, 3, 4, 5, 6, 7)
#define MM_MMA(ai, bj, At, Bt) do { __builtin_amdgcn_s_setprio(1); \
        if constexpr (Epi::FP8) {   \
            _Pragma("unroll") for (int m = 0; m < 4; ++m) _Pragma("unroll") for (int n = 0; n < 2; ++n) \
                acc[ai][bj][m][n] = __builtin_amdgcn_mfma_scale_f32_16x16x128_f8f6f4(MM_CAT8(Bt[n]), MM_CAT8(At[m]), acc[ai][bj][m][n], 0, 0, 0, 0, 0, 0); \
        } else { _Pragma("unroll") for (int m = 0; m < 4; ++m) _Pragma("unroll") for (int n = 0; n < 2; ++n) _Pragma("unroll") for (int k = 0; k < 2; ++k) \
            acc[ai][bj][m][n] = __builtin_amdgcn_mfma_f32_16x16x32_bf16(Bt[n][k], At[m][k], acc[ai][bj][m][n], 0, 0, 0); } \
        __builtin_amdgcn_s_setprio(0); } while (0)
#define MM_WAIT_V(n) asm volatile("s_waitcnt vmcnt(" #n ")" ::: "memory")
#define MM_WAIT_L(n) asm volatile("s_waitcnt lgkmcnt(" #n ")" ::: "memory")
#define MM_BAR __builtin_amdgcn_s_barrier()
#define MM_SCHED __builtin_amdgcn_sched_barrier(0)
    Unit cur, nxt; int ui = 0;
    if (!S.next(0, cur)) return;
    LaneOffT<GATHER> co; lane_offsets<GATHER>(cur, wsb_, tid, co);
#define MM_A1(i) (GATHER ? co.a1[GATHER ? (i) : 0] : co.a0[i] + hs)
    f32x4 acc[2][2][4][2];
#pragma unroll
    for (int a = 0; a < 2; ++a)
#pragma unroll
        for (int b = 0; b < 2; ++b)
#pragma unroll
            for (int m = 0; m < 4; ++m)
#pragma unroll
                for (int n = 0; n < 2; ++n) acc[a][b][m][n] = (f32x4){0.f, 0.f, 0.f, 0.f};
    bf16x8 At[4][2], B0[2][2], B1[2][2];
    typename Epi::Pre epre_[Epi::EARLY ? Epi::GROUP : 1];
    {
        const unsigned hs = 256u * (unsigned)cur.K, hsb = (cur.bperm == 2 ? 16u : 256u) * (unsigned)cur.K;
        MM_STAGE(MM_SB(0, 0), co.b[0], co.b[1], 0); MM_STAGE(MM_SB(0, 1), co.b[0] + hsb, co.b[1] + hsb, 0); MM_STAGE(MM_SA(0, 0), co.a0[0], co.a0[1], 0); MM_STAGE(MM_SA(0, 1), MM_A1(0), MM_A1(1), 0);
        if (wr == 1) MM_BAR;
        MM_WAIT_V(2); MM_BAR;
        MM_STAGE(MM_SB(1, 0), co.b[0], co.b[1], 128); MM_STAGE(MM_SA(1, 0), co.a0[0], co.a0[1], 128); MM_STAGE(MM_SB(1, 1), co.b[0] + hsb, co.b[1] + hsb, 128);
        MM_WAIT_V(6); MM_BAR;
    }
    for (;;) {
        const bool has_next = S.next(ui + 1, nxt);
        if (!has_next) nxt = cur;
        LaneOffT<GATHER> nco;
        if constexpr (GATHER) lane_offsets<GATHER>(nxt, wsb_, tid, nco);
        const int nt = cur.K / BK; unsigned hs = 256u * (unsigned)cur.K, hsb = (cur.bperm == 2 ? 16u : 256u) * (unsigned)cur.K;
        for (int t = 0; t < nt; t += 2) {
            const bool last = (t == nt - 2);
            const unsigned k1 = (unsigned)(t + 1) * 128u, k2 = last ? 0u : (unsigned)(t + 2) * 128u; unsigned k3 = k2 + 128u;
            asm volatile("" : "+s"(k3)); k3 = (unsigned)__builtin_amdgcn_readfirstlane((int)k3);
            MM_LDB(B0, 0, 0); MM_LDB(B1, 0, 1); MM_SCHED; MM_LDA(At, 0, 0); MM_STAGE(MM_SA(1, 1), MM_A1(0), MM_A1(1), k1);
            MM_WAIT_V(8); MM_WAIT_L(0); MM_BAR; MM_MMA(0, 0, At, B0); MM_MMA(0, 1, At, B1); MM_BAR; MM_SCHED;
            if constexpr (Epi::ROWTAB) { if (last) E.rowtab_dma(cur, lds, wid, lane, ui & 1); }
            if (Epi::EARLY && last) { int c8e_ = wc * 32 + fq * 8; asm volatile("" : "+v"(c8e_));
                _Pragma("unroll") for (int q = 0; q < Epi::GROUP; ++q) { int re_ = (q >> 2) * 128 + wr * 64 + (q & 3) * 16 + fr; asm volatile("" : "+v"(re_)); E.pre(cur, re_, c8e_, epre_[q]); } }
            if (last) { if constexpr (GATHER) co = nco; else lane_offsets<GATHER>(nxt, wsb_, tid, co); hs = 256u * (unsigned)nxt.K; hsb = (nxt.bperm == 2 ? 16u : 256u) * (unsigned)nxt.K; }
            MM_LDA(At, 0, 1); MM_STAGE(MM_SB(0, 0), co.b[0], co.b[1], k2); MM_STAGE(MM_SB(0, 1), co.b[0] + hsb, co.b[1] + hsb, k2); MM_STAGE(MM_SA(0, 0), co.a0[0], co.a0[1], k2);
            MM_WAIT_V(8); MM_WAIT_L(0); MM_BAR; MM_MMA(1, 0, At, B0); MM_MMA(1, 1, At, B1); MM_BAR; MM_SCHED;
            MM_LDB(B0, 1, 0); MM_LDB(B1, 1, 1); MM_SCHED; MM_LDA(At, 1, 0); MM_STAGE(MM_SA(0, 1), MM_A1(0), MM_A1(1), k2);
            MM_WAIT_V(8); MM_WAIT_L(0); MM_BAR; MM_MMA(0, 0, At, B0); MM_MMA(0, 1, At, B1); MM_BAR; MM_SCHED;
            MM_LDA(At, 1, 1); MM_STAGE(MM_SB(1, 0), co.b[0], co.b[1], k3); MM_STAGE(MM_SB(1, 1), co.b[0] + hsb, co.b[1] + hsb, k3); MM_STAGE(MM_SA(1, 0), co.a0[0], co.a0[1], k3);
            MM_WAIT_V(8); MM_WAIT_L(0); MM_BAR; MM_MMA(1, 0, At, B0); MM_MMA(1, 1, At, B1); MM_BAR; MM_SCHED;
        }
        if (wr == 0) MM_BAR;
        typename Epi::UState ust_; E.unit_begin(cur, wc * 32 + fq * 8, ust_); const int par_ = ui & 1;
        constexpr int GRP = Epi::GROUP;
#pragma unroll
        for (int g0 = 0; g0 < 8; g0 += GRP) {
            int rows_[GRP]; typename Epi::Pre pre_[GRP]; int c8_ = wc * 32 + fq * 8; asm volatile("" : "+v"(c8_));
            int frx_ = wr * 64 + fr; asm volatile("" : "+v"(frx_));
#pragma unroll
            for (int q = 0; q < GRP; ++q) { const int ai = (g0 + q) >> 2, m = (g0 + q) & 3; rows_[q] = ai * 128 + m * 16 + frx_; asm volatile("" : "+v"(rows_[q]));
                if (Epi::EARLY && g0 == 0) pre_[q] = epre_[q]; else if constexpr (Epi::ROWTAB) E.pre_tab(cur, rows_[q], lds, par_, pre_[q]); else E.pre(cur, rows_[q], c8_, pre_[q]); }
            MM_SCHED;
            if constexpr (Epi::PAIR) {
#pragma unroll
                for (int q = 0; q < GRP; q += 2) { const int ai = (g0 + q) >> 2, m = (g0 + q) & 3;
                    E.apply2(cur, rows_[q], rows_[q + 1], c8_, pre_[q], pre_[q + 1], ust_, acc[ai][0][m][0], acc[ai][0][m][1], acc[ai][1][m][0], acc[ai][1][m][1],
                             acc[ai][0][m + 1][0], acc[ai][0][m + 1][1], acc[ai][1][m + 1][0], acc[ai][1][m + 1][1]); }
            } else
#pragma unroll
            for (int q = 0; q < GRP; ++q) { const int ai = (g0 + q) >> 2, m = (g0 + q) & 3;
                if constexpr (Epi::CHAIN) E.apply_rw(cur, rows_[q], c8_, pre_[q], ust_, acc[ai][0][m][0], acc[ai][0][m][1], acc[ai][1][m][0], acc[ai][1][m][1]);
                else E.apply(cur, rows_[q], c8_, pre_[q], ust_, acc[ai][0][m][0], acc[ai][0][m][1], acc[ai][1][m][0], acc[ai][1][m][1]); }
            MM_SCHED;
        }
        if (!has_next) break;
        bool keep_ = false; if constexpr (Epi::CHAIN) keep_ = E.keep_acc(cur);
        if (!keep_) {
#pragma unroll
        for (int a = 0; a < 2; ++a)
#pragma unroll
            for (int b = 0; b < 2; ++b)
#pragma unroll
                for (int m = 0; m < 4; ++m)
#pragma unroll
                    for (int n = 0; n < 2; ++n) acc[a][b][m][n] = (f32x4){0.f, 0.f, 0.f, 0.f};
        }
        cur = nxt; ++ui;
        if (wr == 1) MM_BAR;
    }
    MM_WAIT_V(0);
    MM_BAR;
#undef MM_SA
#undef MM_A1
#undef MM_SB
#undef MM_STAGE
#undef MM_LDA
#undef MM_LDB
#undef MM_MMA
#undef MM_CAT8
#undef MM_WAIT_V
#undef MM_WAIT_L
#undef MM_BAR
#undef MM_SCHED
}

#ifndef USE_MFMA_GEMM
#define USE_MFMA_GEMM 1
#endif
#if USE_MFMA_GEMM
#define GEMM_UNITS gemm_units_mfma
#else
#define GEMM_UNITS gemm_units_naive
#endif

__device__ __forceinline__ void rope4(f32x4& lo, f32x4& hi, const f32x2* cs) {
#pragma unroll
    for (int i = 0; i < 4; ++i) { const f32x2 t = cs[i]; const float a = lo[i], b = hi[i]; lo[i] = a * t.x - b * t.y; hi[i] = a * t.y + b * t.x; }
}

__device__ __forceinline__ int deal_xcd(const Ctx& c, int i) { return (c.G == 256) ? ((i * 8 + (c.blk & 7)) * 32 + (c.blk >> 3)) : (i * c.G + c.blk); }
struct SchedProj {
    static constexpr bool GATHER = false;
    const Ctx* c; int l, n_main, n_ctx, n_tot;
    __device__ void init(const Ctx* cc, int ll) { c = cc; l = ll; n_main = 128 * 21; n_ctx = 16 * (l == 0 ? 21 : 4); n_tot = n_main + n_ctx + 288; }
    __device__ bool next(int i, Unit& u) const {
        const int L = (c->G == 256) ? ((i * 8 + (c->blk & 7)) * 32 + (c->blk >> 3)) : (i * c->G + c->blk); if (L >= n_tot) return false;
        u.rows = nullptr; u.nrows = 256; u.aux = l; u.aux2 = 0; u.K = 512;
        if (L < n_main + n_ctx) {
            int pm, pn;
            if (L < n_main) { const int rg = L / 168, q = L % 168; pn = q >> 3; const int lt = rg * 8 + (q & 7); pm = (lt >> 3) * 9 + 1 + (lt & 7); }
            else { const int q = L - n_main; if (l == 0) { pm = (q / 21) * 9; pn = q % 21; } else { pm = (q >> 2) * 9; const int s = q & 3; pn = (s < 2) ? s : (s == 2 ? 6 : 8); } }
            u.pm = pm; u.pn = pn; u.kind = 0; u.bperm = (pn >= 9) ? 2 : 0;
            u.a = wsb(*c, A_HX) + (size_t)pm * 256 * 512; u.b = (pn < 9) ? wt(*c, WO_IN) + (size_t)pn * 256 * 512 : wt(*c, WO_G) + (size_t)(pn - 9) * 256 * 512;
        } else {
            const int q = L - n_main - n_ctx; u.pm = q / 144; u.pn = q % 144; u.kind = 1; u.bperm = 1;
            u.a = wt(*c, WO_VD) + (size_t)u.pm * 256 * 512; u.b = wsb(*c, A_HX) + (size_t)u.pn * 256 * 512;
        }
        return true;
    }
};
struct EpiProj {
    const Ctx* c; int l;
    __device__ __forceinline__ float one(const Unit& u, int R, bool lat, int t, int colp, f32x4 lo, f32x4 hi) const {
        const Ctx& C = *c;
        if (u.pn >= 9) {
            unsigned w0 = 0u, w1 = 0u;
#pragma unroll
            for (int i = 0; i < 4; ++i) { w0 = __builtin_amdgcn_cvt_pk_u8_f32(sigmoidf_(lo[i]) * 255.f, i, w0); w1 = __builtin_amdgcn_cvt_pk_u8_f32(sigmoidf_(hi[i]) * 255.f, i, w1); }
            *(u32x2*)((unsigned char*)C.p->out + (size_t)R * 3072 + (u.pn - 9) * 256 + colp) = (u32x2){w0, w1}; return 0.f; }
        switch (u.pn) {
        case 0: case 1: case 2: case 3: {
            const int col = (u.pn & 1) * 256 + colp;
            if (lat) rope4(lo, hi, (const f32x2*)(C.ws + WS_TAB64) + t * 32 + ((col & 63) >> 3) * 4);
            if (u.pn >= 2) { lo *= C2D; hi *= C2D; }
            *(u32x4*)(wsb(C, u.pn < 2 ? A_KD : A_QD) + (size_t)R * 512 + col) = pack8(lo, hi); break; }
        case 4: case 5: *(u32x4*)(wsb(C, A_PL) + (size_t)R * 512 + (u.pn - 4) * 256 + colp) = pack8(lo, hi); break;
        case 6: { *(u32x4*)(wsb(C, A_CKV) + (size_t)R * 256 + colp) = pack8(lo, hi);
            const float s = (lo.x * lo.x + lo.y * lo.y) + (lo.z * lo.z + lo.w * lo.w) + (hi.x * hi.x + hi.y * hi.y) + (hi.z * hi.z + hi.w * hi.w);
            return s; }
        case 7: { *(u32x4*)(wsb(C, A_CQ) + (size_t)R * 384 + colp) = pack8(lo, hi);
            const float s = (lo.x * lo.x + lo.y * lo.y) + (lo.z * lo.z + lo.w * lo.w) + (hi.x * hi.x + hi.y * hi.y) + (hi.z * hi.z + hi.w * hi.w);
            return s; }
        default: {
            if (colp < 128) { *(u32x4*)(wsb(C, A_CQ) + (size_t)R * 384 + 256 + colp) = pack8(lo, hi);
                const float s = (lo.x * lo.x + lo.y * lo.y) + (lo.z * lo.z + lo.w * lo.w) + (hi.x * hi.x + hi.y * hi.y) + (hi.z * hi.z + hi.w * hi.w);
                return s; }
            else if (colp < 160) { const int p = colp - 128;
                if (lat) rope4(lo, hi, (const f32x2*)(C.ws + WS_TAB32) + t * 16 + (p >> 3) * 4);
                *(u32x4*)(wsb(C, A_KR) + (size_t)R * 32 + p) = pack8(lo, hi); }
            break; }
        }
        return 0.f;
    }
    static constexpr int GROUP = 4; static constexpr bool EARLY = false; static constexpr bool CHAIN = false; static constexpr bool ROWTAB = false; struct Pre {}; struct UState {}; __device__ __forceinline__ void unit_begin(const Unit&, int, UState&) const {} __device__ __forceinline__ void pre(const Unit&, int, int, Pre&) const {}
    static constexpr bool PAIR = false; static constexpr bool FP8 = true;
    __device__ __forceinline__ void apply(const Unit& u, int row, int c8, const Pre&, const UState&, f32x4 v0l, f32x4 v0h, f32x4 v1l, f32x4 v1h) const {
        const Ctx& C = *c;
        v0l *= W8_INV; v0h *= W8_INV; v1l *= W8_INV; v1h *= W8_INV;
        if (u.kind == 1) {
            bf16_t* o = wsb(C, A_VDT) + (size_t)(u.pm * 256 + row) * NR + (size_t)u.pn * 256;
            *(u32x4*)(o + c8) = pack8(v0l, v0h); *(u32x4*)(o + 128 + c8) = pack8(v1l, v1h); return; }
        const int R = u.pm * 256 + row; const bool lat = (u.pm % 9) != 0; const int t = (R % RPB) - CTXL;
        if (u.pn >= 9) {
            u32x4 w = (u32x4){0u, 0u, 0u, 0u};
#pragma unroll
            for (int i = 0; i < 4; ++i) { w.x = __builtin_amdgcn_cvt_pk_u8_f32(sigmoidf_(v0l[i]) * 255.f, i, w.x); w.y = __builtin_amdgcn_cvt_pk_u8_f32(sigmoidf_(v0h[i]) * 255.f, i, w.y);
                                          w.z = __builtin_amdgcn_cvt_pk_u8_f32(sigmoidf_(v1l[i]) * 255.f, i, w.z); w.w = __builtin_amdgcn_cvt_pk_u8_f32(sigmoidf_(v1h[i]) * 255.f, i, w.w); }
            *(u32x4*)((unsigned char*)C.p->out + (size_t)R * 3072 + (u.pn - 9) * 256 + 2 * c8) = w; return; }
        float ssq = one(u, R, lat, t, c8, v0l, v0h) + one(u, R, lat, t, 128 + c8, v1l, v1h);
        if (u.pn >= 6 && u.pn <= 8) {
            ssq += __shfl_xor(ssq, 16); ssq += __shfl_xor(ssq, 32);
            if ((c8 & 24) == 0) ss_add((unsigned long long*)(C.ws + (u.pn == 6 ? CTL_SSKV : CTL_SSQ)) + (size_t)l * NR + R, ssq); }
    }
};

struct SchedUp {
    static constexpr bool GATHER = false;
    const Ctx* c; int l, n_kn, n_vm, n_uq, n_tot;
    __device__ void init(const Ctx* cc, int ll) { c = cc; l = ll; n_kn = 144 * 2; n_vm = 2 * 144; n_uq = (l == 0 ? 144 : 128) * 3; n_tot = n_kn + n_vm + n_uq; }
    __device__ bool next(int i, Unit& u) const {
        const int L = deal_xcd(*c, i); if (L >= n_tot) return false;
        u.rows = nullptr; u.nrows = 256; u.aux = l; u.aux2 = 0;
        if (L < n_kn) { u.pm = L >> 1; u.pn = L & 1; u.kind = 0; u.bperm = 0; u.K = 256; u.a = wsb(*c, A_CKV) + (size_t)u.pm * 256 * 256; u.b = wt(*c, WO_UK) + (size_t)u.pn * 256 * 256; }
        else if (L < n_kn + n_vm) { const int q = L - n_kn; u.pm = q & 1; u.pn = q >> 1; u.kind = 1; u.bperm = 1; u.K = 256; u.a = wt(*c, WO_UV) + (size_t)u.pm * 256 * 256; u.b = wsb(*c, A_CKV) + (size_t)u.pn * 256 * 256; }
        else { const int q = L - n_kn - n_vm; const int rt = q / 3; u.pn = q % 3; u.pm = (l == 0) ? rt : ((rt >> 3) * 9 + 1 + (rt & 7)); u.kind = 2; u.bperm = 0; u.K = 384;
            u.a = wsb(*c, A_CQ) + (size_t)u.pm * 256 * 384; u.b = wt(*c, WO_UQ) + (size_t)u.pn * 256 * 384; }
        return true;
    }
};
struct EpiUp {
    const Ctx* c; int l;
    static constexpr bool PAIR = false; static constexpr bool FP8 = false;
    struct UState { float rsv[16]; };
    __device__ __forceinline__ float rstd_kv(int R) const { return 1.f / sqrtf(ss_get((const unsigned long long*)(c->ws + CTL_SSKV) + (size_t)l * NR + R) * (1.f / 256.f) + EPSN); }
    static constexpr int GROUP = 4; static constexpr bool EARLY = false; static constexpr bool CHAIN = false; static constexpr bool ROWTAB = false; struct Pre { unsigned long long ss; };
    __device__ __forceinline__ void unit_begin(const Unit& u, int c8, UState& us) const {
#pragma unroll
        for (int i = 0; i < 16; ++i) us.rsv[i] = 0.f;
        if (u.kind == 1) {
#pragma unroll
            for (int h = 0; h < 2; ++h) { const int q0 = h * 128 + c8;
#pragma unroll
                for (int i = 0; i < 8; ++i) us.rsv[h * 8 + i] = rstd_kv(u.pn * 256 + (q0 & ~31) + pos2tok((q0 & 31) + i)); } }
    }
    __device__ __forceinline__ void pre(const Unit& u, int row, int c8, Pre& p) const {
        p.ss = 0ull;
        if (u.kind == 0) p.ss = *((const unsigned long long*)(c->ws + CTL_SSKV) + (size_t)l * NR + u.pm * 256 + row);
        else if (u.kind == 2) p.ss = *((const unsigned long long*)(c->ws + CTL_SSQ) + (size_t)l * NR + u.pm * 256 + row);
    }
    __device__ __forceinline__ void apply(const Unit& u, int row, int c8, const Pre& p, const UState& us, f32x4 v0l, f32x4 v0h, f32x4 v1l, f32x4 v1h) const {
        const Ctx& C = *c;
        if (u.kind == 0) { const int R = u.pm * 256 + row; const float rs = 1.f / sqrtf((float)p.ss * SS_INV * (1.f / 256.f) + EPSN);
            bf16_t* o = wsb(C, A_KN) + (size_t)R * 512 + u.pn * 256;
            *(u32x4*)(o + c8) = pack8(v0l * rs, v0h * rs); *(u32x4*)(o + 128 + c8) = pack8(v1l * rs, v1h * rs); }
        else if (u.kind == 1) {
            bf16_t* o = wsb(C, A_VMT) + (size_t)(u.pm * 256 + row) * NR + (size_t)u.pn * 256;
#pragma unroll
            for (int h = 0; h < 2; ++h) { const int q0 = h * 128 + c8; f32x4 lo = h ? v1l : v0l, hi = h ? v1h : v0h;
#pragma unroll
                for (int i = 0; i < 4; ++i) { lo[i] *= us.rsv[h * 8 + i]; hi[i] *= us.rsv[h * 8 + 4 + i]; }
                *(u32x4*)(o + q0) = pack8(lo, hi); } }
        else { const int R = u.pm * 256 + row; const bool lat = (u.pm % 9) != 0; const int t = (R % RPB) - CTXL;
            const float rs = C2M / sqrtf((float)p.ss * SS_INV * (1.f / 384.f) + EPSN);
#pragma unroll
            for (int h = 0; h < 2; ++h) { const int col = u.pn * 256 + h * 128 + c8; const int pp = col % 96; f32x4 lo = h ? v1l : v0l, hi = h ? v1h : v0h;
                if (lat && pp >= 64) rope4(lo, hi, (const f32x2*)(C.ws + WS_TAB32) + t * 16 + ((pp - 64) >> 3) * 4);
                *(u32x4*)(wsb(C, A_QM) + (size_t)R * 768 + col) = pack8(lo * rs, hi * rs); } }
    }
};
__device__ __forceinline__ void ph_pool(const Ctx& c, int l) {
    LAS bf16_t* tile = (LAS bf16_t*)c.lds;
    const int nitems = 16 * 32 + (l == 0 ? 16 * 4 : 0);
    for (int it = c.G - 1 - c.blk; it < nitems; it += c.G) {
        int b, s0, n, rbase;
        if (it < 512) { b = it >> 5; s0 = (it & 31) * 64; n = SEQ; rbase = b * RPB + CTXL; } else { const int q = it - 512; b = q >> 2; s0 = (q & 3) * 64; n = CTXL; rbase = b * RPB; }
        __syncthreads();
        for (int q = c.tid; q < 80 * 64; q += 512) { const int rr = q >> 6, ch = q & 63; const int t = s0 - 8 + rr;
            u32x4 v = (u32x4){0u, 0u, 0u, 0u}; if (t >= 0 && t < n) v = *(const u32x4*)(wsb(c, A_PL) + (size_t)(rbase + t) * 512 + ch * 8);
            *(LAS u32x4*)(tile + rr * 512 + ch * 8) = v; }
        __syncthreads();
        const int ch = c.tid & 63, g = ch >> 4, w = 2 << g;
        for (int rr = c.tid >> 6; rr < 64; rr += 8) { const int t = s0 + rr; const int lo = max(t - w / 2, 0), hi = min(t + w / 2, n);
            float acc[8];
#pragma unroll
            for (int q = 0; q < 8; ++q) acc[q] = 0.f;
#pragma unroll
            for (int jj = 0; jj < 16; ++jj) { const int j = lo + jj; if (j < hi) { f32x4 a, bq; unpack8(*(const LAS u32x4*)(tile + (j - s0 + 8) * 512 + ch * 8), a, bq);
                acc[0] += a.x; acc[1] += a.y; acc[2] += a.z; acc[3] += a.w; acc[4] += bq.x; acc[5] += bq.y; acc[6] += bq.z; acc[7] += bq.w; } }
            f32x4 xa, xb; unpack8(*(const LAS u32x4*)(tile + (rr + 8) * 512 + ch * 8), xa, xb);
            const float inv = 1.f / (float)(hi - lo);
            const f32x4 oa = (f32x4){acc[0], acc[1], acc[2], acc[3]} * inv - xa, ob = (f32x4){acc[4], acc[5], acc[6], acc[7]} * inv - xb;
            *(u32x2*)((unsigned char*)(c.ws + A_PD) + (size_t)(rbase + t) * 512 + ch * 8) = (u32x2){pack4_fp8c(oa, BR8_SCALE), pack4_fp8c(ob, BR8_SCALE)}; }
    }
    __syncthreads();
}

__device__ __forceinline__ float lam_of(const Ctx& c, int l) {
    float s1 = 0.f, s2 = 0.f;
    for (int i = 0; i < 64; ++i) { s1 += INP(c, I_LQ1)[l * 64 + i] * INP(c, I_LK1)[l * 64 + i]; s2 += INP(c, I_LQ2)[l * 64 + i] * INP(c, I_LK2)[l * 64 + i]; }
    const float lam_init = 0.8f - 0.6f * expf(-0.3f * (float)l);
    return expf(s1) - expf(s2) + lam_init;
}
__device__ __forceinline__ void ph_attn_naive(const Ctx& c, int l) {
    const long gt = (long)c.blk * 512 + c.tid, NT = (long)c.G * 512;
    for (long it = gt; it < (long)NR * 16; it += NT) {
        const int dc = (int)(it & 1), h = (int)((it >> 1) & 7), R = (int)(it >> 4);
        const int b = R / RPB, j = R % RPB; const bool lat = j >= CTXL;
        if (!lat && l != 0) continue;
        const int nk = lat ? RPB : CTXL; const int kb = b * RPB;
        const bf16_t* qp = wsb(c, A_QM) + (size_t)R * 768 + h * 96;
        float m = -INFINITY, ls = 0.f, o[32];
#pragma unroll
        for (int i = 0; i < 32; ++i) o[i] = 0.f;
        for (int k = 0; k < nk; ++k) {
            const int Rk = kb + k; const bf16_t* kp = wsb(c, A_KN) + (size_t)Rk * 512 + h * 64; const bf16_t* rp = wsb(c, A_KR) + (size_t)Rk * 32;
            float s = 0.f;
            for (int i = 0; i < 96; i += 8) { f32x4 qa, qb, ka, kbb; unpack8(*(const u32x4*)(qp + i), qa, qb); unpack8(*(const u32x4*)(i < 64 ? kp + i : rp + (i - 64)), ka, kbb);
                s += (qa.x * ka.x + qa.y * ka.y) + (qa.z * ka.z + qa.w * ka.w) + (qb.x * kbb.x + qb.y * kbb.y) + (qb.z * kbb.z + qb.w * kbb.w); }
            const float mn = fmaxf(m, s), f = exp2f(m - mn), pv = exp2f(s - mn);
            ls = ls * f + pv; m = mn;
            const size_t vcol = (size_t)(Rk & ~31) + tok2pos(Rk & 31);
            const float pb = bf2f((unsigned short)f2bf(pv));
#pragma unroll
            for (int i = 0; i < 32; ++i) o[i] = o[i] * f + pb * bf2f(wsb(c, A_VMT)[(size_t)(h * 64 + dc * 32 + i) * NR + vcol]);
        }
        const float inv = 1.f / ls;
        bf16_t* op = wsb(c, A_OM) + (size_t)R * 512 + h * 64 + dc * 32;
#pragma unroll
        for (int i = 0; i < 32; i += 2) *(unsigned*)(op + i) = pk2(o[i] * inv, o[i + 1] * inv);
    }
    const float lam = lam_of(c, l); const float lam_init = 0.8f - 0.6f * expf(-0.3f * (float)l);
    for (long it = gt; it < (long)NR * 32; it += NT) {
        const int dc = (int)(it & 7), h = (int)((it >> 3) & 3), R = (int)(it >> 5);
        const int b = R / RPB, j = R % RPB; const bool lat = j >= CTXL;
        const bool act = lat || l == 0;
        const int nk = act ? (lat ? RPB : CTXL) : 0; const int kb = b * RPB;
        const bf16_t* qp = wsb(c, A_QD) + (size_t)R * 512 + h * 128;
        float m0 = -INFINITY, m1 = -INFINITY, l0 = 0.f, l1 = 0.f, o0[16], o1[16];
#pragma unroll
        for (int i = 0; i < 16; ++i) { o0[i] = 0.f; o1[i] = 0.f; }
        for (int k = 0; k < nk; ++k) {
            const int Rk = kb + k; const bf16_t* kp = wsb(c, A_KD) + (size_t)Rk * 512 + h * 128;
            float s0 = 0.f, s1 = 0.f;
#pragma unroll 2
            for (int i = 0; i < 64; i += 8) { f32x4 qa, qb, ka, kbb; unpack8(*(const u32x4*)(qp + i), qa, qb); unpack8(*(const u32x4*)(kp + i), ka, kbb);
                s0 += (qa.x * ka.x + qa.y * ka.y) + (qa.z * ka.z + qa.w * ka.w) + (qb.x * kbb.x + qb.y * kbb.y) + (qb.z * kbb.z + qb.w * kbb.w);
                unpack8(*(const u32x4*)(qp + 64 + i), qa, qb); unpack8(*(const u32x4*)(kp + 64 + i), ka, kbb);
                s1 += (qa.x * ka.x + qa.y * ka.y) + (qa.z * ka.z + qa.w * ka.w) + (qb.x * kbb.x + qb.y * kbb.y) + (qb.z * kbb.z + qb.w * kbb.w); }
            const float mn0 = fmaxf(m0, s0), f0 = exp2f(m0 - mn0), p0 = exp2f(s0 - mn0); l0 = l0 * f0 + p0; m0 = mn0;
            const float mn1 = fmaxf(m1, s1), f1 = exp2f(m1 - mn1), p1 = exp2f(s1 - mn1); l1 = l1 * f1 + p1; m1 = mn1;
            const size_t vcol = (size_t)(Rk & ~31) + tok2pos(Rk & 31);
            const float pb0 = bf2f((unsigned short)f2bf(p0)), pb1 = bf2f((unsigned short)f2bf(p1));
#pragma unroll
            for (int i = 0; i < 16; ++i) { const float v = bf2f(wsb(c, A_VDT)[(size_t)(h * 128 + dc * 16 + i) * NR + vcol]); o0[i] = o0[i] * f0 + pb0 * v; o1[i] = o1[i] * f1 + pb1 * v; }
        }
        float ss = 0.f; const float i0 = act ? 1.f / l0 : 0.f, i1 = act ? lam / l1 : 0.f;
#pragma unroll
        for (int i = 0; i < 16; ++i) { o0[i] = o0[i] * i0 - o1[i] * i1; ss += o0[i] * o0[i]; }
        ss += __shfl_xor(ss, 1); ss += __shfl_xor(ss, 2); ss += __shfl_xor(ss, 4);
        const float rs = (1.f - lam_init) / sqrtf(ss * (1.f / 128.f) + EPSN);
        if (act) { bf16_t* op = wsb(c, A_QD) + (size_t)R * 512 + h * 128 + dc * 16; const float* g = INP(c, I_GSUBLN) + l * 128 + dc * 16;
#pragma unroll
            for (int i = 0; i < 16; i += 2) *(unsigned*)(op + i) = pk2(o0[i] * rs * g[i], o0[i + 1] * rs * g[i + 1]); }
    }
}


typedef float f32x16 __attribute__((ext_vector_type(16)));
template <bool DIFF>
__device__ __forceinline__ void attn_unit(const Ctx& c, int l, int b, int h, int q0  , int nk  , float lam, float lam_init) {
    constexpr int DQ = DIFF ? 64 : 96, DV = DIFF ? 128 : 64, NCK = DIFF ? 16 : 12  , KB = NCK * 1024, VB = 8 * DV * 16, SLOT = KB + VB;
    constexpr int NDS = DQ / 16, NDB = DV / 32;
    static_assert(4 * SLOT + 8 * 512 + (DIFF ? 0 : 32768) <= LDS_MISC && (!DIFF || 65536 <= 4 * SLOT), "attention LDS map");
    LAS unsigned char* lds = c.lds;
    const int lane = c.lane, wid = c.wave, r32 = lane & 31, hi = lane >> 5;
    const int map = DIFF ? (wid >> 2) : 0, wq = DIFF ? (wid & 3) : wid;
    const int kb = b * RPB, NT = nk / 64;
    LAS float* wsf = (LAS float*)(lds + 4 * SLOT + wid * 512);
    unsigned ko0, ko1, vo0, vo1;
    unsigned kstep0, kstep1, kdb0, kdb1, vdb0, vdb1; bool has_k1;
    if constexpr (DIFF) {
        { const int row = 4 * wid + (lane >> 4), ch = (lane & 15) ^ (row & 15); ko0 = (unsigned)(A_KD + ((size_t)(kb + row) * 512 + h * 128 + ch * 8) * 2); }
        { const int row = 4 * (wid + 8) + (lane >> 4), ch = (lane & 15) ^ (row & 15); ko1 = (unsigned)(A_KD + ((size_t)(kb + row) * 512 + h * 128 + ch * 8) * 2); }
        kstep0 = kstep1 = 64 * 512 * 2; kdb0 = wid * 1024; kdb1 = (wid + 8) * 1024; has_k1 = true;
        { const int d = 8 * wid + (lane >> 3), ch = (lane & 7) ^ ((d >> 1) & 7); vo0 = (unsigned)(A_VDT + ((size_t)(h * 128 + d) * NR + kb + ch * 8) * 2); }
        { const int d = 8 * (wid + 8) + (lane >> 3), ch = (lane & 7) ^ ((d >> 1) & 7); vo1 = (unsigned)(A_VDT + ((size_t)(h * 128 + d) * NR + kb + ch * 8) * 2); }
        vdb0 = KB + wid * 1024; vdb1 = KB + (wid + 8) * 1024;
    } else {
        { const int row = 8 * wid + (lane >> 3), ch = (lane & 7) ^ ((row >> 1) & 7); ko0 = (unsigned)(A_KN + ((size_t)(kb + row) * 512 + h * 64 + ch * 8) * 2); }
        { const int w4 = wid & 3, row = 16 * w4 + (lane >> 2), ch = (lane & 3) ^ ((row >> 2) & 3); ko1 = (unsigned)(A_KR + ((size_t)(kb + row) * 32 + ch * 8) * 2); }
        kstep0 = 64 * 512 * 2; kstep1 = 64 * 32 * 2; kdb0 = wid * 1024; kdb1 = 8192 + (wid & 3) * 1024; has_k1 = wid < 4;
        { const int d = 8 * wid + (lane >> 3), ch = (lane & 7) ^ ((d >> 1) & 7); vo0 = (unsigned)(A_VMT + ((size_t)(h * 64 + d) * NR + kb + ch * 8) * 2); }
        vo1 = vo0; vdb0 = KB + wid * 1024; vdb1 = vdb0;
    }
    const GAS unsigned char* wsg_ = c.ws;
#define AT_DMA(t, slot) do { const unsigned so_ = (unsigned)(slot) * SLOT; \
        __builtin_amdgcn_global_load_lds((const GAS unsigned*)(wsg_ + (size_t)((unsigned)(t) * kstep0) + ko0), (LAS unsigned*)(lds + so_ + kdb0), 16, 0, 0); \
        if (has_k1) __builtin_amdgcn_global_load_lds((const GAS unsigned*)(wsg_ + (size_t)((unsigned)(t) * kstep1) + ko1), (LAS unsigned*)(lds + so_ + kdb1), 16, 0, 0); \
        __builtin_amdgcn_global_load_lds((const GAS unsigned*)(wsg_ + (size_t)((unsigned)(t) * 128u) + vo0), (LAS unsigned*)(lds + so_ + vdb0), 16, 0, 0); \
        if (DIFF) __builtin_amdgcn_global_load_lds((const GAS unsigned*)(wsg_ + (size_t)((unsigned)(t) * 128u) + vo1), (LAS unsigned*)(lds + so_ + vdb1), 16, 0, 0); } while (0)
#define AT_WAIT1() do { if (DIFF) asm volatile("s_waitcnt vmcnt(4)" ::: "memory"); else if (has_k1) asm volatile("s_waitcnt vmcnt(3)" ::: "memory"); else asm volatile("s_waitcnt vmcnt(2)" ::: "memory"); } while (0)
    const int qrow = q0 + wq * 32 + r32;
    const bf16_t* qp = DIFF ? (wsb(c, A_QD) + (size_t)qrow * 512 + h * 128 + map * 64) : (wsb(c, A_QM) + (size_t)qrow * 768 + h * 96);
    bf16x8 qr[NDS];
#pragma unroll
    for (int ds = 0; ds < NDS; ++ds) qr[ds] = *(const bf16x8*)(qp + ds * 16 + hi * 8);
    AT_DMA(0, 0); AT_DMA(1, 1); AT_DMA(2, 2);
    f32x16 o[NDB];
#pragma unroll
    for (int d = 0; d < NDB; ++d) o[d] = f32x16{};
    float mhat = 0.f, lsum = 0.f; f32x16 negm = f32x16{};
    const int kchunk0 = DIFF ? map * 8 : 0;
    const unsigned swk_ = (unsigned)((r32 >> 1) & 7), swr_ = (unsigned)((r32 >> 2) & 3), swd_ = (unsigned)(r32 & 15);
#define AT_KOFF(ds) (DIFF ? ((unsigned)r32 * 256u + ((((unsigned)(kchunk0 + 2 * (ds)) ^ swd_) ^ (unsigned)hi) << 4)) \
                          : ((ds) < 4 ? ((unsigned)r32 * 128u + ((((unsigned)(2 * (ds)) ^ swk_) ^ (unsigned)hi) << 4)) : (8192u + (unsigned)r32 * 64u + ((((unsigned)(2 * ((ds) - 4)) ^ swr_) ^ (unsigned)hi) << 4))))
#define AT_KROW32(ds) (DIFF ? 8192 : ((ds) < 4 ? 4096 : 2048))
#define AT_VOFF(s4) ((unsigned)KB + (unsigned)r32 * 128u + ((((unsigned)(2 * (s4)) ^ swk_) ^ (unsigned)hi) << 4))
#define AT_QK(P0, P1, slot_) do { unsigned kb_ = (unsigned)(slot_) * SLOT; asm volatile("" : "+v"(kb_)); const LAS unsigned char* ks_ = lds + kb_; \
        if (DIFF) { P0 = f32x16{}; P1 = f32x16{}; } else { P0 = negm; P1 = negm; } \
        _Pragma("unroll") for (int ds = 0; ds < NDS; ++ds) { \
            const bf16x8 k0 = *(const LAS bf16x8*)(ks_ + AT_KOFF(ds)); \
            const bf16x8 k1 = *(const LAS bf16x8*)(ks_ + AT_KOFF(ds) + AT_KROW32(ds)); \
            P0 = __builtin_amdgcn_mfma_f32_32x32x16_bf16(k0, qr[ds], P0, 0, 0, 0); \
            P1 = __builtin_amdgcn_mfma_f32_32x32x16_bf16(k1, qr[ds], P1, 0, 0, 0); } } while (0)
#define AT_ROWMAX(RM, P0, P1) do { float a_ = fmaxf(fmaxf(P0[0], P1[0]), P0[1]), b_ = fmaxf(fmaxf(P1[1], P0[2]), P1[2]); \
        _Pragma("unroll") for (int r = 3; r < 15; r += 2) { a_ = fmaxf(fmaxf(a_, P0[r]), P1[r]); b_ = fmaxf(fmaxf(b_, P0[r + 1]), P1[r + 1]); } \
        a_ = fmaxf(fmaxf(a_, P0[15]), P1[15]); RM = fmaxf(a_, b_); RM = fmaxf(RM, __shfl_xor(RM, 32)); } while (0)
    if (DIFF) asm volatile("s_waitcnt vmcnt(8)" ::: "memory"); else if (has_k1) asm volatile("s_waitcnt vmcnt(6)" ::: "memory"); else asm volatile("s_waitcnt vmcnt(4)" ::: "memory");
    asm volatile("s_barrier" ::: "memory");
    f32x16 pA0, pA1, pB0, pB1; float rmA, rmB = 0.f;
    AT_QK(pA0, pA1, 0);
    AT_ROWMAX(rmA, pA0, pA1);
#define SGB(mask, n) __builtin_amdgcn_sched_group_barrier(mask, n, 0)
#define AT_STEP(P0, P1, RM, N0, N1, RMN, t, HN) do { \
          \
        if (HN) { if ((t) + 2 < NT) AT_WAIT1(); else asm volatile("s_waitcnt vmcnt(0)" ::: "memory"); } \
        asm volatile("s_barrier" ::: "memory"); \
        if ((t) + 3 < NT) AT_DMA((t) + 3, ((t) + 3) & 3); \
          \
        const bool first_ = ((t) == 0); \
        const float rrel_ = DIFF ? RM - mhat : RM;        \
        if (first_ || __any(rrel_ > 8.0f)) { \
            const float dl = first_ ? rrel_ : fmaxf(rrel_, 0.f); \
            mhat += dl; \
            if (!DIFF) { _Pragma("unroll") for (int r = 0; r < 16; ++r) { P0[r] -= dl; P1[r] -= dl; negm[r] = -mhat; } } \
            if (!first_) { \
                const float f = __builtin_amdgcn_exp2f(-dl); lsum *= f; \
                { int rq_ = r32; asm volatile("" : "+v"(rq_)); if (hi == 0) wsf[rq_] = f; } \
                asm volatile("s_waitcnt lgkmcnt(0)" ::: "memory"); \
                _Pragma("unroll") for (int r = 0; r < 16; ++r) { const float fr_ = wsf[(r & 3) + 8 * (r >> 2) + 4 * hi]; \
                    _Pragma("unroll") for (int d = 0; d < NDB; ++d) o[d][r] *= fr_; } \
            } \
        } \
        __builtin_amdgcn_sched_barrier(0); \
          \
        unsigned kb_ = (unsigned)(((t) + 1) & 3) * SLOT; asm volatile("" : "+v"(kb_)); const LAS unsigned char* ks_ = lds + kb_; \
        unsigned vb_ = (unsigned)((t) & 3) * SLOT; asm volatile("" : "+v"(vb_)); const LAS unsigned char* vs_ = lds + vb_; \
        bf16x8 kf_[2 * NDS], vf_[4], vg_[4]; \
        if (HN) { _Pragma("unroll") for (int ds = 0; ds < NDS; ++ds) { kf_[2 * ds] = *(const LAS bf16x8*)(ks_ + AT_KOFF(ds)); kf_[2 * ds + 1] = *(const LAS bf16x8*)(ks_ + AT_KOFF(ds) + AT_KROW32(ds)); } } \
        if (HN) { if (DIFF) { N0 = f32x16{}; N1 = f32x16{}; } else { N0 = negm; N1 = negm; } \
            _Pragma("unroll") for (int ds = 0; ds < NDS; ++ds) { \
                N0 = __builtin_amdgcn_mfma_f32_32x32x16_bf16(kf_[2 * ds], qr[ds], N0, 0, 0, 0); \
                N1 = __builtin_amdgcn_mfma_f32_32x32x16_bf16(kf_[2 * ds + 1], qr[ds], N1, 0, 0, 0); } } \
        float sacc = 0.f; \
        _Pragma("unroll") for (int r = 0; r < 16; ++r) { P0[r] = __builtin_amdgcn_exp2f(DIFF ? P0[r] - mhat : P0[r]); P1[r] = __builtin_amdgcn_exp2f(DIFF ? P1[r] - mhat : P1[r]); sacc += P0[r] + P1[r]; } \
        lsum += sacc; \
        bf16x8 pa[4]; \
        { u32x4 w; \
          w.x = pk2(P0[0], P0[1]); w.y = pk2(P0[2], P0[3]); w.z = pk2(P0[4], P0[5]); w.w = pk2(P0[6], P0[7]); pa[0] = __builtin_bit_cast(bf16x8, w); \
          w.x = pk2(P0[8], P0[9]); w.y = pk2(P0[10], P0[11]); w.z = pk2(P0[12], P0[13]); w.w = pk2(P0[14], P0[15]); pa[1] = __builtin_bit_cast(bf16x8, w); \
          w.x = pk2(P1[0], P1[1]); w.y = pk2(P1[2], P1[3]); w.z = pk2(P1[4], P1[5]); w.w = pk2(P1[6], P1[7]); pa[2] = __builtin_bit_cast(bf16x8, w); \
          w.x = pk2(P1[8], P1[9]); w.y = pk2(P1[10], P1[11]); w.z = pk2(P1[12], P1[13]); w.w = pk2(P1[14], P1[15]); pa[3] = __builtin_bit_cast(bf16x8, w); } \
        _Pragma("unroll") for (int s4 = 0; s4 < 4; ++s4) vf_[s4] = *(const LAS bf16x8*)(vs_ + AT_VOFF(s4)); \
        _Pragma("unroll") for (int s4 = 0; s4 < 4; ++s4) vg_[s4] = *(const LAS bf16x8*)(vs_ + AT_VOFF(s4) + 4096); \
        _Pragma("unroll") for (int s4 = 0; s4 < 4; ++s4) o[0] = __builtin_amdgcn_mfma_f32_32x32x16_bf16(pa[s4], vf_[s4], o[0], 0, 0, 0); \
        _Pragma("unroll") for (int s4 = 0; s4 < 4; ++s4) o[1] = __builtin_amdgcn_mfma_f32_32x32x16_bf16(pa[s4], vg_[s4], o[1], 0, 0, 0); \
        if (HN) AT_ROWMAX(RMN, N0, N1); \
          \
        SGB(0x100, (HN ? 2 * NDS : 8)); \
        _Pragma("unroll") for (int i_ = 0; i_ < (HN ? 2 * NDS : 0); ++i_) { SGB(0x008, 1); SGB(0x002, 6); } \
        if (HN) SGB(0x100, 8); \
        SGB(0x002, 64); \
        _Pragma("unroll") for (int i_ = 0; i_ < 8; ++i_) { SGB(0x008, 1); SGB(0x002, 2); } \
        __builtin_amdgcn_sched_barrier(0); \
    } while (0)
#define AT_STEP_D(P0, P1, RM, N0, N1, RMN, t) do { \
          \
        if ((t) + 1 < NT) { if ((t) + 2 < NT) AT_WAIT1(); else asm volatile("s_waitcnt vmcnt(0)" ::: "memory"); } \
        asm volatile("s_barrier" ::: "memory"); \
        if ((t) + 3 < NT) AT_DMA((t) + 3, ((t) + 3) & 3); \
          \
        const bool first_ = ((t) == 0); \
        const float rrel_ = DIFF ? RM - mhat : RM;        \
        if (first_ || __any(rrel_ > 8.0f)) { \
            const float dl = first_ ? rrel_ : fmaxf(rrel_, 0.f); \
            mhat += dl; \
            if (!DIFF) { _Pragma("unroll") for (int r = 0; r < 16; ++r) { P0[r] -= dl; P1[r] -= dl; negm[r] = -mhat; } } \
            if (!first_) { \
                const float f = __builtin_amdgcn_exp2f(-dl); lsum *= f; \
                { int rq_ = r32; asm volatile("" : "+v"(rq_)); if (hi == 0) wsf[rq_] = f; } \
                asm volatile("s_waitcnt lgkmcnt(0)" ::: "memory"); \
                _Pragma("unroll") for (int r = 0; r < 16; ++r) { const float fr_ = wsf[(r & 3) + 8 * (r >> 2) + 4 * hi]; \
                    _Pragma("unroll") for (int d = 0; d < NDB; ++d) o[d][r] *= fr_; } \
            } \
        } \
          \
        if ((t) + 1 < NT) AT_QK(N0, N1, ((t) + 1) & 3); \
        float sacc = 0.f; \
        _Pragma("unroll") for (int r = 0; r < 16; ++r) { P0[r] = __builtin_amdgcn_exp2f(DIFF ? P0[r] - mhat : P0[r]); P1[r] = __builtin_amdgcn_exp2f(DIFF ? P1[r] - mhat : P1[r]); sacc += P0[r] + P1[r]; } \
        lsum += sacc; \
        bf16x8 pa[4]; \
        { u32x4 w; \
          w.x = pk2(P0[0], P0[1]); w.y = pk2(P0[2], P0[3]); w.z = pk2(P0[4], P0[5]); w.w = pk2(P0[6], P0[7]); pa[0] = __builtin_bit_cast(bf16x8, w); \
          w.x = pk2(P0[8], P0[9]); w.y = pk2(P0[10], P0[11]); w.z = pk2(P0[12], P0[13]); w.w = pk2(P0[14], P0[15]); pa[1] = __builtin_bit_cast(bf16x8, w); \
          w.x = pk2(P1[0], P1[1]); w.y = pk2(P1[2], P1[3]); w.z = pk2(P1[4], P1[5]); w.w = pk2(P1[6], P1[7]); pa[2] = __builtin_bit_cast(bf16x8, w); \
          w.x = pk2(P1[8], P1[9]); w.y = pk2(P1[10], P1[11]); w.z = pk2(P1[12], P1[13]); w.w = pk2(P1[14], P1[15]); pa[3] = __builtin_bit_cast(bf16x8, w); } \
          \
        { unsigned vb_ = (unsigned)((t) & 3) * SLOT; asm volatile("" : "+v"(vb_)); const LAS unsigned char* vs = lds + vb_; \
          _Pragma("unroll") for (int d = 0; d < NDB; ++d) { \
            _Pragma("unroll") for (int s4 = 0; s4 < 4; ++s4) { \
                const bf16x8 vf = *(const LAS bf16x8*)(vs + AT_VOFF(s4) + d * 4096); \
                o[d] = __builtin_amdgcn_mfma_f32_32x32x16_bf16(pa[s4], vf, o[d], 0, 0, 0); } \
          } } \
        if ((t) + 1 < NT) AT_ROWMAX(RMN, N0, N1); \
    } while (0)
    if constexpr (DIFF) {
        for (int t = 0; t < NT; t += 2) { AT_STEP_D(pA0, pA1, rmA, pB0, pB1, rmB, t); AT_STEP_D(pB0, pB1, rmB, pA0, pA1, rmA, t + 1); }
    } else {
        int t = 0;
        for (; t + 2 < NT; t += 2) {
            AT_STEP(pA0, pA1, rmA, pB0, pB1, rmB, t, true);
            AT_STEP(pB0, pB1, rmB, pA0, pA1, rmA, t + 1, true);
        }
        AT_STEP(pA0, pA1, rmA, pB0, pB1, rmB, t, true);
        AT_STEP(pB0, pB1, rmB, pA0, pA1, rmA, t + 1, false);
    }
#undef AT_STEP
#undef AT_STEP_D
#undef SGB
#undef AT_QK
#undef AT_KOFF
#undef AT_KROW32
#undef AT_VOFF
#undef AT_ROWMAX
    lsum += __shfl_xor(lsum, 32);
    { int rq_ = r32; asm volatile("" : "+v"(rq_)); if (hi == 0) wsf[32 + rq_] = lsum; }
    asm volatile("s_waitcnt lgkmcnt(0)" ::: "memory");
    float rl[16];
#pragma unroll
    for (int r = 0; r < 16; ++r) rl[r] = 1.f / wsf[32 + (r & 3) + 8 * (r >> 2) + 4 * hi];
    LAS unsigned char* xch = DIFF ? lds : lds + 4 * SLOT + 8 * 512;
    asm volatile("s_barrier" ::: "memory");
    if constexpr (DIFF) {
        LAS float* x1 = (LAS float*)xch + wq * 4096;
        if (map == 1) {
#pragma unroll
            for (int d = 0; d < NDB; ++d)
#pragma unroll
                for (int r = 0; r < 16; ++r) x1[((r & 3) + 8 * (r >> 2) + 4 * hi) * 128 + d * 32 + r32] = o[d][r] * rl[r] * lam;
        }
        asm volatile("s_waitcnt lgkmcnt(0)\n\ts_barrier" ::: "memory");
        if (map == 0) {
            float ss[16];
#pragma unroll
            for (int r = 0; r < 16; ++r) ss[r] = 0.f;
#pragma unroll
            for (int d = 0; d < NDB; ++d)
#pragma unroll
                for (int r = 0; r < 16; ++r) { const float v = o[d][r] * rl[r] - x1[((r & 3) + 8 * (r >> 2) + 4 * hi) * 128 + d * 32 + r32]; o[d][r] = v; ss[r] += v * v; }
#pragma unroll
            for (int r = 0; r < 16; ++r) { float v = ss[r]; v += __shfl_xor(v, 1); v += __shfl_xor(v, 2); v += __shfl_xor(v, 4); v += __shfl_xor(v, 8); v += __shfl_xor(v, 16); ss[r] = (1.f - lam_init) / sqrtf(v * (1.f / 128.f) + EPSN); }
            float g[NDB];
#pragma unroll
            for (int d = 0; d < NDB; ++d) g[d] = INP(c, I_GSUBLN)[l * 128 + d * 32 + r32];
            asm volatile("s_waitcnt lgkmcnt(0)" ::: "memory");
            LAS bf16_t* stg = (LAS bf16_t*)x1;
#pragma unroll
            for (int d = 0; d < NDB; ++d)
#pragma unroll
                for (int r = 0; r < 16; ++r) stg[((r & 3) + 8 * (r >> 2) + 4 * hi) * 128 + d * 32 + r32] = (bf16_t)f2bf(o[d][r] * ss[r] * g[d]);
            asm volatile("s_waitcnt lgkmcnt(0)" ::: "memory");
            unsigned char* op = (unsigned char*)(c.ws + A_OD8) + (size_t)(q0 + wq * 32) * 512 + h * 128;
#pragma unroll
            for (int i = 0; i < 8; ++i) { const int row = i * 4 + (lane >> 4), ch = lane & 15; f32x4 a_, b_; unpack8(*(const LAS u32x4*)(stg + row * 128 + ch * 8), a_, b_);
                *(u32x2*)(op + (size_t)row * 512 + ch * 8) = (u32x2){pack4_fp8c(a_, BR8_SCALE), pack4_fp8c(b_, BR8_SCALE)}; }
        }
        asm volatile("s_waitcnt lgkmcnt(0)\n\ts_barrier" ::: "memory");
    } else {
        LAS bf16_t* stg = (LAS bf16_t*)xch + wid * 2048;
#pragma unroll
        for (int d = 0; d < NDB; ++d)
#pragma unroll
            for (int r = 0; r < 16; ++r) stg[((r & 3) + 8 * (r >> 2) + 4 * hi) * 64 + d * 32 + r32] = (bf16_t)f2bf(o[d][r] * rl[r]);
        asm volatile("s_waitcnt lgkmcnt(0)" ::: "memory");
        unsigned char* op = (unsigned char*)(c.ws + A_OM) + (size_t)(q0 + wid * 32) * 512 + h * 64;
#pragma unroll
        for (int i = 0; i < 4; ++i) { const int row = i * 8 + (lane >> 3), ch = lane & 7; f32x4 a_, b_; unpack8(*(const LAS u32x4*)(stg + row * 64 + ch * 8), a_, b_);
            *(u32x2*)(op + (size_t)row * 512 + ch * 8) = (u32x2){pack4_fp8c(a_, BR8_SCALE), pack4_fp8c(b_, BR8_SCALE)}; }
        asm volatile("s_waitcnt lgkmcnt(0)" ::: "memory");
    }
#undef AT_DMA
#undef AT_WAIT1
}
__device__ __forceinline__ void ph_attn_mla(const Ctx& c, int l) {
    const int n_mla = ATT_TEST_NOMLA ? 0 : 1024 + (l == 0 ? 128 : 0);
    for (int rep = 0; rep < NREP(16); ++rep)
    for (int u = c.blk; u < n_mla; u += c.G) {
        if (u < 1024) {
            int b = u >> 6, h = (u >> 3) & 7, qt = u & 7;
            if (c.G == 256) { const int x = c.blk & 7, s = c.blk >> 3, pair = (u >> 8) * 32 + x * 4 + (s >> 3); b = pair >> 3; h = pair & 7; qt = s & 7; }
            attn_unit<false>(c, l, b, h, b * RPB + CTXL + qt * 256, RPB, 0.f, 0.f); }
        else { const int q = u - 1024, b = q >> 3, h = q & 7; attn_unit<false>(c, l, b, h, b * RPB, CTXL, 0.f, 0.f); }
    }
}
__device__ __forceinline__ void ph_attn_diff(const Ctx& c, int l) {
    float lam = lam_of(c, l); const float lam_init = 0.8f - 0.6f * expf(-0.3f * (float)l);
    lam = __builtin_bit_cast(float, __builtin_amdgcn_readfirstlane(__builtin_bit_cast(int, lam)));
    const int n_diff = ATT_TEST_NODIFF ? 0 : 1024 + (l == 0 ? 128 : 0);
    for (int u0 = c.blk; u0 < 1024 + 256; u0 += c.G) {
        int u = u0;
        if (u0 >= 1024) { u = (c.G == 256) ? u0 - 128 : u0; if (u < 1024 || u >= n_diff) continue; }
        if (u < 1024) {
            int b = u >> 6, h = (u >> 4) & 3, qt = u & 15;
            if (c.G == 256) { const int x = c.blk & 7, s = c.blk >> 3, pair = (u >> 8) * 16 + x * 2 + (s >> 4); b = pair >> 2; h = pair & 3; qt = s & 15; }
            attn_unit<true>(c, l, b, h, b * RPB + CTXL + qt * 128, RPB, lam, lam_init); }
        else { const int q = u - 1024, b = q >> 3, h = (q >> 1) & 3, qt = q & 1; attn_unit<true>(c, l, b, h, b * RPB + qt * 128, CTXL, lam, lam_init); }
    }
}

struct SchedMerge1 {
    static constexpr bool GATHER = false;
    const Ctx* c; int l, n_units;
    __device__ void init(const Ctx* cc, int ll) { c = cc; l = ll; n_units = (l == 0 ? 144 : 128) * 4; }
    __device__ bool next(int i, Unit& u) const {
        const int U = deal_xcd(*c, i / 3), br = i % 3; if (U >= n_units) return false;
        const int rt = U >> 2; u.pn = U & 3; u.pm = (l == 0) ? rt : ((rt >> 3) * 9 + 1 + (rt & 7));
        u.rows = nullptr; u.nrows = 256; u.aux = l; u.aux2 = 0; u.bperm = 0; u.kind = br; u.K = 256;
        u.a = wsb(*c, br == 0 ? A_OM : (br == 1 ? A_PD : A_OD8)) + (size_t)u.pm * 256 * 256;
        u.b = wt(*c, br == 0 ? WO_BM : (br == 1 ? WO_PP : WO_BD)) + (size_t)u.pn * 256 * 256;
        return true;
    }
};
struct EpiMerge1 {
    static constexpr bool PAIR = false; static constexpr bool FP8 = true;
    const Ctx* c;
    static constexpr int GROUP = 4; static constexpr bool EARLY = false; static constexpr bool CHAIN = true; static constexpr bool ROWTAB = false; struct Pre { u32x2 a0, a1, b0, b1; };
    struct UState {}; __device__ __forceinline__ void unit_begin(const Unit&, int, UState&) const {}
    __device__ __forceinline__ bool keep_acc(const Unit& u) const { return u.kind < 2; }
    __device__ __forceinline__ void pre(const Unit& u, int row, int c8, Pre& p) const {
        const unsigned char* gp = (const unsigned char*)c->p->out + (size_t)(u.pm * 256 + row) * 3072 + u.kind * 1024 + u.pn * 256 + c8;
        p.a0 = *(const u32x2*)gp; p.a1 = *(const u32x2*)(gp + 128);
        const unsigned char* gn = gp + (u.kind < 2 ? 1024 : 0);
        p.b0 = *(const u32x2*)gn; p.b1 = *(const u32x2*)(gn + 128);
    }
    __device__ __forceinline__ static f32x4 gate4(unsigned w) { return (f32x4){(float)max(w & 255u, 1u), (float)max((w >> 8) & 255u, 1u), (float)max((w >> 16) & 255u, 1u), (float)max(w >> 24, 1u)}; }
    __device__ __forceinline__ static f32x4 rcp4(f32x4 v) { return (f32x4){__builtin_amdgcn_rcpf(v.x), __builtin_amdgcn_rcpf(v.y), __builtin_amdgcn_rcpf(v.z), __builtin_amdgcn_rcpf(v.w)}; }
    __device__ __forceinline__ void apply_rw(const Unit& u, int row, int c8, const Pre& p, const UState&, f32x4& v0l, f32x4& v0h, f32x4& v1l, f32x4& v1h) const {
        const Ctx& C = *c;
        if (u.kind < 2) {
            v0l *= gate4(p.a0.x) * rcp4(gate4(p.b0.x)); v0h *= gate4(p.a0.y) * rcp4(gate4(p.b0.y));
            v1l *= gate4(p.a1.x) * rcp4(gate4(p.b1.x)); v1h *= gate4(p.a1.y) * rcp4(gate4(p.b1.y));
        } else {
            constexpr float sc_ = W8_INV * BR8_INV / 255.f;
            const f32x4 s = (f32x4){sc_, sc_, sc_, sc_};
            unsigned char* o = (unsigned char*)(C.ws + A_MG) + (size_t)(u.pm * 256 + row) * 1024 + u.pn * 256 + c8;
            *(u32x2*)o = (u32x2){pack4_fp8c(v0l * gate4(p.a0.x) * s, MG8_SCALE), pack4_fp8c(v0h * gate4(p.a0.y) * s, MG8_SCALE)};
            *(u32x2*)(o + 128) = (u32x2){pack4_fp8c(v1l * gate4(p.a1.x) * s, MG8_SCALE), pack4_fp8c(v1h * gate4(p.a1.y) * s, MG8_SCALE)};
        }
    }
    __device__ __forceinline__ void apply(const Unit&, int, int, const Pre&, const UState&, f32x4, f32x4, f32x4, f32x4) const {}
};
struct SchedMerge2 {
    static constexpr bool GATHER = false;
    const Ctx* c; int l, n_units;
    __device__ void init(const Ctx* cc, int ll) { c = cc; l = ll; n_units = (l == 0 ? 144 : 128) * 4; }
    __device__ bool next(int i, Unit& u) const {
        const int U = deal_xcd(*c, i); if (U >= n_units) return false;
        const int rt = U >> 2; u.pn = U & 3; u.pm = (l == 0) ? rt : ((rt >> 3) * 9 + 1 + (rt & 7));
        u.rows = nullptr; u.nrows = 256; u.aux = l; u.aux2 = 0; u.bperm = 0; u.kind = 0; u.K = 512;
        u.a = wsb(*c, A_MG) + (size_t)u.pm * 256 * 512; u.b = wt(*c, WO_O) + (size_t)u.pn * 256 * 512; return true;
    }
};
struct EpiMerge2 {
    const Ctx* c;
    static constexpr bool PAIR = false; static constexpr bool FP8 = true;
    static constexpr int GROUP = 4; static constexpr bool EARLY = false; static constexpr bool CHAIN = false; static constexpr bool ROWTAB = false; struct Pre {}; struct UState {}; __device__ __forceinline__ void unit_begin(const Unit&, int, UState&) const {} __device__ __forceinline__ void pre(const Unit&, int, int, Pre&) const {}
    __device__ __forceinline__ void apply(const Unit& u, int row, int c8, const Pre&, const UState&, f32x4 v0l, f32x4 v0h, f32x4 v1l, f32x4 v1h) const {
        bf16_t* o = wsb(*c, A_Y1) + (size_t)(u.pm * 256 + row) * 1024 + u.pn * 256; constexpr float sc_ = W8_INV * MG8_INV;
        *(u32x4*)(o + c8) = pack8(v0l * sc_, v0h * sc_); *(u32x4*)(o + 128 + c8) = pack8(v1l * sc_, v1h * sc_);
    }
};

struct T4Raw { u32x2 y[4]; u32x4 h[4]; };
__device__ __forceinline__ void t4_load(const Ctx& c, int l, int R, int lane, T4Raw& d) {
    const bf16_t* yp = wsb(c, A_Y1) + (size_t)R * 1024;
#pragma unroll
    for (int q = 0; q < 4; ++q) d.y[q] = *((const u32x2*)yp + lane + 64 * q);
    if (l == 0) {
#pragma unroll
        for (int q = 0; q < 4; ++q) d.h[q] = *((const u32x4*)res_rd(c, 0, R) + lane + 64 * q);
    } else {
#pragma unroll
        for (int q = 0; q < 4; ++q) { const u32x2 w = *((const u32x2*)hb_row(c, R) + lane + 64 * q); d.h[q].x = w.x; d.h[q].y = w.y; }
    }
}
__device__ __forceinline__ void ph_t4_router(const Ctx& c, int l) {
    LAS bf16_t* wr = (LAS bf16_t*)c.lds; constexpr int WRP = 1032;
    {
        const GAS unsigned char* src = c.ws + WS_W + (size_t)WO_R * 2;
#pragma unroll
        for (int q = 0; q < 16; ++q) { const int e = c.wave * 8 + (q >> 1), hf = q & 1, m_ = e & 31;
            const int ex = (e & 32) + ((m_ >> 2) & 1) * 16 + (m_ >> 3) * 4 + (m_ & 3);
            __builtin_amdgcn_global_load_lds((const GAS unsigned*)(src + (size_t)ex * 2048 + hf * 1024 + c.lane * 16), (LAS unsigned*)((LAS unsigned char*)wr + e * (WRP * 2) + hf * 1024), 16, 0, 0); }
    }
    LAS unsigned* hist = (LAS unsigned*)(c.lds + 64 * WRP * 2 + c.wave * 512);
    LAS unsigned* stash = (LAS unsigned*)(c.lds + 64 * WRP * 2 + 4096 + c.wave * 2048);
    LAS float* brl = (LAS float*)(c.lds + 64 * WRP * 2 + 4096 + 8 * 2048);
    static_assert(64 * WRP * 2 + 4096 + 8 * 2048 + 256 <= LDS_MISC, "router LDS map");
    if (c.tid < 64) brl[c.tid] = INP(c, I_BROUTER)[l * 64 + c.tid];
    LAS unsigned* wgh = (LAS unsigned*)(c.lds + 64 * WRP * 2 + 4096 + 8 * 2048 + 256);
    LAS unsigned* wgb = wgh + 64;
    static_assert(64 * WRP * 2 + 4096 + 8 * 2048 + 768 <= LDS_MISC && NCHUNK == 1, "router LDS map (workgroup-level position allocation assumes one token chunk)");
    if (c.tid < 64) wgh[c.tid] = 0u;
    const int r32 = c.lane & 31, hi = c.lane >> 5;
    unsigned* CNT = (unsigned*)(c.ws + CTL_CNT);
    const int NGV = (l == 0) ? NR / 32 : NB * (SEQ / 32);
#define T4_GROUP(q) ((l == 0) ? (q) : (((q) >> 6) * 72 + 8 + ((q) & 63)))
    const int gq0 = (c.blk * NGV) / c.G, ngrp = ((c.blk + 1) * NGV) / c.G - gq0;
    {
        const int nrow = ngrp * 32;
#define T4_ROW(j) (T4_GROUP(gq0 + ((j) >> 5)) * 32 + ((j) & 31))
        T4Raw ra, rb, rc; f32x4 h[4], am[4], mul[4], add[4]; int key = -1;
#pragma unroll
        for (int q = 0; q < 4; ++q) { ra.y[q] = (u32x2){0u, 0u}; ra.h[q] = (u32x4){0u, 0u, 0u, 0u}; rb.y[q] = ra.y[q]; rb.h[q] = ra.h[q]; rc.y[q] = ra.y[q]; rc.h[q] = ra.h[q]; }
        int j = c.wave;
        if (j < nrow) t4_load(c, l, T4_ROW(j), c.lane, ra);
        if (j + 8 < nrow) t4_load(c, l, T4_ROW(j + 8), c.lane, rb);
#pragma unroll 1
        for (; j < nrow; j += 8) { const int R = T4_ROW(j);
            if (j + 16 < nrow) t4_load(c, l, T4_ROW(j + 16), c.lane, rc);
            f32x4 y[4];
#pragma unroll
            for (int q = 0; q < 4; ++q) { y[q] = (f32x4){bflo(ra.y[q].x), bfhi(ra.y[q].x), bflo(ra.y[q].y), bfhi(ra.y[q].y)};
                if (l == 0) h[q] = __builtin_bit_cast(f32x4, ra.h[q]);
                else h[q] = (f32x4){bflo(ra.h[q].x), bfhi(ra.h[q].x), bflo(ra.h[q].y), bfhi(ra.h[q].y)}; }
            if (batch_key(R) != key) { key = batch_key(R); const float* g1 = INP(c, I_GPOSTMIX) + l * DM; const float* m2 = modvec(c, l, R, 2);
#pragma unroll
                for (int q = 0; q < 4; ++q) { const int o = c.lane + 64 * q; am[q] = *((const f32x4*)m2 + o) * *((const f32x4*)g1 + o); }
                mod_fold(c, INP(c, I_GPREFFN) + l * DM, l, R, 3, 4, c.lane, mul, add); }
            const float rs1 = 1.f / sqrtf(row_sumsq(y) * (1.f / DM) + EPSN);
#pragma unroll
            for (int q = 0; q < 4; ++q) h[q] += am[q] * (y[q] * rs1);
            bf16_t* hw = hb_row(c, R);
#pragma unroll
            for (int q = 0; q < 4; ++q) { u32x2 w_; w_.x = pk2(h[q].x, h[q].y); w_.y = pk2(h[q].z, h[q].w); *((u32x2*)hw + c.lane + 64 * q) = w_; }
            const float rs2 = 1.f / sqrtf(row_sumsq(h) * (1.f / DM) + EPSN);
            { bf16_t* orow = wsb(c, A_FXR) + (size_t)R * DM; unsigned char* o8 = (unsigned char*)(c.ws + A_HX) + (size_t)R * DM;
#pragma unroll
              for (int q = 0; q < 4; ++q) { const f32x4 yy = (h[q] * rs2) * mul[q] + add[q]; u32x2 w_; w_.x = pk2(yy.x, yy.y); w_.y = pk2(yy.z, yy.w); *((u32x2*)orow + c.lane + 64 * q) = w_;
                  *((unsigned*)o8 + c.lane + 64 * q) = pack4_fp8c(yy, 1.f); } }
#pragma unroll
            for (int q = 0; q < 4; ++q) { ra.y[q] = rb.y[q]; ra.h[q] = rb.h[q]; rb.y[q] = rc.y[q]; rb.h[q] = rc.h[q]; }
        }
#undef T4_ROW
    }
    asm volatile("s_waitcnt vmcnt(0)" ::: "memory");
    __syncthreads();
#define T4SLOT(i) (((volatile LAS unsigned long long*)(c.lds + LDS_MISC + 128))[i])
    if (TMASK & 4096) T4SLOT(65) = __builtin_amdgcn_s_memrealtime();
    int ei[8]; float ew[8]; unsigned rk[8]; float wn = 0.f; int R = 0;
#pragma unroll
    for (int k = 0; k < 8; ++k) { ei[k] = 0; ew[k] = 0.f; rk[k] = 0u; }
    if (c.wave < ngrp) {
        const int R0 = T4_GROUP(gq0 + c.wave) * 32;
#undef T4_GROUP
        typedef float f32x16 __attribute__((ext_vector_type(16)));
        f32x16 a0 = {}, a1 = {};
        const bf16_t* fxp = wsb(c, A_FXR) + (size_t)(R0 + r32) * 1024 + hi * 8;
        bf16x8 fb[2][16];
#pragma unroll
        for (int i = 0; i < 16; ++i) fb[0][i] = *(const bf16x8*)(fxp + i * 16);
#pragma unroll
        for (int bt = 0; bt < 4; ++bt) {
            if (bt + 1 < 4) {
#pragma unroll
                for (int i = 0; i < 16; ++i) fb[(bt + 1) & 1][i] = *(const bf16x8*)(fxp + ((bt + 1) * 16 + i) * 16); }
#pragma unroll
            for (int i = 0; i < 16; ++i) { const int s = bt * 16 + i;
                const bf16x8 w0 = *(const LAS bf16x8*)(wr + r32 * WRP + s * 16 + hi * 8), w1 = *(const LAS bf16x8*)(wr + (32 + r32) * WRP + s * 16 + hi * 8);
                a0 = __builtin_amdgcn_mfma_f32_32x32x16_bf16(w0, fb[bt & 1][i], a0, 0, 0, 0); a1 = __builtin_amdgcn_mfma_f32_32x32x16_bf16(w1, fb[bt & 1][i], a1, 0, 0, 0); }
        }
        if (TMASK & 8192) { asm volatile("" :: "v"(a0), "v"(a1)); if (c.wave == 0) T4SLOT(42 + l) = __builtin_amdgcn_s_memrealtime() - T4SLOT(65); }
        float sel[32];
        { const LAS float* bl0 = brl + hi * 16; const LAS float* bl1 = brl + 32 + hi * 16;
#pragma unroll
          for (int i = 0; i < 16; ++i) { sel[i] = sigmoidf_(a0[i]) + bl0[i]; sel[16 + i] = sigmoidf_(a1[i]) + bl1[i]; } }
        float gsm[4], gso[4];
#pragma unroll
        for (int G = 0; G < 4; ++G) { float m1 = -INFINITY, m2 = -INFINITY;
#pragma unroll
            for (int q = 0; q < 8; ++q) { const float v = sel[G * 8 + q]; if (v > m1) { m2 = m1; m1 = v; } else if (v > m2) m2 = v; }
            gsm[G] = m1 + m2; }
#pragma unroll
        for (int G = 0; G < 4; ++G) gso[G] = __shfl_xor(gsm[G], 32);
#pragma unroll
        for (int G = 0; G < 4; ++G) { const int gi = (G >> 1) * 4 + 2 * hi + (G & 1); int rank = 0;
#pragma unroll
            for (int q = 0; q < 4; ++q) { const int qm = (q >> 1) * 4 + 2 * hi + (q & 1), qo = (q >> 1) * 4 + 2 * (1 - hi) + (q & 1);
                rank += (gsm[q] > gsm[G] || (gsm[q] == gsm[G] && qm < gi)) ? 1 : 0;
                rank += (gso[q] > gsm[G] || (gso[q] == gsm[G] && qo < gi)) ? 1 : 0; }
#pragma unroll
            for (int q = 0; q < 8; ++q) { const int i = G * 8 + q; const int e = (i < 16) ? hi * 16 + i : 32 + hi * 16 + (i - 16);
                const float key = __builtin_bit_cast(float, (__builtin_bit_cast(unsigned, sel[i]) & ~63u) | (unsigned)(63 - e)); sel[i] = (rank >= 4) ? -1e30f : key; } }
        float wsum = 0.f;
#pragma unroll 1
        for (int k = 0; k < 8; ++k) { float best = sel[0];
#pragma unroll
            for (int e = 1; e < 32; ++e) best = fmaxf(best, sel[e]);
            best = fmaxf(best, __shfl_xor(best, 32));
#pragma unroll
            for (int e = 0; e < 32; ++e) sel[e] = (sel[e] == best) ? -1e30f : sel[e];
            const int bi = 63 - (int)(__builtin_bit_cast(unsigned, best) & 63u); const float bs = best - brl[bi];
            stash[k * 64 + c.lane] = (__builtin_bit_cast(unsigned, bs) & ~63u) | (unsigned)bi; wsum += bs; }
        asm volatile("s_waitcnt lgkmcnt(0)" ::: "memory");
#pragma unroll
        for (int k = 0; k < 8; ++k) { const unsigned w_ = stash[k * 64 + c.lane]; ei[k] = (int)(w_ & 63u); ew[k] = __builtin_bit_cast(float, w_ & ~63u); }
        wn = 2.5f / wsum;
        R = R0 + r32;
        hist[c.lane] = 0u; asm volatile("s_waitcnt lgkmcnt(0)" ::: "memory");
#pragma unroll
        for (int k = 0; k < 8; ++k) { rk[k] = 0u; if (hi == 0) rk[k] = atomicAdd((unsigned*)&hist[ei[k]], 1u); }
        asm volatile("s_waitcnt lgkmcnt(0)" ::: "memory");
        { const unsigned cnt = hist[c.lane]; unsigned off = 0u; if (cnt) off = atomicAdd((unsigned*)&wgh[c.lane], cnt); hist[64 + c.lane] = off; }
        asm volatile("s_waitcnt lgkmcnt(0)" ::: "memory");
    }
    __syncthreads();
    if (c.tid < 64) { const unsigned tot = wgh[c.tid]; unsigned base = 0u; if (tot) base = atomicAdd(CNT + (l * 2) * 128 + c.tid, tot); wgb[c.tid] = base; asm volatile("s_waitcnt vmcnt(0) lgkmcnt(0)" ::: "memory"); }
    __syncthreads();
    if (c.wave < ngrp && hi == 0) {
        unsigned* rt_ = (unsigned*)(c.ws + WS_REGT); float* rw_ = (float*)(c.ws + WS_REGW);
#pragma unroll
        for (int k = 0; k < 8; ++k) { const unsigned pos = wgb[ei[k]] + hist[64 + ei[k]] + rk[k]; const size_t o = (size_t)ei[k] * CAP + pos;
            rt_[o] = ((unsigned)R << 4) | (unsigned)k; rw_[o] = ew[k] * wn; }
    }
    __syncthreads();
    if (TMASK & 4096) T4SLOT(40 + l) = __builtin_amdgcn_s_memrealtime() - T4SLOT(65);
#undef T4SLOT
}

struct MoeTab { LAS int* tstart; int TR, nsh, ch, l; };
__device__ __forceinline__ MoeTab moe_table(const Ctx& c, int l, int ch) {
    MoeTab T; T.tstart = (LAS int*)(c.lds + LDS_RING + 1024 + ch * 4096); T.ch = ch; T.l = l;
    LAS int* tile_e = (LAS int*)(c.lds + LDS_RING + 2048 + ch * 4096);
    __syncthreads();
    if (c.tid < 64) {
        unsigned* CNT = (unsigned*)(c.ws + CTL_CNT) + (l * 2 + ch) * 128;
        const int n = (int)__hip_atomic_load(CNT + c.tid, __ATOMIC_RELAXED, __HIP_MEMORY_SCOPE_AGENT); const int tiles = (n + 255) >> 8;
        int x = tiles;
#pragma unroll
        for (int d = 1; d < 64; d <<= 1) { const int y = __shfl_up(x, d); if (c.tid >= d) x += y; }
        T.tstart[c.tid] = x - tiles; T.tstart[65 + c.tid] = n; if (c.tid == 63) T.tstart[64] = x; }
    __syncthreads();
    T.TR = T.tstart[64]; T.nsh = (l == 0) ? CHROWS / 256 : (NB / NCHUNK) * SEQ / 256;
    for (int t = c.tid; t < T.TR; t += 512) { int lo = 0;
#pragma unroll 1
        for (int st = 32; st >= 1; st >>= 1) { const int q = lo + st; if (q < 64 && T.tstart[q] <= t) lo = q; }
        tile_e[t] = lo; }
    __syncthreads();
    return T;
}
__device__ __forceinline__ void moe_tile(const Ctx& c, const MoeTab& T, int t, int& e, int& j, int& nrows, const unsigned*& rows, int& pm_sh) {
    if (t < T.TR) { e = ((LAS int*)(c.lds + LDS_RING + 2048 + T.ch * 4096))[t]; j = t - T.tstart[e]; const int n = T.tstart[65 + e]; nrows = min(256, n - 256 * j);
        rows = (const unsigned*)(c.ws + WS_REGT) + ((size_t)T.ch * 64 + e) * CAP + 256 * j; pm_sh = 0; }
    else { const int s = t - T.TR; e = 64; j = s; nrows = 256; rows = nullptr;
        const int bl = (T.l == 0) ? s / 9 : s / 8, r9 = (T.l == 0) ? s % 9 : 1 + (s % 8); pm_sh = (T.ch * (NB / NCHUNK) + bl) * 9 + r9; }
}
struct SchedGU {
    static constexpr bool GATHER = true;
    const Ctx* c; MoeTab T0, T1;
    __device__ bool next(int i, Unit& u) const {
        const int L = deal_xcd(*c, i); int t = L >> 1; const int n0 = T0.TR + T0.nsh;
        const bool second = t >= n0; if (second) t -= n0;
        const MoeTab& T = second ? T1 : T0;
        if (t >= T.TR + T.nsh) return false;
        int e, j, nrows, pm_sh; const unsigned* rows; moe_tile(*c, T, t, e, j, nrows, rows, pm_sh);
        u.pn = L & 1; u.pm = T.ch * ACT_TILES + t; u.kind = (e < 64) ? 0 : 1; u.bperm = 0; u.K = 512  ; u.rows = rows; u.nrows = nrows; u.aux = e; u.aux2 = T.ch * CHROWS + CTXL;
        u.a = (e < 64) ? wsb(*c, A_HX) : wsb(*c, A_HX) + (size_t)pm_sh * 256 * 512;
        u.b = wt(*c, WO_GU) + (size_t)e * 262144 + (size_t)u.pn * 256 * 512; return true;
    }
};
struct EpiGU {
    const Ctx* c; int ch;
    static constexpr bool PAIR = true; static constexpr bool FP8 = true;
    static constexpr int GROUP = 4; static constexpr bool EARLY = false; static constexpr bool CHAIN = false; static constexpr bool ROWTAB = false; struct Pre { float w; };
    struct UState {}; __device__ __forceinline__ void unit_begin(const Unit&, int, UState&) const {}
    __device__ __forceinline__ void pre(const Unit& u, int row, int c8, Pre& p) const {
        p.w = 1.f;
        if (u.kind == 0) { p.w = 0.f; if (row < u.nrows) p.w = ((const float*)(c->ws + WS_REGW))[(u.rows - (const unsigned*)(c->ws + WS_REGT)) + row]; }
    }
    __device__ __forceinline__ u32x2 act8(const Pre& p, f32x4 gl, f32x4 gh, f32x4 ul, f32x4 uh) const {
        const float w = p.w * W8_INV; gl *= W8_INV; gh *= W8_INV;
#pragma unroll
        for (int i = 0; i < 4; ++i) { gl[i] = gl[i] * sigmoidf_(gl[i]) * ul[i] * w; gh[i] = gh[i] * sigmoidf_(gh[i]) * uh[i] * w; }
        return (u32x2){pack4_fp8c(gl, ACT8_SCALE), pack4_fp8c(gh, ACT8_SCALE)};
    }
    __device__ __forceinline__ void apply2(const Unit& u, int rowA, int rowB, int c8, const Pre& pA, const Pre& pB, const UState&, f32x4 gAl, f32x4 gAh, f32x4 uAl, f32x4 uAh, f32x4 gBl, f32x4 gBh, f32x4 uBl, f32x4 uBh) const {
        u32x2 a = act8(pA, gAl, gAh, uAl, uAh), b = act8(pB, gBl, gBh, uBl, uBh);
        { auto r = __builtin_amdgcn_permlane16_swap(a.x, b.x, false, false); a.x = r[0]; b.x = r[1]; }
        { auto r = __builtin_amdgcn_permlane16_swap(a.y, b.y, false, false); a.y = r[0]; b.y = r[1]; }
        const bool odd = (c8 >> 3) & 1;
        const int row = odd ? rowB : rowA, col = odd ? c8 - 8 : c8;
        *(u32x4*)((unsigned char*)(c->ws + A_ACT) + ((size_t)u.pm * 256 + row) * 256 + u.pn * 128 + col) = (u32x4){a.x, a.y, b.x, b.y};
    }
    __device__ __forceinline__ void apply(const Unit& u, int row, int c8, const Pre& p, const UState&, f32x4 gl, f32x4 gh, f32x4 ul, f32x4 uh) const {
        const float w = p.w * W8_INV;
        gl *= W8_INV; gh *= W8_INV;
#pragma unroll
        for (int i = 0; i < 4; ++i) { gl[i] = gl[i] * sigmoidf_(gl[i]) * ul[i] * w; gh[i] = gh[i] * sigmoidf_(gh[i]) * uh[i] * w; }
#pragma unroll
        for (int i = 0; i < 4; ++i) { gl[i] = __builtin_amdgcn_fmed3f(gl[i] * ACT8_SCALE, -448.f, 448.f); gh[i] = __builtin_amdgcn_fmed3f(gh[i] * ACT8_SCALE, -448.f, 448.f); }
        *(u32x2*)((unsigned char*)(c->ws + A_ACT) + ((size_t)u.pm * 256 + row) * 256 + u.pn * 128 + c8) = (u32x2){pack4_fp8s(gl.x, gl.y, gl.z, gl.w, 1.f), pack4_fp8s(gh.x, gh.y, gh.z, gh.w, 1.f)};
    }
};
struct SchedD {
    static constexpr bool GATHER = false;
    const Ctx* c; MoeTab T;
    __device__ bool next(int i, Unit& u) const {
        const int L = deal_xcd(*c, i); const int t = L >> 2; if (t >= T.TR + T.nsh) return false;
        int e, j, nrows, pm_sh; const unsigned* rows; moe_tile(*c, T, t, e, j, nrows, rows, pm_sh);
        u.pn = L & 3; u.pm = t; u.kind = (e < 64) ? 0 : 1; u.bperm = 2; { int k_ = 128  ; asm volatile("" : "+s"(k_)); u.K = k_; }     u.rows = nullptr; u.nrows = nrows; u.aux = pm_sh;
        u.a = wsb(*c, A_ACT) + (size_t)(T.ch * ACT_TILES + t) * 256 * 128; u.b = wt(*c, WO_D) + (size_t)e * 131072 + (size_t)u.pn * 256 * 128;
        u.aux2 = (e < 64) ? (int)(rows - (const unsigned*)(c->ws + WS_REGT)) : -1;
        return true;
    }
};
struct EpiD {
    const Ctx* c; int ch;
    static constexpr bool PAIR = false; static constexpr bool FP8 = true;
    static constexpr int GROUP = 8; static constexpr bool EARLY = false; static constexpr bool CHAIN = false; static constexpr bool ROWTAB = true; struct Pre { unsigned ent; };
    static constexpr int TAB_OFF = LDS_RING + 12288;
    __device__ __forceinline__ void rowtab_dma(const Unit& u, LAS unsigned char* lds, int wid, int lane, int par) const {
        if (u.kind == 0 && wid < 4)
            __builtin_amdgcn_global_load_lds((const GAS unsigned*)(c->ws + WS_REGT) + (size_t)u.aux2 + wid * 64 + lane, (LAS unsigned*)(lds + TAB_OFF + par * 1024 + wid * 256), 4, 0, 0);
    }
    __device__ __forceinline__ void pre_tab(const Unit& u, int row, LAS unsigned char* lds, int par, Pre& p) const { p.ent = ((const LAS unsigned*)(lds + TAB_OFF + par * 1024))[row]; }
    struct UState {}; __device__ __forceinline__ void unit_begin(const Unit&, int, UState&) const {}
    __device__ __forceinline__ void pre(const Unit& u, int row, int c8, Pre& p) const {
        p.ent = 0u; if (u.kind == 0 && row < u.nrows) p.ent = ((const unsigned*)(c->ws + WS_REGT))[(size_t)u.aux2 + row];
    }
    __device__ __forceinline__ void apply(const Unit& u, int row, int c8, const Pre& p, const UState& us, f32x4 v0l, f32x4 v0h, f32x4 v1l, f32x4 v1h) const {
        if (row >= u.nrows) return;
        size_t slot;
        if (u.kind == 0) { const unsigned ent = p.ent; slot = (size_t)((int)(ent >> 4) - ch * CHROWS) * 9 + (ent & 15u); }
        else slot = (size_t)(u.aux * 256 + row - ch * CHROWS) * 9 + 8;
        unsigned char* o = (unsigned char*)(c->ws + A_Y) + slot * 1024 + u.pn * 256 + 2 * c8;
        constexpr float SC = Y_SCALE * W8_INV * ACT8_INV;
        *(u32x4*)o = (u32x4){pack4_fp8c(v0l, SC), pack4_fp8c(v0h, SC), pack4_fp8c(v1l, SC), pack4_fp8c(v1h, SC)};
    }
};
struct CombRow { u32x4 y[9]; u32x4 h[2]; };
__device__ __forceinline__ void comb_load(const Ctx& c, int rr, int R, CombRow& d) {
    const unsigned char* yp = (const unsigned char*)(c.ws + A_Y) + (size_t)rr * 9 * 1024 + c.lane * 16;
#pragma unroll
    for (int k = 0; k < 9; ++k) d.y[k] = *(const u32x4*)(yp + k * 1024);
    const bf16_t* hp = hb_row(c, R) + c.lane * 16;
    d.h[0] = *(const u32x4*)hp; d.h[1] = *(const u32x4*)(hp + 8);
}
__device__ __forceinline__ void ph_combine(const Ctx& c, int l, int ch) {
    const int gw = c.blk * 8 + c.wave, NGW = c.G * 8;
    const int nv = (l == 0) ? CHROWS : (NB / NCHUNK) * SEQ;
#define COMB_RR(v) ((l == 0) ? (v) : (((v) >> 11) * RPB + CTXL + ((v) & 2047)))
    const int per = (nv + NGW - 1) / NGW, v0 = gw * per, v1 = min(nv, v0 + per);
    CombRow cur, nxt;
    f32x4 am[4], mul[4], add[4]; int key = -1;
    int v = v0;
    if (v < v1) comb_load(c, COMB_RR(v), ch * CHROWS + COMB_RR(v), cur);
    for (; v < v1; ++v) {
        const int rr = COMB_RR(v), R = ch * CHROWS + rr;
        const int v2 = v + 1;
        if (v2 < v1) comb_load(c, COMB_RR(v2), ch * CHROWS + COMB_RR(v2), nxt);
        if (batch_key(R) != key) { key = batch_key(R);
            const float* g = INP(c, I_GPOSTFFN) + l * DM + c.lane * 16; const float* m5 = modvec(c, l, R, 5) + c.lane * 16;
#pragma unroll
            for (int j = 0; j < 4; ++j) am[j] = *((const f32x4*)m5 + j) * *((const f32x4*)g + j);
            if (l == 0) { const float* g2 = INP(c, I_GPREMIX) + 1 * DM + c.lane * 16; const float* sh = modvec(c, 1, R, 0) + c.lane * 16; const float* sc = modvec(c, 1, R, 1) + c.lane * 16;
#pragma unroll
                for (int j = 0; j < 4; ++j) { mul[j] = *((const f32x4*)g2 + j) * (*((const f32x4*)sc + j) + 1.0f); add[j] = *((const f32x4*)sh + j); } } }
        f32x4 f[4];
#pragma unroll
        for (int j = 0; j < 4; ++j) f[j] = (f32x4){0.f, 0.f, 0.f, 0.f};
#pragma unroll
        for (int k = 0; k < 9; ++k) { f[0] += unpack4_fp8(cur.y[k].x); f[1] += unpack4_fp8(cur.y[k].y); f[2] += unpack4_fp8(cur.y[k].z); f[3] += unpack4_fp8(cur.y[k].w); }
#pragma unroll
        for (int j = 0; j < 4; ++j) f[j] *= Y_INV;
        const float rs = 1.f / sqrtf(row_sumsq(f) * (1.f / DM) + EPSN);
        f32x4 h[4];
        { f32x4 ha, hb2; unpack8(cur.h[0], ha, hb2); h[0] = ha; h[1] = hb2; unpack8(cur.h[1], ha, hb2); h[2] = ha; h[3] = hb2; }
#pragma unroll
        for (int j = 0; j < 4; ++j) h[j] += am[j] * (f[j] * rs);
        LAS unsigned char* rowb = (l == 0) ? c.lds + 131072 + c.wave * 2048 : c.lds + c.wave * 4096;
        static_assert(131072 + 8 * 2048 <= LDS_MISC, "combine row buffers");
        if (l == 0) { *(LAS u32x4*)(rowb + c.lane * 32) = pack8(h[0], h[1]); *(LAS u32x4*)(rowb + c.lane * 32 + 16) = pack8(h[2], h[3]);
            asm volatile("s_waitcnt lgkmcnt(0)" ::: "memory");
            const u32x4 w0 = *(const LAS u32x4*)(rowb + c.lane * 16), w1 = *(const LAS u32x4*)(rowb + 1024 + c.lane * 16);
            unsigned char* hw = (unsigned char*)hb_row(c, R); *(u32x4*)(hw + c.lane * 16) = w0; *(u32x4*)(hw + 1024 + c.lane * 16) = w1; }
        else {
#pragma unroll
            for (int j = 0; j < 4; ++j) *(LAS f32x4*)(rowb + c.lane * 64 + j * 16) = h[j];
            asm volatile("s_waitcnt lgkmcnt(0)" ::: "memory");
            unsigned char* hw = (unsigned char*)out_row(c, R);
#pragma unroll
            for (int j = 0; j < 4; ++j) { const f32x4 w_ = *(const LAS f32x4*)(rowb + j * 1024 + c.lane * 16); *(f32x4*)(hw + j * 1024 + c.lane * 16) = w_; } }
        asm volatile("s_waitcnt lgkmcnt(0)" ::: "memory");
        if (l == 0) { const float rs2 = 1.f / sqrtf(row_sumsq(h) * (1.f / DM) + EPSN);
            f32x4 y[4];
#pragma unroll
            for (int j = 0; j < 4; ++j) y[j] = (h[j] * rs2) * mul[j] + add[j];
            unsigned char* op = (unsigned char*)(c.ws + A_HX) + (size_t)R * DM + c.lane * 16;
            *(u32x4*)op = (u32x4){pack4_fp8c(y[0], 1.f), pack4_fp8c(y[1], 1.f), pack4_fp8c(y[2], 1.f), pack4_fp8c(y[3], 1.f)}; }
        if (v2 < v1) cur = nxt;
    }
#undef COMB_RR
}

__global__ void __launch_bounds__(512, 2) fwd_kernel(Params prm) {
    extern __shared__ __attribute__((aligned(16))) unsigned char lds_raw[];
    Ctx c; c.p = (ParamsK)__builtin_amdgcn_kernarg_segment_ptr(); c.lds = (LAS unsigned char*)lds_raw; c.tid = threadIdx.x; c.lane = c.tid & 63; c.wave = __builtin_amdgcn_readfirstlane(c.tid >> 6);
    c.G = gridDim.x; c.blk = blockIdx.x; c.ws = (GAS unsigned char*)prm.ws; c.z = 0;
    volatile LAS unsigned* MISC = (volatile LAS unsigned*)(c.lds + LDS_MISC);
    if (c.tid < 16) MISC[c.tid] = 0u;
    if (TMASK) { if (c.tid < 160) ((volatile LAS unsigned*)(c.lds + LDS_MISC + 128))[c.tid] = 0u; }
    __syncthreads();
    XcdBarrier bar; bar.bar = (unsigned*)(c.ws + CTL_BAR); bar.x = 0; bar.st = nullptr;
    const int lo = prm.step_lo, hi = prm.step_hi;
    if (hi - lo > 1) bar = xcd_barrier_post((unsigned*)(c.ws + CTL_BAR), MISC + 8);
    int step = 0;
#define TSLOT(i) (((volatile LAS unsigned long long*)((LAS unsigned char*)lds_raw + LDS_MISC + 128))[i])
#define TB(bit) do { if ((TMASK) & (bit)) TSLOT(64) = __builtin_amdgcn_s_memrealtime(); } while (0)
#define TE(bit) do { if ((TMASK) & (bit)) TSLOT(step & 63) = __builtin_amdgcn_s_memrealtime() - TSLOT(64); } while (0)
#define RUN() (step >= lo && step < hi)
#define SEAM() do { if (step >= lo && step + 1 < hi) { XcdBarrier b2_ = bar; asm volatile("" : "+s"(b2_.bar), "+s"(b2_.x)); b2_.bar = (unsigned*)rfl64((unsigned long long)b2_.bar); b2_.x = (unsigned)__builtin_amdgcn_readfirstlane((int)b2_.x); TB(2048); int w_ = c.wave; asm volatile("" : "+s"(w_)); unsigned on_ = ~0u; asm volatile("" : "+s"(on_)); const bool ldr_ = (w_ == 0) && (__builtin_amdgcn_mbcnt_hi(on_, __builtin_amdgcn_mbcnt_lo(on_, 0u)) == 0u); xcd_barrier(b2_, ldr_); TE(2048); } ++step; } while (0)
    { constexpr int l = 0;
        if (RUN()) { TB(1); if (PHM & 1) for (int rep = 0; rep < NREP(1); ++rep) { PHASE_CTX(cl); ph_prologue(cl, l); }  TE(1); }
        SEAM();
        if (l == 0) { if (RUN()) { TB(2); if (PHM & 2) { PHASE_CTX(cl); ph_t1(cl, 0); } } SEAM();  TE(2); }
        if (RUN()) { TB(4); if (PHM & 4) { PHASE_CTX(cl); SchedProj S; S.init(&cl, l); EpiProj E{&cl, l}; GEMM_UNITS(cl, S, E); }  TE(4); }
        SEAM();
        if (RUN()) { TB(8); if (PHM & 8) for (int rep = 0; rep < NREP(8); ++rep) { { PHASE_CTX(cl); SchedUp S; S.init(&cl, l); EpiUp E{&cl, l}; GEMM_UNITS(cl, S, E); } { PHASE_CTX(cl); ph_pool(cl, l); } }  TE(8); }
        SEAM();
        if (RUN()) { TB(16); if (PHM & 16) { { PHASE_CTX(cl); ph_attn_mla(cl, l); } { PHASE_CTX(cl); ph_attn_diff(cl, l); } }  TE(16); }
        SEAM();
        if (RUN()) { TB(32); if (PHM & 32) for (int rep = 0; rep < NREP(32); ++rep) { PHASE_CTX(cl); SchedMerge1 S; S.init(&cl, l); EpiMerge1 E{&cl}; GEMM_UNITS(cl, S, E); }  TE(32); }
        SEAM();
        if (RUN()) { TB(64); if (PHM & 64) for (int rep = 0; rep < NREP(64); ++rep) { PHASE_CTX(cl); SchedMerge2 S; S.init(&cl, l); EpiMerge2 E{&cl}; GEMM_UNITS(cl, S, E); }  TE(64); }
        SEAM();
        if (RUN()) { TB(128); if (PHM & 128) { PHASE_CTX(cl); ph_t4_router(cl, l); }  TE(128); }
        SEAM();
        if (RUN()) { TB(256); if (PHM & 256) for (int rep = 0; rep < NREP(256); ++rep) { PHASE_CTX(cl); SchedGU S; S.c = &cl; S.T0 = moe_table(cl, l, 0); if (NCHUNK > 1) S.T1 = moe_table(cl, l, NCHUNK - 1); else { S.T1 = S.T0; S.T1.TR = 0; S.T1.nsh = 0; } EpiGU E{&cl, 0}; GEMM_UNITS(cl, S, E); }  TE(256); }
        SEAM();
        { constexpr int ch = 0;
            if (RUN()) { TB(512); if (PHM & 512) for (int rep = 0; rep < NREP(512); ++rep) { PHASE_CTX(cl); SchedD S; S.c = &cl; S.T = moe_table(cl, l, ch); EpiD E{&cl, ch}; GEMM_UNITS(cl, S, E); }  TE(512); }
            SEAM();
            if (RUN()) { TB(1024); if (PHM & 1024) { { PHASE_CTX(cl); ph_combine(cl, l, ch); } if (NCHUNK == 1) { PHASE_CTX(cl); ph_prologue(cl, 1); } }  TE(1024); }
            SEAM();

        }
        if constexpr (NCHUNK > 1) { constexpr int ch = 1;
            if (RUN()) { TB(512); if (PHM & 512) for (int rep = 0; rep < NREP(512); ++rep) { PHASE_CTX(cl); SchedD S; S.c = &cl; S.T = moe_table(cl, l, ch); EpiD E{&cl, ch}; GEMM_UNITS(cl, S, E); }  TE(512); }
            SEAM();
            if (RUN()) { TB(1024); if (PHM & 1024) { { PHASE_CTX(cl); ph_combine(cl, l, ch); } { PHASE_CTX(cl); ph_prologue(cl, 1); } }  TE(1024); }
            SEAM();

        }
    }
    { constexpr int l = 1;
        if (l == 0) { if (RUN()) { TB(2); if (PHM & 2) { PHASE_CTX(cl); ph_t1(cl, 0); } } SEAM();  TE(2); }
        if (RUN()) { TB(4); if (PHM & 4) { PHASE_CTX(cl); SchedProj S; S.init(&cl, l); EpiProj E{&cl, l}; GEMM_UNITS(cl, S, E); }  TE(4); }
        SEAM();
        if (RUN()) { TB(8); if (PHM & 8) for (int rep = 0; rep < NREP(8); ++rep) { { PHASE_CTX(cl); SchedUp S; S.init(&cl, l); EpiUp E{&cl, l}; GEMM_UNITS(cl, S, E); } { PHASE_CTX(cl); ph_pool(cl, l); } }  TE(8); }
        SEAM();
        if (RUN()) { TB(16); if (PHM & 16) { { PHASE_CTX(cl); ph_attn_mla(cl, l); } { PHASE_CTX(cl); ph_attn_diff(cl, l); } }  TE(16); }
        SEAM();
        if (RUN()) { TB(32); if (PHM & 32) for (int rep = 0; rep < NREP(32); ++rep) { PHASE_CTX(cl); SchedMerge1 S; S.init(&cl, l); EpiMerge1 E{&cl}; GEMM_UNITS(cl, S, E); }  TE(32); }
        SEAM();
        if (RUN()) { TB(64); if (PHM & 64) for (int rep = 0; rep < NREP(64); ++rep) { PHASE_CTX(cl); SchedMerge2 S; S.init(&cl, l); EpiMerge2 E{&cl}; GEMM_UNITS(cl, S, E); }  TE(64); }
        SEAM();
        if (RUN()) { TB(128); if (PHM & 128) { PHASE_CTX(cl); ph_t4_router(cl, l); }  TE(128); }
        SEAM();
        if (RUN()) { TB(256); if (PHM & 256) for (int rep = 0; rep < NREP(256); ++rep) { PHASE_CTX(cl); SchedGU S; S.c = &cl; S.T0 = moe_table(cl, l, 0); if (NCHUNK > 1) S.T1 = moe_table(cl, l, NCHUNK - 1); else { S.T1 = S.T0; S.T1.TR = 0; S.T1.nsh = 0; } EpiGU E{&cl, 0}; GEMM_UNITS(cl, S, E); }  TE(256); }
        SEAM();
        { constexpr int ch = 0;
            if (RUN()) { TB(512); if (PHM & 512) for (int rep = 0; rep < NREP(512); ++rep) { PHASE_CTX(cl); SchedD S; S.c = &cl; S.T = moe_table(cl, l, ch); EpiD E{&cl, ch}; GEMM_UNITS(cl, S, E); }  TE(512); }
            SEAM();
            if (RUN()) { TB(1024); if (PHM & 1024) { PHASE_CTX(cl); ph_combine(cl, l, ch); }  TE(1024); }
            SEAM();

        }
        if constexpr (NCHUNK > 1) { constexpr int ch = 1;
            if (RUN()) { TB(512); if (PHM & 512) for (int rep = 0; rep < NREP(512); ++rep) { PHASE_CTX(cl); SchedD S; S.c = &cl; S.T = moe_table(cl, l, ch); EpiD E{&cl, ch}; GEMM_UNITS(cl, S, E); }  TE(512); }
            SEAM();
            if (RUN()) { TB(1024); if (PHM & 1024) { PHASE_CTX(cl); ph_combine(cl, l, ch); }  TE(1024); }
            SEAM();

        }
    }
    if (TMASK) { __syncthreads(); if (blockIdx.x == 0) { unsigned long long tacc_ = 0ull; for (int i = 0; i < 64; ++i) tacc_ += TSLOT(i);
        const unsigned long long ts_ = __builtin_amdgcn_s_memrealtime(); while (__builtin_amdgcn_s_memrealtime() - ts_ < tacc_) __builtin_amdgcn_s_sleep(8); } }
#undef RUN
#undef SEAM
}
constexpr int N_STEPS = 2 * (8 + 2 * NCHUNK);

extern "C" void kernel_launch(void* const* d_in, const int* in_sizes, int n_in, void* d_out, int out_size, void* d_ws, size_t ws_size, hipStream_t stream) {
    static int grid = 0;
    if (grid == 0) {
        if (n_in != 34 || out_size != NB * SEQ * DM || ws_size < WS_END) { fprintf(stderr, "kernel_launch: unexpected shapes (n_in %d out %d ws %zu need %zu)\n", n_in, out_size, ws_size, (size_t)WS_END); grid = -1; return; }
        int dev = 0, cus = 0;
        if (hipGetDevice(&dev) != hipSuccess || hipDeviceGetAttribute(&cus, hipDeviceAttributeMultiprocessorCount, dev) != hipSuccess) { grid = -1; return; }
        if (hipFuncSetAttribute((const void*)fwd_kernel, hipFuncAttributeMaxDynamicSharedMemorySize, LDS_BYTES) != hipSuccess) { fprintf(stderr, "kernel_launch: hipFuncSetAttribute failed\n"); grid = -1; return; }
        int per_cu = 0; (void)hipOccupancyMaxActiveBlocksPerMultiprocessor(&per_cu, (const void*)fwd_kernel, 512, LDS_BYTES); (void)hipGetLastError();
        if (per_cu < 1) fprintf(stderr, "kernel_launch: occupancy query says %d\n", per_cu);
        grid = cus;
    }
    if (grid < 0) return;
    (void)hipMemsetAsync((char*)d_ws + WS_CTL, 0, CTL_BYTES, stream);
    Params p{};
    for (int i = 0; i < 34; ++i) p.in[i] = (const float*)d_in[i];
    p.out = (float*)d_out; p.ws = (unsigned char*)d_ws;
#if N_LAUNCH_MODE == 1
    p.step_lo = 0; p.step_hi = N_STEPS;
    hipLaunchKernelGGL(fwd_kernel, dim3(grid), dim3(512), LDS_BYTES, stream, p);
#else
    for (int s = 0; s < N_STEPS; ++s) { p.step_lo = s; p.step_hi = s + 1; hipLaunchKernelGGL(fwd_kernel, dim3(grid), dim3(512), LDS_BYTES, stream, p); }
#endif
}
```

```cpp
#include <hip/hip_runtime.h>
#include <cstdio>
#include <cstdint>
#include <cmath>

#ifndef PHM
#define PHM 0xFFFF
#endif
#ifndef USE_FAST_ATTN
#define USE_FAST_ATTN 1
#endif
#if USE_FAST_ATTN
#define ATTN_PHASE ph_attn_fast
#else
#define ATTN_PHASE ph_attn_naive
#endif
#ifndef REP
#define REP 0
#endif
#define NREP(bit) (((REP) & (bit)) ? 2 : 1)
#ifndef TMASK
#define TMASK 0
#endif
#ifndef ATT_TEST_NODIFF
#define ATT_TEST_NODIFF 0
#endif
#ifndef ATT_TEST_NOMLA
#define ATT_TEST_NOMLA 0
#endif
#ifndef N_LAUNCH_MODE
#define N_LAUNCH_MODE 1
#endif

#define GAS __attribute__((address_space(1)))
#define LAS __attribute__((address_space(3)))
typedef unsigned short bf16_t;
typedef float f32x4 __attribute__((ext_vector_type(4)));
typedef float f32x2 __attribute__((ext_vector_type(2)));
typedef unsigned u32x4 __attribute__((ext_vector_type(4)));
typedef unsigned u32x2 __attribute__((ext_vector_type(2)));
typedef short bf16x8 __attribute__((ext_vector_type(8)));

constexpr int DM = 1024, NB = 16, SEQ = 2048, CTXL = 256, RPB = SEQ + CTXL  ;
constexpr int NR = NB * RPB;
constexpr int NTILE = NR / 256;
constexpr int IN_COLS = 5792, KV_COLS = 1312;
constexpr int NEXP = 64, EFF = 256;
constexpr int NCHUNK = 1, CHROWS = NR / NCHUNK, CAP = CHROWS;
constexpr float EPSN = 1e-6f;
constexpr float LOG2E = 1.4426950408889634f;
constexpr float C2M = 0.10206207261596577f * LOG2E;
constexpr float C2D = 0.125f * LOG2E;

constexpr size_t WO_IN = 0;
constexpr size_t WO_VD = WO_IN + 2304ull * 1024 / 2;
constexpr size_t WO_G  = WO_VD + 512ull * 1024 / 2;
constexpr size_t WO_UK = WO_G + 3072ull * 1024 / 2;
constexpr size_t WO_UV = WO_UK + 512ull * 256;
constexpr size_t WO_UQ = WO_UV + 512ull * 256;
constexpr size_t WO_BM = WO_UQ + 768ull * 384;
constexpr size_t WO_PP = WO_BM + 1024ull * 512 / 2;
constexpr size_t WO_BD = WO_PP + 1024ull * 512 / 2;
constexpr size_t WO_O  = WO_BD + 1024ull * 512 / 2;
constexpr size_t WO_R  = WO_O + 1024ull * 1024 / 2;
constexpr size_t WO_GU = WO_R + 64ull * 1024;
constexpr size_t WO_D  = WO_GU + 65ull * 512 * 1024 / 2;
constexpr size_t W_ELEMS = WO_D + 65ull * 1024 * 256 / 2;

constexpr size_t WS_CTL = 0, CTL_BYTES = 3u << 20;
constexpr size_t CTL_BAR = 16384;
constexpr size_t CTL_CNT = 65536;
constexpr size_t CTL_SSKV = 131072;
constexpr size_t CTL_SSQ = CTL_SSKV + 2ull * NR * 8;
constexpr size_t CTL_MOD = CTL_SSQ + 2ull * NR * 8;
static_assert(CTL_MOD + 2ull * 17 * 6144 * 4 <= CTL_BYTES, "ctl");
constexpr size_t WS_TAB64 = CTL_BYTES;
constexpr size_t WS_TAB32 = WS_TAB64 + 2048ull * 32 * 8;
constexpr size_t WS_W = WS_TAB32 + 2048ull * 16 * 8;
constexpr size_t WS_REGT = WS_W + W_ELEMS * 2;
constexpr size_t WS_REGW = WS_REGT + (size_t)NCHUNK * 64 * CAP * 4;
constexpr size_t WS_ACT0 = WS_REGW + (size_t)NCHUNK * 64 * CAP * 4;
constexpr size_t SZ_ROW2K = (size_t)NR * 2048, SZ_ROW1K = (size_t)NR * 1024;
constexpr size_t A_HB = WS_ACT0;
constexpr size_t A_HX = A_HB + SZ_ROW2K;
constexpr size_t A_PD = A_HX;
constexpr size_t A_VMT = A_HX + SZ_ROW1K;
constexpr size_t A_KD = A_HX + SZ_ROW2K;
constexpr size_t A_VDT = A_KD + SZ_ROW1K;
constexpr size_t A_QD = A_VDT + SZ_ROW1K;
constexpr size_t A_OM = A_QD + SZ_ROW1K;
constexpr size_t A_PL = A_OM + SZ_ROW1K;
constexpr size_t A_CKV = A_PL + SZ_ROW1K;
constexpr size_t A_CQ = A_CKV + (size_t)NR * 512;
constexpr size_t A_KN = A_CQ + (size_t)NR * 768;
constexpr size_t A_KR = A_KN + SZ_ROW1K;
constexpr size_t A_QM = A_KR + (size_t)NR * 64;
constexpr size_t A_MIXEND = A_QM + (size_t)NR * 1536;
static_assert((size_t)NR * 3072 <= (size_t)NB * SEQ * DM * 4, "gates fit in d_out");
constexpr size_t A_MG = A_PL;
constexpr size_t A_Y1 = A_KN;
constexpr size_t A_SCR = A_KD;
static_assert(A_MG + SZ_ROW2K <= A_KN && A_Y1 + SZ_ROW2K <= A_MIXEND && 256ull * 131072 <= 2 * SZ_ROW1K, "overlays");
constexpr int ACT_TILES = (CHROWS * 8) / 256 + 64 + CHROWS / 256;
constexpr size_t A_ACT = A_KD;
constexpr size_t A_Y = A_ACT + (size_t)NCHUNK * ACT_TILES * 256 * 256;
constexpr size_t A_FXR = A_KD;
constexpr size_t A_YEND = (A_Y + (size_t)CHROWS * 9 * 1024) > A_MIXEND ? (A_Y + (size_t)CHROWS * 9 * 1024) : A_MIXEND;
constexpr size_t A_OD8 = A_HX + (size_t)NR * 512;
constexpr size_t WS_END = A_YEND;
static_assert(WS_END <= 684360192ull, "workspace budget");

__device__ __forceinline__ unsigned f2bf(float f) { unsigned u = __builtin_bit_cast(unsigned, f); return (u + 0x7fffu + ((u >> 16) & 1u)) >> 16; }
typedef __bf16 bf16x2_hw __attribute__((ext_vector_type(2)));
__device__ __forceinline__ unsigned pk2(float lo, float hi) { const f32x2 v = {lo, hi}; return __builtin_bit_cast(unsigned, __builtin_convertvector(v, bf16x2_hw)); }
__device__ __forceinline__ float bf2f(unsigned short b) { return __builtin_bit_cast(float, (unsigned)b << 16); }
__device__ __forceinline__ float bflo(unsigned w) { return __builtin_bit_cast(float, w << 16); }
__device__ __forceinline__ float bfhi(unsigned w) { return __builtin_bit_cast(float, w & 0xffff0000u); }
__device__ __forceinline__ u32x4 pack8(f32x4 lo, f32x4 hi) { u32x4 w; w.x = pk2(lo[0], lo[1]); w.y = pk2(lo[2], lo[3]); w.z = pk2(hi[0], hi[1]); w.w = pk2(hi[2], hi[3]); return w; }
__device__ __forceinline__ void unpack8(u32x4 w, f32x4& lo, f32x4& hi) { lo = (f32x4){bflo(w.x), bfhi(w.x), bflo(w.y), bfhi(w.y)}; hi = (f32x4){bflo(w.z), bfhi(w.z), bflo(w.w), bfhi(w.w)}; }
constexpr float Y_SCALE = 16.f, Y_INV = 1.f / 16.f;
constexpr float BR8_SCALE = 8.f, BR8_INV = 0.125f;
constexpr float MG8_SCALE = 4.f, MG8_INV = 0.25f;
constexpr float ACT8_SCALE = 2.f, ACT8_INV = 0.5f;
constexpr float W8_SCALE = 32.f, W8_INV = 1.f / 32.f;
__device__ __forceinline__ unsigned pack4_fp8s(float a, float b, float c_, float d, float sc) { int p = __builtin_amdgcn_cvt_pk_fp8_f32(a * sc, b * sc, 0, false); p = __builtin_amdgcn_cvt_pk_fp8_f32(c_ * sc, d * sc, p, true); return (unsigned)p; }
__device__ __forceinline__ unsigned pack4_fp8c(f32x4 v, float sc) { return pack4_fp8s(__builtin_amdgcn_fmed3f(v.x * sc, -448.f, 448.f), __builtin_amdgcn_fmed3f(v.y * sc, -448.f, 448.f), __builtin_amdgcn_fmed3f(v.z * sc, -448.f, 448.f), __builtin_amdgcn_fmed3f(v.w * sc, -448.f, 448.f), 1.f); }
typedef int i32x4 __attribute__((ext_vector_type(4)));
typedef int i32x8 __attribute__((ext_vector_type(8)));

__device__ __forceinline__ u32x2 pack8_fp8(f32x4 lo, f32x4 hi) {
    u32x2 w; int p = __builtin_amdgcn_cvt_pk_fp8_f32(lo[0] * Y_SCALE, lo[1] * Y_SCALE, 0, false); p = __builtin_amdgcn_cvt_pk_fp8_f32(lo[2] * Y_SCALE, lo[3] * Y_SCALE, p, true); w.x = (unsigned)p;
    p = __builtin_amdgcn_cvt_pk_fp8_f32(hi[0] * Y_SCALE, hi[1] * Y_SCALE, 0, false); p = __builtin_amdgcn_cvt_pk_fp8_f32(hi[2] * Y_SCALE, hi[3] * Y_SCALE, p, true); w.y = (unsigned)p; return w; }
__device__ __forceinline__ f32x4 unpack4_fp8(unsigned w) { const f32x2 a = __builtin_amdgcn_cvt_pk_f32_fp8((int)w, false), b = __builtin_amdgcn_cvt_pk_f32_fp8((int)w, true); return (f32x4){a.x, a.y, b.x, b.y}; }
__device__ __forceinline__ float wave_sum(float v) {
#pragma unroll
    for (int o = 1; o < 64; o <<= 1) v += __shfl_xor(v, o);
    return v;
}
constexpr float SS_SCALE = 16777216.f, SS_INV = 1.f / 16777216.f;
__device__ __forceinline__ void ss_add(unsigned long long* p, float s) { atomicAdd(p, (unsigned long long)(s * SS_SCALE)); }
__device__ __forceinline__ float ss_get(const unsigned long long* p) { return (float)(*p) * SS_INV; }
__device__ __forceinline__ float sigmoidf_(float x) { return __builtin_amdgcn_rcpf(1.f + __builtin_amdgcn_exp2f(x * -LOG2E)); }
__host__ __device__ __forceinline__ int pos2tok(int q) { const int fq = q >> 3, n = (q >> 2) & 1, i = q & 3; return 16 * (fq >> 1) + 4 * (fq & 1) + 8 * n + i; }
__host__ __device__ __forceinline__ int tok2pos(int t) { const int A = t >> 4, n = (t >> 3) & 1, B = (t >> 2) & 1, i = t & 3; return 8 * (2 * A + B) + 4 * n + i; }
__host__ __device__ __forceinline__ int ropedim(int RD, int p) { const int Q = p >> 3, n = (p >> 2) & 1, i = p & 3, P = 4 * Q + i, half = RD / 4; return (P < half ? 0 : RD / 2) + (P % half) + (n ? half : 0); }

#define XB_TMO      128
#define XB_XCNT(j)  (256  + 64 * (j))
#define XB_XSUB(j)  (1280 + 64 * (j))
#define XB_XGEN(j)  (2304 + 64 * (j))
#define XB_TOP      3328
#define XB_TOPGEN   3392
#define XCD_BAR_WORDS 3456
#define XB_SPIN_CAP (1u << 20)
__device__ __forceinline__ unsigned xb_ld(unsigned* p)              { return __hip_atomic_load(p, __ATOMIC_RELAXED, __HIP_MEMORY_SCOPE_AGENT); }
__device__ __forceinline__ unsigned xb_add(unsigned* p, unsigned v) { return __hip_atomic_fetch_add(p, v, __ATOMIC_RELAXED, __HIP_MEMORY_SCOPE_AGENT); }
__device__ __forceinline__ unsigned xb_xcc_id() { return (unsigned)__builtin_amdgcn_s_getreg((3 << 11) | 20) & 0xFu; }
#define XB_SPIN(cond, bar) do { unsigned _sp = 0; while (cond) { __builtin_amdgcn_s_sleep(1); \
    if ((++_sp & 255u) == 0u) { if (xb_ld(&(bar)[XB_TMO])) break; if (_sp > XB_SPIN_CAP) { atomicAdd(&(bar)[XB_TMO], 1u); break; } } } } while (0)
struct XcdBarrier { unsigned* bar; unsigned x; volatile LAS unsigned* st; };
__device__ __forceinline__ XcdBarrier xcd_barrier_post(unsigned* bar, volatile LAS unsigned* st) {
    XcdBarrier b; b.bar = bar; b.x = xb_xcc_id(); b.st = st;
    if (threadIdx.x == 0) (void)xb_add(&bar[XB_XCNT(b.x)], 1u);
    return b;
}
__device__ __forceinline__ void xcd_barrier_complete(unsigned* bar, unsigned x, unsigned& nloc, unsigned& nx) {
    const unsigned G = gridDim.x * gridDim.y * gridDim.z;
    unsigned sum, cnt, mine, sp = 0u;
    for (;;) {
        sum = 0u; cnt = 0u; mine = 0u;
#pragma unroll
        for (unsigned j = 0; j < 16; ++j) { const unsigned c = xb_ld(&bar[XB_XCNT(j)]); sum += c; cnt += (c > 0u) ? 1u : 0u; mine = (j == x) ? c : mine; }
        if (sum == G) break;
        __builtin_amdgcn_s_sleep(1);
        if ((++sp & 255u) == 0u) { if (xb_ld(&bar[XB_TMO])) break; if (sp > XB_SPIN_CAP) { atomicAdd(&bar[XB_TMO], 1u); break; } }
    }
    nloc = mine > 0u ? mine : 1u; nx = cnt > 0u ? cnt : 1u;
}
__device__ __forceinline__ void xcd_barrier(const XcdBarrier& b, bool leader  ) {
    asm volatile("s_waitcnt vmcnt(0)" ::: "memory");
    __syncthreads();
    if (leader) {
        unsigned* bar = b.bar;
        __builtin_amdgcn_s_waitcnt(0);
        unsigned nloc = b.st[0], nx = b.st[1];
        if (nloc == 0u) { xcd_barrier_complete(bar, b.x, nloc, nx); b.st[0] = nloc; b.st[1] = nx; }
        const unsigned old = xb_add(&bar[XB_XSUB(b.x)], 1u);
        const unsigned gen = old / nloc;
        if (old + 1u == (gen + 1u) * nloc) {
            __builtin_amdgcn_fence(__ATOMIC_RELEASE, "agent");
            asm volatile("s_waitcnt vmcnt(0)" ::: "memory");
            const unsigned og = xb_add(&bar[XB_TOP], 1u);
            const unsigned tg = og / nx;
            if (og + 1u == (tg + 1u) * nx) xb_add(&bar[XB_TOPGEN], 1u);
            else XB_SPIN(xb_ld(&bar[XB_TOPGEN]) == tg, bar);
            __builtin_amdgcn_fence(__ATOMIC_ACQUIRE, "agent");
            xb_add(&bar[XB_XGEN(b.x)], 1u);
            asm volatile("s_waitcnt vmcnt(0)" ::: "memory");
        } else {
            XB_SPIN(xb_ld(&bar[XB_XGEN(b.x)]) == gen, bar);
            __builtin_amdgcn_fence(__ATOMIC_ACQUIRE, "agent");
            asm volatile("s_waitcnt vmcnt(0)" ::: "memory");
        }
    }
    __syncthreads();
}

struct Params {
    const float* in[34];
    float* out; unsigned char* ws;
    int step_lo, step_hi;
};
enum { I_X = 0, I_C, I_CTX, I_CCTX, I_WMOD, I_BMOD, I_GPREMIX, I_GPOSTMIX, I_GPREFFN, I_GPOSTFFN, I_WIN, I_GCQ, I_WUQ, I_GCKV, I_WUKV, I_WPOOL, I_PSCALE,
       I_LQ1, I_LK1, I_LQ2, I_LK2, I_GSUBLN, I_WBMLA, I_WBPOOL, I_WBDIFF, I_WOUT, I_WROUTER, I_BROUTER, I_WEGATE, I_WEUP, I_WEDOWN, I_WSGATE, I_WSUP, I_WSDOWN };

typedef const __attribute__((address_space(4))) Params* ParamsK;
struct Ctx {
    ParamsK p;
    LAS unsigned char* lds;
    int tid, lane, wave, G, blk;
    GAS unsigned char* ws;
    size_t z;
};
#define INP(cx, I) ((const float*)((const GAS float*)(cx).p->in[I] + (cx).z))
__device__ __forceinline__ unsigned long long rfl64(unsigned long long v) { return ((unsigned long long)(unsigned)__builtin_amdgcn_readfirstlane((int)(unsigned)(v >> 32)) << 32) | (unsigned)__builtin_amdgcn_readfirstlane((int)(unsigned)v); }
#define PHASE_CTX(cl) Ctx cl = c; asm volatile("" : "+s"(cl.ws), "+s"(cl.z), "+s"(cl.blk), "+s"(cl.G), "+s"(cl.wave)); cl.wave = __builtin_amdgcn_readfirstlane(cl.wave); \
    { unsigned ones_ = ~0u; asm volatile("" : "+s"(ones_)); cl.lane = (int)__builtin_amdgcn_mbcnt_hi(ones_, __builtin_amdgcn_mbcnt_lo(ones_, 0u)); } cl.tid = cl.wave * 64 + cl.lane; \
    cl.blk = __builtin_amdgcn_readfirstlane(cl.blk); cl.G = __builtin_amdgcn_readfirstlane(cl.G); cl.ws = (GAS unsigned char*)rfl64((unsigned long long)cl.ws); cl.z = (size_t)rfl64((unsigned long long)cl.z)
constexpr int LDS_RING = 131072;
constexpr int LDS_BYTES = 163840;
constexpr int LDS_MISC = LDS_BYTES - 1024;

__device__ __forceinline__ bf16_t* wsb(const Ctx& c, size_t off) { return (bf16_t*)(c.ws + off); }
__device__ __forceinline__ bf16_t* wt(const Ctx& c, size_t eoff) { return (bf16_t*)(c.ws + WS_W) + eoff; }

__device__ __forceinline__ const float* res_rd(const Ctx& c, int l, int R) {
    const int b = R / RPB, j = R % RPB;
    if (j < CTXL) return INP(c, I_CTX) + (size_t)(b * CTXL + j) * DM;
    return INP(c, I_X) + (size_t)(b * SEQ + (j - CTXL)) * DM;
}
__device__ __forceinline__ bf16_t* hb_row(const Ctx& c, int R) { return (bf16_t*)(c.ws + A_HB) + (size_t)R * DM; }
__device__ __forceinline__ float* out_row(const Ctx& c, int R) { const int b = R / RPB, j = R % RPB; return c.p->out + (size_t)(b * SEQ + (j - CTXL)) * DM; }
__device__ __forceinline__ void load_res(const Ctx& c, int l, int R, int lane, f32x4 (&v)[4]) {
    if (l == 0) {
#pragma unroll
        for (int j = 0; j < 4; ++j) v[j] = *((const f32x4*)res_rd(c, 0, R) + lane + 64 * j);
    } else {
#pragma unroll
        for (int j = 0; j < 4; ++j) { const u32x2 w = *((const u32x2*)hb_row(c, R) + lane + 64 * j); v[j] = (f32x4){__builtin_bit_cast(float, w.x << 16), __builtin_bit_cast(float, w.x & 0xffff0000u), __builtin_bit_cast(float, w.y << 16), __builtin_bit_cast(float, w.y & 0xffff0000u)}; }
    }
}
__device__ __forceinline__ const float* modvec(const Ctx& c, int l, int R, int which) {
    const int b = R / RPB, j = R % RPB; const int bb = (j < CTXL) ? 16 : b;
    return (const float*)(c.ws + CTL_MOD) + ((size_t)(l * 17 + bb) * 6144 + which * 1024);
}

struct SrcCol { const float* p; int ld; bool ok; };
template <class Map>
__device__ __forceinline__ void cvt_item(const Map& map, const float* kscale, int K, bf16_t* Dst, int nblk_n, LAS float* scr, int item, int lane, bool q8 = false  ) {
    const int kb = item / nblk_n, nb = item % nblk_n, k0 = 64 * kb, n0 = 32 * nb;
    const SrcCol s = map(n0 + (lane & 31));
    float vv[32];
#pragma unroll
    for (int i = 0; i < 32; ++i) { const int kk = 2 * i + (lane >> 5); vv[i] = s.ok ? s.p[(size_t)(k0 + kk) * s.ld] : 0.f; }
#pragma unroll
    for (int i = 0; i < 32; ++i) { const int kk = 2 * i + (lane >> 5); float v = vv[i]; if (kscale) v *= kscale[k0 + kk]; scr[kk * 33 + (lane & 31)] = v; }
    asm volatile("s_waitcnt lgkmcnt(0)" ::: "memory");
    const int cch = lane & 7;
#pragma unroll
    for (int j = 0; j < 4; ++j) { const int n = (lane >> 3) + 8 * j; const LAS float* sp = scr + (8 * cch) * 33 + n;
        if (q8) { u32x2 o8; o8.x = pack4_fp8s(sp[0 * 33], sp[1 * 33], sp[2 * 33], sp[3 * 33], W8_SCALE); o8.y = pack4_fp8s(sp[4 * 33], sp[5 * 33], sp[6 * 33], sp[7 * 33], W8_SCALE);
            *(u32x2*)((unsigned char*)Dst + (size_t)(n0 + n) * K + k0 + 8 * cch) = o8; continue; }
        u32x4 o; o.x = pk2(sp[0 * 33], sp[1 * 33]); o.y = pk2(sp[2 * 33], sp[3 * 33]); o.z = pk2(sp[4 * 33], sp[5 * 33]); o.w = pk2(sp[6 * 33], sp[7 * 33]);
        *(u32x4*)(Dst + (size_t)(n0 + n) * K + k0 + 8 * cch) = o; }
    asm volatile("s_waitcnt lgkmcnt(0)" ::: "memory");
}
struct MapLin { const float* W; int ld; int off; __device__ SrcCol operator()(int n) const { return SrcCol{W + off + n, ld, true}; } };
struct MapWin { const float* W; __device__ SrcCol operator()(int n) const {
    int col; bool ok = true;
    if (n < 512) col = 288 + (n & ~63) + ropedim(64, n & 63);
    else if (n < 1024) { const int m = n - 512; col = KV_COLS + 384 + (m & ~63) + ropedim(64, m & 63); }
    else if (n < 1536) col = KV_COLS + 896 + (n - 1024);
    else if (n < 1792) col = n - 1536;
    else if (n < 2176) col = KV_COLS + (n - 1792);
    else if (n < 2208) col = 256 + ropedim(32, n - 2176);
    else { col = 0; ok = false; }
    return SrcCol{W + col, IN_COLS, ok}; } };
struct MapUkv { const float* W; int voff; __device__ SrcCol operator()(int n) const { return SrcCol{W + (n >> 6) * 128 + voff + (n & 63), 1024, true}; } };
struct MapUq { const float* W; __device__ SrcCol operator()(int n) const { const int h = n / 96, p = n % 96; return SrcCol{W + h * 96 + (p < 64 ? p : 64 + ropedim(32, p - 64)), 768, true}; } };
struct MapGU { const float* Wg; const float* Wu; __device__ SrcCol operator()(int n) const { const int pn = n >> 8, r = n & 255; return SrcCol{(r < 128 ? Wg + pn * 128 + r : Wu + pn * 128 + (r - 128)), 256, true}; } };


struct EItem { const float* p; int ld; bf16_t* dst; int K, k0, n0; bool q8; };
__device__ __forceinline__ EItem eitem_decode(const Ctx& ci, int l, int x, int lane) {
    constexpr int IT10 = 65 * 16 * 16;
    EItem it;
    if (x < IT10) { const int e = x / 256, ri = x % 256, kb = ri / 16, nb = ri % 16; it.k0 = 64 * kb; it.n0 = 32 * nb; it.K = 1024; it.ld = 256;
        const float* wg = (e < 64) ? INP(ci, I_WEGATE) + ((size_t)l * 64 + e) * 262144 : INP(ci, I_WSGATE) + (size_t)l * 262144;
        const float* wu = (e < 64) ? INP(ci, I_WEUP) + ((size_t)l * 64 + e) * 262144 : INP(ci, I_WSUP) + (size_t)l * 262144;
        const int n = it.n0 + (lane & 31), pn = n >> 8, r = n & 255; it.p = (r < 128 ? wg + pn * 128 + r : wu + pn * 128 + (r - 128));
        it.dst = wt(ci, WO_GU) + (size_t)e * 262144; it.q8 = true; }
    else { const int y = x - IT10, e = y / 128, ri = y % 128, kb = ri / 32, nb = ri % 32; it.k0 = 64 * kb; it.n0 = 32 * nb; it.K = 256; it.ld = 1024;
        const float* wd = (e < 64) ? INP(ci, I_WEDOWN) + ((size_t)l * 64 + e) * 262144 : INP(ci, I_WSDOWN) + (size_t)l * 262144;
        it.p = wd + it.n0 + (lane & 31); it.dst = wt(ci, WO_D) + (size_t)e * 131072; it.q8 = true; }
    return it;
}
__device__ __forceinline__ void eitem_load(const EItem& it, int lane, float (&vv)[32]) {
#pragma unroll
    for (int i = 0; i < 32; ++i) { const int kk = 2 * i + (lane >> 5); vv[i] = it.p[(size_t)(it.k0 + kk) * it.ld]; }
}
__device__ __forceinline__ void eitem_finish(const EItem& it, int lane, const float (&vv)[32], LAS float* scr) {
#pragma unroll
    for (int i = 0; i < 32; ++i) { const int kk = 2 * i + (lane >> 5); scr[kk * 33 + (lane & 31)] = vv[i]; }
    asm volatile("s_waitcnt lgkmcnt(0)" ::: "memory");
    const int cch = lane & 7;
#pragma unroll
    for (int j = 0; j < 4; ++j) { const int n = (lane >> 3) + 8 * j; const LAS float* sp = scr + (8 * cch) * 33 + n;
        if (it.q8) { u32x2 o8; o8.x = pack4_fp8s(sp[0 * 33], sp[1 * 33], sp[2 * 33], sp[3 * 33], W8_SCALE); o8.y = pack4_fp8s(sp[4 * 33], sp[5 * 33], sp[6 * 33], sp[7 * 33], W8_SCALE);
            *(u32x2*)((unsigned char*)it.dst + (size_t)(it.n0 + n) * it.K + it.k0 + 8 * cch) = o8; continue; }
        u32x4 o; o.x = pk2(sp[0 * 33], sp[1 * 33]); o.y = pk2(sp[2 * 33], sp[3 * 33]); o.z = pk2(sp[4 * 33], sp[5 * 33]); o.w = pk2(sp[6 * 33], sp[7 * 33]);
        *(u32x4*)(it.dst + (size_t)(it.n0 + n) * it.K + it.k0 + 8 * cch) = o; }
    asm volatile("s_waitcnt lgkmcnt(0)" ::: "memory");
}
__device__ __forceinline__ void ph_prologue(const Ctx& c, int l) {
    LAS float* scr = (LAS float*)(c.lds + c.wave * 16384);
    const int gw = c.blk * 8 + c.wave, NGW = c.G * 8;
    constexpr int IT0 = 72 * 16, IT1 = 16 * 16, IT2 = 96 * 16, IT3 = 16 * 4, IT4 = 16 * 4, IT5 = 24 * 6, IT6 = 32 * 8, IT7 = 32 * 8, IT8 = 32 * 16, IT9 = 2 * 16;
    constexpr int IT10 = 65 * 16 * 16, IT11 = 65 * 32 * 4, IT12 = 4 * 16 * 16;
    constexpr int NIT = IT0 + IT1 + IT2 + IT3 + IT4 + IT5 + IT6 + IT7 + IT8 + IT9 + IT12;
    for (int it = gw; it < NIT; it += NGW) {
        Ctx ci = c; asm volatile("" : "+s"(ci.z)); ci.z = (size_t)rfl64((unsigned long long)ci.z);
        int r = it; const float* w_in = INP(ci, I_WIN) + (size_t)l * DM * IN_COLS;
        if (r < IT0) { cvt_item(MapWin{w_in}, nullptr, 1024, wt(c, WO_IN), 72, scr, r, c.lane, true); continue; } r -= IT0;
        if (r < IT1) { cvt_item(MapLin{w_in, IN_COLS, 800}, nullptr, 1024, wt(c, WO_VD), 16, scr, r, c.lane, true); continue; } r -= IT1;
        if (r < IT2) { cvt_item(MapLin{w_in, IN_COLS, KV_COLS + 1408}, nullptr, 1024, wt(c, WO_G), 96, scr, r, c.lane, true); continue; } r -= IT2;
        if (r < IT3) { cvt_item(MapUkv{INP(ci, I_WUKV) + (size_t)l * 256 * 1024, 0}, INP(ci, I_GCKV) + l * 256, 256, wt(c, WO_UK), 16, scr, r, c.lane); continue; } r -= IT3;
        if (r < IT4) { cvt_item(MapUkv{INP(ci, I_WUKV) + (size_t)l * 256 * 1024, 64}, INP(ci, I_GCKV) + l * 256, 256, wt(c, WO_UV), 16, scr, r, c.lane); continue; } r -= IT4;
        if (r < IT5) { cvt_item(MapUq{INP(ci, I_WUQ) + (size_t)l * 384 * 768}, INP(ci, I_GCQ) + l * 384, 384, wt(c, WO_UQ), 24, scr, r, c.lane); continue; } r -= IT5;
        if (r < IT6) { cvt_item(MapLin{INP(ci, I_WBMLA) + (size_t)l * 512 * 1024, 1024, 0}, nullptr, 512, wt(c, WO_BM), 32, scr, r, c.lane, true); continue; } r -= IT6;
        if (r < IT7) { cvt_item(MapLin{INP(ci, I_WBDIFF) + (size_t)l * 512 * 1024, 1024, 0}, nullptr, 512, wt(c, WO_BD), 32, scr, r, c.lane, true); continue; } r -= IT7;
        if (r < IT8) { cvt_item(MapLin{INP(ci, I_WOUT) + (size_t)l * 1024 * 1024, 1024, 0}, nullptr, 1024, wt(c, WO_O), 32, scr, r, c.lane, true); continue; } r -= IT8;
        if (r < IT9) { cvt_item(MapLin{INP(ci, I_WROUTER) + (size_t)l * 1024 * 64, 64, 0}, nullptr, 1024, wt(c, WO_R), 2, scr, r, c.lane); continue; } r -= IT9;
        {
            const int g = r / 256, cb = (r / 16) % 16, db = r % 16, d = db * 64 + c.lane;
            const float* wp = INP(ci, I_WPOOL) + ((size_t)l * 4 + g) * 16384 + (size_t)(cb * 8) * 128;
            const float* ps = INP(ci, I_PSCALE) + l * 512 + g * 128;
            const float* wb = INP(ci, I_WBPOOL) + (size_t)l * 512 * 1024 + (size_t)(g * 128) * 1024 + d;
            float acc[8];
#pragma unroll
            for (int q = 0; q < 8; ++q) acc[q] = 0.f;
            for (int j = 0; j < 128; ++j) { const float bv = wb[(size_t)j * 1024] * ps[j];
#pragma unroll
                for (int q = 0; q < 8; ++q) acc[q] += wp[q * 128 + j] * bv; }
            *(u32x2*)((unsigned char*)wt(c, WO_PP) + (size_t)d * 512 + g * 128 + cb * 8) = (u32x2){pack4_fp8s(acc[0], acc[1], acc[2], acc[3], W8_SCALE), pack4_fp8s(acc[4], acc[5], acc[6], acc[7], W8_SCALE)};
        }
    }
    {
        constexpr int NE = IT10 + IT11;
        Ctx ci = c; asm volatile("" : "+s"(ci.z)); ci.z = (size_t)rfl64((unsigned long long)ci.z);
        float va[32], vb[32];
        int x = gw;
        EItem cur{}; if (x < NE) { cur = eitem_decode(ci, l, x, c.lane); eitem_load(cur, c.lane, va); }
        for (; x < NE; x += NGW) {
            EItem nxt{}; const bool hn = x + NGW < NE;
            if (hn) { nxt = eitem_decode(ci, l, x + NGW, c.lane); eitem_load(nxt, c.lane, vb); }
            eitem_finish(cur, c.lane, va, scr);
            if (hn) { cur = nxt;
#pragma unroll
                for (int i = 0; i < 32; ++i) va[i] = vb[i]; }
        }
    }
    if (l == 0) {
        const int gt = c.blk * 512 + c.tid, NT = c.G * 512;
        f32x2* t64 = (f32x2*)(c.ws + WS_TAB64); f32x2* t32 = (f32x2*)(c.ws + WS_TAB32);
        for (int i = gt; i < 2048 * 32; i += NT) { const int t = i >> 5, Pp = i & 31; const float pos = (float)(Pp < 16 ? (t >> 6) : (t & 63));
            const float inv = powf(10000.f, -(float)(2 * (Pp & 15)) / 32.f); const float a = pos * inv; t64[i] = (f32x2){cosf(a), sinf(a)}; }
        for (int i = gt; i < 2048 * 16; i += NT) { const int t = i >> 4, Pp = i & 15; const float pos = (float)(Pp < 8 ? (t >> 6) : (t & 63));
            const float inv = powf(10000.f, -(float)(2 * (Pp & 7)) / 16.f); const float a = pos * inv; t32[i] = (f32x2){cosf(a), sinf(a)}; }
        __syncthreads();
        if (c.blk < 192) {
            LAS float* sb = (LAS float*)(c.lds + c.wave * 10240);
            LAS float* part = (LAS float*)(c.lds + 81920);
            const int ll = c.blk / 96, cb = c.blk % 96, col = cb * 64 + c.lane, k0 = c.wave * 128;
#pragma unroll
            for (int qi = 0; qi < 34; ++qi) { const int q = c.lane + 64 * qi; const int b = q >> 7, k = q & 127; const float v = (b < 16) ? INP(c, I_C)[b * 1024 + k0 + k] : INP(c, I_CCTX)[k0 + k]; sb[k * 20 + b] = v / (1.f + __expf(-v)); }
            asm volatile("s_waitcnt lgkmcnt(0)" ::: "memory");
            float acc[17];
#pragma unroll
            for (int b = 0; b < 17; ++b) acc[b] = 0.f;
            const float* wm = INP(c, I_WMOD) + (size_t)ll * 1024 * 6144 + (size_t)k0 * 6144 + col;
#pragma unroll 32
            for (int k = 0; k < 128; ++k) { const float w = wm[(size_t)k * 6144];
#pragma unroll
                for (int b = 0; b < 17; ++b) acc[b] += sb[k * 20 + b] * w; }
#pragma unroll
            for (int b = 0; b < 17; ++b) part[(c.wave * 17 + b) * 64 + c.lane] = acc[b];
            __syncthreads();
            float* MOD = (float*)(c.ws + CTL_MOD);
            for (int q = c.tid; q < 17 * 64; q += 512) { const int b = q >> 6, cc = q & 63; float sum = INP(c, I_BMOD)[ll * 6144 + cb * 64 + cc];
#pragma unroll
                for (int w = 0; w < 8; ++w) sum += part[(w * 17 + b) * 64 + cc];
                MOD[(size_t)(ll * 17 + b) * 6144 + cb * 64 + cc] = sum; }
        }
    }
}

__device__ __forceinline__ void load_row_f32(const float* row, int lane, f32x4 (&v)[4]) {
#pragma unroll
    for (int j = 0; j < 4; ++j) v[j] = *((const f32x4*)row + lane + 64 * j);
}
__device__ __forceinline__ float row_sumsq(const f32x4 (&v)[4]) {
    float s = 0.f;
#pragma unroll
    for (int j = 0; j < 4; ++j) s += (v[j].x * v[j].x + v[j].y * v[j].y) + (v[j].z * v[j].z + v[j].w * v[j].w);
    return wave_sum(s);
}
__device__ __forceinline__ void norm_mod_store(const f32x4 (&v)[4], float rstd, const float* g, const float* shift, const float* scale, bf16_t* orow, int lane) {
#pragma unroll
    for (int j = 0; j < 4; ++j) { const int o = lane + 64 * j; const f32x4 gg = *((const f32x4*)g + o), sh = *((const f32x4*)shift + o), sc = *((const f32x4*)scale + o);
        const f32x4 y = (v[j] * rstd * gg) * (sc + 1.0f) + sh;
        u32x2 w; w.x = pk2(y.x, y.y); w.y = pk2(y.z, y.w); *((u32x2*)orow + o) = w; }
}
__device__ __forceinline__ void mod_fold(const Ctx& c, const float* g, int l, int R, int w_shift, int w_scale, int lane, f32x4 (&mul)[4], f32x4 (&add)[4]) {
    const float* sh = modvec(c, l, R, w_shift); const float* sc = modvec(c, l, R, w_scale);
#pragma unroll
    for (int j = 0; j < 4; ++j) { const int o = lane + 64 * j; mul[j] = *((const f32x4*)g + o) * (*((const f32x4*)sc + o) + 1.0f); add[j] = *((const f32x4*)sh + o); }
}
__device__ __forceinline__ int batch_key(int R) { return (R % RPB) < CTXL ? 16 + 32 * (R / RPB) : R / RPB; }
__device__ __forceinline__ void ph_t1(const Ctx& c, int l) {
    const int gw = c.blk * 8 + c.wave, NGW = c.G * 8;
    const int per = (NR + NGW - 1) / NGW, r0 = gw * per, r1 = min(NR, r0 + per);
    f32x4 v[4], vn[4], vn2[4], mul[4], add[4]; int key = -1;
#pragma unroll
    for (int j = 0; j < 4; ++j) { v[j] = (f32x4){0.f, 0.f, 0.f, 0.f}; vn[j] = v[j]; vn2[j] = v[j]; }
    int R = r0;
    if (R < r1) load_row_f32(res_rd(c, l, R), c.lane, v);
    if (R + 1 < r1) load_row_f32(res_rd(c, l, R + 1), c.lane, vn);
    for (; R < r1; ++R) {
        if (R + 2 < r1) load_row_f32(res_rd(c, l, R + 2), c.lane, vn2);
        if (batch_key(R) != key) { key = batch_key(R); mod_fold(c, INP(c, I_GPREMIX) + l * DM, l, R, 0, 1, c.lane, mul, add); }
        const float rstd = 1.f / sqrtf(row_sumsq(v) * (1.f / DM) + EPSN);
        unsigned char* orow = (unsigned char*)(c.ws + A_HX) + (size_t)R * DM;
#pragma unroll
        for (int j = 0; j < 4; ++j) { const f32x4 y = (v[j] * rstd) * mul[j] + add[j]; *((unsigned*)orow + c.lane + 64 * j) = pack4_fp8c(y, 1.f); }
#pragma unroll
        for (int j = 0; j < 4; ++j) { v[j] = vn[j]; vn[j] = vn2[j]; }
    }
}

struct Unit {
    const bf16_t* a;
    const bf16_t* b;
    const unsigned* rows;
    int K, kind, pm, pn, bperm, nrows, aux, aux2;
};
__device__ __forceinline__ int b_srcrow(int q, int bperm) { return (q & ~31) + (bperm ? pos2tok(q & 31) : (q & 31)); }

template <class Sched, class Epi>
__device__ __forceinline__ void gemm_units_naive(const Ctx& c, const Sched& S, const Epi& E) {
    Unit u;
    for (int i = 0; S.next(i, u); ++i) {
        for (int it = c.tid; it < 256 * 16; it += 512) {
            const int row = it >> 4, c8 = (it & 15) * 8;
            const bf16_t* ar;
            if (u.rows) { const int rr = (row < u.nrows) ? (int)(u.rows[row] >> 4) : u.aux2; ar = u.a + (size_t)rr * u.K; } else ar = u.a + (size_t)row * u.K;
            float acc[16];
#pragma unroll
            for (int q = 0; q < 16; ++q) acc[q] = 0.f;
            const bf16_t* br[16];
#pragma unroll
            for (int q = 0; q < 16; ++q) br[q] = u.b + (size_t)b_srcrow((q < 8 ? c8 + q : 128 + c8 + (q - 8)), u.bperm) * u.K;
            for (int k = 0; k < u.K; k += 8) {
                f32x4 alo, ahi; unpack8(*(const u32x4*)(ar + k), alo, ahi);
#pragma unroll
                for (int q = 0; q < 16; ++q) { f32x4 blo, bhi; unpack8(*(const u32x4*)(br[q] + k), blo, bhi);
                    acc[q] += (alo.x * blo.x + alo.y * blo.y) + (alo.z * blo.z + alo.w * blo.w) + (ahi.x * bhi.x + ahi.y * bhi.y) + (ahi.z * bhi.z + ahi.w * bhi.w); }
            }
            { typename Epi::UState ust_; E.unit_begin(u, c8, ust_); typename Epi::Pre pre_; E.pre(u, row, c8, pre_);
              E.apply(u, row, c8, pre_, ust_, (f32x4){acc[0], acc[1], acc[2], acc[3]}, (f32x4){acc[4], acc[5], acc[6], acc[7]}, (f32x4){acc[8], acc[9], acc[10], acc[11]}, (f32x4){acc[12], acc[13], acc[14], acc[15]}); }
        }
        asm volatile("s_waitcnt vmcnt(0)" ::: "memory");
        __syncthreads();
    }
}

namespace mm {
constexpr int BK = 64, HALF = 128, HTB = HALF * BK * 2;
__device__ __forceinline__ int lds_byte(int r, int c) { const int st = (r >> 4) * 2 + (c >> 5), rr = r & 15, cc = c & 31, ob = rr * 64 + cc * 2; return st * 1024 + (ob ^ (((ob >> 9) & 1) << 5)); }
__device__ __forceinline__ void stage_rc(int b, int& R, int& C) { const int st = b / 1024, sb = b % 1024, swz = sb ^ (((sb >> 9) & 1) << 5); R = (st >> 1) * 16 + swz / 64; C = (st & 1) * 32 + (swz % 64) / 2; }
__device__ __forceinline__ int perm32(int rho) { const int n = rho >> 4, i = rho & 15; return 8 * (i >> 2) + 4 * n + (i & 3); }
__device__ __forceinline__ int permtau(int rho) { const int n = rho >> 4, fq = (rho >> 2) & 3, i = rho & 3; return 16 * (fq >> 1) + 4 * (fq & 1) + 8 * n + i; }
template <bool GATHER> struct LaneOffT { unsigned a0[2], a1[GATHER ? 2 : 1], b[2]; };
template <bool GATHER> __device__ __forceinline__ void lane_offsets(const Unit& u, const GAS unsigned char* ws, int tid, LaneOffT<GATHER>& o) {
    int Rl[2], Cl[2]; asm volatile("" : "+v"(tid));
#pragma unroll
    for (int i = 0; i < 2; ++i) stage_rc(tid * 16 + i * 8192, Rl[i], Cl[i]);
    const unsigned K2 = (unsigned)u.K * 2u; const unsigned ab = (unsigned)((unsigned long long)u.a - (unsigned long long)ws), bb = (unsigned)((unsigned long long)u.b - (unsigned long long)ws);
#pragma unroll
    for (int i = 0; i < 2; ++i) {
        if constexpr (GATHER) {
            if (u.rows) { const int r0 = Rl[i], r1 = 128 + Rl[i];
                const unsigned t0 = (r0 < u.nrows) ? (u.rows[r0] >> 4) : (unsigned)u.aux2, t1 = (r1 < u.nrows) ? (u.rows[r1] >> 4) : (unsigned)u.aux2;
                o.a0[i] = ab + t0 * K2 + (unsigned)Cl[i] * 2u; o.a1[i] = ab + t1 * K2 + (unsigned)Cl[i] * 2u; }
            else { o.a0[i] = ab + (unsigned)Rl[i] * K2 + (unsigned)Cl[i] * 2u; o.a1[i] = o.a0[i] + 128u * K2; }
        } else o.a0[i] = ab + (unsigned)Rl[i] * K2 + (unsigned)Cl[i] * 2u;
        const int rho_ = Rl[i] & 31; const int Rb = (u.bperm == 2) ? (64 * (Rl[i] >> 5) + 16 * ((rho_ >> 2) & 3) + 4 * (rho_ >> 4) + (rho_ & 3)) : ((Rl[i] & ~31) + (u.bperm ? permtau(rho_) : perm32(rho_)));
        o.b[i] = bb + (unsigned)Rb * K2 + (unsigned)Cl[i] * 2u;
    }
}
}

template <class Sched, class Epi>
__device__ __forceinline__ void gemm_units_mfma(const Ctx& c, const Sched& S, const Epi& E) {
    constexpr bool GATHER = Sched::GATHER;
    using namespace mm;
    LAS unsigned char* lds = c.lds;
    const int tid = c.tid, wid = c.wave, lane = c.lane, wr = wid >> 2, wc = wid & 3, fr = lane & 15, fq = lane >> 4;
    const unsigned ldsw = (unsigned)wid * 1024u;
    const int aoff = lds_byte(wr * 64 + fr, fq * 8), boff = lds_byte(wc * 32 + fr, fq * 8);
    const GAS unsigned char* wsb_ = c.ws;
#define MM_SA(b, h) (((b) * 2 + (h)) * HTB)
#define MM_SB(b, h) ((4 + (b) * 2 + (h)) * HTB)
#define MM_STAGE(bufoff, o0, o1, kofs) do { const GAS unsigned char* kb_ = wsb_ + (size_t)(kofs);   \
        __builtin_amdgcn_global_load_lds((const GAS unsigned*)(kb_ + (o0)), (LAS unsigned*)(lds + (bufoff) + ldsw), 16, 0, 0); \
        __builtin_amdgcn_global_load_lds((const GAS unsigned*)(kb_ + (o1)), (LAS unsigned*)(lds + (bufoff) + ldsw + 8192), 16, 0, 0); } while (0)
#define MM_LDA(dst, b, h) do { _Pragma("unroll") for (int m = 0; m < 4; ++m) _Pragma("unroll") for (int k = 0; k < 2; ++k) dst[m][k] = *(const LAS bf16x8*)(lds + MM_SA(b, h) + aoff + m * 2048 + k * 1024); } while (0)
#define MM_LDB(dst, b, h) do { _Pragma("unroll") for (int n = 0; n < 2; ++n) _Pragma("unroll") for (int k = 0; k < 2; ++k) dst[n][k] = *(const LAS bf16x8*)(lds + MM_SB(b, h) + boff + n * 2048 + k * 1024); } while (0)
#define MM_CAT8(x) __builtin_shufflevector(__builtin_bit_cast(i32x4, (x)[0]), __builtin_bit_cast(i32x4, (x)[1]), 0, 1, 2, 3, 4, 5, 6, 7)
#define MM_MMA(ai, bj, At, Bt) do { __builtin_amdgcn_s_setprio(1); \
        if constexpr (Epi::FP8) {   \
            _Pragma("unroll") for (int m = 0; m < 4; ++m) _Pragma("unroll") for (int n = 0; n < 2; ++n) \
                acc[ai][bj][m][n] = __builtin_amdgcn_mfma_scale_f32_16x16x128_f8f6f4(MM_CAT8(Bt[n]), MM_CAT8(At[m]), acc[ai][bj][m][n], 0, 0, 0, 0, 0, 0); \
        } else { _Pragma("unroll") for (int m = 0; m < 4; ++m) _Pragma("unroll") for (int n = 0; n < 2; ++n) _Pragma("unroll") for (int k = 0; k < 2; ++k) \
            acc[ai][bj][m][n] = __builtin_amdgcn_mfma_f32_16x16x32_bf16(Bt[n][k], At[m][k], acc[ai][bj][m][n], 0, 0, 0); } \
        __builtin_amdgcn_s_setprio(0); } while (0)
#define MM_WAIT_V(n) asm volatile("s_waitcnt vmcnt(" #n ")" ::: "memory")
#define MM_WAIT_L(n) asm volatile("s_waitcnt lgkmcnt(" #n ")" ::: "memory")
#define MM_BAR __builtin_amdgcn_s_barrier()
#define MM_SCHED __builtin_amdgcn_sched_barrier(0)
    Unit cur, nxt; int ui = 0;
    if (!S.next(0, cur)) return;
    LaneOffT<GATHER> co; lane_offsets<GATHER>(cur, wsb_, tid, co);
#define MM_A1(i) (GATHER ? co.a1[GATHER ? (i) : 0] : co.a0[i] + hs)
    f32x4 acc[2][2][4][2];
#pragma unroll
    for (int a = 0; a < 2; ++a)
#pragma unroll
        for (int b = 0; b < 2; ++b)
#pragma unroll
            for (int m = 0; m < 4; ++m)
#pragma unroll
                for (int n = 0; n < 2; ++n) acc[a][b][m][n] = (f32x4){0.f, 0.f, 0.f, 0.f};
    bf16x8 At[4][2], B0[2][2], B1[2][2];
    typename Epi::Pre epre_[Epi::EARLY ? Epi::GROUP : 1];
    {
        const unsigned hs = 256u * (unsigned)cur.K, hsb = (cur.bperm == 2 ? 16u : 256u) * (unsigned)cur.K;
        MM_STAGE(MM_SB(0, 0), co.b[0], co.b[1], 0); MM_STAGE(MM_SB(0, 1), co.b[0] + hsb, co.b[1] + hsb, 0); MM_STAGE(MM_SA(0, 0), co.a0[0], co.a0[1], 0); MM_STAGE(MM_SA(0, 1), MM_A1(0), MM_A1(1), 0);
        if (wr == 1) MM_BAR;
        MM_WAIT_V(2); MM_BAR;
        MM_STAGE(MM_SB(1, 0), co.b[0], co.b[1], 128); MM_STAGE(MM_SA(1, 0), co.a0[0], co.a0[1], 128); MM_STAGE(MM_SB(1, 1), co.b[0] + hsb, co.b[1] + hsb, 128);
        MM_WAIT_V(6); MM_BAR;
    }
    for (;;) {
        const bool has_next = S.next(ui + 1, nxt);
        if (!has_next) nxt = cur;
        LaneOffT<GATHER> nco;
        if constexpr (GATHER) lane_offsets<GATHER>(nxt, wsb_, tid, nco);
        const int nt = cur.K / BK; unsigned hs = 256u * (unsigned)cur.K, hsb = (cur.bperm == 2 ? 16u : 256u) * (unsigned)cur.K;
        for (int t = 0; t < nt; t += 2) {
            const bool last = (t == nt - 2);
            const unsigned k1 = (unsigned)(t + 1) * 128u, k2 = last ? 0u : (unsigned)(t + 2) * 128u; unsigned k3 = k2 + 128u;
            asm volatile("" : "+s"(k3)); k3 = (unsigned)__builtin_amdgcn_readfirstlane((int)k3);
            MM_LDB(B0, 0, 0); MM_LDB(B1, 0, 1); MM_SCHED; MM_LDA(At, 0, 0); MM_STAGE(MM_SA(1, 1), MM_A1(0), MM_A1(1), k1);
            MM_WAIT_V(8); MM_WAIT_L(0); MM_BAR; MM_MMA(0, 0, At, B0); MM_MMA(0, 1, At, B1); MM_BAR; MM_SCHED;
            if constexpr (Epi::ROWTAB) { if (last) E.rowtab_dma(cur, lds, wid, lane, ui & 1); }
            if (Epi::EARLY && last) { int c8e_ = wc * 32 + fq * 8; asm volatile("" : "+v"(c8e_));
                _Pragma("unroll") for (int q = 0; q < Epi::GROUP; ++q) { int re_ = (q >> 2) * 128 + wr * 64 + (q & 3) * 16 + fr; asm volatile("" : "+v"(re_)); E.pre(cur, re_, c8e_, epre_[q]); } }
            if (last) { if constexpr (GATHER) co = nco; else lane_offsets<GATHER>(nxt, wsb_, tid, co); hs = 256u * (unsigned)nxt.K; hsb = (nxt.bperm == 2 ? 16u : 256u) * (unsigned)nxt.K; }
            MM_LDA(At, 0, 1); MM_STAGE(MM_SB(0, 0), co.b[0], co.b[1], k2); MM_STAGE(MM_SB(0, 1), co.b[0] + hsb, co.b[1] + hsb, k2); MM_STAGE(MM_SA(0, 0), co.a0[0], co.a0[1], k2);
            MM_WAIT_V(8); MM_WAIT_L(0); MM_BAR; MM_MMA(1, 0, At, B0); MM_MMA(1, 1, At, B1); MM_BAR; MM_SCHED;
            MM_LDB(B0, 1, 0); MM_LDB(B1, 1, 1); MM_SCHED; MM_LDA(At, 1, 0); MM_STAGE(MM_SA(0, 1), MM_A1(0), MM_A1(1), k2);
            MM_WAIT_V(8); MM_WAIT_L(0); MM_BAR; MM_MMA(0, 0, At, B0); MM_MMA(0, 1, At, B1); MM_BAR; MM_SCHED;
            MM_LDA(At, 1, 1); MM_STAGE(MM_SB(1, 0), co.b[0], co.b[1], k3); MM_STAGE(MM_SB(1, 1), co.b[0] + hsb, co.b[1] + hsb, k3); MM_STAGE(MM_SA(1, 0), co.a0[0], co.a0[1], k3);
            MM_WAIT_V(8); MM_WAIT_L(0); MM_BAR; MM_MMA(1, 0, At, B0); MM_MMA(1, 1, At, B1); MM_BAR; MM_SCHED;
        }
        if (wr == 0) MM_BAR;
        typename Epi::UState ust_; E.unit_begin(cur, wc * 32 + fq * 8, ust_); const int par_ = ui & 1;
        constexpr int GRP = Epi::GROUP;
#pragma unroll
        for (int g0 = 0; g0 < 8; g0 += GRP) {
            int rows_[GRP]; typename Epi::Pre pre_[GRP]; int c8_ = wc * 32 + fq * 8; asm volatile("" : "+v"(c8_));
            int frx_ = wr * 64 + fr; asm volatile("" : "+v"(frx_));
#pragma unroll
            for (int q = 0; q < GRP; ++q) { const int ai = (g0 + q) >> 2, m = (g0 + q) & 3; rows_[q] = ai * 128 + m * 16 + frx_; asm volatile("" : "+v"(rows_[q]));
                if (Epi::EARLY && g0 == 0) pre_[q] = epre_[q]; else if constexpr (Epi::ROWTAB) E.pre_tab(cur, rows_[q], lds, par_, pre_[q]); else E.pre(cur, rows_[q], c8_, pre_[q]); }
            MM_SCHED;
            if constexpr (Epi::PAIR) {
#pragma unroll
                for (int q = 0; q < GRP; q += 2) { const int ai = (g0 + q) >> 2, m = (g0 + q) & 3;
                    E.apply2(cur, rows_[q], rows_[q + 1], c8_, pre_[q], pre_[q + 1], ust_, acc[ai][0][m][0], acc[ai][0][m][1], acc[ai][1][m][0], acc[ai][1][m][1],
                             acc[ai][0][m + 1][0], acc[ai][0][m + 1][1], acc[ai][1][m + 1][0], acc[ai][1][m + 1][1]); }
            } else
#pragma unroll
            for (int q = 0; q < GRP; ++q) { const int ai = (g0 + q) >> 2, m = (g0 + q) & 3;
                if constexpr (Epi::CHAIN) E.apply_rw(cur, rows_[q], c8_, pre_[q], ust_, acc[ai][0][m][0], acc[ai][0][m][1], acc[ai][1][m][0], acc[ai][1][m][1]);
                else E.apply(cur, rows_[q], c8_, pre_[q], ust_, acc[ai][0][m][0], acc[ai][0][m][1], acc[ai][1][m][0], acc[ai][1][m][1]); }
            MM_SCHED;
        }
        if (!has_next) break;
        bool keep_ = false; if constexpr (Epi::CHAIN) keep_ = E.keep_acc(cur);
        if (!keep_) {
#pragma unroll
        for (int a = 0; a < 2; ++a)
#pragma unroll
            for (int b = 0; b < 2; ++b)
#pragma unroll
                for (int m = 0; m < 4; ++m)
#pragma unroll
                    for (int n = 0; n < 2; ++n) acc[a][b][m][n] = (f32x4){0.f, 0.f, 0.f, 0.f};
        }
        cur = nxt; ++ui;
        if (wr == 1) MM_BAR;
    }
    MM_WAIT_V(0);
    MM_BAR;
#undef MM_SA
#undef MM_A1
#undef MM_SB
#undef MM_STAGE
#undef MM_LDA
#undef MM_LDB
#undef MM_MMA
#undef MM_CAT8
#undef MM_WAIT_V
#undef MM_WAIT_L
#undef MM_BAR
#undef MM_SCHED
}

#ifndef USE_MFMA_GEMM
#define USE_MFMA_GEMM 1
#endif
#if USE_MFMA_GEMM
#define GEMM_UNITS gemm_units_mfma
#else
#define GEMM_UNITS gemm_units_naive
#endif

__device__ __forceinline__ void rope4(f32x4& lo, f32x4& hi, const f32x2* cs) {
#pragma unroll
    for (int i = 0; i < 4; ++i) { const f32x2 t = cs[i]; const float a = lo[i], b = hi[i]; lo[i] = a * t.x - b * t.y; hi[i] = a * t.y + b * t.x; }
}

__device__ __forceinline__ int deal_xcd(const Ctx& c, int i) { return (c.G == 256) ? ((i * 8 + (c.blk & 7)) * 32 + (c.blk >> 3)) : (i * c.G + c.blk); }
struct SchedProj {
    static constexpr bool GATHER = false;
    const Ctx* c; int l, n_main, n_ctx, n_tot;
    __device__ void init(const Ctx* cc, int ll) { c = cc; l = ll; n_main = 128 * 21; n_ctx = 16 * (l == 0 ? 21 : 4); n_tot = n_main + n_ctx + 288; }
    __device__ bool next(int i, Unit& u) const {
        const int L = (c->G == 256) ? ((i * 8 + (c->blk & 7)) * 32 + (c->blk >> 3)) : (i * c->G + c->blk); if (L >= n_tot) return false;
        u.rows = nullptr; u.nrows = 256; u.aux = l; u.aux2 = 0; u.K = 512;
        if (L < n_main + n_ctx) {
            int pm, pn;
            if (L < n_main) { const int rg = L / 168, q = L % 168; pn = q >> 3; const int lt = rg * 8 + (q & 7); pm = (lt >> 3) * 9 + 1 + (lt & 7); }
            else { const int q = L - n_main; if (l == 0) { pm = (q / 21) * 9; pn = q % 21; } else { pm = (q >> 2) * 9; const int s = q & 3; pn = (s < 2) ? s : (s == 2 ? 6 : 8); } }
            u.pm = pm; u.pn = pn; u.kind = 0; u.bperm = (pn >= 9) ? 2 : 0;
            u.a = wsb(*c, A_HX) + (size_t)pm * 256 * 512; u.b = (pn < 9) ? wt(*c, WO_IN) + (size_t)pn * 256 * 512 : wt(*c, WO_G) + (size_t)(pn - 9) * 256 * 512;
        } else {
            const int q = L - n_main - n_ctx; u.pm = q / 144; u.pn = q % 144; u.kind = 1; u.bperm = 1;
            u.a = wt(*c, WO_VD) + (size_t)u.pm * 256 * 512; u.b = wsb(*c, A_HX) + (size_t)u.pn * 256 * 512;
        }
        return true;
    }
};
struct EpiProj {
    const Ctx* c; int l;
    __device__ __forceinline__ float one(const Unit& u, int R, bool lat, int t, int colp, f32x4 lo, f32x4 hi) const {
        const Ctx& C = *c;
        if (u.pn >= 9) {
            unsigned w0 = 0u, w1 = 0u;
#pragma unroll
            for (int i = 0; i < 4; ++i) { w0 = __builtin_amdgcn_cvt_pk_u8_f32(sigmoidf_(lo[i]) * 255.f, i, w0); w1 = __builtin_amdgcn_cvt_pk_u8_f32(sigmoidf_(hi[i]) * 255.f, i, w1); }
            *(u32x2*)((unsigned char*)C.p->out + (size_t)R * 3072 + (u.pn - 9) * 256 + colp) = (u32x2){w0, w1}; return 0.f; }
        switch (u.pn) {
        case 0: case 1: case 2: case 3: {
            const int col = (u.pn & 1) * 256 + colp;
            if (lat) rope4(lo, hi, (const f32x2*)(C.ws + WS_TAB64) + t * 32 + ((col & 63) >> 3) * 4);
            if (u.pn >= 2) { lo *= C2D; hi *= C2D; }
            *(u32x4*)(wsb(C, u.pn < 2 ? A_KD : A_QD) + (size_t)R * 512 + col) = pack8(lo, hi); break; }
        case 4: case 5: *(u32x4*)(wsb(C, A_PL) + (size_t)R * 512 + (u.pn - 4) * 256 + colp) = pack8(lo, hi); break;
        case 6: { *(u32x4*)(wsb(C, A_CKV) + (size_t)R * 256 + colp) = pack8(lo, hi);
            const float s = (lo.x * lo.x + lo.y * lo.y) + (lo.z * lo.z + lo.w * lo.w) + (hi.x * hi.x + hi.y * hi.y) + (hi.z * hi.z + hi.w * hi.w);
            return s; }
        case 7: { *(u32x4*)(wsb(C, A_CQ) + (size_t)R * 384 + colp) = pack8(lo, hi);
            const float s = (lo.x * lo.x + lo.y * lo.y) + (lo.z * lo.z + lo.w * lo.w) + (hi.x * hi.x + hi.y * hi.y) + (hi.z * hi.z + hi.w * hi.w);
            return s; }
        default: {
            if (colp < 128) { *(u32x4*)(wsb(C, A_CQ) + (size_t)R * 384 + 256 + colp) = pack8(lo, hi);
                const float s = (lo.x * lo.x + lo.y * lo.y) + (lo.z * lo.z + lo.w * lo.w) + (hi.x * hi.x + hi.y * hi.y) + (hi.z * hi.z + hi.w * hi.w);
                return s; }
            else if (colp < 160) { const int p = colp - 128;
                if (lat) rope4(lo, hi, (const f32x2*)(C.ws + WS_TAB32) + t * 16 + (p >> 3) * 4);
                *(u32x4*)(wsb(C, A_KR) + (size_t)R * 32 + p) = pack8(lo, hi); }
            break; }
        }
        return 0.f;
    }
    static constexpr int GROUP = 4; static constexpr bool EARLY = false; static constexpr bool CHAIN = false; static constexpr bool ROWTAB = false; struct Pre {}; struct UState {}; __device__ __forceinline__ void unit_begin(const Unit&, int, UState&) const {} __device__ __forceinline__ void pre(const Unit&, int, int, Pre&) const {}
    static constexpr bool PAIR = false; static constexpr bool FP8 = true;
    __device__ __forceinline__ void apply(const Unit& u, int row, int c8, const Pre&, const UState&, f32x4 v0l, f32x4 v0h, f32x4 v1l, f32x4 v1h) const {
        const Ctx& C = *c;
        v0l *= W8_INV; v0h *= W8_INV; v1l *= W8_INV; v1h *= W8_INV;
        if (u.kind == 1) {
            bf16_t* o = wsb(C, A_VDT) + (size_t)(u.pm * 256 + row) * NR + (size_t)u.pn * 256;
            *(u32x4*)(o + c8) = pack8(v0l, v0h); *(u32x4*)(o + 128 + c8) = pack8(v1l, v1h); return; }
        const int R = u.pm * 256 + row; const bool lat = (u.pm % 9) != 0; const int t = (R % RPB) - CTXL;
        if (u.pn >= 9) {
            u32x4 w = (u32x4){0u, 0u, 0u, 0u};
#pragma unroll
            for (int i = 0; i < 4; ++i) { w.x = __builtin_amdgcn_cvt_pk_u8_f32(sigmoidf_(v0l[i]) * 255.f, i, w.x); w.y = __builtin_amdgcn_cvt_pk_u8_f32(sigmoidf_(v0h[i]) * 255.f, i, w.y);
                                          w.z = __builtin_amdgcn_cvt_pk_u8_f32(sigmoidf_(v1l[i]) * 255.f, i, w.z); w.w = __builtin_amdgcn_cvt_pk_u8_f32(sigmoidf_(v1h[i]) * 255.f, i, w.w); }
            *(u32x4*)((unsigned char*)C.p->out + (size_t)R * 3072 + (u.pn - 9) * 256 + 2 * c8) = w; return; }
        float ssq = one(u, R, lat, t, c8, v0l, v0h) + one(u, R, lat, t, 128 + c8, v1l, v1h);
        if (u.pn >= 6 && u.pn <= 8) {
            ssq += __shfl_xor(ssq, 16); ssq += __shfl_xor(ssq, 32);
            if ((c8 & 24) == 0) ss_add((unsigned long long*)(C.ws + (u.pn == 6 ? CTL_SSKV : CTL_SSQ)) + (size_t)l * NR + R, ssq); }
    }
};

struct SchedUp {
    static constexpr bool GATHER = false;
    const Ctx* c; int l, n_kn, n_vm, n_uq, n_tot;
    __device__ void init(const Ctx* cc, int ll) { c = cc; l = ll; n_kn = 144 * 2; n_vm = 2 * 144; n_uq = (l == 0 ? 144 : 128) * 3; n_tot = n_kn + n_vm + n_uq; }
    __device__ bool next(int i, Unit& u) const {
        const int L = i * c->G + c->blk; if (L >= n_tot) return false;
        u.rows = nullptr; u.nrows = 256; u.aux = l; u.aux2 = 0;
        if (L < n_kn) { u.pm = L >> 1; u.pn = L & 1; u.kind = 0; u.bperm = 0; u.K = 256; u.a = wsb(*c, A_CKV) + (size_t)u.pm * 256 * 256; u.b = wt(*c, WO_UK) + (size_t)u.pn * 256 * 256; }
        else if (L < n_kn + n_vm) { const int q = L - n_kn; u.pm = q / 144; u.pn = q % 144; u.kind = 1; u.bperm = 1; u.K = 256; u.a = wt(*c, WO_UV) + (size_t)u.pm * 256 * 256; u.b = wsb(*c, A_CKV) + (size_t)u.pn * 256 * 256; }
        else { const int q = L - n_kn - n_vm; const int rt = q / 3; u.pn = q % 3; u.pm = (l == 0) ? rt : ((rt >> 3) * 9 + 1 + (rt & 7)); u.kind = 2; u.bperm = 0; u.K = 384;
            u.a = wsb(*c, A_CQ) + (size_t)u.pm * 256 * 384; u.b = wt(*c, WO_UQ) + (size_t)u.pn * 256 * 384; }
        return true;
    }
};
struct EpiUp {
    const Ctx* c; int l;
    static constexpr bool PAIR = false; static constexpr bool FP8 = false;
    struct UState { float rsv[16]; };
    __device__ __forceinline__ float rstd_kv(int R) const { return 1.f / sqrtf(ss_get((const unsigned long long*)(c->ws + CTL_SSKV) + (size_t)l * NR + R) * (1.f / 256.f) + EPSN); }
    static constexpr int GROUP = 4; static constexpr bool EARLY = false; static constexpr bool CHAIN = false; static constexpr bool ROWTAB = false; struct Pre { unsigned long long ss; };
    __device__ __forceinline__ void unit_begin(const Unit& u, int c8, UState& us) const {
#pragma unroll
        for (int i = 0; i < 16; ++i) us.rsv[i] = 0.f;
        if (u.kind == 1) {
#pragma unroll
            for (int h = 0; h < 2; ++h) { const int q0 = h * 128 + c8;
#pragma unroll
                for (int i = 0; i < 8; ++i) us.rsv[h * 8 + i] = rstd_kv(u.pn * 256 + (q0 & ~31) + pos2tok((q0 & 31) + i)); } }
    }
    __device__ __forceinline__ void pre(const Unit& u, int row, int c8, Pre& p) const {
        p.ss = 0ull;
        if (u.kind == 0) p.ss = *((const unsigned long long*)(c->ws + CTL_SSKV) + (size_t)l * NR + u.pm * 256 + row);
        else if (u.kind == 2) p.ss = *((const unsigned long long*)(c->ws + CTL_SSQ) + (size_t)l * NR + u.pm * 256 + row);
    }
    __device__ __forceinline__ void apply(const Unit& u, int row, int c8, const Pre& p, const UState& us, f32x4 v0l, f32x4 v0h, f32x4 v1l, f32x4 v1h) const {
        const Ctx& C = *c;
        if (u.kind == 0) { const int R = u.pm * 256 + row; const float rs = 1.f / sqrtf((float)p.ss * SS_INV * (1.f / 256.f) + EPSN);
            bf16_t* o = wsb(C, A_KN) + (size_t)R * 512 + u.pn * 256;
            *(u32x4*)(o + c8) = pack8(v0l * rs, v0h * rs); *(u32x4*)(o + 128 + c8) = pack8(v1l * rs, v1h * rs); }
        else if (u.kind == 1) {
            bf16_t* o = wsb(C, A_VMT) + (size_t)(u.pm * 256 + row) * NR + (size_t)u.pn * 256;
#pragma unroll
            for (int h = 0; h < 2; ++h) { const int q0 = h * 128 + c8; f32x4 lo = h ? v1l : v0l, hi = h ? v1h : v0h;
#pragma unroll
                for (int i = 0; i < 4; ++i) { lo[i] *= us.rsv[h * 8 + i]; hi[i] *= us.rsv[h * 8 + 4 + i]; }
                *(u32x4*)(o + q0) = pack8(lo, hi); } }
        else { const int R = u.pm * 256 + row; const bool lat = (u.pm % 9) != 0; const int t = (R % RPB) - CTXL;
            const float rs = C2M / sqrtf((float)p.ss * SS_INV * (1.f / 384.f) + EPSN);
#pragma unroll
            for (int h = 0; h < 2; ++h) { const int col = u.pn * 256 + h * 128 + c8; const int pp = col % 96; f32x4 lo = h ? v1l : v0l, hi = h ? v1h : v0h;
                if (lat && pp >= 64) rope4(lo, hi, (const f32x2*)(C.ws + WS_TAB32) + t * 16 + ((pp - 64) >> 3) * 4);
                *(u32x4*)(wsb(C, A_QM) + (size_t)R * 768 + col) = pack8(lo * rs, hi * rs); } }
    }
};
__device__ __forceinline__ void ph_pool(const Ctx& c, int l) {
    LAS bf16_t* tile = (LAS bf16_t*)c.lds;
    const int nitems = 16 * 32 + (l == 0 ? 16 * 4 : 0);
    for (int it = c.G - 1 - c.blk; it < nitems; it += c.G) {
        int b, s0, n, rbase;
        if (it < 512) { b = it >> 5; s0 = (it & 31) * 64; n = SEQ; rbase = b * RPB + CTXL; } else { const int q = it - 512; b = q >> 2; s0 = (q & 3) * 64; n = CTXL; rbase = b * RPB; }
        __syncthreads();
        for (int q = c.tid; q < 80 * 64; q += 512) { const int rr = q >> 6, ch = q & 63; const int t = s0 - 8 + rr;
            u32x4 v = (u32x4){0u, 0u, 0u, 0u}; if (t >= 0 && t < n) v = *(const u32x4*)(wsb(c, A_PL) + (size_t)(rbase + t) * 512 + ch * 8);
            *(LAS u32x4*)(tile + rr * 512 + ch * 8) = v; }
        __syncthreads();
        const int ch = c.tid & 63, g = ch >> 4, w = 2 << g;
        for (int rr = c.tid >> 6; rr < 64; rr += 8) { const int t = s0 + rr; const int lo = max(t - w / 2, 0), hi = min(t + w / 2, n);
            float acc[8];
#pragma unroll
            for (int q = 0; q < 8; ++q) acc[q] = 0.f;
            for (int j = lo; j < hi; ++j) { f32x4 a, bq; unpack8(*(const LAS u32x4*)(tile + (j - s0 + 8) * 512 + ch * 8), a, bq);
                acc[0] += a.x; acc[1] += a.y; acc[2] += a.z; acc[3] += a.w; acc[4] += bq.x; acc[5] += bq.y; acc[6] += bq.z; acc[7] += bq.w; }
            f32x4 xa, xb; unpack8(*(const LAS u32x4*)(tile + (rr + 8) * 512 + ch * 8), xa, xb);
            const float inv = 1.f / (float)(hi - lo);
            const f32x4 oa = (f32x4){acc[0], acc[1], acc[2], acc[3]} * inv - xa, ob = (f32x4){acc[4], acc[5], acc[6], acc[7]} * inv - xb;
            *(u32x2*)((unsigned char*)(c.ws + A_PD) + (size_t)(rbase + t) * 512 + ch * 8) = (u32x2){pack4_fp8c(oa, BR8_SCALE), pack4_fp8c(ob, BR8_SCALE)}; }
    }
    __syncthreads();
}

__device__ __forceinline__ float lam_of(const Ctx& c, int l) {
    float s1 = 0.f, s2 = 0.f;
    for (int i = 0; i < 64; ++i) { s1 += INP(c, I_LQ1)[l * 64 + i] * INP(c, I_LK1)[l * 64 + i]; s2 += INP(c, I_LQ2)[l * 64 + i] * INP(c, I_LK2)[l * 64 + i]; }
    const float lam_init = 0.8f - 0.6f * expf(-0.3f * (float)l);
    return expf(s1) - expf(s2) + lam_init;
}
__device__ __forceinline__ void ph_attn_naive(const Ctx& c, int l) {
    const long gt = (long)c.blk * 512 + c.tid, NT = (long)c.G * 512;
    for (long it = gt; it < (long)NR * 16; it += NT) {
        const int dc = (int)(it & 1), h = (int)((it >> 1) & 7), R = (int)(it >> 4);
        const int b = R / RPB, j = R % RPB; const bool lat = j >= CTXL;
        if (!lat && l != 0) continue;
        const int nk = lat ? RPB : CTXL; const int kb = b * RPB;
        const bf16_t* qp = wsb(c, A_QM) + (size_t)R * 768 + h * 96;
        float m = -INFINITY, ls = 0.f, o[32];
#pragma unroll
        for (int i = 0; i < 32; ++i) o[i] = 0.f;
        for (int k = 0; k < nk; ++k) {
            const int Rk = kb + k; const bf16_t* kp = wsb(c, A_KN) + (size_t)Rk * 512 + h * 64; const bf16_t* rp = wsb(c, A_KR) + (size_t)Rk * 32;
            float s = 0.f;
            for (int i = 0; i < 96; i += 8) { f32x4 qa, qb, ka, kbb; unpack8(*(const u32x4*)(qp + i), qa, qb); unpack8(*(const u32x4*)(i < 64 ? kp + i : rp + (i - 64)), ka, kbb);
                s += (qa.x * ka.x + qa.y * ka.y) + (qa.z * ka.z + qa.w * ka.w) + (qb.x * kbb.x + qb.y * kbb.y) + (qb.z * kbb.z + qb.w * kbb.w); }
            const float mn = fmaxf(m, s), f = exp2f(m - mn), pv = exp2f(s - mn);
            ls = ls * f + pv; m = mn;
            const size_t vcol = (size_t)(Rk & ~31) + tok2pos(Rk & 31);
            const float pb = bf2f((unsigned short)f2bf(pv));
#pragma unroll
            for (int i = 0; i < 32; ++i) o[i] = o[i] * f + pb * bf2f(wsb(c, A_VMT)[(size_t)(h * 64 + dc * 32 + i) * NR + vcol]);
        }
        const float inv = 1.f / ls;
        bf16_t* op = wsb(c, A_OM) + (size_t)R * 512 + h * 64 + dc * 32;
#pragma unroll
        for (int i = 0; i < 32; i += 2) *(unsigned*)(op + i) = pk2(o[i] * inv, o[i + 1] * inv);
    }
    const float lam = lam_of(c, l); const float lam_init = 0.8f - 0.6f * expf(-0.3f * (float)l);
    for (long it = gt; it < (long)NR * 32; it += NT) {
        const int dc = (int)(it & 7), h = (int)((it >> 3) & 3), R = (int)(it >> 5);
        const int b = R / RPB, j = R % RPB; const bool lat = j >= CTXL;
        const bool act = lat || l == 0;
        const int nk = act ? (lat ? RPB : CTXL) : 0; const int kb = b * RPB;
        const bf16_t* qp = wsb(c, A_QD) + (size_t)R * 512 + h * 128;
        float m0 = -INFINITY, m1 = -INFINITY, l0 = 0.f, l1 = 0.f, o0[16], o1[16];
#pragma unroll
        for (int i = 0; i < 16; ++i) { o0[i] = 0.f; o1[i] = 0.f; }
        for (int k = 0; k < nk; ++k) {
            const int Rk = kb + k; const bf16_t* kp = wsb(c, A_KD) + (size_t)Rk * 512 + h * 128;
            float s0 = 0.f, s1 = 0.f;
#pragma unroll 2
            for (int i = 0; i < 64; i += 8) { f32x4 qa, qb, ka, kbb; unpack8(*(const u32x4*)(qp + i), qa, qb); unpack8(*(const u32x4*)(kp + i), ka, kbb);
                s0 += (qa.x * ka.x + qa.y * ka.y) + (qa.z * ka.z + qa.w * ka.w) + (qb.x * kbb.x + qb.y * kbb.y) + (qb.z * kbb.z + qb.w * kbb.w);
                unpack8(*(const u32x4*)(qp + 64 + i), qa, qb); unpack8(*(const u32x4*)(kp + 64 + i), ka, kbb);
                s1 += (qa.x * ka.x + qa.y * ka.y) + (qa.z * ka.z + qa.w * ka.w) + (qb.x * kbb.x + qb.y * kbb.y) + (qb.z * kbb.z + qb.w * kbb.w); }
            const float mn0 = fmaxf(m0, s0), f0 = exp2f(m0 - mn0), p0 = exp2f(s0 - mn0); l0 = l0 * f0 + p0; m0 = mn0;
            const float mn1 = fmaxf(m1, s1), f1 = exp2f(m1 - mn1), p1 = exp2f(s1 - mn1); l1 = l1 * f1 + p1; m1 = mn1;
            const size_t vcol = (size_t)(Rk & ~31) + tok2pos(Rk & 31);
            const float pb0 = bf2f((unsigned short)f2bf(p0)), pb1 = bf2f((unsigned short)f2bf(p1));
#pragma unroll
            for (int i = 0; i < 16; ++i) { const float v = bf2f(wsb(c, A_VDT)[(size_t)(h * 128 + dc * 16 + i) * NR + vcol]); o0[i] = o0[i] * f0 + pb0 * v; o1[i] = o1[i] * f1 + pb1 * v; }
        }
        float ss = 0.f; const float i0 = act ? 1.f / l0 : 0.f, i1 = act ? lam / l1 : 0.f;
#pragma unroll
        for (int i = 0; i < 16; ++i) { o0[i] = o0[i] * i0 - o1[i] * i1; ss += o0[i] * o0[i]; }
        ss += __shfl_xor(ss, 1); ss += __shfl_xor(ss, 2); ss += __shfl_xor(ss, 4);
        const float rs = (1.f - lam_init) / sqrtf(ss * (1.f / 128.f) + EPSN);
        if (act) { bf16_t* op = wsb(c, A_QD) + (size_t)R * 512 + h * 128 + dc * 16; const float* g = INP(c, I_GSUBLN) + l * 128 + dc * 16;
#pragma unroll
            for (int i = 0; i < 16; i += 2) *(unsigned*)(op + i) = pk2(o0[i] * rs * g[i], o0[i + 1] * rs * g[i + 1]); }
    }
}


typedef float f32x16 __attribute__((ext_vector_type(16)));
template <bool DIFF>
__device__ __forceinline__ void attn_unit(const Ctx& c, int l, int b, int h, int q0  , int nk  , float lam, float lam_init) {
    constexpr int DQ = DIFF ? 64 : 96, DV = DIFF ? 128 : 64, NCK = DIFF ? 16 : 12  , KB = NCK * 1024, VB = 8 * DV * 16, SLOT = KB + VB;
    constexpr int NDS = DQ / 16, NDB = DV / 32;
    static_assert(4 * SLOT + 8 * 512 + (DIFF ? 0 : 32768) <= LDS_MISC && (!DIFF || 65536 <= 4 * SLOT), "attention LDS map");
    LAS unsigned char* lds = c.lds;
    const int lane = c.lane, wid = c.wave, r32 = lane & 31, hi = lane >> 5;
    const int map = DIFF ? (wid >> 2) : 0, wq = DIFF ? (wid & 3) : wid;
    const int kb = b * RPB, NT = nk / 64;
    LAS float* wsf = (LAS float*)(lds + 4 * SLOT + wid * 512);
    unsigned ko0, ko1, vo0, vo1;
    unsigned kstep0, kstep1, kdb0, kdb1, vdb0, vdb1; bool has_k1;
    if constexpr (DIFF) {
        { const int row = 4 * wid + (lane >> 4), ch = (lane & 15) ^ (row & 15); ko0 = (unsigned)(A_KD + ((size_t)(kb + row) * 512 + h * 128 + ch * 8) * 2); }
        { const int row = 4 * (wid + 8) + (lane >> 4), ch = (lane & 15) ^ (row & 15); ko1 = (unsigned)(A_KD + ((size_t)(kb + row) * 512 + h * 128 + ch * 8) * 2); }
        kstep0 = kstep1 = 64 * 512 * 2; kdb0 = wid * 1024; kdb1 = (wid + 8) * 1024; has_k1 = true;
        { const int d = 8 * wid + (lane >> 3), ch = (lane & 7) ^ ((d >> 1) & 7); vo0 = (unsigned)(A_VDT + ((size_t)(h * 128 + d) * NR + kb + ch * 8) * 2); }
        { const int d = 8 * (wid + 8) + (lane >> 3), ch = (lane & 7) ^ ((d >> 1) & 7); vo1 = (unsigned)(A_VDT + ((size_t)(h * 128 + d) * NR + kb + ch * 8) * 2); }
        vdb0 = KB + wid * 1024; vdb1 = KB + (wid + 8) * 1024;
    } else {
        { const int row = 8 * wid + (lane >> 3), ch = (lane & 7) ^ ((row >> 1) & 7); ko0 = (unsigned)(A_KN + ((size_t)(kb + row) * 512 + h * 64 + ch * 8) * 2); }
        { const int w4 = wid & 3, row = 16 * w4 + (lane >> 2), ch = (lane & 3) ^ ((row >> 2) & 3); ko1 = (unsigned)(A_KR + ((size_t)(kb + row) * 32 + ch * 8) * 2); }
        kstep0 = 64 * 512 * 2; kstep1 = 64 * 32 * 2; kdb0 = wid * 1024; kdb1 = 8192 + (wid & 3) * 1024; has_k1 = wid < 4;
        { const int d = 8 * wid + (lane >> 3), ch = (lane & 7) ^ ((d >> 1) & 7); vo0 = (unsigned)(A_VMT + ((size_t)(h * 64 + d) * NR + kb + ch * 8) * 2); }
        vo1 = vo0; vdb0 = KB + wid * 1024; vdb1 = vdb0;
    }
    const GAS unsigned char* wsg_ = c.ws;
#define AT_DMA(t, slot) do { const unsigned so_ = (unsigned)(slot) * SLOT; \
        __builtin_amdgcn_global_load_lds((const GAS unsigned*)(wsg_ + (size_t)((unsigned)(t) * kstep0) + ko0), (LAS unsigned*)(lds + so_ + kdb0), 16, 0, 0); \
        if (has_k1) __builtin_amdgcn_global_load_lds((const GAS unsigned*)(wsg_ + (size_t)((unsigned)(t) * kstep1) + ko1), (LAS unsigned*)(lds + so_ + kdb1), 16, 0, 0); \
        __builtin_amdgcn_global_load_lds((const GAS unsigned*)(wsg_ + (size_t)((unsigned)(t) * 128u) + vo0), (LAS unsigned*)(lds + so_ + vdb0), 16, 0, 0); \
        if (DIFF) __builtin_amdgcn_global_load_lds((const GAS unsigned*)(wsg_ + (size_t)((unsigned)(t) * 128u) + vo1), (LAS unsigned*)(lds + so_ + vdb1), 16, 0, 0); } while (0)
#define AT_WAIT1() do { if (DIFF) asm volatile("s_waitcnt vmcnt(4)" ::: "memory"); else if (has_k1) asm volatile("s_waitcnt vmcnt(3)" ::: "memory"); else asm volatile("s_waitcnt vmcnt(2)" ::: "memory"); } while (0)
    const int qrow = q0 + wq * 32 + r32;
    const bf16_t* qp = DIFF ? (wsb(c, A_QD) + (size_t)qrow * 512 + h * 128 + map * 64) : (wsb(c, A_QM) + (size_t)qrow * 768 + h * 96);
    bf16x8 qr[NDS];
#pragma unroll
    for (int ds = 0; ds < NDS; ++ds) qr[ds] = *(const bf16x8*)(qp + ds * 16 + hi * 8);
    AT_DMA(0, 0); AT_DMA(1, 1); AT_DMA(2, 2);
    f32x16 o[NDB];
#pragma unroll
    for (int d = 0; d < NDB; ++d) o[d] = f32x16{};
    float mhat = 0.f, lsum = 0.f; f32x16 negm = f32x16{};
    const int kchunk0 = DIFF ? map * 8 : 0;
    const unsigned swk_ = (unsigned)((r32 >> 1) & 7), swr_ = (unsigned)((r32 >> 2) & 3), swd_ = (unsigned)(r32 & 15);
#define AT_KOFF(ds) (DIFF ? ((unsigned)r32 * 256u + ((((unsigned)(kchunk0 + 2 * (ds)) ^ swd_) ^ (unsigned)hi) << 4)) \
                          : ((ds) < 4 ? ((unsigned)r32 * 128u + ((((unsigned)(2 * (ds)) ^ swk_) ^ (unsigned)hi) << 4)) : (8192u + (unsigned)r32 * 64u + ((((unsigned)(2 * ((ds) - 4)) ^ swr_) ^ (unsigned)hi) << 4))))
#define AT_KROW32(ds) (DIFF ? 8192 : ((ds) < 4 ? 4096 : 2048))
#define AT_VOFF(s4) ((unsigned)KB + (unsigned)r32 * 128u + ((((unsigned)(2 * (s4)) ^ swk_) ^ (unsigned)hi) << 4))
#define AT_QK(P0, P1, slot_) do { unsigned kb_ = (unsigned)(slot_) * SLOT; asm volatile("" : "+v"(kb_)); const LAS unsigned char* ks_ = lds + kb_; \
        if (DIFF) { P0 = f32x16{}; P1 = f32x16{}; } else { P0 = negm; P1 = negm; } \
        _Pragma("unroll") for (int ds = 0; ds < NDS; ++ds) { \
            const bf16x8 k0 = *(const LAS bf16x8*)(ks_ + AT_KOFF(ds)); \
            const bf16x8 k1 = *(const LAS bf16x8*)(ks_ + AT_KOFF(ds) + AT_KROW32(ds)); \
            P0 = __builtin_amdgcn_mfma_f32_32x32x16_bf16(k0, qr[ds], P0, 0, 0, 0); \
            P1 = __builtin_amdgcn_mfma_f32_32x32x16_bf16(k1, qr[ds], P1, 0, 0, 0); } } while (0)
#define AT_ROWMAX(RM, P0, P1) do { float a_ = fmaxf(fmaxf(P0[0], P1[0]), P0[1]), b_ = fmaxf(fmaxf(P1[1], P0[2]), P1[2]); \
        _Pragma("unroll") for (int r = 3; r < 15; r += 2) { a_ = fmaxf(fmaxf(a_, P0[r]), P1[r]); b_ = fmaxf(fmaxf(b_, P0[r + 1]), P1[r + 1]); } \
        a_ = fmaxf(fmaxf(a_, P0[15]), P1[15]); RM = fmaxf(a_, b_); RM = fmaxf(RM, __shfl_xor(RM, 32)); } while (0)
    if (DIFF) asm volatile("s_waitcnt vmcnt(8)" ::: "memory"); else if (has_k1) asm volatile("s_waitcnt vmcnt(6)" ::: "memory"); else asm volatile("s_waitcnt vmcnt(4)" ::: "memory");
    asm volatile("s_barrier" ::: "memory");
    f32x16 pA0, pA1, pB0, pB1; float rmA, rmB = 0.f;
    AT_QK(pA0, pA1, 0);
    AT_ROWMAX(rmA, pA0, pA1);
#define SGB(mask, n) __builtin_amdgcn_sched_group_barrier(mask, n, 0)
#define AT_STEP(P0, P1, RM, N0, N1, RMN, t, HN) do { \
          \
        if (HN) { if ((t) + 2 < NT) AT_WAIT1(); else asm volatile("s_waitcnt vmcnt(0)" ::: "memory"); } \
        asm volatile("s_barrier" ::: "memory"); \
        if ((t) + 3 < NT) AT_DMA((t) + 3, ((t) + 3) & 3); \
          \
        const bool first_ = ((t) == 0); \
        const float rrel_ = DIFF ? RM - mhat : RM;        \
        if (first_ || __any(rrel_ > 8.0f)) { \
            const float dl = first_ ? rrel_ : fmaxf(rrel_, 0.f); \
            mhat += dl; \
            if (!DIFF) { _Pragma("unroll") for (int r = 0; r < 16; ++r) { P0[r] -= dl; P1[r] -= dl; negm[r] = -mhat; } } \
            if (!first_) { \
                const float f = __builtin_amdgcn_exp2f(-dl); lsum *= f; \
                { int rq_ = r32; asm volatile("" : "+v"(rq_)); if (hi == 0) wsf[rq_] = f; } \
                asm volatile("s_waitcnt lgkmcnt(0)" ::: "memory"); \
                _Pragma("unroll") for (int r = 0; r < 16; ++r) { const float fr_ = wsf[(r & 3) + 8 * (r >> 2) + 4 * hi]; \
                    _Pragma("unroll") for (int d = 0; d < NDB; ++d) o[d][r] *= fr_; } \
            } \
        } \
        __builtin_amdgcn_sched_barrier(0); \
          \
        unsigned kb_ = (unsigned)(((t) + 1) & 3) * SLOT; asm volatile("" : "+v"(kb_)); const LAS unsigned char* ks_ = lds + kb_; \
        unsigned vb_ = (unsigned)((t) & 3) * SLOT; asm volatile("" : "+v"(vb_)); const LAS unsigned char* vs_ = lds + vb_; \
        bf16x8 kf_[2 * NDS], vf_[4], vg_[4]; \
        if (HN) { _Pragma("unroll") for (int ds = 0; ds < NDS; ++ds) { kf_[2 * ds] = *(const LAS bf16x8*)(ks_ + AT_KOFF(ds)); kf_[2 * ds + 1] = *(const LAS bf16x8*)(ks_ + AT_KOFF(ds) + AT_KROW32(ds)); } } \
        if (HN) { if (DIFF) { N0 = f32x16{}; N1 = f32x16{}; } else { N0 = negm; N1 = negm; } \
            _Pragma("unroll") for (int ds = 0; ds < NDS; ++ds) { \
                N0 = __builtin_amdgcn_mfma_f32_32x32x16_bf16(kf_[2 * ds], qr[ds], N0, 0, 0, 0); \
                N1 = __builtin_amdgcn_mfma_f32_32x32x16_bf16(kf_[2 * ds + 1], qr[ds], N1, 0, 0, 0); } } \
        float sacc = 0.f; \
        _Pragma("unroll") for (int r = 0; r < 16; ++r) { P0[r] = __builtin_amdgcn_exp2f(DIFF ? P0[r] - mhat : P0[r]); P1[r] = __builtin_amdgcn_exp2f(DIFF ? P1[r] - mhat : P1[r]); sacc += P0[r] + P1[r]; } \
        lsum += sacc; \
        bf16x8 pa[4]; \
        { u32x4 w; \
          w.x = pk2(P0[0], P0[1]); w.y = pk2(P0[2], P0[3]); w.z = pk2(P0[4], P0[5]); w.w = pk2(P0[6], P0[7]); pa[0] = __builtin_bit_cast(bf16x8, w); \
          w.x = pk2(P0[8], P0[9]); w.y = pk2(P0[10], P0[11]); w.z = pk2(P0[12], P0[13]); w.w = pk2(P0[14], P0[15]); pa[1] = __builtin_bit_cast(bf16x8, w); \
          w.x = pk2(P1[0], P1[1]); w.y = pk2(P1[2], P1[3]); w.z = pk2(P1[4], P1[5]); w.w = pk2(P1[6], P1[7]); pa[2] = __builtin_bit_cast(bf16x8, w); \
          w.x = pk2(P1[8], P1[9]); w.y = pk2(P1[10], P1[11]); w.z = pk2(P1[12], P1[13]); w.w = pk2(P1[14], P1[15]); pa[3] = __builtin_bit_cast(bf16x8, w); } \
        _Pragma("unroll") for (int s4 = 0; s4 < 4; ++s4) vf_[s4] = *(const LAS bf16x8*)(vs_ + AT_VOFF(s4)); \
        _Pragma("unroll") for (int s4 = 0; s4 < 4; ++s4) vg_[s4] = *(const LAS bf16x8*)(vs_ + AT_VOFF(s4) + 4096); \
        _Pragma("unroll") for (int s4 = 0; s4 < 4; ++s4) o[0] = __builtin_amdgcn_mfma_f32_32x32x16_bf16(pa[s4], vf_[s4], o[0], 0, 0, 0); \
        _Pragma("unroll") for (int s4 = 0; s4 < 4; ++s4) o[1] = __builtin_amdgcn_mfma_f32_32x32x16_bf16(pa[s4], vg_[s4], o[1], 0, 0, 0); \
        if (HN) AT_ROWMAX(RMN, N0, N1); \
          \
        SGB(0x100, (HN ? 2 * NDS : 8)); \
        _Pragma("unroll") for (int i_ = 0; i_ < (HN ? 2 * NDS : 0); ++i_) { SGB(0x008, 1); SGB(0x002, 6); } \
        if (HN) SGB(0x100, 8); \
        SGB(0x002, 64); \
        _Pragma("unroll") for (int i_ = 0; i_ < 8; ++i_) { SGB(0x008, 1); SGB(0x002, 2); } \
        __builtin_amdgcn_sched_barrier(0); \
    } while (0)
#define AT_STEP_D(P0, P1, RM, N0, N1, RMN, t) do { \
          \
        if ((t) + 1 < NT) { if ((t) + 2 < NT) AT_WAIT1(); else asm volatile("s_waitcnt vmcnt(0)" ::: "memory"); } \
        asm volatile("s_barrier" ::: "memory"); \
        if ((t) + 3 < NT) AT_DMA((t) + 3, ((t) + 3) & 3); \
          \
        const bool first_ = ((t) == 0); \
        const float rrel_ = DIFF ? RM - mhat : RM;        \
        if (first_ || __any(rrel_ > 8.0f)) { \
            const float dl = first_ ? rrel_ : fmaxf(rrel_, 0.f); \
            mhat += dl; \
            if (!DIFF) { _Pragma("unroll") for (int r = 0; r < 16; ++r) { P0[r] -= dl; P1[r] -= dl; negm[r] = -mhat; } } \
            if (!first_) { \
                const float f = __builtin_amdgcn_exp2f(-dl); lsum *= f; \
                { int rq_ = r32; asm volatile("" : "+v"(rq_)); if (hi == 0) wsf[rq_] = f; } \
                asm volatile("s_waitcnt lgkmcnt(0)" ::: "memory"); \
                _Pragma("unroll") for (int r = 0; r < 16; ++r) { const float fr_ = wsf[(r & 3) + 8 * (r >> 2) + 4 * hi]; \
                    _Pragma("unroll") for (int d = 0; d < NDB; ++d) o[d][r] *= fr_; } \
            } \
        } \
          \
        if ((t) + 1 < NT) AT_QK(N0, N1, ((t) + 1) & 3); \
        float sacc = 0.f; \
        _Pragma("unroll") for (int r = 0; r < 16; ++r) { P0[r] = __builtin_amdgcn_exp2f(DIFF ? P0[r] - mhat : P0[r]); P1[r] = __builtin_amdgcn_exp2f(DIFF ? P1[r] - mhat : P1[r]); sacc += P0[r] + P1[r]; } \
        lsum += sacc; \
        bf16x8 pa[4]; \
        { u32x4 w; \
          w.x = pk2(P0[0], P0[1]); w.y = pk2(P0[2], P0[3]); w.z = pk2(P0[4], P0[5]); w.w = pk2(P0[6], P0[7]); pa[0] = __builtin_bit_cast(bf16x8, w); \
          w.x = pk2(P0[8], P0[9]); w.y = pk2(P0[10], P0[11]); w.z = pk2(P0[12], P0[13]); w.w = pk2(P0[14], P0[15]); pa[1] = __builtin_bit_cast(bf16x8, w); \
          w.x = pk2(P1[0], P1[1]); w.y = pk2(P1[2], P1[3]); w.z = pk2(P1[4], P1[5]); w.w = pk2(P1[6], P1[7]); pa[2] = __builtin_bit_cast(bf16x8, w); \
          w.x = pk2(P1[8], P1[9]); w.y = pk2(P1[10], P1[11]); w.z = pk2(P1[12], P1[13]); w.w = pk2(P1[14], P1[15]); pa[3] = __builtin_bit_cast(bf16x8, w); } \
          \
        { unsigned vb_ = (unsigned)((t) & 3) * SLOT; asm volatile("" : "+v"(vb_)); const LAS unsigned char* vs = lds + vb_; \
          _Pragma("unroll") for (int d = 0; d < NDB; ++d) { \
            _Pragma("unroll") for (int s4 = 0; s4 < 4; ++s4) { \
                const bf16x8 vf = *(const LAS bf16x8*)(vs + AT_VOFF(s4) + d * 4096); \
                o[d] = __builtin_amdgcn_mfma_f32_32x32x16_bf16(pa[s4], vf, o[d], 0, 0, 0); } \
          } } \
        if ((t) + 1 < NT) AT_ROWMAX(RMN, N0, N1); \
    } while (0)
    if constexpr (DIFF) {
        for (int t = 0; t < NT; t += 2) { AT_STEP_D(pA0, pA1, rmA, pB0, pB1, rmB, t); AT_STEP_D(pB0, pB1, rmB, pA0, pA1, rmA, t + 1); }
    } else {
        int t = 0;
        for (; t + 2 < NT; t += 2) {
            AT_STEP(pA0, pA1, rmA, pB0, pB1, rmB, t, true);
            AT_STEP(pB0, pB1, rmB, pA0, pA1, rmA, t + 1, true);
        }
        AT_STEP(pA0, pA1, rmA, pB0, pB1, rmB, t, true);
        AT_STEP(pB0, pB1, rmB, pA0, pA1, rmA, t + 1, false);
    }
#undef AT_STEP
#undef AT_STEP_D
#undef SGB
#undef AT_QK
#undef AT_KOFF
#undef AT_KROW32
#undef AT_VOFF
#undef AT_ROWMAX
    lsum += __shfl_xor(lsum, 32);
    { int rq_ = r32; asm volatile("" : "+v"(rq_)); if (hi == 0) wsf[32 + rq_] = lsum; }
    asm volatile("s_waitcnt lgkmcnt(0)" ::: "memory");
    float rl[16];
#pragma unroll
    for (int r = 0; r < 16; ++r) rl[r] = 1.f / wsf[32 + (r & 3) + 8 * (r >> 2) + 4 * hi];
    LAS unsigned char* xch = DIFF ? lds : lds + 4 * SLOT + 8 * 512;
    asm volatile("s_barrier" ::: "memory");
    if constexpr (DIFF) {
        LAS float* x1 = (LAS float*)xch + wq * 4096;
        if (map == 1) {
#pragma unroll
            for (int d = 0; d < NDB; ++d)
#pragma unroll
                for (int r = 0; r < 16; ++r) x1[((r & 3) + 8 * (r >> 2) + 4 * hi) * 128 + d * 32 + r32] = o[d][r] * rl[r] * lam;
        }
        asm volatile("s_waitcnt lgkmcnt(0)\n\ts_barrier" ::: "memory");
        if (map == 0) {
            float ss[16];
#pragma unroll
            for (int r = 0; r < 16; ++r) ss[r] = 0.f;
#pragma unroll
            for (int d = 0; d < NDB; ++d)
#pragma unroll
                for (int r = 0; r < 16; ++r) { const float v = o[d][r] * rl[r] - x1[((r & 3) + 8 * (r >> 2) + 4 * hi) * 128 + d * 32 + r32]; o[d][r] = v; ss[r] += v * v; }
#pragma unroll
            for (int r = 0; r < 16; ++r) { float v = ss[r]; v += __shfl_xor(v, 1); v += __shfl_xor(v, 2); v += __shfl_xor(v, 4); v += __shfl_xor(v, 8); v += __shfl_xor(v, 16); ss[r] = (1.f - lam_init) / sqrtf(v * (1.f / 128.f) + EPSN); }
            float g[NDB];
#pragma unroll
            for (int d = 0; d < NDB; ++d) g[d] = INP(c, I_GSUBLN)[l * 128 + d * 32 + r32];
            asm volatile("s_waitcnt lgkmcnt(0)" ::: "memory");
            LAS bf16_t* stg = (LAS bf16_t*)x1;
#pragma unroll
            for (int d = 0; d < NDB; ++d)
#pragma unroll
                for (int r = 0; r < 16; ++r) stg[((r & 3) + 8 * (r >> 2) + 4 * hi) * 128 + d * 32 + r32] = (bf16_t)f2bf(o[d][r] * ss[r] * g[d]);
            asm volatile("s_waitcnt lgkmcnt(0)" ::: "memory");
            unsigned char* op = (unsigned char*)(c.ws + A_OD8) + (size_t)(q0 + wq * 32) * 512 + h * 128;
#pragma unroll
            for (int i = 0; i < 8; ++i) { const int row = i * 4 + (lane >> 4), ch = lane & 15; f32x4 a_, b_; unpack8(*(const LAS u32x4*)(stg + row * 128 + ch * 8), a_, b_);
                *(u32x2*)(op + (size_t)row * 512 + ch * 8) = (u32x2){pack4_fp8c(a_, BR8_SCALE), pack4_fp8c(b_, BR8_SCALE)}; }
        }
        asm volatile("s_waitcnt lgkmcnt(0)\n\ts_barrier" ::: "memory");
    } else {
        LAS bf16_t* stg = (LAS bf16_t*)xch + wid * 2048;
#pragma unroll
        for (int d = 0; d < NDB; ++d)
#pragma unroll
            for (int r = 0; r < 16; ++r) stg[((r & 3) + 8 * (r >> 2) + 4 * hi) * 64 + d * 32 + r32] = (bf16_t)f2bf(o[d][r] * rl[r]);
        asm volatile("s_waitcnt lgkmcnt(0)" ::: "memory");
        unsigned char* op = (unsigned char*)(c.ws + A_OM) + (size_t)(q0 + wid * 32) * 512 + h * 64;
#pragma unroll
        for (int i = 0; i < 4; ++i) { const int row = i * 8 + (lane >> 3), ch = lane & 7; f32x4 a_, b_; unpack8(*(const LAS u32x4*)(stg + row * 64 + ch * 8), a_, b_);
            *(u32x2*)(op + (size_t)row * 512 + ch * 8) = (u32x2){pack4_fp8c(a_, BR8_SCALE), pack4_fp8c(b_, BR8_SCALE)}; }
        asm volatile("s_waitcnt lgkmcnt(0)" ::: "memory");
    }
#undef AT_DMA
#undef AT_WAIT1
}
__device__ __forceinline__ void ph_attn_mla(const Ctx& c, int l) {
    const int n_mla = ATT_TEST_NOMLA ? 0 : 1024 + (l == 0 ? 128 : 0);
    for (int rep = 0; rep < NREP(16); ++rep)
    for (int u = c.blk; u < n_mla; u += c.G) {
        if (u < 1024) {
            int b = u >> 6, h = (u >> 3) & 7, qt = u & 7;
            if (c.G == 256) { const int x = c.blk & 7, s = c.blk >> 3, pair = (u >> 8) * 32 + x * 4 + (s >> 3); b = pair >> 3; h = pair & 7; qt = s & 7; }
            attn_unit<false>(c, l, b, h, b * RPB + CTXL + qt * 256, RPB, 0.f, 0.f); }
        else { const int q = u - 1024, b = q >> 3, h = q & 7; attn_unit<false>(c, l, b, h, b * RPB, CTXL, 0.f, 0.f); }
    }
}
__device__ __forceinline__ void ph_attn_diff(const Ctx& c, int l) {
    float lam = lam_of(c, l); const float lam_init = 0.8f - 0.6f * expf(-0.3f * (float)l);
    lam = __builtin_bit_cast(float, __builtin_amdgcn_readfirstlane(__builtin_bit_cast(int, lam)));
    const int n_diff = ATT_TEST_NODIFF ? 0 : 1024 + (l == 0 ? 128 : 0);
    for (int u0 = c.blk; u0 < 1024 + 256; u0 += c.G) {
        int u = u0;
        if (u0 >= 1024) { u = (c.G == 256) ? u0 - 128 : u0; if (u < 1024 || u >= n_diff) continue; }
        if (u < 1024) {
            int b = u >> 6, h = (u >> 4) & 3, qt = u & 15;
            if (c.G == 256) { const int x = c.blk & 7, s = c.blk >> 3, pair = (u >> 8) * 16 + x * 2 + (s >> 4); b = pair >> 2; h = pair & 3; qt = s & 15; }
            attn_unit<true>(c, l, b, h, b * RPB + CTXL + qt * 128, RPB, lam, lam_init); }
        else { const int q = u - 1024, b = q >> 3, h = (q >> 1) & 3, qt = q & 1; attn_unit<true>(c, l, b, h, b * RPB + qt * 128, CTXL, lam, lam_init); }
    }
}

struct SchedMerge1 {
    static constexpr bool GATHER = false;
    const Ctx* c; int l, n_units;
    __device__ void init(const Ctx* cc, int ll) { c = cc; l = ll; n_units = (l == 0 ? 144 : 128) * 4; }
    __device__ bool next(int i, Unit& u) const {
        const int U = deal_xcd(*c, i / 3), br = i % 3; if (U >= n_units) return false;
        const int rt = U >> 2; u.pn = U & 3; u.pm = (l == 0) ? rt : ((rt >> 3) * 9 + 1 + (rt & 7));
        u.rows = nullptr; u.nrows = 256; u.aux = l; u.aux2 = 0; u.bperm = 0; u.kind = br; u.K = 256;
        u.a = wsb(*c, br == 0 ? A_OM : (br == 1 ? A_PD : A_OD8)) + (size_t)u.pm * 256 * 256;
        u.b = wt(*c, br == 0 ? WO_BM : (br == 1 ? WO_PP : WO_BD)) + (size_t)u.pn * 256 * 256;
        return true;
    }
};
struct EpiMerge1 {
    static constexpr bool PAIR = false; static constexpr bool FP8 = true;
    const Ctx* c;
    static constexpr int GROUP = 4; static constexpr bool EARLY = false; static constexpr bool CHAIN = true; static constexpr bool ROWTAB = false; struct Pre { u32x2 a0, a1, b0, b1; };
    struct UState {}; __device__ __forceinline__ void unit_begin(const Unit&, int, UState&) const {}
    __device__ __forceinline__ bool keep_acc(const Unit& u) const { return u.kind < 2; }
    __device__ __forceinline__ void pre(const Unit& u, int row, int c8, Pre& p) const {
        const unsigned char* gp = (const unsigned char*)c->p->out + (size_t)(u.pm * 256 + row) * 3072 + u.kind * 1024 + u.pn * 256 + c8;
        p.a0 = *(const u32x2*)gp; p.a1 = *(const u32x2*)(gp + 128);
        const unsigned char* gn = gp + (u.kind < 2 ? 1024 : 0);
        p.b0 = *(const u32x2*)gn; p.b1 = *(const u32x2*)(gn + 128);
    }
    __device__ __forceinline__ static f32x4 gate4(unsigned w) { return (f32x4){(float)max(w & 255u, 1u), (float)max((w >> 8) & 255u, 1u), (float)max((w >> 16) & 255u, 1u), (float)max(w >> 24, 1u)}; }
    __device__ __forceinline__ static f32x4 rcp4(f32x4 v) { return (f32x4){__builtin_amdgcn_rcpf(v.x), __builtin_amdgcn_rcpf(v.y), __builtin_amdgcn_rcpf(v.z), __builtin_amdgcn_rcpf(v.w)}; }
    __device__ __forceinline__ void apply_rw(const Unit& u, int row, int c8, const Pre& p, const UState&, f32x4& v0l, f32x4& v0h, f32x4& v1l, f32x4& v1h) const {
        const Ctx& C = *c;
        if (u.kind < 2) {
            v0l *= gate4(p.a0.x) * rcp4(gate4(p.b0.x)); v0h *= gate4(p.a0.y) * rcp4(gate4(p.b0.y));
            v1l *= gate4(p.a1.x) * rcp4(gate4(p.b1.x)); v1h *= gate4(p.a1.y) * rcp4(gate4(p.b1.y));
        } else {
            constexpr float sc_ = W8_INV * BR8_INV / 255.f;
            const f32x4 s = (f32x4){sc_, sc_, sc_, sc_};
            unsigned char* o = (unsigned char*)(C.ws + A_MG) + (size_t)(u.pm * 256 + row) * 1024 + u.pn * 256 + c8;
            *(u32x2*)o = (u32x2){pack4_fp8c(v0l * gate4(p.a0.x) * s, MG8_SCALE), pack4_fp8c(v0h * gate4(p.a0.y) * s, MG8_SCALE)};
            *(u32x2*)(o + 128) = (u32x2){pack4_fp8c(v1l * gate4(p.a1.x) * s, MG8_SCALE), pack4_fp8c(v1h * gate4(p.a1.y) * s, MG8_SCALE)};
        }
    }
    __device__ __forceinline__ void apply(const Unit&, int, int, const Pre&, const UState&, f32x4, f32x4, f32x4, f32x4) const {}
};
struct SchedMerge2 {
    static constexpr bool GATHER = false;
    const Ctx* c; int l, n_units;
    __device__ void init(const Ctx* cc, int ll) { c = cc; l = ll; n_units = (l == 0 ? 144 : 128) * 4; }
    __device__ bool next(int i, Unit& u) const {
        const int U = deal_xcd(*c, i); if (U >= n_units) return false;
        const int rt = U >> 2; u.pn = U & 3; u.pm = (l == 0) ? rt : ((rt >> 3) * 9 + 1 + (rt & 7));
        u.rows = nullptr; u.nrows = 256; u.aux = l; u.aux2 = 0; u.bperm = 0; u.kind = 0; u.K = 512;
        u.a = wsb(*c, A_MG) + (size_t)u.pm * 256 * 512; u.b = wt(*c, WO_O) + (size_t)u.pn * 256 * 512; return true;
    }
};
struct EpiMerge2 {
    const Ctx* c;
    static constexpr bool PAIR = false; static constexpr bool FP8 = true;
    static constexpr int GROUP = 4; static constexpr bool EARLY = false; static constexpr bool CHAIN = false; static constexpr bool ROWTAB = false; struct Pre {}; struct UState {}; __device__ __forceinline__ void unit_begin(const Unit&, int, UState&) const {} __device__ __forceinline__ void pre(const Unit&, int, int, Pre&) const {}
    __device__ __forceinline__ void apply(const Unit& u, int row, int c8, const Pre&, const UState&, f32x4 v0l, f32x4 v0h, f32x4 v1l, f32x4 v1h) const {
        bf16_t* o = wsb(*c, A_Y1) + (size_t)(u.pm * 256 + row) * 1024 + u.pn * 256; constexpr float sc_ = W8_INV * MG8_INV;
        *(u32x4*)(o + c8) = pack8(v0l * sc_, v0h * sc_); *(u32x4*)(o + 128 + c8) = pack8(v1l * sc_, v1h * sc_);
    }
};

struct T4Raw { u32x2 y[4]; u32x4 h[4]; };
__device__ __forceinline__ void t4_load(const Ctx& c, int l, int R, int lane, T4Raw& d) {
    const bf16_t* yp = wsb(c, A_Y1) + (size_t)R * 1024;
#pragma unroll
    for (int q = 0; q < 4; ++q) d.y[q] = *((const u32x2*)yp + lane + 64 * q);
    if (l == 0) {
#pragma unroll
        for (int q = 0; q < 4; ++q) d.h[q] = *((const u32x4*)res_rd(c, 0, R) + lane + 64 * q);
    } else {
#pragma unroll
        for (int q = 0; q < 4; ++q) { const u32x2 w = *((const u32x2*)hb_row(c, R) + lane + 64 * q); d.h[q].x = w.x; d.h[q].y = w.y; }
    }
}
__device__ __forceinline__ void ph_t4_router(const Ctx& c, int l) {
    LAS bf16_t* wr = (LAS bf16_t*)c.lds; constexpr int WRP = 1032;
    {
        const GAS unsigned char* src = c.ws + WS_W + (size_t)WO_R * 2;
#pragma unroll
        for (int q = 0; q < 16; ++q) { const int e = c.wave * 8 + (q >> 1), hf = q & 1, m_ = e & 31;
            const int ex = (e & 32) + ((m_ >> 2) & 1) * 16 + (m_ >> 3) * 4 + (m_ & 3);
            __builtin_amdgcn_global_load_lds((const GAS unsigned*)(src + (size_t)ex * 2048 + hf * 1024 + c.lane * 16), (LAS unsigned*)((LAS unsigned char*)wr + e * (WRP * 2) + hf * 1024), 16, 0, 0); }
    }
    LAS unsigned* hist = (LAS unsigned*)(c.lds + 64 * WRP * 2 + c.wave * 512);
    LAS unsigned* stash = (LAS unsigned*)(c.lds + 64 * WRP * 2 + 4096 + c.wave * 2048);
    LAS float* brl = (LAS float*)(c.lds + 64 * WRP * 2 + 4096 + 8 * 2048);
    static_assert(64 * WRP * 2 + 4096 + 8 * 2048 + 256 <= LDS_MISC, "router LDS map");
    if (c.tid < 64) brl[c.tid] = INP(c, I_BROUTER)[l * 64 + c.tid];
    LAS unsigned* wgh = (LAS unsigned*)(c.lds + 64 * WRP * 2 + 4096 + 8 * 2048 + 256);
    LAS unsigned* wgb = wgh + 64;
    static_assert(64 * WRP * 2 + 4096 + 8 * 2048 + 768 <= LDS_MISC && NCHUNK == 1, "router LDS map (workgroup-level position allocation assumes one token chunk)");
    if (c.tid < 64) wgh[c.tid] = 0u;
    const int r32 = c.lane & 31, hi = c.lane >> 5;
    unsigned* CNT = (unsigned*)(c.ws + CTL_CNT);
    const int NGV = (l == 0) ? NR / 32 : NB * (SEQ / 32);
#define T4_GROUP(q) ((l == 0) ? (q) : (((q) >> 6) * 72 + 8 + ((q) & 63)))
    const bool even_ = (l == 0) && (c.G == 256);
    const int gq0 = (c.blk * NGV) / c.G, ngrp = even_ ? 5 : ((c.blk + 1) * NGV) / c.G - gq0;
    {
        const int nrow = even_ ? 144 : ngrp * 32;
#define T4_ROW(j) (even_ ? (c.blk * 144 + (j)) : (T4_GROUP(gq0 + ((j) >> 5)) * 32 + ((j) & 31)))
        T4Raw ra, rb, rc; f32x4 h[4], am[4], mul[4], add[4]; int key = -1;
#pragma unroll
        for (int q = 0; q < 4; ++q) { ra.y[q] = (u32x2){0u, 0u}; ra.h[q] = (u32x4){0u, 0u, 0u, 0u}; rb.y[q] = ra.y[q]; rb.h[q] = ra.h[q]; rc.y[q] = ra.y[q]; rc.h[q] = ra.h[q]; }
        int j = c.wave;
        if (j < nrow) t4_load(c, l, T4_ROW(j), c.lane, ra);
        if (j + 8 < nrow) t4_load(c, l, T4_ROW(j + 8), c.lane, rb);
#pragma unroll 1
        for (; j < nrow; j += 8) { const int R = T4_ROW(j);
            if (j + 16 < nrow) t4_load(c, l, T4_ROW(j + 16), c.lane, rc);
            f32x4 y[4];
#pragma unroll
            for (int q = 0; q < 4; ++q) { y[q] = (f32x4){bflo(ra.y[q].x), bfhi(ra.y[q].x), bflo(ra.y[q].y), bfhi(ra.y[q].y)};
                if (l == 0) h[q] = __builtin_bit_cast(f32x4, ra.h[q]);
                else h[q] = (f32x4){bflo(ra.h[q].x), bfhi(ra.h[q].x), bflo(ra.h[q].y), bfhi(ra.h[q].y)}; }
            if (batch_key(R) != key) { key = batch_key(R); const float* g1 = INP(c, I_GPOSTMIX) + l * DM; const float* m2 = modvec(c, l, R, 2);
#pragma unroll
                for (int q = 0; q < 4; ++q) { const int o = c.lane + 64 * q; am[q] = *((const f32x4*)m2 + o) * *((const f32x4*)g1 + o); }
                mod_fold(c, INP(c, I_GPREFFN) + l * DM, l, R, 3, 4, c.lane, mul, add); }
            const float rs1 = 1.f / sqrtf(row_sumsq(y) * (1.f / DM) + EPSN);
#pragma unroll
            for (int q = 0; q < 4; ++q) h[q] += am[q] * (y[q] * rs1);
            bf16_t* hw = hb_row(c, R);
#pragma unroll
            for (int q = 0; q < 4; ++q) { u32x2 w_; w_.x = pk2(h[q].x, h[q].y); w_.y = pk2(h[q].z, h[q].w); *((u32x2*)hw + c.lane + 64 * q) = w_; }
            const float rs2 = 1.f / sqrtf(row_sumsq(h) * (1.f / DM) + EPSN);
            { bf16_t* orow = wsb(c, A_FXR) + (size_t)R * DM; unsigned char* o8 = (unsigned char*)(c.ws + A_HX) + (size_t)R * DM;
#pragma unroll
              for (int q = 0; q < 4; ++q) { const f32x4 yy = (h[q] * rs2) * mul[q] + add[q]; u32x2 w_; w_.x = pk2(yy.x, yy.y); w_.y = pk2(yy.z, yy.w); *((u32x2*)orow + c.lane + 64 * q) = w_;
                  *((unsigned*)o8 + c.lane + 64 * q) = pack4_fp8c(yy, 1.f); } }
#pragma unroll
            for (int q = 0; q < 4; ++q) { ra.y[q] = rb.y[q]; ra.h[q] = rb.h[q]; rb.y[q] = rc.y[q]; rb.h[q] = rc.h[q]; }
        }
#undef T4_ROW
    }
    asm volatile("s_waitcnt vmcnt(0)" ::: "memory");
    __syncthreads();
#define T4SLOT(i) (((volatile LAS unsigned long long*)(c.lds + LDS_MISC + 128))[i])
    if (TMASK & 4096) T4SLOT(65) = __builtin_amdgcn_s_memrealtime();
    int ei[8]; float ew[8]; unsigned rk[8]; float wn = 0.f; int R = 0; bool tok_ok = true;
#pragma unroll
    for (int k = 0; k < 8; ++k) { ei[k] = 0; ew[k] = 0.f; rk[k] = 0u; }
    if (c.wave < ngrp) {
        const int R0 = even_ ? c.blk * 144 + c.wave * 32 : T4_GROUP(gq0 + c.wave) * 32;
#undef T4_GROUP
        typedef float f32x16 __attribute__((ext_vector_type(16)));
        f32x16 a0 = {}, a1 = {};
        const bf16_t* fxp = wsb(c, A_FXR) + (size_t)(R0 + r32) * 1024 + hi * 8;
        bf16x8 fb[2][16];
#pragma unroll
        for (int i = 0; i < 16; ++i) fb[0][i] = *(const bf16x8*)(fxp + i * 16);
#pragma unroll
        for (int bt = 0; bt < 4; ++bt) {
            if (bt + 1 < 4) {
#pragma unroll
                for (int i = 0; i < 16; ++i) fb[(bt + 1) & 1][i] = *(const bf16x8*)(fxp + ((bt + 1) * 16 + i) * 16); }
#pragma unroll
            for (int i = 0; i < 16; ++i) { const int s = bt * 16 + i;
                const bf16x8 w0 = *(const LAS bf16x8*)(wr + r32 * WRP + s * 16 + hi * 8), w1 = *(const LAS bf16x8*)(wr + (32 + r32) * WRP + s * 16 + hi * 8);
                a0 = __builtin_amdgcn_mfma_f32_32x32x16_bf16(w0, fb[bt & 1][i], a0, 0, 0, 0); a1 = __builtin_amdgcn_mfma_f32_32x32x16_bf16(w1, fb[bt & 1][i], a1, 0, 0, 0); }
        }
        if (TMASK & 8192) { asm volatile("" :: "v"(a0), "v"(a1)); if (c.wave == 0) T4SLOT(42 + l) = __builtin_amdgcn_s_memrealtime() - T4SLOT(65); }
        float sel[32];
        { const LAS float* bl0 = brl + hi * 16; const LAS float* bl1 = brl + 32 + hi * 16;
#pragma unroll
          for (int i = 0; i < 16; ++i) { sel[i] = sigmoidf_(a0[i]) + bl0[i]; sel[16 + i] = sigmoidf_(a1[i]) + bl1[i]; } }
        float gsm[4], gso[4];
#pragma unroll
        for (int G = 0; G < 4; ++G) { float m1 = -INFINITY, m2 = -INFINITY;
#pragma unroll
            for (int q = 0; q < 8; ++q) { const float v = sel[G * 8 + q]; if (v > m1) { m2 = m1; m1 = v; } else if (v > m2) m2 = v; }
            gsm[G] = m1 + m2; }
#pragma unroll
        for (int G = 0; G < 4; ++G) gso[G] = __shfl_xor(gsm[G], 32);
#pragma unroll
        for (int G = 0; G < 4; ++G) { const int gi = (G >> 1) * 4 + 2 * hi + (G & 1); int rank = 0;
#pragma unroll
            for (int q = 0; q < 4; ++q) { const int qm = (q >> 1) * 4 + 2 * hi + (q & 1), qo = (q >> 1) * 4 + 2 * (1 - hi) + (q & 1);
                rank += (gsm[q] > gsm[G] || (gsm[q] == gsm[G] && qm < gi)) ? 1 : 0;
                rank += (gso[q] > gsm[G] || (gso[q] == gsm[G] && qo < gi)) ? 1 : 0; }
#pragma unroll
            for (int q = 0; q < 8; ++q) { const int i = G * 8 + q; const int e = (i < 16) ? hi * 16 + i : 32 + hi * 16 + (i - 16);
                const float key = __builtin_bit_cast(float, (__builtin_bit_cast(unsigned, sel[i]) & ~63u) | (unsigned)(63 - e)); sel[i] = (rank >= 4) ? -1e30f : key; } }
        float wsum = 0.f;
#pragma unroll 1
        for (int k = 0; k < 8; ++k) { float best = sel[0];
#pragma unroll
            for (int e = 1; e < 32; ++e) best = fmaxf(best, sel[e]);
            best = fmaxf(best, __shfl_xor(best, 32));
#pragma unroll
            for (int e = 0; e < 32; ++e) sel[e] = (sel[e] == best) ? -1e30f : sel[e];
            const int bi = 63 - (int)(__builtin_bit_cast(unsigned, best) & 63u); const float bs = best - brl[bi];
            stash[k * 64 + c.lane] = (__builtin_bit_cast(unsigned, bs) & ~63u) | (unsigned)bi; wsum += bs; }
        asm volatile("s_waitcnt lgkmcnt(0)" ::: "memory");
#pragma unroll
        for (int k = 0; k < 8; ++k) { const unsigned w_ = stash[k * 64 + c.lane]; ei[k] = (int)(w_ & 63u); ew[k] = __builtin_bit_cast(float, w_ & ~63u); }
        wn = 2.5f / wsum;
        R = R0 + r32;
        hist[c.lane] = 0u; asm volatile("s_waitcnt lgkmcnt(0)" ::: "memory");
        tok_ok = !(even_ && c.wave == 4 && r32 >= 16);
#pragma unroll
        for (int k = 0; k < 8; ++k) { rk[k] = 0u; if (hi == 0 && tok_ok) rk[k] = atomicAdd((unsigned*)&hist[ei[k]], 1u); }
        asm volatile("s_waitcnt lgkmcnt(0)" ::: "memory");
        { const unsigned cnt = hist[c.lane]; unsigned off = 0u; if (cnt) off = atomicAdd((unsigned*)&wgh[c.lane], cnt); hist[64 + c.lane] = off; }
        asm volatile("s_waitcnt lgkmcnt(0)" ::: "memory");
    }
    __syncthreads();
    if (c.tid < 64) { const unsigned tot = wgh[c.tid]; unsigned base = 0u; if (tot) base = atomicAdd(CNT + (l * 2) * 128 + c.tid, tot); wgb[c.tid] = base; asm volatile("s_waitcnt vmcnt(0) lgkmcnt(0)" ::: "memory"); }
    __syncthreads();
    if (c.wave < ngrp && hi == 0 && tok_ok) {
        unsigned* rt_ = (unsigned*)(c.ws + WS_REGT); float* rw_ = (float*)(c.ws + WS_REGW);
#pragma unroll
        for (int k = 0; k < 8; ++k) { const unsigned pos = wgb[ei[k]] + hist[64 + ei[k]] + rk[k]; const size_t o = (size_t)ei[k] * CAP + pos;
            rt_[o] = ((unsigned)R << 4) | (unsigned)k; rw_[o] = ew[k] * wn; }
    }
    __syncthreads();
    if (TMASK & 4096) T4SLOT(40 + l) = __builtin_amdgcn_s_memrealtime() - T4SLOT(65);
#undef T4SLOT
}

struct MoeTab { LAS int* tstart; int TR, nsh, ch, l; };
__device__ __forceinline__ MoeTab moe_table(const Ctx& c, int l, int ch) {
    MoeTab T; T.tstart = (LAS int*)(c.lds + LDS_RING + 1024 + ch * 4096); T.ch = ch; T.l = l;
    LAS int* tile_e = (LAS int*)(c.lds + LDS_RING + 2048 + ch * 4096);
    __syncthreads();
    if (c.tid < 64) {
        unsigned* CNT = (unsigned*)(c.ws + CTL_CNT) + (l * 2 + ch) * 128;
        const int n = (int)__hip_atomic_load(CNT + c.tid, __ATOMIC_RELAXED, __HIP_MEMORY_SCOPE_AGENT); const int tiles = (n + 255) >> 8;
        int x = tiles;
#pragma unroll
        for (int d = 1; d < 64; d <<= 1) { const int y = __shfl_up(x, d); if (c.tid >= d) x += y; }
        T.tstart[c.tid] = x - tiles; T.tstart[65 + c.tid] = n; if (c.tid == 63) T.tstart[64] = x; }
    __syncthreads();
    T.TR = T.tstart[64]; T.nsh = (l == 0) ? CHROWS / 256 : (NB / NCHUNK) * SEQ / 256;
    for (int t = c.tid; t < T.TR; t += 512) { int lo = 0;
#pragma unroll 1
        for (int st = 32; st >= 1; st >>= 1) { const int q = lo + st; if (q < 64 && T.tstart[q] <= t) lo = q; }
        tile_e[t] = lo; }
    __syncthreads();
    return T;
}
__device__ __forceinline__ void moe_tile(const Ctx& c, const MoeTab& T, int t, int& e, int& j, int& nrows, const unsigned*& rows, int& pm_sh) {
    if (t < T.TR) { e = ((LAS int*)(c.lds + LDS_RING + 2048 + T.ch * 4096))[t]; j = t - T.tstart[e]; const int n = T.tstart[65 + e]; nrows = min(256, n - 256 * j);
        rows = (const unsigned*)(c.ws + WS_REGT) + ((size_t)T.ch * 64 + e) * CAP + 256 * j; pm_sh = 0; }
    else { const int s = t - T.TR; e = 64; j = s; nrows = 256; rows = nullptr;
        const int bl = (T.l == 0) ? s / 9 : s / 8, r9 = (T.l == 0) ? s % 9 : 1 + (s % 8); pm_sh = (T.ch * (NB / NCHUNK) + bl) * 9 + r9; }
}
struct SchedGU {
    static constexpr bool GATHER = true;
    const Ctx* c; MoeTab T0, T1;
    __device__ bool next(int i, Unit& u) const {
        const int L = deal_xcd(*c, i); int t = L >> 1; const int n0 = T0.TR + T0.nsh;
        const bool second = t >= n0; if (second) t -= n0;
        const MoeTab& T = second ? T1 : T0;
        if (t >= T.TR + T.nsh) return false;
        int e, j, nrows, pm_sh; const unsigned* rows; moe_tile(*c, T, t, e, j, nrows, rows, pm_sh);
        u.pn = L & 1; u.pm = T.ch * ACT_TILES + t; u.kind = (e < 64) ? 0 : 1; u.bperm = 0; u.K = 512  ; u.rows = rows; u.nrows = nrows; u.aux = e; u.aux2 = T.ch * CHROWS + CTXL;
        u.a = (e < 64) ? wsb(*c, A_HX) : wsb(*c, A_HX) + (size_t)pm_sh * 256 * 512;
        u.b = wt(*c, WO_GU) + (size_t)e * 262144 + (size_t)u.pn * 256 * 512; return true;
    }
};
struct EpiGU {
    const Ctx* c; int ch;
    static constexpr bool PAIR = true; static constexpr bool FP8 = true;
    static constexpr int GROUP = 4; static constexpr bool EARLY = false; static constexpr bool CHAIN = false; static constexpr bool ROWTAB = false; struct Pre { float w; };
    struct UState {}; __device__ __forceinline__ void unit_begin(const Unit&, int, UState&) const {}
    __device__ __forceinline__ void pre(const Unit& u, int row, int c8, Pre& p) const {
        p.w = 1.f;
        if (u.kind == 0) { p.w = 0.f; if (row < u.nrows) p.w = ((const float*)(c->ws + WS_REGW))[(u.rows - (const unsigned*)(c->ws + WS_REGT)) + row]; }
    }
    __device__ __forceinline__ u32x2 act8(const Pre& p, f32x4 gl, f32x4 gh, f32x4 ul, f32x4 uh) const {
        const float w = p.w * W8_INV; gl *= W8_INV; gh *= W8_INV;
#pragma unroll
        for (int i = 0; i < 4; ++i) { gl[i] = gl[i] * sigmoidf_(gl[i]) * ul[i] * w; gh[i] = gh[i] * sigmoidf_(gh[i]) * uh[i] * w; }
        return (u32x2){pack4_fp8c(gl, ACT8_SCALE), pack4_fp8c(gh, ACT8_SCALE)};
    }
    __device__ __forceinline__ void apply2(const Unit& u, int rowA, int rowB, int c8, const Pre& pA, const Pre& pB, const UState&, f32x4 gAl, f32x4 gAh, f32x4 uAl, f32x4 uAh, f32x4 gBl, f32x4 gBh, f32x4 uBl, f32x4 uBh) const {
        u32x2 a = act8(pA, gAl, gAh, uAl, uAh), b = act8(pB, gBl, gBh, uBl, uBh);
        { auto r = __builtin_amdgcn_permlane16_swap(a.x, b.x, false, false); a.x = r[0]; b.x = r[1]; }
        { auto r = __builtin_amdgcn_permlane16_swap(a.y, b.y, false, false); a.y = r[0]; b.y = r[1]; }
        const bool odd = (c8 >> 3) & 1;
        const int row = odd ? rowB : rowA, col = odd ? c8 - 8 : c8;
        *(u32x4*)((unsigned char*)(c->ws + A_ACT) + ((size_t)u.pm * 256 + row) * 256 + u.pn * 128 + col) = (u32x4){a.x, a.y, b.x, b.y};
    }
    __device__ __forceinline__ void apply(const Unit& u, int row, int c8, const Pre& p, const UState&, f32x4 gl, f32x4 gh, f32x4 ul, f32x4 uh) const {
        const float w = p.w * W8_INV;
        gl *= W8_INV; gh *= W8_INV;
#pragma unroll
        for (int i = 0; i < 4; ++i) { gl[i] = gl[i] * sigmoidf_(gl[i]) * ul[i] * w; gh[i] = gh[i] * sigmoidf_(gh[i]) * uh[i] * w; }
#pragma unroll
        for (int i = 0; i < 4; ++i) { gl[i] = __builtin_amdgcn_fmed3f(gl[i] * ACT8_SCALE, -448.f, 448.f); gh[i] = __builtin_amdgcn_fmed3f(gh[i] * ACT8_SCALE, -448.f, 448.f); }
        *(u32x2*)((unsigned char*)(c->ws + A_ACT) + ((size_t)u.pm * 256 + row) * 256 + u.pn * 128 + c8) = (u32x2){pack4_fp8s(gl.x, gl.y, gl.z, gl.w, 1.f), pack4_fp8s(gh.x, gh.y, gh.z, gh.w, 1.f)};
    }
};
struct SchedD {
    static constexpr bool GATHER = false;
    const Ctx* c; MoeTab T;
    __device__ bool next(int i, Unit& u) const {
        const int L = deal_xcd(*c, i); const int t = L >> 2; if (t >= T.TR + T.nsh) return false;
        int e, j, nrows, pm_sh; const unsigned* rows; moe_tile(*c, T, t, e, j, nrows, rows, pm_sh);
        u.pn = L & 3; u.pm = t; u.kind = (e < 64) ? 0 : 1; u.bperm = 2; { int k_ = 128  ; asm volatile("" : "+s"(k_)); u.K = k_; }     u.rows = nullptr; u.nrows = nrows; u.aux = pm_sh;
        u.a = wsb(*c, A_ACT) + (size_t)(T.ch * ACT_TILES + t) * 256 * 128; u.b = wt(*c, WO_D) + (size_t)e * 131072 + (size_t)u.pn * 256 * 128;
        u.aux2 = (e < 64) ? (int)(rows - (const unsigned*)(c->ws + WS_REGT)) : -1;
        return true;
    }
};
struct EpiD {
    const Ctx* c; int ch;
    static constexpr bool PAIR = false; static constexpr bool FP8 = true;
    static constexpr int GROUP = 8; static constexpr bool EARLY = false; static constexpr bool CHAIN = false; static constexpr bool ROWTAB = true; struct Pre { unsigned ent; };
    static constexpr int TAB_OFF = LDS_RING + 12288;
    __device__ __forceinline__ void rowtab_dma(const Unit& u, LAS unsigned char* lds, int wid, int lane, int par) const {
        if (u.kind == 0 && wid < 4)
            __builtin_amdgcn_global_load_lds((const GAS unsigned*)(c->ws + WS_REGT) + (size_t)u.aux2 + wid * 64 + lane, (LAS unsigned*)(lds + TAB_OFF + par * 1024 + wid * 256), 4, 0, 0);
    }
    __device__ __forceinline__ void pre_tab(const Unit& u, int row, LAS unsigned char* lds, int par, Pre& p) const { p.ent = ((const LAS unsigned*)(lds + TAB_OFF + par * 1024))[row]; }
    struct UState {}; __device__ __forceinline__ void unit_begin(const Unit&, int, UState&) const {}
    __device__ __forceinline__ void pre(const Unit& u, int row, int c8, Pre& p) const {
        p.ent = 0u; if (u.kind == 0 && row < u.nrows) p.ent = ((const unsigned*)(c->ws + WS_REGT))[(size_t)u.aux2 + row];
    }
    __device__ __forceinline__ void apply(const Unit& u, int row, int c8, const Pre& p, const UState& us, f32x4 v0l, f32x4 v0h, f32x4 v1l, f32x4 v1h) const {
        if (row >= u.nrows) return;
        size_t slot;
        if (u.kind == 0) { const unsigned ent = p.ent; slot = (size_t)((int)(ent >> 4) - ch * CHROWS) * 9 + (ent & 15u); }
        else slot = (size_t)(u.aux * 256 + row - ch * CHROWS) * 9 + 8;
        unsigned char* o = (unsigned char*)(c->ws + A_Y) + slot * 1024 + u.pn * 256 + 2 * c8;
        constexpr float SC = Y_SCALE * W8_INV * ACT8_INV;
        *(u32x4*)o = (u32x4){pack4_fp8c(v0l, SC), pack4_fp8c(v0h, SC), pack4_fp8c(v1l, SC), pack4_fp8c(v1h, SC)};
    }
};
struct CombRow { u32x4 y[9]; u32x4 h[2]; };
__device__ __forceinline__ void comb_load(const Ctx& c, int rr, int R, CombRow& d) {
    const unsigned char* yp = (const unsigned char*)(c.ws + A_Y) + (size_t)rr * 9 * 1024 + c.lane * 16;
#pragma unroll
    for (int k = 0; k < 9; ++k) d.y[k] = *(const u32x4*)(yp + k * 1024);
    const bf16_t* hp = hb_row(c, R) + c.lane * 16;
    d.h[0] = *(const u32x4*)hp; d.h[1] = *(const u32x4*)(hp + 8);
}
__device__ __forceinline__ void ph_combine(const Ctx& c, int l, int ch) {
    const int gw = c.blk * 8 + c.wave, NGW = c.G * 8;
    const int nv = (l == 0) ? CHROWS : (NB / NCHUNK) * SEQ;
#define COMB_RR(v) ((l == 0) ? (v) : (((v) >> 11) * RPB + CTXL + ((v) & 2047)))
    const int per = (nv + NGW - 1) / NGW, v0 = gw * per, v1 = min(nv, v0 + per);
    CombRow cur, nxt;
    f32x4 am[4], mul[4], add[4]; int key = -1;
    int v = v0;
    if (v < v1) comb_load(c, COMB_RR(v), ch * CHROWS + COMB_RR(v), cur);
    for (; v < v1; ++v) {
        const int rr = COMB_RR(v), R = ch * CHROWS + rr;
        const int v2 = v + 1;
        if (v2 < v1) comb_load(c, COMB_RR(v2), ch * CHROWS + COMB_RR(v2), nxt);
        if (batch_key(R) != key) { key = batch_key(R);
            const float* g = INP(c, I_GPOSTFFN) + l * DM + c.lane * 16; const float* m5 = modvec(c, l, R, 5) + c.lane * 16;
#pragma unroll
            for (int j = 0; j < 4; ++j) am[j] = *((const f32x4*)m5 + j) * *((const f32x4*)g + j);
            if (l == 0) { const float* g2 = INP(c, I_GPREMIX) + 1 * DM + c.lane * 16; const float* sh = modvec(c, 1, R, 0) + c.lane * 16; const float* sc = modvec(c, 1, R, 1) + c.lane * 16;
#pragma unroll
                for (int j = 0; j < 4; ++j) { mul[j] = *((const f32x4*)g2 + j) * (*((const f32x4*)sc + j) + 1.0f); add[j] = *((const f32x4*)sh + j); } } }
        f32x4 f[4];
#pragma unroll
        for (int j = 0; j < 4; ++j) f[j] = (f32x4){0.f, 0.f, 0.f, 0.f};
#pragma unroll
        for (int k = 0; k < 9; ++k) { f[0] += unpack4_fp8(cur.y[k].x); f[1] += unpack4_fp8(cur.y[k].y); f[2] += unpack4_fp8(cur.y[k].z); f[3] += unpack4_fp8(cur.y[k].w); }
#pragma unroll
        for (int j = 0; j < 4; ++j) f[j] *= Y_INV;
        const float rs = 1.f / sqrtf(row_sumsq(f) * (1.f / DM) + EPSN);
        f32x4 h[4];
        { f32x4 ha, hb2; unpack8(cur.h[0], ha, hb2); h[0] = ha; h[1] = hb2; unpack8(cur.h[1], ha, hb2); h[2] = ha; h[3] = hb2; }
#pragma unroll
        for (int j = 0; j < 4; ++j) h[j] += am[j] * (f[j] * rs);
        LAS unsigned char* rowb = (l == 0) ? c.lds + 131072 + c.wave * 2048 : c.lds + c.wave * 4096;
        static_assert(131072 + 8 * 2048 <= LDS_MISC, "combine row buffers");
        if (l == 0) { *(LAS u32x4*)(rowb + c.lane * 32) = pack8(h[0], h[1]); *(LAS u32x4*)(rowb + c.lane * 32 + 16) = pack8(h[2], h[3]);
            asm volatile("s_waitcnt lgkmcnt(0)" ::: "memory");
            const u32x4 w0 = *(const LAS u32x4*)(rowb + c.lane * 16), w1 = *(const LAS u32x4*)(rowb + 1024 + c.lane * 16);
            unsigned char* hw = (unsigned char*)hb_row(c, R); *(u32x4*)(hw + c.lane * 16) = w0; *(u32x4*)(hw + 1024 + c.lane * 16) = w1; }
        else {
#pragma unroll
            for (int j = 0; j < 4; ++j) *(LAS f32x4*)(rowb + c.lane * 64 + j * 16) = h[j];
            asm volatile("s_waitcnt lgkmcnt(0)" ::: "memory");
            unsigned char* hw = (unsigned char*)out_row(c, R);
#pragma unroll
            for (int j = 0; j < 4; ++j) { const f32x4 w_ = *(const LAS f32x4*)(rowb + j * 1024 + c.lane * 16); *(f32x4*)(hw + j * 1024 + c.lane * 16) = w_; } }
        asm volatile("s_waitcnt lgkmcnt(0)" ::: "memory");
        if (l == 0) { const float rs2 = 1.f / sqrtf(row_sumsq(h) * (1.f / DM) + EPSN);
            f32x4 y[4];
#pragma unroll
            for (int j = 0; j < 4; ++j) y[j] = (h[j] * rs2) * mul[j] + add[j];
            unsigned char* op = (unsigned char*)(c.ws + A_HX) + (size_t)R * DM + c.lane * 16;
            *(u32x4*)op = (u32x4){pack4_fp8c(y[0], 1.f), pack4_fp8c(y[1], 1.f), pack4_fp8c(y[2], 1.f), pack4_fp8c(y[3], 1.f)}; }
        if (v2 < v1) cur = nxt;
    }
#undef COMB_RR
}

__global__ void __launch_bounds__(512, 2) fwd_kernel(Params prm) {
    extern __shared__ __attribute__((aligned(16))) unsigned char lds_raw[];
    Ctx c; c.p = (ParamsK)__builtin_amdgcn_kernarg_segment_ptr(); c.lds = (LAS unsigned char*)lds_raw; c.tid = threadIdx.x; c.lane = c.tid & 63; c.wave = __builtin_amdgcn_readfirstlane(c.tid >> 6);
    c.G = gridDim.x; c.blk = blockIdx.x; c.ws = (GAS unsigned char*)prm.ws; c.z = 0;
    volatile LAS unsigned* MISC = (volatile LAS unsigned*)(c.lds + LDS_MISC);
    if (c.tid < 16) MISC[c.tid] = 0u;
    if (TMASK) { if (c.tid < 160) ((volatile LAS unsigned*)(c.lds + LDS_MISC + 128))[c.tid] = 0u; }
    __syncthreads();
    XcdBarrier bar; bar.bar = (unsigned*)(c.ws + CTL_BAR); bar.x = 0; bar.st = nullptr;
    const int lo = prm.step_lo, hi = prm.step_hi;
    if (hi - lo > 1) bar = xcd_barrier_post((unsigned*)(c.ws + CTL_BAR), MISC + 8);
    int step = 0;
#define TSLOT(i) (((volatile LAS unsigned long long*)((LAS unsigned char*)lds_raw + LDS_MISC + 128))[i])
#define TB(bit) do { if ((TMASK) & (bit)) TSLOT(64) = __builtin_amdgcn_s_memrealtime(); } while (0)
#define TE(bit) do { if ((TMASK) & (bit)) TSLOT(step & 63) = __builtin_amdgcn_s_memrealtime() - TSLOT(64); } while (0)
#define RUN() (step >= lo && step < hi)
#define SEAM() do { if (step >= lo && step + 1 < hi) { XcdBarrier b2_ = bar; asm volatile("" : "+s"(b2_.bar), "+s"(b2_.x)); b2_.bar = (unsigned*)rfl64((unsigned long long)b2_.bar); b2_.x = (unsigned)__builtin_amdgcn_readfirstlane((int)b2_.x); TB(2048); int w_ = c.wave; asm volatile("" : "+s"(w_)); unsigned on_ = ~0u; asm volatile("" : "+s"(on_)); const bool ldr_ = (w_ == 0) && (__builtin_amdgcn_mbcnt_hi(on_, __builtin_amdgcn_mbcnt_lo(on_, 0u)) == 0u); xcd_barrier(b2_, ldr_); TE(2048); } ++step; } while (0)
    { constexpr int l = 0;
        if (RUN()) { TB(1); if (PHM & 1) for (int rep = 0; rep < NREP(1); ++rep) { PHASE_CTX(cl); ph_prologue(cl, l); }  TE(1); }
        SEAM();
        if (l == 0) { if (RUN()) { TB(2); if (PHM & 2) { PHASE_CTX(cl); ph_t1(cl, 0); } } SEAM();  TE(2); }
        if (RUN()) { TB(4); if (PHM & 4) { PHASE_CTX(cl); SchedProj S; S.init(&cl, l); EpiProj E{&cl, l}; GEMM_UNITS(cl, S, E); }  TE(4); }
        SEAM();
        if (RUN()) { TB(8); if (PHM & 8) for (int rep = 0; rep < NREP(8); ++rep) { { PHASE_CTX(cl); SchedUp S; S.init(&cl, l); EpiUp E{&cl, l}; GEMM_UNITS(cl, S, E); } { PHASE_CTX(cl); ph_pool(cl, l); } }  TE(8); }
        SEAM();
        if (RUN()) { TB(16); if (PHM & 16) { { PHASE_CTX(cl); ph_attn_mla(cl, l); } { PHASE_CTX(cl); ph_attn_diff(cl, l); } }  TE(16); }
        SEAM();
        if (RUN()) { TB(32); if (PHM & 32) for (int rep = 0; rep < NREP(32); ++rep) { PHASE_CTX(cl); SchedMerge1 S; S.init(&cl, l); EpiMerge1 E{&cl}; GEMM_UNITS(cl, S, E); }  TE(32); }
        SEAM();
        if (RUN()) { TB(64); if (PHM & 64) for (int rep = 0; rep < NREP(64); ++rep) { PHASE_CTX(cl); SchedMerge2 S; S.init(&cl, l); EpiMerge2 E{&cl}; GEMM_UNITS(cl, S, E); }  TE(64); }
        SEAM();
        if (RUN()) { TB(128); if (PHM & 128) { PHASE_CTX(cl); ph_t4_router(cl, l); }  TE(128); }
        SEAM();
        if (RUN()) { TB(256); if (PHM & 256) for (int rep = 0; rep < NREP(256); ++rep) { PHASE_CTX(cl); SchedGU S; S.c = &cl; S.T0 = moe_table(cl, l, 0); if (NCHUNK > 1) S.T1 = moe_table(cl, l, NCHUNK - 1); else { S.T1 = S.T0; S.T1.TR = 0; S.T1.nsh = 0; } EpiGU E{&cl, 0}; GEMM_UNITS(cl, S, E); }  TE(256); }
        SEAM();
        { constexpr int ch = 0;
            if (RUN()) { TB(512); if (PHM & 512) for (int rep = 0; rep < NREP(512); ++rep) { PHASE_CTX(cl); SchedD S; S.c = &cl; S.T = moe_table(cl, l, ch); EpiD E{&cl, ch}; GEMM_UNITS(cl, S, E); }  TE(512); }
            SEAM();
            if (RUN()) { TB(1024); if (PHM & 1024) { { PHASE_CTX(cl); ph_combine(cl, l, ch); } if (NCHUNK == 1) { PHASE_CTX(cl); ph_prologue(cl, 1); } }  TE(1024); }
            SEAM();

        }
        if constexpr (NCHUNK > 1) { constexpr int ch = 1;
            if (RUN()) { TB(512); if (PHM & 512) for (int rep = 0; rep < NREP(512); ++rep) { PHASE_CTX(cl); SchedD S; S.c = &cl; S.T = moe_table(cl, l, ch); EpiD E{&cl, ch}; GEMM_UNITS(cl, S, E); }  TE(512); }
            SEAM();
            if (RUN()) { TB(1024); if (PHM & 1024) { { PHASE_CTX(cl); ph_combine(cl, l, ch); } { PHASE_CTX(cl); ph_prologue(cl, 1); } }  TE(1024); }
            SEAM();

        }
    }
    { constexpr int l = 1;
        if (l == 0) { if (RUN()) { TB(2); if (PHM & 2) { PHASE_CTX(cl); ph_t1(cl, 0); } } SEAM();  TE(2); }
        if (RUN()) { TB(4); if (PHM & 4) { PHASE_CTX(cl); SchedProj S; S.init(&cl, l); EpiProj E{&cl, l}; GEMM_UNITS(cl, S, E); }  TE(4); }
        SEAM();
        if (RUN()) { TB(8); if (PHM & 8) for (int rep = 0; rep < NREP(8); ++rep) { { PHASE_CTX(cl); SchedUp S; S.init(&cl, l); EpiUp E{&cl, l}; GEMM_UNITS(cl, S, E); } { PHASE_CTX(cl); ph_pool(cl, l); } }  TE(8); }
        SEAM();
        if (RUN()) { TB(16); if (PHM & 16) { { PHASE_CTX(cl); ph_attn_mla(cl, l); } { PHASE_CTX(cl); ph_attn_diff(cl, l); } }  TE(16); }
        SEAM();
        if (RUN()) { TB(32); if (PHM & 32) for (int rep = 0; rep < NREP(32); ++rep) { PHASE_CTX(cl); SchedMerge1 S; S.init(&cl, l); EpiMerge1 E{&cl}; GEMM_UNITS(cl, S, E); }  TE(32); }
        SEAM();
        if (RUN()) { TB(64); if (PHM & 64) for (int rep = 0; rep < NREP(64); ++rep) { PHASE_CTX(cl); SchedMerge2 S; S.init(&cl, l); EpiMerge2 E{&cl}; GEMM_UNITS(cl, S, E); }  TE(64); }
        SEAM();
        if (RUN()) { TB(128); if (PHM & 128) { PHASE_CTX(cl); ph_t4_router(cl, l); }  TE(128); }
        SEAM();
        if (RUN()) { TB(256); if (PHM & 256) for (int rep = 0; rep < NREP(256); ++rep) { PHASE_CTX(cl); SchedGU S; S.c = &cl; S.T0 = moe_table(cl, l, 0); if (NCHUNK > 1) S.T1 = moe_table(cl, l, NCHUNK - 1); else { S.T1 = S.T0; S.T1.TR = 0; S.T1.nsh = 0; } EpiGU E{&cl, 0}; GEMM_UNITS(cl, S, E); }  TE(256); }
        SEAM();
        { constexpr int ch = 0;
            if (RUN()) { TB(512); if (PHM & 512) for (int rep = 0; rep < NREP(512); ++rep) { PHASE_CTX(cl); SchedD S; S.c = &cl; S.T = moe_table(cl, l, ch); EpiD E{&cl, ch}; GEMM_UNITS(cl, S, E); }  TE(512); }
            SEAM();
            if (RUN()) { TB(1024); if (PHM & 1024) { PHASE_CTX(cl); ph_combine(cl, l, ch); }  TE(1024); }
            SEAM();

        }
        if constexpr (NCHUNK > 1) { constexpr int ch = 1;
            if (RUN()) { TB(512); if (PHM & 512) for (int rep = 0; rep < NREP(512); ++rep) { PHASE_CTX(cl); SchedD S; S.c = &cl; S.T = moe_table(cl, l, ch); EpiD E{&cl, ch}; GEMM_UNITS(cl, S, E); }  TE(512); }
            SEAM();
            if (RUN()) { TB(1024); if (PHM & 1024) { PHASE_CTX(cl); ph_combine(cl, l, ch); }  TE(1024); }
            SEAM();

        }
    }
    if (TMASK) { __syncthreads(); if (blockIdx.x == 0) { unsigned long long tacc_ = 0ull; for (int i = 0; i < 64; ++i) tacc_ += TSLOT(i);
        const unsigned long long ts_ = __builtin_amdgcn_s_memrealtime(); while (__builtin_amdgcn_s_memrealtime() - ts_ < tacc_) __builtin_amdgcn_s_sleep(8); } }
#undef RUN
#undef SEAM
}
constexpr int N_STEPS = 2 * (8 + 2 * NCHUNK);

extern "C" void kernel_launch(void* const* d_in, const int* in_sizes, int n_in, void* d_out, int out_size, void* d_ws, size_t ws_size, hipStream_t stream) {
    static int grid = 0;
    if (grid == 0) {
        if (n_in != 34 || out_size != NB * SEQ * DM || ws_size < WS_END) { fprintf(stderr, "kernel_launch: unexpected shapes (n_in %d out %d ws %zu need %zu)\n", n_in, out_size, ws_size, (size_t)WS_END); grid = -1; return; }
        int dev = 0, cus = 0;
        if (hipGetDevice(&dev) != hipSuccess || hipDeviceGetAttribute(&cus, hipDeviceAttributeMultiprocessorCount, dev) != hipSuccess) { grid = -1; return; }
        if (hipFuncSetAttribute((const void*)fwd_kernel, hipFuncAttributeMaxDynamicSharedMemorySize, LDS_BYTES) != hipSuccess) { fprintf(stderr, "kernel_launch: hipFuncSetAttribute failed\n"); grid = -1; return; }
        int per_cu = 0; (void)hipOccupancyMaxActiveBlocksPerMultiprocessor(&per_cu, (const void*)fwd_kernel, 512, LDS_BYTES); (void)hipGetLastError();
        if (per_cu < 1) fprintf(stderr, "kernel_launch: occupancy query says %d\n", per_cu);
        grid = cus;
    }
    if (grid < 0) return;
    (void)hipMemsetAsync((char*)d_ws + WS_CTL, 0, CTL_BYTES, stream);
    Params p{};
    for (int i = 0; i < 34; ++i) p.in[i] = (const float*)d_in[i];
    p.out = (float*)d_out; p.ws = (unsigned char*)d_ws;
#if N_LAUNCH_MODE == 1
    p.step_lo = 0; p.step_hi = N_STEPS;
    hipLaunchKernelGGL(fwd_kernel, dim3(grid), dim3(512), LDS_BYTES, stream, p);
#else
    for (int s = 0; s < N_STEPS; ++s) { p.step_lo = s; p.step_hi = s + 1; hipLaunchKernelGGL(fwd_kernel, dim3(grid), dim3(512), LDS_BYTES, stream, p); }
#endif
}
```

```cpp
#include <hip/hip_runtime.h>
#include <cstdio>
#include <cstdint>
#include <cmath>

#ifndef PHM
#define PHM 0xFFFF
#endif
#ifndef USE_FAST_ATTN
#define USE_FAST_ATTN 1
#endif
#if USE_FAST_ATTN
#define ATTN_PHASE ph_attn_fast
#else
#define ATTN_PHASE ph_attn_naive
#endif
#ifndef REP
#define REP 0
#endif
#define NREP(bit) (((REP) & (bit)) ? 2 : 1)
#ifndef TMASK
#define TMASK 0
#endif
#ifndef ATT_TEST_NODIFF
#define ATT_TEST_NODIFF 0
#endif
#ifndef ATT_TEST_NOMLA
#define ATT_TEST_NOMLA 0
#endif
#ifndef N_LAUNCH_MODE
#define N_LAUNCH_MODE 1
#endif

#define GAS __attribute__((address_space(1)))
#define LAS __attribute__((address_space(3)))
typedef unsigned short bf16_t;
typedef float f32x4 __attribute__((ext_vector_type(4)));
typedef float f32x2 __attribute__((ext_vector_type(2)));
typedef unsigned u32x4 __attribute__((ext_vector_type(4)));
typedef unsigned u32x2 __attribute__((ext_vector_type(2)));
typedef short bf16x8 __attribute__((ext_vector_type(8)));

constexpr int DM = 1024, NB = 16, SEQ = 2048, CTXL = 256, RPB = SEQ + CTXL  ;
constexpr int NR = NB * RPB;
constexpr int NTILE = NR / 256;
constexpr int IN_COLS = 5792, KV_COLS = 1312;
constexpr int NEXP = 64, EFF = 256;
constexpr int NCHUNK = 1, CHROWS = NR / NCHUNK, CAP = CHROWS;
constexpr float EPSN = 1e-6f;
constexpr float LOG2E = 1.4426950408889634f;
constexpr float C2M = 0.10206207261596577f * LOG2E;
constexpr float C2D = 0.125f * LOG2E;

constexpr size_t WO_IN = 0;
constexpr size_t WO_VD = WO_IN + 2304ull * 1024 / 2;
constexpr size_t WO_G  = WO_VD + 512ull * 1024 / 2;
constexpr size_t WO_UK = WO_G + 3072ull * 1024 / 2;
constexpr size_t WO_UV = WO_UK + 512ull * 256;
constexpr size_t WO_UQ = WO_UV + 512ull * 256;
constexpr size_t WO_BM = WO_UQ + 768ull * 384;
constexpr size_t WO_PP = WO_BM + 1024ull * 512 / 2;
constexpr size_t WO_BD = WO_PP + 1024ull * 512 / 2;
constexpr size_t WO_O  = WO_BD + 1024ull * 512 / 2;
constexpr size_t WO_R  = WO_O + 1024ull * 1024 / 2;
constexpr size_t WO_GU = WO_R + 64ull * 1024;
constexpr size_t WO_D  = WO_GU + 65ull * 512 * 1024 / 2;
constexpr size_t W_ELEMS = WO_D + 65ull * 1024 * 256 / 2;

constexpr size_t WS_CTL = 0, CTL_BYTES = 3u << 20;
constexpr size_t CTL_BAR = 16384;
constexpr size_t CTL_CNT = 65536;
constexpr size_t CTL_SSKV = 131072;
constexpr size_t CTL_SSQ = CTL_SSKV + 2ull * NR * 8;
constexpr size_t CTL_MOD = CTL_SSQ + 2ull * NR * 8;
static_assert(CTL_MOD + 2ull * 17 * 6144 * 4 <= CTL_BYTES, "ctl");
constexpr size_t WS_TAB64 = CTL_BYTES;
constexpr size_t WS_TAB32 = WS_TAB64 + 2048ull * 32 * 8;
constexpr size_t WS_W = WS_TAB32 + 2048ull * 16 * 8;
constexpr size_t WS_REGT = WS_W + W_ELEMS * 2;
constexpr size_t WS_REGW = WS_REGT + (size_t)NCHUNK * 64 * CAP * 4;
constexpr size_t WS_ACT0 = WS_REGW + (size_t)NCHUNK * 64 * CAP * 4;
constexpr size_t SZ_ROW2K = (size_t)NR * 2048, SZ_ROW1K = (size_t)NR * 1024;
constexpr size_t A_HB = WS_ACT0;
constexpr size_t A_HX = A_HB + SZ_ROW2K;
constexpr size_t A_PD = A_HX;
constexpr size_t A_VMT = A_HX + SZ_ROW1K;
constexpr size_t A_KD = A_HX + SZ_ROW2K;
constexpr size_t A_VDT = A_KD + SZ_ROW1K;
constexpr size_t A_QD = A_VDT + SZ_ROW1K;
constexpr size_t A_OM = A_QD + SZ_ROW1K;
constexpr size_t A_PL = A_OM + SZ_ROW1K;
constexpr size_t A_CKV = A_PL + SZ_ROW1K;
constexpr size_t A_CQ = A_CKV + (size_t)NR * 512;
constexpr size_t A_KN = A_CQ + (size_t)NR * 768;
constexpr size_t A_KR = A_KN + SZ_ROW1K;
constexpr size_t A_QM = A_KR + (size_t)NR * 64;
constexpr size_t A_MIXEND = A_QM + (size_t)NR * 1536;
static_assert((size_t)NR * 3072 <= (size_t)NB * SEQ * DM * 4, "gates fit in d_out");
constexpr size_t A_MG = A_PL;
constexpr size_t A_Y1 = A_KN;
constexpr size_t A_SCR = A_KD;
static_assert(A_MG + SZ_ROW2K <= A_KN && A_Y1 + SZ_ROW2K <= A_MIXEND && 256ull * 131072 <= 2 * SZ_ROW1K, "overlays");
constexpr int ACT_TILES = (CHROWS * 8) / 256 + 64 + CHROWS / 256;
constexpr size_t A_ACT = A_KD;
constexpr size_t A_Y = A_ACT + (size_t)NCHUNK * ACT_TILES * 256 * 256;
constexpr size_t A_FXR = A_KD;
constexpr size_t A_YEND = (A_Y + (size_t)CHROWS * 9 * 1024) > A_MIXEND ? (A_Y + (size_t)CHROWS * 9 * 1024) : A_MIXEND;
constexpr size_t A_OD8 = A_HX + (size_t)NR * 512;
constexpr size_t WS_END = A_YEND;
static_assert(WS_END <= 684360192ull, "workspace budget");

__device__ __forceinline__ unsigned f2bf(float f) { unsigned u = __builtin_bit_cast(unsigned, f); return (u + 0x7fffu + ((u >> 16) & 1u)) >> 16; }
typedef __bf16 bf16x2_hw __attribute__((ext_vector_type(2)));
__device__ __forceinline__ unsigned pk2(float lo, float hi) { const f32x2 v = {lo, hi}; return __builtin_bit_cast(unsigned, __builtin_convertvector(v, bf16x2_hw)); }
__device__ __forceinline__ float bf2f(unsigned short b) { return __builtin_bit_cast(float, (unsigned)b << 16); }
__device__ __forceinline__ float bflo(unsigned w) { return __builtin_bit_cast(float, w << 16); }
__device__ __forceinline__ float bfhi(unsigned w) { return __builtin_bit_cast(float, w & 0xffff0000u); }
__device__ __forceinline__ u32x4 pack8(f32x4 lo, f32x4 hi) { u32x4 w; w.x = pk2(lo[0], lo[1]); w.y = pk2(lo[2], lo[3]); w.z = pk2(hi[0], hi[1]); w.w = pk2(hi[2], hi[3]); return w; }
__device__ __forceinline__ void unpack8(u32x4 w, f32x4& lo, f32x4& hi) { lo = (f32x4){bflo(w.x), bfhi(w.x), bflo(w.y), bfhi(w.y)}; hi = (f32x4){bflo(w.z), bfhi(w.z), bflo(w.w), bfhi(w.w)}; }
constexpr float Y_SCALE = 16.f, Y_INV = 1.f / 16.f;
constexpr float BR8_SCALE = 8.f, BR8_INV = 0.125f;
constexpr float MG8_SCALE = 4.f, MG8_INV = 0.25f;
constexpr float ACT8_SCALE = 2.f, ACT8_INV = 0.5f;
constexpr float W8_SCALE = 32.f, W8_INV = 1.f / 32.f;
__device__ __forceinline__ unsigned pack4_fp8s(float a, float b, float c_, float d, float sc) { int p = __builtin_amdgcn_cvt_pk_fp8_f32(a * sc, b * sc, 0, false); p = __builtin_amdgcn_cvt_pk_fp8_f32(c_ * sc, d * sc, p, true); return (unsigned)p; }
__device__ __forceinline__ unsigned pack4_fp8c(f32x4 v, float sc) { return pack4_fp8s(__builtin_amdgcn_fmed3f(v.x * sc, -448.f, 448.f), __builtin_amdgcn_fmed3f(v.y * sc, -448.f, 448.f), __builtin_amdgcn_fmed3f(v.z * sc, -448.f, 448.f), __builtin_amdgcn_fmed3f(v.w * sc, -448.f, 448.f), 1.f); }
typedef int i32x4 __attribute__((ext_vector_type(4)));
typedef int i32x8 __attribute__((ext_vector_type(8)));

__device__ __forceinline__ u32x2 pack8_fp8(f32x4 lo, f32x4 hi) {
    u32x2 w; int p = __builtin_amdgcn_cvt_pk_fp8_f32(lo[0] * Y_SCALE, lo[1] * Y_SCALE, 0, false); p = __builtin_amdgcn_cvt_pk_fp8_f32(lo[2] * Y_SCALE, lo[3] * Y_SCALE, p, true); w.x = (unsigned)p;
    p = __builtin_amdgcn_cvt_pk_fp8_f32(hi[0] * Y_SCALE, hi[1] * Y_SCALE, 0, false); p = __builtin_amdgcn_cvt_pk_fp8_f32(hi[2] * Y_SCALE, hi[3] * Y_SCALE, p, true); w.y = (unsigned)p; return w; }
__device__ __forceinline__ f32x4 unpack4_fp8(unsigned w) { const f32x2 a = __builtin_amdgcn_cvt_pk_f32_fp8((int)w, false), b = __builtin_amdgcn_cvt_pk_f32_fp8((int)w, true); return (f32x4){a.x, a.y, b.x, b.y}; }
__device__ __forceinline__ float wave_sum(float v) {
#pragma unroll
    for (int o = 1; o < 64; o <<= 1) v += __shfl_xor(v, o);
    return v;
}
constexpr float SS_SCALE = 16777216.f, SS_INV = 1.f / 16777216.f;
__device__ __forceinline__ void ss_add(unsigned long long* p, float s) { atomicAdd(p, (unsigned long long)(s * SS_SCALE)); }
__device__ __forceinline__ float ss_get(const unsigned long long* p) { return (float)(*p) * SS_INV; }
__device__ __forceinline__ float sigmoidf_(float x) { return __builtin_amdgcn_rcpf(1.f + __builtin_amdgcn_exp2f(x * -LOG2E)); }
__host__ __device__ __forceinline__ int pos2tok(int q) { const int fq = q >> 3, n = (q >> 2) & 1, i = q & 3; return 16 * (fq >> 1) + 4 * (fq & 1) + 8 * n + i; }
__host__ __device__ __forceinline__ int tok2pos(int t) { const int A = t >> 4, n = (t >> 3) & 1, B = (t >> 2) & 1, i = t & 3; return 8 * (2 * A + B) + 4 * n + i; }
__host__ __device__ __forceinline__ int ropedim(int RD, int p) { const int Q = p >> 3, n = (p >> 2) & 1, i = p & 3, P = 4 * Q + i, half = RD / 4; return (P < half ? 0 : RD / 2) + (P % half) + (n ? half : 0); }

#define XB_TMO      128
#define XB_XCNT(j)  (256  + 64 * (j))
#define XB_XSUB(j)  (1280 + 64 * (j))
#define XB_XGEN(j)  (2304 + 64 * (j))
#define XB_TOP      3328
#define XB_TOPGEN   3392
#define XCD_BAR_WORDS 3456
#define XB_SPIN_CAP (1u << 20)
__device__ __forceinline__ unsigned xb_ld(unsigned* p)              { return __hip_atomic_load(p, __ATOMIC_RELAXED, __HIP_MEMORY_SCOPE_AGENT); }
__device__ __forceinline__ unsigned xb_add(unsigned* p, unsigned v) { return __hip_atomic_fetch_add(p, v, __ATOMIC_RELAXED, __HIP_MEMORY_SCOPE_AGENT); }
__device__ __forceinline__ unsigned xb_xcc_id() { return (unsigned)__builtin_amdgcn_s_getreg((3 << 11) | 20) & 0xFu; }
#define XB_SPIN(cond, bar) do { unsigned _sp = 0; while (cond) { __builtin_amdgcn_s_sleep(1); \
    if ((++_sp & 255u) == 0u) { if (xb_ld(&(bar)[XB_TMO])) break; if (_sp > XB_SPIN_CAP) { atomicAdd(&(bar)[XB_TMO], 1u); break; } } } } while (0)
struct XcdBarrier { unsigned* bar; unsigned x; volatile LAS unsigned* st; };
__device__ __forceinline__ XcdBarrier xcd_barrier_post(unsigned* bar, volatile LAS unsigned* st) {
    XcdBarrier b; b.bar = bar; b.x = xb_xcc_id(); b.st = st;
    if (threadIdx.x == 0) (void)xb_add(&bar[XB_XCNT(b.x)], 1u);
    return b;
}
__device__ __forceinline__ void xcd_barrier_complete(unsigned* bar, unsigned x, unsigned& nloc, unsigned& nx) {
    const unsigned G = gridDim.x * gridDim.y * gridDim.z;
    unsigned sum, cnt, mine, sp = 0u;
    for (;;) {
        sum = 0u; cnt = 0u; mine = 0u;
#pragma unroll
        for (unsigned j = 0; j < 16; ++j) { const unsigned c = xb_ld(&bar[XB_XCNT(j)]); sum += c; cnt += (c > 0u) ? 1u : 0u; mine = (j == x) ? c : mine; }
        if (sum == G) break;
        __builtin_amdgcn_s_sleep(1);
        if ((++sp & 255u) == 0u) { if (xb_ld(&bar[XB_TMO])) break; if (sp > XB_SPIN_CAP) { atomicAdd(&bar[XB_TMO], 1u); break; } }
    }
    nloc = mine > 0u ? mine : 1u; nx = cnt > 0u ? cnt : 1u;
}
__device__ __forceinline__ void xcd_barrier(const XcdBarrier& b, bool leader  ) {
    asm volatile("s_waitcnt vmcnt(0)" ::: "memory");
    __syncthreads();
    if (leader) {
        unsigned* bar = b.bar;
        __builtin_amdgcn_s_waitcnt(0);
        unsigned nloc = b.st[0], nx = b.st[1];
        if (nloc == 0u) { xcd_barrier_complete(bar, b.x, nloc, nx); b.st[0] = nloc; b.st[1] = nx; }
        const unsigned old = xb_add(&bar[XB_XSUB(b.x)], 1u);
        const unsigned gen = old / nloc;
        if (old + 1u == (gen + 1u) * nloc) {
            __builtin_amdgcn_fence(__ATOMIC_RELEASE, "agent");
            asm volatile("s_waitcnt vmcnt(0)" ::: "memory");
            const unsigned og = xb_add(&bar[XB_TOP], 1u);
            const unsigned tg = og / nx;
            if (og + 1u == (tg + 1u) * nx) xb_add(&bar[XB_TOPGEN], 1u);
            else XB_SPIN(xb_ld(&bar[XB_TOPGEN]) == tg, bar);
            __builtin_amdgcn_fence(__ATOMIC_ACQUIRE, "agent");
            xb_add(&bar[XB_XGEN(b.x)], 1u);
            asm volatile("s_waitcnt vmcnt(0)" ::: "memory");
        } else {
            XB_SPIN(xb_ld(&bar[XB_XGEN(b.x)]) == gen, bar);
            __builtin_amdgcn_fence(__ATOMIC_ACQUIRE, "agent");
            asm volatile("s_waitcnt vmcnt(0)" ::: "memory");
        }
    }
    __syncthreads();
}

struct Params {
    const float* in[34];
    float* out; unsigned char* ws;
    int step_lo, step_hi;
};
enum { I_X = 0, I_C, I_CTX, I_CCTX, I_WMOD, I_BMOD, I_GPREMIX, I_GPOSTMIX, I_GPREFFN, I_GPOSTFFN, I_WIN, I_GCQ, I_WUQ, I_GCKV, I_WUKV, I_WPOOL, I_PSCALE,
       I_LQ1, I_LK1, I_LQ2, I_LK2, I_GSUBLN, I_WBMLA, I_WBPOOL, I_WBDIFF, I_WOUT, I_WROUTER, I_BROUTER, I_WEGATE, I_WEUP, I_WEDOWN, I_WSGATE, I_WSUP, I_WSDOWN };

typedef const __attribute__((address_space(4))) Params* ParamsK;
struct Ctx {
    ParamsK p;
    LAS unsigned char* lds;
    int tid, lane, wave, G, blk;
    GAS unsigned char* ws;
    size_t z;
};
#define INP(cx, I) ((const float*)((const GAS float*)(cx).p->in[I] + (cx).z))
__device__ __forceinline__ unsigned long long rfl64(unsigned long long v) { return ((unsigned long long)(unsigned)__builtin_amdgcn_readfirstlane((int)(unsigned)(v >> 32)) << 32) | (unsigned)__builtin_amdgcn_readfirstlane((int)(unsigned)v); }
#define PHASE_CTX(cl) Ctx cl = c; asm volatile("" : "+s"(cl.ws), "+s"(cl.z), "+s"(cl.blk), "+s"(cl.G), "+s"(cl.wave)); cl.wave = __builtin_amdgcn_readfirstlane(cl.wave); \
    { unsigned ones_ = ~0u; asm volatile("" : "+s"(ones_)); cl.lane = (int)__builtin_amdgcn_mbcnt_hi(ones_, __builtin_amdgcn_mbcnt_lo(ones_, 0u)); } cl.tid = cl.wave * 64 + cl.lane; \
    cl.blk = __builtin_amdgcn_readfirstlane(cl.blk); cl.G = __builtin_amdgcn_readfirstlane(cl.G); cl.ws = (GAS unsigned char*)rfl64((unsigned long long)cl.ws); cl.z = (size_t)rfl64((unsigned long long)cl.z)
constexpr int LDS_RING = 131072;
constexpr int LDS_BYTES = 163840;
constexpr int LDS_MISC = LDS_BYTES - 1024;

__device__ __forceinline__ bf16_t* wsb(const Ctx& c, size_t off) { return (bf16_t*)(c.ws + off); }
__device__ __forceinline__ bf16_t* wt(const Ctx& c, size_t eoff) { return (bf16_t*)(c.ws + WS_W) + eoff; }

__device__ __forceinline__ const float* res_rd(const Ctx& c, int l, int R) {
    const int b = R / RPB, j = R % RPB;
    if (j < CTXL) return INP(c, I_CTX) + (size_t)(b * CTXL + j) * DM;
    return INP(c, I_X) + (size_t)(b * SEQ + (j - CTXL)) * DM;
}
__device__ __forceinline__ bf16_t* hb_row(const Ctx& c, int R) { return (bf16_t*)(c.ws + A_HB) + (size_t)R * DM; }
__device__ __forceinline__ float* out_row(const Ctx& c, int R) { const int b = R / RPB, j = R % RPB; return c.p->out + (size_t)(b * SEQ + (j - CTXL)) * DM; }
__device__ __forceinline__ void load_res(const Ctx& c, int l, int R, int lane, f32x4 (&v)[4]) {
    if (l == 0) {
#pragma unroll
        for (int j = 0; j < 4; ++j) v[j] = *((const f32x4*)res_rd(c, 0, R) + lane + 64 * j);
    } else {
#pragma unroll
        for (int j = 0; j < 4; ++j) { const u32x2 w = *((const u32x2*)hb_row(c, R) + lane + 64 * j); v[j] = (f32x4){__builtin_bit_cast(float, w.x << 16), __builtin_bit_cast(float, w.x & 0xffff0000u), __builtin_bit_cast(float, w.y << 16), __builtin_bit_cast(float, w.y & 0xffff0000u)}; }
    }
}
__device__ __forceinline__ const float* modvec(const Ctx& c, int l, int R, int which) {
    const int b = R / RPB, j = R % RPB; const int bb = (j < CTXL) ? 16 : b;
    return (const float*)(c.ws + CTL_MOD) + ((size_t)(l * 17 + bb) * 6144 + which * 1024);
}

struct SrcCol { const float* p; int ld; bool ok; };
template <class Map>
__device__ __forceinline__ void cvt_item(const Map& map, const float* kscale, int K, bf16_t* Dst, int nblk_n, LAS float* scr, int item, int lane, bool q8 = false  ) {
    const int kb = item / nblk_n, nb = item % nblk_n, k0 = 64 * kb, n0 = 32 * nb;
    const SrcCol s = map(n0 + (lane & 31));
    float vv[32];
#pragma unroll
    for (int i = 0; i < 32; ++i) { const int kk = 2 * i + (lane >> 5); vv[i] = s.ok ? s.p[(size_t)(k0 + kk) * s.ld] : 0.f; }
#pragma unroll
    for (int i = 0; i < 32; ++i) { const int kk = 2 * i + (lane >> 5); float v = vv[i]; if (kscale) v *= kscale[k0 + kk]; scr[kk * 33 + (lane & 31)] = v; }
    asm volatile("s_waitcnt lgkmcnt(0)" ::: "memory");
    const int cch = lane & 7;
#pragma unroll
    for (int j = 0; j < 4; ++j) { const int n = (lane >> 3) + 8 * j; const LAS float* sp = scr + (8 * cch) * 33 + n;
        if (q8) { u32x2 o8; o8.x = pack4_fp8s(sp[0 * 33], sp[1 * 33], sp[2 * 33], sp[3 * 33], W8_SCALE); o8.y = pack4_fp8s(sp[4 * 33], sp[5 * 33], sp[6 * 33], sp[7 * 33], W8_SCALE);
            *(u32x2*)((unsigned char*)Dst + (size_t)(n0 + n) * K + k0 + 8 * cch) = o8; continue; }
        u32x4 o; o.x = pk2(sp[0 * 33], sp[1 * 33]); o.y = pk2(sp[2 * 33], sp[3 * 33]); o.z = pk2(sp[4 * 33], sp[5 * 33]); o.w = pk2(sp[6 * 33], sp[7 * 33]);
        *(u32x4*)(Dst + (size_t)(n0 + n) * K + k0 + 8 * cch) = o; }
    asm volatile("s_waitcnt lgkmcnt(0)" ::: "memory");
}
struct MapLin { const float* W; int ld; int off; __device__ SrcCol operator()(int n) const { return SrcCol{W + off + n, ld, true}; } };
struct MapWin { const float* W; __device__ SrcCol operator()(int n) const {
    int col; bool ok = true;
    if (n < 512) col = 288 + (n & ~63) + ropedim(64, n & 63);
    else if (n < 1024) { const int m = n - 512; col = KV_COLS + 384 + (m & ~63) + ropedim(64, m & 63); }
    else if (n < 1536) col = KV_COLS + 896 + (n - 1024);
    else if (n < 1792) col = n - 1536;
    else if (n < 2176) col = KV_COLS + (n - 1792);
    else if (n < 2208) col = 256 + ropedim(32, n - 2176);
    else { col = 0; ok = false; }
    return SrcCol{W + col, IN_COLS, ok}; } };
struct MapUkv { const float* W; int voff; __device__ SrcCol operator()(int n) const { return SrcCol{W + (n >> 6) * 128 + voff + (n & 63), 1024, true}; } };
struct MapUq { const float* W; __device__ SrcCol operator()(int n) const { const int h = n / 96, p = n % 96; return SrcCol{W + h * 96 + (p < 64 ? p : 64 + ropedim(32, p - 64)), 768, true}; } };
struct MapGU { const float* Wg; const float* Wu; __device__ SrcCol operator()(int n) const { const int pn = n >> 8, r = n & 255; return SrcCol{(r < 128 ? Wg + pn * 128 + r : Wu + pn * 128 + (r - 128)), 256, true}; } };


struct EItem { const float* p; int ld; bf16_t* dst; int K, k0, n0; bool q8; };
__device__ __forceinline__ EItem eitem_decode(const Ctx& ci, int l, int x, int lane) {
    constexpr int IT10 = 65 * 16 * 16;
    EItem it;
    if (x < IT10) { const int e = x / 256, ri = x % 256, kb = ri / 16, nb = ri % 16; it.k0 = 64 * kb; it.n0 = 32 * nb; it.K = 1024; it.ld = 256;
        const float* wg = (e < 64) ? INP(ci, I_WEGATE) + ((size_t)l * 64 + e) * 262144 : INP(ci, I_WSGATE) + (size_t)l * 262144;
        const float* wu = (e < 64) ? INP(ci, I_WEUP) + ((size_t)l * 64 + e) * 262144 : INP(ci, I_WSUP) + (size_t)l * 262144;
        const int n = it.n0 + (lane & 31), pn = n >> 8, r = n & 255; it.p = (r < 128 ? wg + pn * 128 + r : wu + pn * 128 + (r - 128));
        it.dst = wt(ci, WO_GU) + (size_t)e * 262144; it.q8 = true; }
    else { const int y = x - IT10, e = y / 128, ri = y % 128, kb = ri / 32, nb = ri % 32; it.k0 = 64 * kb; it.n0 = 32 * nb; it.K = 256; it.ld = 1024;
        const float* wd = (e < 64) ? INP(ci, I_WEDOWN) + ((size_t)l * 64 + e) * 262144 : INP(ci, I_WSDOWN) + (size_t)l * 262144;
        it.p = wd + it.n0 + (lane & 31); it.dst = wt(ci, WO_D) + (size_t)e * 131072; it.q8 = true; }
    return it;
}
__device__ __forceinline__ void eitem_load(const EItem& it, int lane, float (&vv)[32]) {
#pragma unroll
    for (int i = 0; i < 32; ++i) { const int kk = 2 * i + (lane >> 5); vv[i] = it.p[(size_t)(it.k0 + kk) * it.ld]; }
}
__device__ __forceinline__ void eitem_finish(const EItem& it, int lane, const float (&vv)[32], LAS float* scr) {
#pragma unroll
    for (int i = 0; i < 32; ++i) { const int kk = 2 * i + (lane >> 5); scr[kk * 33 + (lane & 31)] = vv[i]; }
    asm volatile("s_waitcnt lgkmcnt(0)" ::: "memory");
    const int cch = lane & 7;
#pragma unroll
    for (int j = 0; j < 4; ++j) { const int n = (lane >> 3) + 8 * j; const LAS float* sp = scr + (8 * cch) * 33 + n;
        if (it.q8) { u32x2 o8; o8.x = pack4_fp8s(sp[0 * 33], sp[1 * 33], sp[2 * 33], sp[3 * 33], W8_SCALE); o8.y = pack4_fp8s(sp[4 * 33], sp[5 * 33], sp[6 * 33], sp[7 * 33], W8_SCALE);
            *(u32x2*)((unsigned char*)it.dst + (size_t)(it.n0 + n) * it.K + it.k0 + 8 * cch) = o8; continue; }
        u32x4 o; o.x = pk2(sp[0 * 33], sp[1 * 33]); o.y = pk2(sp[2 * 33], sp[3 * 33]); o.z = pk2(sp[4 * 33], sp[5 * 33]); o.w = pk2(sp[6 * 33], sp[7 * 33]);
        *(u32x4*)(it.dst + (size_t)(it.n0 + n) * it.K + it.k0 + 8 * cch) = o; }
    asm volatile("s_waitcnt lgkmcnt(0)" ::: "memory");
}
__device__ __forceinline__ void ph_prologue(const Ctx& c, int l) {
    LAS float* scr = (LAS float*)(c.lds + c.wave * 16384);
    const int gw = c.blk * 8 + c.wave, NGW = c.G * 8;
    constexpr int IT0 = 72 * 16, IT1 = 16 * 16, IT2 = 96 * 16, IT3 = 16 * 4, IT4 = 16 * 4, IT5 = 24 * 6, IT6 = 32 * 8, IT7 = 32 * 8, IT8 = 32 * 16, IT9 = 2 * 16;
    constexpr int IT10 = 65 * 16 * 16, IT11 = 65 * 32 * 4, IT12 = 4 * 16 * 16;
    constexpr int NIT = IT0 + IT1 + IT2 + IT3 + IT4 + IT5 + IT6 + IT7 + IT8 + IT9 + IT12;
    for (int it = gw; it < NIT; it += NGW) {
        Ctx ci = c; asm volatile("" : "+s"(ci.z)); ci.z = (size_t)rfl64((unsigned long long)ci.z);
        int r = it; const float* w_in = INP(ci, I_WIN) + (size_t)l * DM * IN_COLS;
        if (r < IT0) { cvt_item(MapWin{w_in}, nullptr, 1024, wt(c, WO_IN), 72, scr, r, c.lane, true); continue; } r -= IT0;
        if (r < IT1) { cvt_item(MapLin{w_in, IN_COLS, 800}, nullptr, 1024, wt(c, WO_VD), 16, scr, r, c.lane, true); continue; } r -= IT1;
        if (r < IT2) { cvt_item(MapLin{w_in, IN_COLS, KV_COLS + 1408}, nullptr, 1024, wt(c, WO_G), 96, scr, r, c.lane, true); continue; } r -= IT2;
        if (r < IT3) { cvt_item(MapUkv{INP(ci, I_WUKV) + (size_t)l * 256 * 1024, 0}, INP(ci, I_GCKV) + l * 256, 256, wt(c, WO_UK), 16, scr, r, c.lane); continue; } r -= IT3;
        if (r < IT4) { cvt_item(MapUkv{INP(ci, I_WUKV) + (size_t)l * 256 * 1024, 64}, INP(ci, I_GCKV) + l * 256, 256, wt(c, WO_UV), 16, scr, r, c.lane); continue; } r -= IT4;
        if (r < IT5) { cvt_item(MapUq{INP(ci, I_WUQ) + (size_t)l * 384 * 768}, INP(ci, I_GCQ) + l * 384, 384, wt(c, WO_UQ), 24, scr, r, c.lane); continue; } r -= IT5;
        if (r < IT6) { cvt_item(MapLin{INP(ci, I_WBMLA) + (size_t)l * 512 * 1024, 1024, 0}, nullptr, 512, wt(c, WO_BM), 32, scr, r, c.lane, true); continue; } r -= IT6;
        if (r < IT7) { cvt_item(MapLin{INP(ci, I_WBDIFF) + (size_t)l * 512 * 1024, 1024, 0}, nullptr, 512, wt(c, WO_BD), 32, scr, r, c.lane, true); continue; } r -= IT7;
        if (r < IT8) { cvt_item(MapLin{INP(ci, I_WOUT) + (size_t)l * 1024 * 1024, 1024, 0}, nullptr, 1024, wt(c, WO_O), 32, scr, r, c.lane, true); continue; } r -= IT8;
        if (r < IT9) { cvt_item(MapLin{INP(ci, I_WROUTER) + (size_t)l * 1024 * 64, 64, 0}, nullptr, 1024, wt(c, WO_R), 2, scr, r, c.lane); continue; } r -= IT9;
        {
            const int g = r / 256, cb = (r / 16) % 16, db = r % 16, d = db * 64 + c.lane;
            const float* wp = INP(ci, I_WPOOL) + ((size_t)l * 4 + g) * 16384 + (size_t)(cb * 8) * 128;
            const float* ps = INP(ci, I_PSCALE) + l * 512 + g * 128;
            const float* wb = INP(ci, I_WBPOOL) + (size_t)l * 512 * 1024 + (size_t)(g * 128) * 1024 + d;
            float acc[8];
#pragma unroll
            for (int q = 0; q < 8; ++q) acc[q] = 0.f;
            for (int j = 0; j < 128; ++j) { const float bv = wb[(size_t)j * 1024] * ps[j];
#pragma unroll
                for (int q = 0; q < 8; ++q) acc[q] += wp[q * 128 + j] * bv; }
            *(u32x2*)((unsigned char*)wt(c, WO_PP) + (size_t)d * 512 + g * 128 + cb * 8) = (u32x2){pack4_fp8s(acc[0], acc[1], acc[2], acc[3], W8_SCALE), pack4_fp8s(acc[4], acc[5], acc[6], acc[7], W8_SCALE)};
        }
    }
    {
        constexpr int NE = IT10 + IT11;
        Ctx ci = c; asm volatile("" : "+s"(ci.z)); ci.z = (size_t)rfl64((unsigned long long)ci.z);
        float va[32], vb[32];
        int x = gw;
        EItem cur{}; if (x < NE) { cur = eitem_decode(ci, l, x, c.lane); eitem_load(cur, c.lane, va); }
        for (; x < NE; x += NGW) {
            EItem nxt{}; const bool hn = x + NGW < NE;
            if (hn) { nxt = eitem_decode(ci, l, x + NGW, c.lane); eitem_load(nxt, c.lane, vb); }
            eitem_finish(cur, c.lane, va, scr);
            if (hn) { cur = nxt;
#pragma unroll
                for (int i = 0; i < 32; ++i) va[i] = vb[i]; }
        }
    }
    if (l == 0) {
        const int gt = c.blk * 512 + c.tid, NT = c.G * 512;
        f32x2* t64 = (f32x2*)(c.ws + WS_TAB64); f32x2* t32 = (f32x2*)(c.ws + WS_TAB32);
        for (int i = gt; i < 2048 * 32; i += NT) { const int t = i >> 5, Pp = i & 31; const float pos = (float)(Pp < 16 ? (t >> 6) : (t & 63));
            const float inv = powf(10000.f, -(float)(2 * (Pp & 15)) / 32.f); const float a = pos * inv; t64[i] = (f32x2){cosf(a), sinf(a)}; }
        for (int i = gt; i < 2048 * 16; i += NT) { const int t = i >> 4, Pp = i & 15; const float pos = (float)(Pp < 8 ? (t >> 6) : (t & 63));
            const float inv = powf(10000.f, -(float)(2 * (Pp & 7)) / 16.f); const float a = pos * inv; t32[i] = (f32x2){cosf(a), sinf(a)}; }
        __syncthreads();
        if (c.blk < 192) {
            LAS float* sb = (LAS float*)(c.lds + c.wave * 10240);
            LAS float* part = (LAS float*)(c.lds + 81920);
            const int ll = c.blk / 96, cb = c.blk % 96, col = cb * 64 + c.lane, k0 = c.wave * 128;
#pragma unroll
            for (int qi = 0; qi < 34; ++qi) { const int q = c.lane + 64 * qi; const int b = q >> 7, k = q & 127; const float v = (b < 16) ? INP(c, I_C)[b * 1024 + k0 + k] : INP(c, I_CCTX)[k0 + k]; sb[k * 20 + b] = v / (1.f + __expf(-v)); }
            asm volatile("s_waitcnt lgkmcnt(0)" ::: "memory");
            float acc[17];
#pragma unroll
            for (int b = 0; b < 17; ++b) acc[b] = 0.f;
            const float* wm = INP(c, I_WMOD) + (size_t)ll * 1024 * 6144 + (size_t)k0 * 6144 + col;
#pragma unroll 32
            for (int k = 0; k < 128; ++k) { const float w = wm[(size_t)k * 6144];
#pragma unroll
                for (int b = 0; b < 17; ++b) acc[b] += sb[k * 20 + b] * w; }
#pragma unroll
            for (int b = 0; b < 17; ++b) part[(c.wave * 17 + b) * 64 + c.lane] = acc[b];
            __syncthreads();
            float* MOD = (float*)(c.ws + CTL_MOD);
            for (int q = c.tid; q < 17 * 64; q += 512) { const int b = q >> 6, cc = q & 63; float sum = INP(c, I_BMOD)[ll * 6144 + cb * 64 + cc];
#pragma unroll
                for (int w = 0; w < 8; ++w) sum += part[(w * 17 + b) * 64 + cc];
                MOD[(size_t)(ll * 17 + b) * 6144 + cb * 64 + cc] = sum; }
        }
    }
}

__device__ __forceinline__ void load_row_f32(const float* row, int lane, f32x4 (&v)[4]) {
#pragma unroll
    for (int j = 0; j < 4; ++j) v[j] = *((const f32x4*)row + lane + 64 * j);
}
__device__ __forceinline__ float row_sumsq(const f32x4 (&v)[4]) {
    float s = 0.f;
#pragma unroll
    for (int j = 0; j < 4; ++j) s += (v[j].x * v[j].x + v[j].y * v[j].y) + (v[j].z * v[j].z + v[j].w * v[j].w);
    return wave_sum(s);
}
__device__ __forceinline__ void norm_mod_store(const f32x4 (&v)[4], float rstd, const float* g, const float* shift, const float* scale, bf16_t* orow, int lane) {
#pragma unroll
    for (int j = 0; j < 4; ++j) { const int o = lane + 64 * j; const f32x4 gg = *((const f32x4*)g + o), sh = *((const f32x4*)shift + o), sc = *((const f32x4*)scale + o);
        const f32x4 y = (v[j] * rstd * gg) * (sc + 1.0f) + sh;
        u32x2 w; w.x = pk2(y.x, y.y); w.y = pk2(y.z, y.w); *((u32x2*)orow + o) = w; }
}
__device__ __forceinline__ void mod_fold(const Ctx& c, const float* g, int l, int R, int w_shift, int w_scale, int lane, f32x4 (&mul)[4], f32x4 (&add)[4]) {
    const float* sh = modvec(c, l, R, w_shift); const float* sc = modvec(c, l, R, w_scale);
#pragma unroll
    for (int j = 0; j < 4; ++j) { const int o = lane + 64 * j; mul[j] = *((const f32x4*)g + o) * (*((const f32x4*)sc + o) + 1.0f); add[j] = *((const f32x4*)sh + o); }
}
__device__ __forceinline__ int batch_key(int R) { return (R % RPB) < CTXL ? 16 + 32 * (R / RPB) : R / RPB; }
__device__ __forceinline__ void ph_t1(const Ctx& c, int l) {
    const int gw = c.blk * 8 + c.wave, NGW = c.G * 8;
    const int per = (NR + NGW - 1) / NGW, r0 = gw * per, r1 = min(NR, r0 + per);
    f32x4 v[4], vn[4], vn2[4], mul[4], add[4]; int key = -1;
#pragma unroll
    for (int j = 0; j < 4; ++j) { v[j] = (f32x4){0.f, 0.f, 0.f, 0.f}; vn[j] = v[j]; vn2[j] = v[j]; }
    int R = r0;
    if (R < r1) load_row_f32(res_rd(c, l, R), c.lane, v);
    if (R + 1 < r1) load_row_f32(res_rd(c, l, R + 1), c.lane, vn);
    for (; R < r1; ++R) {
        if (R + 2 < r1) load_row_f32(res_rd(c, l, R + 2), c.lane, vn2);
        if (batch_key(R) != key) { key = batch_key(R); mod_fold(c, INP(c, I_GPREMIX) + l * DM, l, R, 0, 1, c.lane, mul, add); }
        const float rstd = 1.f / sqrtf(row_sumsq(v) * (1.f / DM) + EPSN);
        unsigned char* orow = (unsigned char*)(c.ws + A_HX) + (size_t)R * DM;
#pragma unroll
        for (int j = 0; j < 4; ++j) { const f32x4 y = (v[j] * rstd) * mul[j] + add[j]; *((unsigned*)orow + c.lane + 64 * j) = pack4_fp8c(y, 1.f); }
#pragma unroll
        for (int j = 0; j < 4; ++j) { v[j] = vn[j]; vn[j] = vn2[j]; }
    }
}

struct Unit {
    const bf16_t* a;
    const bf16_t* b;
    const unsigned* rows;
    int K, kind, pm, pn, bperm, nrows, aux, aux2;
};
__device__ __forceinline__ int b_srcrow(int q, int bperm) { return (q & ~31) + (bperm ? pos2tok(q & 31) : (q & 31)); }

template <class Sched, class Epi>
__device__ __forceinline__ void gemm_units_naive(const Ctx& c, const Sched& S, const Epi& E) {
    Unit u;
    for (int i = 0; S.next(i, u); ++i) {
        for (int it = c.tid; it < 256 * 16; it += 512) {
            const int row = it >> 4, c8 = (it & 15) * 8;
            const bf16_t* ar;
            if (u.rows) { const int rr = (row < u.nrows) ? (int)(u.rows[row] >> 4) : u.aux2; ar = u.a + (size_t)rr * u.K; } else ar = u.a + (size_t)row * u.K;
            float acc[16];
#pragma unroll
            for (int q = 0; q < 16; ++q) acc[q] = 0.f;
            const bf16_t* br[16];
#pragma unroll
            for (int q = 0; q < 16; ++q) br[q] = u.b + (size_t)b_srcrow((q < 8 ? c8 + q : 128 + c8 + (q - 8)), u.bperm) * u.K;
            for (int k = 0; k < u.K; k += 8) {
                f32x4 alo, ahi; unpack8(*(const u32x4*)(ar + k), alo, ahi);
#pragma unroll
                for (int q = 0; q < 16; ++q) { f32x4 blo, bhi; unpack8(*(const u32x4*)(br[q] + k), blo, bhi);
                    acc[q] += (alo.x * blo.x + alo.y * blo.y) + (alo.z * blo.z + alo.w * blo.w) + (ahi.x * bhi.x + ahi.y * bhi.y) + (ahi.z * bhi.z + ahi.w * bhi.w); }
            }
            { typename Epi::UState ust_; E.unit_begin(u, c8, ust_); typename Epi::Pre pre_; E.pre(u, row, c8, pre_);
              E.apply(u, row, c8, pre_, ust_, (f32x4){acc[0], acc[1], acc[2], acc[3]}, (f32x4){acc[4], acc[5], acc[6], acc[7]}, (f32x4){acc[8], acc[9], acc[10], acc[11]}, (f32x4){acc[12], acc[13], acc[14], acc[15]}); }
        }
        asm volatile("s_waitcnt vmcnt(0)" ::: "memory");
        __syncthreads();
    }
}

namespace mm {
constexpr int BK = 64, HALF = 128, HTB = HALF * BK * 2;
__device__ __forceinline__ int lds_byte(int r, int c) { const int st = (r >> 4) * 2 + (c >> 5), rr = r & 15, cc = c & 31, ob = rr * 64 + cc * 2; return st * 1024 + (ob ^ (((ob >> 9) & 1) << 5)); }
__device__ __forceinline__ void stage_rc(int b, int& R, int& C) { const int st = b / 1024, sb = b % 1024, swz = sb ^ (((sb >> 9) & 1) << 5); R = (st >> 1) * 16 + swz / 64; C = (st & 1) * 32 + (swz % 64) / 2; }
__device__ __forceinline__ int perm32(int rho) { const int n = rho >> 4, i = rho & 15; return 8 * (i >> 2) + 4 * n + (i & 3); }
__device__ __forceinline__ int permtau(int rho) { const int n = rho >> 4, fq = (rho >> 2) & 3, i = rho & 3; return 16 * (fq >> 1) + 4 * (fq & 1) + 8 * n + i; }
template <bool GATHER> struct LaneOffT { unsigned a0[2], a1[GATHER ? 2 : 1], b[2]; };
template <bool GATHER> __device__ __forceinline__ void lane_offsets(const Unit& u, const GAS unsigned char* ws, int tid, LaneOffT<GATHER>& o) {
    int Rl[2], Cl[2]; asm volatile("" : "+v"(tid));
#pragma unroll
    for (int i = 0; i < 2; ++i) stage_rc(tid * 16 + i * 8192, Rl[i], Cl[i]);
    const unsigned K2 = (unsigned)u.K * 2u; const unsigned ab = (unsigned)((unsigned long long)u.a - (unsigned long long)ws), bb = (unsigned)((unsigned long long)u.b - (unsigned long long)ws);
#pragma unroll
    for (int i = 0; i < 2; ++i) {
        if constexpr (GATHER) {
            if (u.rows) { const int r0 = Rl[i], r1 = 128 + Rl[i];
                const unsigned t0 = (r0 < u.nrows) ? (u.rows[r0] >> 4) : (unsigned)u.aux2, t1 = (r1 < u.nrows) ? (u.rows[r1] >> 4) : (unsigned)u.aux2;
                o.a0[i] = ab + t0 * K2 + (unsigned)Cl[i] * 2u; o.a1[i] = ab + t1 * K2 + (unsigned)Cl[i] * 2u; }
            else { o.a0[i] = ab + (unsigned)Rl[i] * K2 + (unsigned)Cl[i] * 2u; o.a1[i] = o.a0[i] + 128u * K2; }
        } else o.a0[i] = ab + (unsigned)Rl[i] * K2 + (unsigned)Cl[i] * 2u;
        const int rho_ = Rl[i] & 31; const int Rb = (u.bperm == 2) ? (64 * (Rl[i] >> 5) + 16 * ((rho_ >> 2) & 3) + 4 * (rho_ >> 4) + (rho_ & 3)) : ((Rl[i] & ~31) + (u.bperm ? permtau(rho_) : perm32(rho_)));
        o.b[i] = bb + (unsigned)Rb * K2 + (unsigned)Cl[i] * 2u;
    }
}
}

template <class Sched, class Epi>
__device__ __forceinline__ void gemm_units_mfma(const Ctx& c, const Sched& S, const Epi& E) {
    constexpr bool GATHER = Sched::GATHER;
    using namespace mm;
    LAS unsigned char* lds = c.lds;
    const int tid = c.tid, wid = c.wave, lane = c.lane, wr = wid >> 2, wc = wid & 3, fr = lane & 15, fq = lane >> 4;
    const unsigned ldsw = (unsigned)wid * 1024u;
    const int aoff = lds_byte(wr * 64 + fr, fq * 8), boff = lds_byte(wc * 32 + fr, fq * 8);
    const GAS unsigned char* wsb_ = c.ws;
#define MM_SA(b, h) (((b) * 2 + (h)) * HTB)
#define MM_SB(b, h) ((4 + (b) * 2 + (h)) * HTB)
#define MM_STAGE(bufoff, o0, o1, kofs) do { const GAS unsigned char* kb_ = wsb_ + (size_t)(kofs);   \
        __builtin_amdgcn_global_load_lds((const GAS unsigned*)(kb_ + (o0)), (LAS unsigned*)(lds + (bufoff) + ldsw), 16, 0, 0); \
        __builtin_amdgcn_global_load_lds((const GAS unsigned*)(kb_ + (o1)), (LAS unsigned*)(lds + (bufoff) + ldsw + 8192), 16, 0, 0); } while (0)
#define MM_LDA(dst, b, h) do { _Pragma("unroll") for (int m = 0; m < 4; ++m) _Pragma("unroll") for (int k = 0; k < 2; ++k) dst[m][k] = *(const LAS bf16x8*)(lds + MM_SA(b, h) + aoff + m * 2048 + k * 1024); } while (0)
#define MM_LDB(dst, b, h) do { _Pragma("unroll") for (int n = 0; n < 2; ++n) _Pragma("unroll") for (int k = 0; k < 2; ++k) dst[n][k] = *(const LAS bf16x8*)(lds + MM_SB(b, h) + boff + n * 2048 + k * 1024); } while (0)
#define MM_CAT8(x) __builtin_shufflevector(__builtin_bit_cast(i32x4, (x)[0]), __builtin_bit_cast(i32x4, (x)[1]), 0, 1, 2, 3, 4, 5, 6, 7)
#define MM_MMA(ai, bj, At, Bt) do { __builtin_amdgcn_s_setprio(1); \
        if constexpr (Epi::FP8) {   \
            _Pragma("unroll") for (int m = 0; m < 4; ++m) _Pragma("unroll") for (int n = 0; n < 2; ++n) \
                acc[ai][bj][m][n] = __builtin_amdgcn_mfma_scale_f32_16x16x128_f8f6f4(MM_CAT8(Bt[n]), MM_CAT8(At[m]), acc[ai][bj][m][n], 0, 0, 0, 0, 0, 0); \
        } else { _Pragma("unroll") for (int m = 0; m < 4; ++m) _Pragma("unroll") for (int n = 0; n < 2; ++n) _Pragma("unroll") for (int k = 0; k < 2; ++k) \
            acc[ai][bj][m][n] = __builtin_amdgcn_mfma_f32_16x16x32_bf16(Bt[n][k], At[m][k], acc[ai][bj][m][n], 0, 0, 0); } \
        __builtin_amdgcn_s_setprio(0); } while (0)
#define MM_WAIT_V(n) asm volatile("s_waitcnt vmcnt(" #n ")" ::: "memory")
#define MM_WAIT_L(n) asm volatile("s_waitcnt lgkmcnt(" #n ")" ::: "memory")
#define MM_BAR __builtin_amdgcn_s_barrier()
#define MM_SCHED __builtin_amdgcn_sched_barrier(0)
    Unit cur, nxt; int ui = 0;
    if (!S.next(0, cur)) return;
    LaneOffT<GATHER> co; lane_offsets<GATHER>(cur, wsb_, tid, co);
#define MM_A1(i) (GATHER ? co.a1[GATHER ? (i) : 0] : co.a0[i] + hs)
    f32x4 acc[2][2][4][2];
#pragma unroll
    for (int a = 0; a < 2; ++a)
#pragma unroll
        for (int b = 0; b < 2; ++b)
#pragma unroll
            for (int m = 0; m < 4; ++m)
#pragma unroll
                for (int n = 0; n < 2; ++n) acc[a][b][m][n] = (f32x4){0.f, 0.f, 0.f, 0.f};
    bf16x8 At[4][2], B0[2][2], B1[2][2];
    typename Epi::Pre epre_[Epi::EARLY ? Epi::GROUP : 1];
    {
        const unsigned hs = 256u * (unsigned)cur.K, hsb = (cur.bperm == 2 ? 16u : 256u) * (unsigned)cur.K;
        MM_STAGE(MM_SB(0, 0), co.b[0], co.b[1], 0); MM_STAGE(MM_SB(0, 1), co.b[0] + hsb, co.b[1] + hsb, 0); MM_STAGE(MM_SA(0, 0), co.a0[0], co.a0[1], 0); MM_STAGE(MM_SA(0, 1), MM_A1(0), MM_A1(1), 0);
        if (wr == 1) MM_BAR;
        MM_WAIT_V(2); MM_BAR;
        MM_STAGE(MM_SB(1, 0), co.b[0], co.b[1], 128); MM_STAGE(MM_SA(1, 0), co.a0[0], co.a0[1], 128); MM_STAGE(MM_SB(1, 1), co.b[0] + hsb, co.b[1] + hsb, 128);
        MM_WAIT_V(6); MM_BAR;
    }
    for (;;) {
        const bool has_next = S.next(ui + 1, nxt);
        if (!has_next) nxt = cur;
        LaneOffT<GATHER> nco;
        if constexpr (GATHER) lane_offsets<GATHER>(nxt, wsb_, tid, nco);
        const int nt = cur.K / BK; unsigned hs = 256u * (unsigned)cur.K, hsb = (cur.bperm == 2 ? 16u : 256u) * (unsigned)cur.K;
        for (int t = 0; t < nt; t += 2) {
            const bool last = (t == nt - 2);
            const unsigned k1 = (unsigned)(t + 1) * 128u, k2 = last ? 0u : (unsigned)(t + 2) * 128u; unsigned k3 = k2 + 128u;
            asm volatile("" : "+s"(k3)); k3 = (unsigned)__builtin_amdgcn_readfirstlane((int)k3);
            MM_LDB(B0, 0, 0); MM_LDB(B1, 0, 1); MM_SCHED; MM_LDA(At, 0, 0); MM_STAGE(MM_SA(1, 1), MM_A1(0), MM_A1(1), k1);
            MM_WAIT_V(8); MM_WAIT_L(0); MM_BAR; MM_MMA(0, 0, At, B0); MM_MMA(0, 1, At, B1); MM_BAR; MM_SCHED;
            if constexpr (Epi::ROWTAB) { if (last) E.rowtab_dma(cur, lds, wid, lane, ui & 1); }
            if (Epi::EARLY && last) { int c8e_ = wc * 32 + fq * 8; asm volatile("" : "+v"(c8e_));
                _Pragma("unroll") for (int q = 0; q < Epi::GROUP; ++q) { int re_ = (q >> 2) * 128 + wr * 64 + (q & 3) * 16 + fr; asm volatile("" : "+v"(re_)); E.pre(cur, re_, c8e_, epre_[q]); } }
            if (last) { if constexpr (GATHER) co = nco; else lane_offsets<GATHER>(nxt, wsb_, tid, co); hs = 256u * (unsigned)nxt.K; hsb = (nxt.bperm == 2 ? 16u : 256u) * (unsigned)nxt.K; }
            MM_LDA(At, 0, 1); MM_STAGE(MM_SB(0, 0), co.b[0], co.b[1], k2); MM_STAGE(MM_SB(0, 1), co.b[0] + hsb, co.b[1] + hsb, k2); MM_STAGE(MM_SA(0, 0), co.a0[0], co.a0[1], k2);
            MM_WAIT_V(8); MM_WAIT_L(0); MM_BAR; MM_MMA(1, 0, At, B0); MM_MMA(1, 1, At, B1); MM_BAR; MM_SCHED;
            MM_LDB(B0, 1, 0); MM_LDB(B1, 1, 1); MM_SCHED; MM_LDA(At, 1, 0); MM_STAGE(MM_SA(0, 1), MM_A1(0), MM_A1(1), k2);
            MM_WAIT_V(8); MM_WAIT_L(0); MM_BAR; MM_MMA(0, 0, At, B0); MM_MMA(0, 1, At, B1); MM_BAR; MM_SCHED;
            MM_LDA(At, 1, 1); MM_STAGE(MM_SB(1, 0), co.b[0], co.b[1], k3); MM_STAGE(MM_SB(1, 1), co.b[0] + hsb, co.b[1] + hsb, k3); MM_STAGE(MM_SA(1, 0), co.a0[0], co.a0[1], k3);
            MM_WAIT_V(8); MM_WAIT_L(0); MM_BAR; MM_MMA(1, 0, At, B0); MM_MMA(1, 1, At, B1); MM_BAR; MM_SCHED;
        }
        if (wr == 0) MM_BAR;
        typename Epi::UState ust_; E.unit_begin(cur, wc * 32 + fq * 8, ust_); const int par_ = ui & 1;
        constexpr int GRP = Epi::GROUP;
#pragma unroll
        for (int g0 = 0; g0 < 8; g0 += GRP) {
            int rows_[GRP]; typename Epi::Pre pre_[GRP]; int c8_ = wc * 32 + fq * 8; asm volatile("" : "+v"(c8_));
            int frx_ = wr * 64 + fr; asm volatile("" : "+v"(frx_));
#pragma unroll
            for (int q = 0; q < GRP; ++q) { const int ai = (g0 + q) >> 2, m = (g0 + q) & 3; rows_[q] = ai * 128 + m * 16 + frx_; asm volatile("" : "+v"(rows_[q]));
                if (Epi::EARLY && g0 == 0) pre_[q] = epre_[q]; else if constexpr (Epi::ROWTAB) E.pre_tab(cur, rows_[q], lds, par_, pre_[q]); else E.pre(cur, rows_[q], c8_, pre_[q]); }
            MM_SCHED;
            if constexpr (Epi::PAIR) {
#pragma unroll
                for (int q = 0; q < GRP; q += 2) { const int ai = (g0 + q) >> 2, m = (g0 + q) & 3;
                    E.apply2(cur, rows_[q], rows_[q + 1], c8_, pre_[q], pre_[q + 1], ust_, acc[ai][0][m][0], acc[ai][0][m][1], acc[ai][1][m][0], acc[ai][1][m][1],
                             acc[ai][0][m + 1][0], acc[ai][0][m + 1][1], acc[ai][1][m + 1][0], acc[ai][1][m + 1][1]); }
            } else
#pragma unroll
            for (int q = 0; q < GRP; ++q) { const int ai = (g0 + q) >> 2, m = (g0 + q) & 3;
                if constexpr (Epi::CHAIN) E.apply_rw(cur, rows_[q], c8_, pre_[q], ust_, acc[ai][0][m][0], acc[ai][0][m][1], acc[ai][1][m][0], acc[ai][1][m][1]);
                else E.apply(cur, rows_[q], c8_, pre_[q], ust_, acc[ai][0][m][0], acc[ai][0][m][1], acc[ai][1][m][0], acc[ai][1][m][1]); }
            MM_SCHED;
        }
        if (!has_next) break;
        bool keep_ = false; if constexpr (Epi::CHAIN) keep_ = E.keep_acc(cur);
        if (!keep_) {
#pragma unroll
        for (int a = 0; a < 2; ++a)
#pragma unroll
            for (int b = 0; b < 2; ++b)
#pragma unroll
                for (int m = 0; m < 4; ++m)
#pragma unroll
                    for (int n = 0; n < 2; ++n) acc[a][b][m][n] = (f32x4){0.f, 0.f, 0.f, 0.f};
        }
        cur = nxt; ++ui;
        if (wr == 1) MM_BAR;
    }
    MM_WAIT_V(0);
    MM_BAR;
#undef MM_SA
#undef MM_A1
#undef MM_SB
#undef MM_STAGE
#undef MM_LDA
#undef MM_LDB
#undef MM_MMA
#undef MM_CAT8
#undef MM_WAIT_V
#undef MM_WAIT_L
#undef MM_BAR
#undef MM_SCHED
}

#ifndef USE_MFMA_GEMM
#define USE_MFMA_GEMM 1
#endif
#if USE_MFMA_GEMM
#define GEMM_UNITS gemm_units_mfma
#else
#define GEMM_UNITS gemm_units_naive
#endif

__device__ __forceinline__ void rope4(f32x4& lo, f32x4& hi, const f32x2* cs) {
#pragma unroll
    for (int i = 0; i < 4; ++i) { const f32x2 t = cs[i]; const float a = lo[i], b = hi[i]; lo[i] = a * t.x - b * t.y; hi[i] = a * t.y + b * t.x; }
}

__device__ __forceinline__ int deal_xcd(const Ctx& c, int i) { return (c.G == 256) ? ((i * 8 + (c.blk & 7)) * 32 + (c.blk >> 3)) : (i * c.G + c.blk); }
struct SchedProj {
    static constexpr bool GATHER = false;
    const Ctx* c; int l, n_main, n_ctx, n_tot;
    __device__ void init(const Ctx* cc, int ll) { c = cc; l = ll; n_main = 128 * 21; n_ctx = 16 * (l == 0 ? 21 : 4); n_tot = n_main + n_ctx + 288; }
    __device__ bool next(int i, Unit& u) const {
        const int L = (c->G == 256) ? ((i * 8 + (c->blk & 7)) * 32 + (c->blk >> 3)) : (i * c->G + c->blk); if (L >= n_tot) return false;
        u.rows = nullptr; u.nrows = 256; u.aux = l; u.aux2 = 0; u.K = 512;
        if (L < n_main + n_ctx) {
            int pm, pn;
            if (L < n_main) { const int rg = L / 168, q = L % 168; pn = q >> 3; const int lt = rg * 8 + (q & 7); pm = (lt >> 3) * 9 + 1 + (lt & 7); }
            else { const int q = L - n_main; if (l == 0) { pm = (q / 21) * 9; pn = q % 21; } else { pm = (q >> 2) * 9; const int s = q & 3; pn = (s < 2) ? s : (s == 2 ? 6 : 8); } }
            u.pm = pm; u.pn = pn; u.kind = 0; u.bperm = (pn >= 9) ? 2 : 0;
            u.a = wsb(*c, A_HX) + (size_t)pm * 256 * 512; u.b = (pn < 9) ? wt(*c, WO_IN) + (size_t)pn * 256 * 512 : wt(*c, WO_G) + (size_t)(pn - 9) * 256 * 512;
        } else {
            const int q = L - n_main - n_ctx; u.pm = q / 144; u.pn = q % 144; u.kind = 1; u.bperm = 1;
            u.a = wt(*c, WO_VD) + (size_t)u.pm * 256 * 512; u.b = wsb(*c, A_HX) + (size_t)u.pn * 256 * 512;
        }
        return true;
    }
};
struct EpiProj {
    const Ctx* c; int l;
    __device__ __forceinline__ float one(const Unit& u, int R, bool lat, int t, int colp, f32x4 lo, f32x4 hi) const {
        const Ctx& C = *c;
        if (u.pn >= 9) {
            unsigned w0 = 0u, w1 = 0u;
#pragma unroll
            for (int i = 0; i < 4; ++i) { w0 = __builtin_amdgcn_cvt_pk_u8_f32(sigmoidf_(lo[i]) * 255.f, i, w0); w1 = __builtin_amdgcn_cvt_pk_u8_f32(sigmoidf_(hi[i]) * 255.f, i, w1); }
            *(u32x2*)((unsigned char*)C.p->out + (size_t)R * 3072 + (u.pn - 9) * 256 + colp) = (u32x2){w0, w1}; return 0.f; }
        switch (u.pn) {
        case 0: case 1: case 2: case 3: {
            const int col = (u.pn & 1) * 256 + colp;
            if (lat) rope4(lo, hi, (const f32x2*)(C.ws + WS_TAB64) + t * 32 + ((col & 63) >> 3) * 4);
            if (u.pn >= 2) { lo *= C2D; hi *= C2D; }
            *(u32x4*)(wsb(C, u.pn < 2 ? A_KD : A_QD) + (size_t)R * 512 + col) = pack8(lo, hi); break; }
        case 4: case 5: *(u32x4*)(wsb(C, A_PL) + (size_t)R * 512 + (u.pn - 4) * 256 + colp) = pack8(lo, hi); break;
        case 6: { *(u32x4*)(wsb(C, A_CKV) + (size_t)R * 256 + colp) = pack8(lo, hi);
            const float s = (lo.x * lo.x + lo.y * lo.y) + (lo.z * lo.z + lo.w * lo.w) + (hi.x * hi.x + hi.y * hi.y) + (hi.z * hi.z + hi.w * hi.w);
            return s; }
        case 7: { *(u32x4*)(wsb(C, A_CQ) + (size_t)R * 384 + colp) = pack8(lo, hi);
            const float s = (lo.x * lo.x + lo.y * lo.y) + (lo.z * lo.z + lo.w * lo.w) + (hi.x * hi.x + hi.y * hi.y) + (hi.z * hi.z + hi.w * hi.w);
            return s; }
        default: {
            if (colp < 128) { *(u32x4*)(wsb(C, A_CQ) + (size_t)R * 384 + 256 + colp) = pack8(lo, hi);
                const float s = (lo.x * lo.x + lo.y * lo.y) + (lo.z * lo.z + lo.w * lo.w) + (hi.x * hi.x + hi.y * hi.y) + (hi.z * hi.z + hi.w * hi.w);
                return s; }
            else if (colp < 160) { const int p = colp - 128;
                if (lat) rope4(lo, hi, (const f32x2*)(C.ws + WS_TAB32) + t * 16 + (p >> 3) * 4);
                *(u32x4*)(wsb(C, A_KR) + (size_t)R * 32 + p) = pack8(lo, hi); }
            break; }
        }
        return 0.f;
    }
    static constexpr int GROUP = 4; static constexpr bool EARLY = false; static constexpr bool CHAIN = false; static constexpr bool ROWTAB = false; struct Pre {}; struct UState {}; __device__ __forceinline__ void unit_begin(const Unit&, int, UState&) const {} __device__ __forceinline__ void pre(const Unit&, int, int, Pre&) const {}
    static constexpr bool PAIR = false; static constexpr bool FP8 = true;
    __device__ __forceinline__ void apply(const Unit& u, int row, int c8, const Pre&, const UState&, f32x4 v0l, f32x4 v0h, f32x4 v1l, f32x4 v1h) const {
        const Ctx& C = *c;
        v0l *= W8_INV; v0h *= W8_INV; v1l *= W8_INV; v1h *= W8_INV;
        if (u.kind == 1) {
            bf16_t* o = wsb(C, A_VDT) + (size_t)(u.pm * 256 + row) * NR + (size_t)u.pn * 256;
            *(u32x4*)(o + c8) = pack8(v0l, v0h); *(u32x4*)(o + 128 + c8) = pack8(v1l, v1h); return; }
        const int R = u.pm * 256 + row; const bool lat = (u.pm % 9) != 0; const int t = (R % RPB) - CTXL;
        if (u.pn >= 9) {
            u32x4 w = (u32x4){0u, 0u, 0u, 0u};
#pragma unroll
            for (int i = 0; i < 4; ++i) { w.x = __builtin_amdgcn_cvt_pk_u8_f32(sigmoidf_(v0l[i]) * 255.f, i, w.x); w.y = __builtin_amdgcn_cvt_pk_u8_f32(sigmoidf_(v0h[i]) * 255.f, i, w.y);
                                          w.z = __builtin_amdgcn_cvt_pk_u8_f32(sigmoidf_(v1l[i]) * 255.f, i, w.z); w.w = __builtin_amdgcn_cvt_pk_u8_f32(sigmoidf_(v1h[i]) * 255.f, i, w.w); }
            *(u32x4*)((unsigned char*)C.p->out + (size_t)R * 3072 + (u.pn - 9) * 256 + 2 * c8) = w; return; }
        float ssq = one(u, R, lat, t, c8, v0l, v0h) + one(u, R, lat, t, 128 + c8, v1l, v1h);
        if (u.pn >= 6 && u.pn <= 8) {
            ssq += __shfl_xor(ssq, 16); ssq += __shfl_xor(ssq, 32);
            if ((c8 & 24) == 0) ss_add((unsigned long long*)(C.ws + (u.pn == 6 ? CTL_SSKV : CTL_SSQ)) + (size_t)l * NR + R, ssq); }
    }
};

struct SchedUp {
    static constexpr bool GATHER = false;
    const Ctx* c; int l, n_kn, n_vm, n_uq, n_tot;
    __device__ void init(const Ctx* cc, int ll) { c = cc; l = ll; n_kn = 144 * 2; n_vm = 2 * 144; n_uq = (l == 0 ? 144 : 128) * 3; n_tot = n_kn + n_vm + n_uq; }
    __device__ bool next(int i, Unit& u) const {
        const int L = i * c->G + c->blk; if (L >= n_tot) return false;
        u.rows = nullptr; u.nrows = 256; u.aux = l; u.aux2 = 0;
        if (L < n_kn) { u.pm = L >> 1; u.pn = L & 1; u.kind = 0; u.bperm = 0; u.K = 256; u.a = wsb(*c, A_CKV) + (size_t)u.pm * 256 * 256; u.b = wt(*c, WO_UK) + (size_t)u.pn * 256 * 256; }
        else if (L < n_kn + n_vm) { const int q = L - n_kn; u.pm = q / 144; u.pn = q % 144; u.kind = 1; u.bperm = 1; u.K = 256; u.a = wt(*c, WO_UV) + (size_t)u.pm * 256 * 256; u.b = wsb(*c, A_CKV) + (size_t)u.pn * 256 * 256; }
        else { const int q = L - n_kn - n_vm; const int rt = q / 3; u.pn = q % 3; u.pm = (l == 0) ? rt : ((rt >> 3) * 9 + 1 + (rt & 7)); u.kind = 2; u.bperm = 0; u.K = 384;
            u.a = wsb(*c, A_CQ) + (size_t)u.pm * 256 * 384; u.b = wt(*c, WO_UQ) + (size_t)u.pn * 256 * 384; }
        return true;
    }
};
struct EpiUp {
    const Ctx* c; int l;
    static constexpr bool PAIR = false; static constexpr bool FP8 = false;
    struct UState { float rsv[16]; };
    __device__ __forceinline__ float rstd_kv(int R) const { return __builtin_amdgcn_rsqf(ss_get((const unsigned long long*)(c->ws + CTL_SSKV) + (size_t)l * NR + R) * (1.f / 256.f) + EPSN); }
    static constexpr int GROUP = 4; static constexpr bool EARLY = false; static constexpr bool CHAIN = false; static constexpr bool ROWTAB = false; struct Pre { unsigned long long ss; };
    __device__ __forceinline__ void unit_begin(const Unit& u, int c8, UState& us) const {
#pragma unroll
        for (int i = 0; i < 16; ++i) us.rsv[i] = 0.f;
        if (u.kind == 1) {
#pragma unroll
            for (int h = 0; h < 2; ++h) { const int q0 = h * 128 + c8;
#pragma unroll
                for (int i = 0; i < 8; ++i) us.rsv[h * 8 + i] = rstd_kv(u.pn * 256 + (q0 & ~31) + pos2tok((q0 & 31) + i)); } }
    }
    __device__ __forceinline__ void pre(const Unit& u, int row, int c8, Pre& p) const {
        p.ss = 0ull;
        if (u.kind == 0) p.ss = *((const unsigned long long*)(c->ws + CTL_SSKV) + (size_t)l * NR + u.pm * 256 + row);
        else if (u.kind == 2) p.ss = *((const unsigned long long*)(c->ws + CTL_SSQ) + (size_t)l * NR + u.pm * 256 + row);
    }
    __device__ __forceinline__ void apply(const Unit& u, int row, int c8, const Pre& p, const UState& us, f32x4 v0l, f32x4 v0h, f32x4 v1l, f32x4 v1h) const {
        const Ctx& C = *c;
        if (u.kind == 0) { const int R = u.pm * 256 + row; const float rs = __builtin_amdgcn_rsqf((float)p.ss * SS_INV * (1.f / 256.f) + EPSN);
            bf16_t* o = wsb(C, A_KN) + (size_t)R * 512 + u.pn * 256;
            *(u32x4*)(o + c8) = pack8(v0l * rs, v0h * rs); *(u32x4*)(o + 128 + c8) = pack8(v1l * rs, v1h * rs); }
        else if (u.kind == 1) {
            bf16_t* o = wsb(C, A_VMT) + (size_t)(u.pm * 256 + row) * NR + (size_t)u.pn * 256;
#pragma unroll
            for (int h = 0; h < 2; ++h) { const int q0 = h * 128 + c8; f32x4 lo = h ? v1l : v0l, hi = h ? v1h : v0h;
#pragma unroll
                for (int i = 0; i < 4; ++i) { lo[i] *= us.rsv[h * 8 + i]; hi[i] *= us.rsv[h * 8 + 4 + i]; }
                *(u32x4*)(o + q0) = pack8(lo, hi); } }
        else { const int R = u.pm * 256 + row; const bool lat = (u.pm % 9) != 0; const int t = (R % RPB) - CTXL;
            const float rs = C2M * __builtin_amdgcn_rsqf((float)p.ss * SS_INV * (1.f / 384.f) + EPSN);
#pragma unroll
            for (int h = 0; h < 2; ++h) { const int col = u.pn * 256 + h * 128 + c8; const int pp = col % 96; f32x4 lo = h ? v1l : v0l, hi = h ? v1h : v0h;
                if (lat && pp >= 64) rope4(lo, hi, (const f32x2*)(C.ws + WS_TAB32) + t * 16 + ((pp - 64) >> 3) * 4);
                *(u32x4*)(wsb(C, A_QM) + (size_t)R * 768 + col) = pack8(lo * rs, hi * rs); } }
    }
};
__device__ __forceinline__ void ph_pool(const Ctx& c, int l) {
    LAS bf16_t* tile = (LAS bf16_t*)c.lds;
    const int nitems = 16 * 32 + (l == 0 ? 16 * 4 : 0);
    for (int it = c.G - 1 - c.blk; it < nitems; it += c.G) {
        int b, s0, n, rbase;
        if (it < 512) { b = it >> 5; s0 = (it & 31) * 64; n = SEQ; rbase = b * RPB + CTXL; } else { const int q = it - 512; b = q >> 2; s0 = (q & 3) * 64; n = CTXL; rbase = b * RPB; }
        __syncthreads();
        for (int q = c.tid; q < 80 * 64; q += 512) { const int rr = q >> 6, ch = q & 63; const int t = s0 - 8 + rr;
            u32x4 v = (u32x4){0u, 0u, 0u, 0u}; if (t >= 0 && t < n) v = *(const u32x4*)(wsb(c, A_PL) + (size_t)(rbase + t) * 512 + ch * 8);
            *(LAS u32x4*)(tile + rr * 512 + ch * 8) = v; }
        __syncthreads();
        const int ch = c.tid & 63, g = ch >> 4, w = 2 << g;
        for (int rr = c.tid >> 6; rr < 64; rr += 8) { const int t = s0 + rr; const int lo = max(t - w / 2, 0), hi = min(t + w / 2, n);
            float acc[8];
#pragma unroll
            for (int q = 0; q < 8; ++q) acc[q] = 0.f;
            for (int j = lo; j < hi; ++j) { f32x4 a, bq; unpack8(*(const LAS u32x4*)(tile + (j - s0 + 8) * 512 + ch * 8), a, bq);
                acc[0] += a.x; acc[1] += a.y; acc[2] += a.z; acc[3] += a.w; acc[4] += bq.x; acc[5] += bq.y; acc[6] += bq.z; acc[7] += bq.w; }
            f32x4 xa, xb; unpack8(*(const LAS u32x4*)(tile + (rr + 8) * 512 + ch * 8), xa, xb);
            const float inv = 1.f / (float)(hi - lo);
            const f32x4 oa = (f32x4){acc[0], acc[1], acc[2], acc[3]} * inv - xa, ob = (f32x4){acc[4], acc[5], acc[6], acc[7]} * inv - xb;
            *(u32x2*)((unsigned char*)(c.ws + A_PD) + (size_t)(rbase + t) * 512 + ch * 8) = (u32x2){pack4_fp8c(oa, BR8_SCALE), pack4_fp8c(ob, BR8_SCALE)}; }
    }
    __syncthreads();
}

__device__ __forceinline__ float lam_of(const Ctx& c, int l) {
    float s1 = 0.f, s2 = 0.f;
    for (int i = 0; i < 64; ++i) { s1 += INP(c, I_LQ1)[l * 64 + i] * INP(c, I_LK1)[l * 64 + i]; s2 += INP(c, I_LQ2)[l * 64 + i] * INP(c, I_LK2)[l * 64 + i]; }
    const float lam_init = 0.8f - 0.6f * expf(-0.3f * (float)l);
    return expf(s1) - expf(s2) + lam_init;
}
__device__ __forceinline__ void ph_attn_naive(const Ctx& c, int l) {
    const long gt = (long)c.blk * 512 + c.tid, NT = (long)c.G * 512;
    for (long it = gt; it < (long)NR * 16; it += NT) {
        const int dc = (int)(it & 1), h = (int)((it >> 1) & 7), R = (int)(it >> 4);
        const int b = R / RPB, j = R % RPB; const bool lat = j >= CTXL;
        if (!lat && l != 0) continue;
        const int nk = lat ? RPB : CTXL; const int kb = b * RPB;
        const bf16_t* qp = wsb(c, A_QM) + (size_t)R * 768 + h * 96;
        float m = -INFINITY, ls = 0.f, o[32];
#pragma unroll
        for (int i = 0; i < 32; ++i) o[i] = 0.f;
        for (int k = 0; k < nk; ++k) {
            const int Rk = kb + k; const bf16_t* kp = wsb(c, A_KN) + (size_t)Rk * 512 + h * 64; const bf16_t* rp = wsb(c, A_KR) + (size_t)Rk * 32;
            float s = 0.f;
            for (int i = 0; i < 96; i += 8) { f32x4 qa, qb, ka, kbb; unpack8(*(const u32x4*)(qp + i), qa, qb); unpack8(*(const u32x4*)(i < 64 ? kp + i : rp + (i - 64)), ka, kbb);
                s += (qa.x * ka.x + qa.y * ka.y) + (qa.z * ka.z + qa.w * ka.w) + (qb.x * kbb.x + qb.y * kbb.y) + (qb.z * kbb.z + qb.w * kbb.w); }
            const float mn = fmaxf(m, s), f = exp2f(m - mn), pv = exp2f(s - mn);
            ls = ls * f + pv; m = mn;
            const size_t vcol = (size_t)(Rk & ~31) + tok2pos(Rk & 31);
            const float pb = bf2f((unsigned short)f2bf(pv));
#pragma unroll
            for (int i = 0; i < 32; ++i) o[i] = o[i] * f + pb * bf2f(wsb(c, A_VMT)[(size_t)(h * 64 + dc * 32 + i) * NR + vcol]);
        }
        const float inv = 1.f / ls;
        bf16_t* op = wsb(c, A_OM) + (size_t)R * 512 + h * 64 + dc * 32;
#pragma unroll
        for (int i = 0; i < 32; i += 2) *(unsigned*)(op + i) = pk2(o[i] * inv, o[i + 1] * inv);
    }
    const float lam = lam_of(c, l); const float lam_init = 0.8f - 0.6f * expf(-0.3f * (float)l);
    for (long it = gt; it < (long)NR * 32; it += NT) {
        const int dc = (int)(it & 7), h = (int)((it >> 3) & 3), R = (int)(it >> 5);
        const int b = R / RPB, j = R % RPB; const bool lat = j >= CTXL;
        const bool act = lat || l == 0;
        const int nk = act ? (lat ? RPB : CTXL) : 0; const int kb = b * RPB;
        const bf16_t* qp = wsb(c, A_QD) + (size_t)R * 512 + h * 128;
        float m0 = -INFINITY, m1 = -INFINITY, l0 = 0.f, l1 = 0.f, o0[16], o1[16];
#pragma unroll
        for (int i = 0; i < 16; ++i) { o0[i] = 0.f; o1[i] = 0.f; }
        for (int k = 0; k < nk; ++k) {
            const int Rk = kb + k; const bf16_t* kp = wsb(c, A_KD) + (size_t)Rk * 512 + h * 128;
            float s0 = 0.f, s1 = 0.f;
#pragma unroll 2
            for (int i = 0; i < 64; i += 8) { f32x4 qa, qb, ka, kbb; unpack8(*(const u32x4*)(qp + i), qa, qb); unpack8(*(const u32x4*)(kp + i), ka, kbb);
                s0 += (qa.x * ka.x + qa.y * ka.y) + (qa.z * ka.z + qa.w * ka.w) + (qb.x * kbb.x + qb.y * kbb.y) + (qb.z * kbb.z + qb.w * kbb.w);
                unpack8(*(const u32x4*)(qp + 64 + i), qa, qb); unpack8(*(const u32x4*)(kp + 64 + i), ka, kbb);
                s1 += (qa.x * ka.x + qa.y * ka.y) + (qa.z * ka.z + qa.w * ka.w) + (qb.x * kbb.x + qb.y * kbb.y) + (qb.z * kbb.z + qb.w * kbb.w); }
            const float mn0 = fmaxf(m0, s0), f0 = exp2f(m0 - mn0), p0 = exp2f(s0 - mn0); l0 = l0 * f0 + p0; m0 = mn0;
            const float mn1 = fmaxf(m1, s1), f1 = exp2f(m1 - mn1), p1 = exp2f(s1 - mn1); l1 = l1 * f1 + p1; m1 = mn1;
            const size_t vcol = (size_t)(Rk & ~31) + tok2pos(Rk & 31);
            const float pb0 = bf2f((unsigned short)f2bf(p0)), pb1 = bf2f((unsigned short)f2bf(p1));
#pragma unroll
            for (int i = 0; i < 16; ++i) { const float v = bf2f(wsb(c, A_VDT)[(size_t)(h * 128 + dc * 16 + i) * NR + vcol]); o0[i] = o0[i] * f0 + pb0 * v; o1[i] = o1[i] * f1 + pb1 * v; }
        }
        float ss = 0.f; const float i0 = act ? 1.f / l0 : 0.f, i1 = act ? lam / l1 : 0.f;
#pragma unroll
        for (int i = 0; i < 16; ++i) { o0[i] = o0[i] * i0 - o1[i] * i1; ss += o0[i] * o0[i]; }
        ss += __shfl_xor(ss, 1); ss += __shfl_xor(ss, 2); ss += __shfl_xor(ss, 4);
        const float rs = (1.f - lam_init) / sqrtf(ss * (1.f / 128.f) + EPSN);
        if (act) { bf16_t* op = wsb(c, A_QD) + (size_t)R * 512 + h * 128 + dc * 16; const float* g = INP(c, I_GSUBLN) + l * 128 + dc * 16;
#pragma unroll
            for (int i = 0; i < 16; i += 2) *(unsigned*)(op + i) = pk2(o0[i] * rs * g[i], o0[i + 1] * rs * g[i + 1]); }
    }
}


typedef float f32x16 __attribute__((ext_vector_type(16)));
template <bool DIFF>
__device__ __forceinline__ void attn_unit(const Ctx& c, int l, int b, int h, int q0  , int nk  , float lam, float lam_init) {
    constexpr int DQ = DIFF ? 64 : 96, DV = DIFF ? 128 : 64, NCK = DIFF ? 16 : 12  , KB = NCK * 1024, VB = 8 * DV * 16, SLOT = KB + VB;
    constexpr int NDS = DQ / 16, NDB = DV / 32;
    static_assert(4 * SLOT + 8 * 512 + (DIFF ? 0 : 32768) <= LDS_MISC && (!DIFF || 65536 <= 4 * SLOT), "attention LDS map");
    LAS unsigned char* lds = c.lds;
    const int lane = c.lane, wid = c.wave, r32 = lane & 31, hi = lane >> 5;
    const int map = DIFF ? (wid >> 2) : 0, wq = DIFF ? (wid & 3) : wid;
    const int kb = b * RPB, NT = nk / 64;
    LAS float* wsf = (LAS float*)(lds + 4 * SLOT + wid * 512);
    unsigned ko0, ko1, vo0, vo1;
    unsigned kstep0, kstep1, kdb0, kdb1, vdb0, vdb1; bool has_k1;
    if constexpr (DIFF) {
        { const int row = 4 * wid + (lane >> 4), ch = (lane & 15) ^ (row & 15); ko0 = (unsigned)(A_KD + ((size_t)(kb + row) * 512 + h * 128 + ch * 8) * 2); }
        { const int row = 4 * (wid + 8) + (lane >> 4), ch = (lane & 15) ^ (row & 15); ko1 = (unsigned)(A_KD + ((size_t)(kb + row) * 512 + h * 128 + ch * 8) * 2); }
        kstep0 = kstep1 = 64 * 512 * 2; kdb0 = wid * 1024; kdb1 = (wid + 8) * 1024; has_k1 = true;
        { const int d = 8 * wid + (lane >> 3), ch = (lane & 7) ^ ((d >> 1) & 7); vo0 = (unsigned)(A_VDT + ((size_t)(h * 128 + d) * NR + kb + ch * 8) * 2); }
        { const int d = 8 * (wid + 8) + (lane >> 3), ch = (lane & 7) ^ ((d >> 1) & 7); vo1 = (unsigned)(A_VDT + ((size_t)(h * 128 + d) * NR + kb + ch * 8) * 2); }
        vdb0 = KB + wid * 1024; vdb1 = KB + (wid + 8) * 1024;
    } else {
        { const int row = 8 * wid + (lane >> 3), ch = (lane & 7) ^ ((row >> 1) & 7); ko0 = (unsigned)(A_KN + ((size_t)(kb + row) * 512 + h * 64 + ch * 8) * 2); }
        { const int w4 = wid & 3, row = 16 * w4 + (lane >> 2), ch = (lane & 3) ^ ((row >> 2) & 3); ko1 = (unsigned)(A_KR + ((size_t)(kb + row) * 32 + ch * 8) * 2); }
        kstep0 = 64 * 512 * 2; kstep1 = 64 * 32 * 2; kdb0 = wid * 1024; kdb1 = 8192 + (wid & 3) * 1024; has_k1 = wid < 4;
        { const int d = 8 * wid + (lane >> 3), ch = (lane & 7) ^ ((d >> 1) & 7); vo0 = (unsigned)(A_VMT + ((size_t)(h * 64 + d) * NR + kb + ch * 8) * 2); }
        vo1 = vo0; vdb0 = KB + wid * 1024; vdb1 = vdb0;
    }
    const GAS unsigned char* wsg_ = c.ws;
#define AT_DMA(t, slot) do { const unsigned so_ = (unsigned)(slot) * SLOT; \
        __builtin_amdgcn_global_load_lds((const GAS unsigned*)(wsg_ + (size_t)((unsigned)(t) * kstep0) + ko0), (LAS unsigned*)(lds + so_ + kdb0), 16, 0, 0); \
        if (has_k1) __builtin_amdgcn_global_load_lds((const GAS unsigned*)(wsg_ + (size_t)((unsigned)(t) * kstep1) + ko1), (LAS unsigned*)(lds + so_ + kdb1), 16, 0, 0); \
        __builtin_amdgcn_global_load_lds((const GAS unsigned*)(wsg_ + (size_t)((unsigned)(t) * 128u) + vo0), (LAS unsigned*)(lds + so_ + vdb0), 16, 0, 0); \
        if (DIFF) __builtin_amdgcn_global_load_lds((const GAS unsigned*)(wsg_ + (size_t)((unsigned)(t) * 128u) + vo1), (LAS unsigned*)(lds + so_ + vdb1), 16, 0, 0); } while (0)
#define AT_WAIT1() do { if (DIFF) asm volatile("s_waitcnt vmcnt(4)" ::: "memory"); else if (has_k1) asm volatile("s_waitcnt vmcnt(3)" ::: "memory"); else asm volatile("s_waitcnt vmcnt(2)" ::: "memory"); } while (0)
    const int qrow = q0 + wq * 32 + r32;
    const bf16_t* qp = DIFF ? (wsb(c, A_QD) + (size_t)qrow * 512 + h * 128 + map * 64) : (wsb(c, A_QM) + (size_t)qrow * 768 + h * 96);
    bf16x8 qr[NDS];
#pragma unroll
    for (int ds = 0; ds < NDS; ++ds) qr[ds] = *(const bf16x8*)(qp + ds * 16 + hi * 8);
    AT_DMA(0, 0); AT_DMA(1, 1); AT_DMA(2, 2);
    f32x16 o[NDB];
#pragma unroll
    for (int d = 0; d < NDB; ++d) o[d] = f32x16{};
    float mhat = 0.f, lsum = 0.f; f32x16 negm = f32x16{};
    const int kchunk0 = DIFF ? map * 8 : 0;
    const unsigned swk_ = (unsigned)((r32 >> 1) & 7), swr_ = (unsigned)((r32 >> 2) & 3), swd_ = (unsigned)(r32 & 15);
#define AT_KOFF(ds) (DIFF ? ((unsigned)r32 * 256u + ((((unsigned)(kchunk0 + 2 * (ds)) ^ swd_) ^ (unsigned)hi) << 4)) \
                          : ((ds) < 4 ? ((unsigned)r32 * 128u + ((((unsigned)(2 * (ds)) ^ swk_) ^ (unsigned)hi) << 4)) : (8192u + (unsigned)r32 * 64u + ((((unsigned)(2 * ((ds) - 4)) ^ swr_) ^ (unsigned)hi) << 4))))
#define AT_KROW32(ds) (DIFF ? 8192 : ((ds) < 4 ? 4096 : 2048))
#define AT_VOFF(s4) ((unsigned)KB + (unsigned)r32 * 128u + ((((unsigned)(2 * (s4)) ^ swk_) ^ (unsigned)hi) << 4))
#define AT_QK(P0, P1, slot_) do { unsigned kb_ = (unsigned)(slot_) * SLOT; asm volatile("" : "+v"(kb_)); const LAS unsigned char* ks_ = lds + kb_; \
        if (DIFF) { P0 = f32x16{}; P1 = f32x16{}; } else { P0 = negm; P1 = negm; } \
        _Pragma("unroll") for (int ds = 0; ds < NDS; ++ds) { \
            const bf16x8 k0 = *(const LAS bf16x8*)(ks_ + AT_KOFF(ds)); \
            const bf16x8 k1 = *(const LAS bf16x8*)(ks_ + AT_KOFF(ds) + AT_KROW32(ds)); \
            P0 = __builtin_amdgcn_mfma_f32_32x32x16_bf16(k0, qr[ds], P0, 0, 0, 0); \
            P1 = __builtin_amdgcn_mfma_f32_32x32x16_bf16(k1, qr[ds], P1, 0, 0, 0); } } while (0)
#define AT_ROWMAX(RM, P0, P1) do { float a_ = fmaxf(fmaxf(P0[0], P1[0]), P0[1]), b_ = fmaxf(fmaxf(P1[1], P0[2]), P1[2]); \
        _Pragma("unroll") for (int r = 3; r < 15; r += 2) { a_ = fmaxf(fmaxf(a_, P0[r]), P1[r]); b_ = fmaxf(fmaxf(b_, P0[r + 1]), P1[r + 1]); } \
        a_ = fmaxf(fmaxf(a_, P0[15]), P1[15]); RM = fmaxf(a_, b_); RM = fmaxf(RM, __shfl_xor(RM, 32)); } while (0)
    if (DIFF) asm volatile("s_waitcnt vmcnt(8)" ::: "memory"); else if (has_k1) asm volatile("s_waitcnt vmcnt(6)" ::: "memory"); else asm volatile("s_waitcnt vmcnt(4)" ::: "memory");
    asm volatile("s_barrier" ::: "memory");
    f32x16 pA0, pA1, pB0, pB1; float rmA, rmB = 0.f;
    AT_QK(pA0, pA1, 0);
    AT_ROWMAX(rmA, pA0, pA1);
#define SGB(mask, n) __builtin_amdgcn_sched_group_barrier(mask, n, 0)
#define AT_STEP(P0, P1, RM, N0, N1, RMN, t, HN) do { \
          \
        if (HN) { if ((t) + 2 < NT) AT_WAIT1(); else asm volatile("s_waitcnt vmcnt(0)" ::: "memory"); } \
        asm volatile("s_barrier" ::: "memory"); \
        if ((t) + 3 < NT) AT_DMA((t) + 3, ((t) + 3) & 3); \
          \
        const bool first_ = ((t) == 0); \
        const float rrel_ = DIFF ? RM - mhat : RM;        \
        if (first_ || __any(rrel_ > 8.0f)) { \
            const float dl = first_ ? rrel_ : fmaxf(rrel_, 0.f); \
            mhat += dl; \
            if (!DIFF) { _Pragma("unroll") for (int r = 0; r < 16; ++r) { P0[r] -= dl; P1[r] -= dl; negm[r] = -mhat; } } \
            if (!first_) { \
                const float f = __builtin_amdgcn_exp2f(-dl); lsum *= f; \
                { int rq_ = r32; asm volatile("" : "+v"(rq_)); if (hi == 0) wsf[rq_] = f; } \
                asm volatile("s_waitcnt lgkmcnt(0)" ::: "memory"); \
                _Pragma("unroll") for (int r = 0; r < 16; ++r) { const float fr_ = wsf[(r & 3) + 8 * (r >> 2) + 4 * hi]; \
                    _Pragma("unroll") for (int d = 0; d < NDB; ++d) o[d][r] *= fr_; } \
            } \
        } \
        __builtin_amdgcn_sched_barrier(0); \
          \
        unsigned kb_ = (unsigned)(((t) + 1) & 3) * SLOT; asm volatile("" : "+v"(kb_)); const LAS unsigned char* ks_ = lds + kb_; \
        unsigned vb_ = (unsigned)((t) & 3) * SLOT; asm volatile("" : "+v"(vb_)); const LAS unsigned char* vs_ = lds + vb_; \
        bf16x8 kf_[2 * NDS], vf_[4], vg_[4]; \
        if (HN) { _Pragma("unroll") for (int ds = 0; ds < NDS; ++ds) { kf_[2 * ds] = *(const LAS bf16x8*)(ks_ + AT_KOFF(ds)); kf_[2 * ds + 1] = *(const LAS bf16x8*)(ks_ + AT_KOFF(ds) + AT_KROW32(ds)); } } \
        if (HN) { if (DIFF) { N0 = f32x16{}; N1 = f32x16{}; } else { N0 = negm; N1 = negm; } \
            _Pragma("unroll") for (int ds = 0; ds < NDS; ++ds) { \
                N0 = __builtin_amdgcn_mfma_f32_32x32x16_bf16(kf_[2 * ds], qr[ds], N0, 0, 0, 0); \
                N1 = __builtin_amdgcn_mfma_f32_32x32x16_bf16(kf_[2 * ds + 1], qr[ds], N1, 0, 0, 0); } } \
        float sacc = 0.f; \
        _Pragma("unroll") for (int r = 0; r < 16; ++r) { P0[r] = __builtin_amdgcn_exp2f(DIFF ? P0[r] - mhat : P0[r]); P1[r] = __builtin_amdgcn_exp2f(DIFF ? P1[r] - mhat : P1[r]); sacc += P0[r] + P1[r]; } \
        lsum += sacc; \
        bf16x8 pa[4]; \
        { u32x4 w; \
          w.x = pk2(P0[0], P0[1]); w.y = pk2(P0[2], P0[3]); w.z = pk2(P0[4], P0[5]); w.w = pk2(P0[6], P0[7]); pa[0] = __builtin_bit_cast(bf16x8, w); \
          w.x = pk2(P0[8], P0[9]); w.y = pk2(P0[10], P0[11]); w.z = pk2(P0[12], P0[13]); w.w = pk2(P0[14], P0[15]); pa[1] = __builtin_bit_cast(bf16x8, w); \
          w.x = pk2(P1[0], P1[1]); w.y = pk2(P1[2], P1[3]); w.z = pk2(P1[4], P1[5]); w.w = pk2(P1[6], P1[7]); pa[2] = __builtin_bit_cast(bf16x8, w); \
          w.x = pk2(P1[8], P1[9]); w.y = pk2(P1[10], P1[11]); w.z = pk2(P1[12], P1[13]); w.w = pk2(P1[14], P1[15]); pa[3] = __builtin_bit_cast(bf16x8, w); } \
        _Pragma("unroll") for (int s4 = 0; s4 < 4; ++s4) vf_[s4] = *(const LAS bf16x8*)(vs_ + AT_VOFF(s4)); \
        _Pragma("unroll") for (int s4 = 0; s4 < 4; ++s4) vg_[s4] = *(const LAS bf16x8*)(vs_ + AT_VOFF(s4) + 4096); \
        _Pragma("unroll") for (int s4 = 0; s4 < 4; ++s4) o[0] = __builtin_amdgcn_mfma_f32_32x32x16_bf16(pa[s4], vf_[s4], o[0], 0, 0, 0); \
        _Pragma("unroll") for (int s4 = 0; s4 < 4; ++s4) o[1] = __builtin_amdgcn_mfma_f32_32x32x16_bf16(pa[s4], vg_[s4], o[1], 0, 0, 0); \
        if (HN) AT_ROWMAX(RMN, N0, N1); \
          \
        SGB(0x100, (HN ? 2 * NDS : 8)); \
        _Pragma("unroll") for (int i_ = 0; i_ < (HN ? 2 * NDS : 0); ++i_) { SGB(0x008, 1); SGB(0x002, 6); } \
        if (HN) SGB(0x100, 8); \
        SGB(0x002, 64); \
        _Pragma("unroll") for (int i_ = 0; i_ < 8; ++i_) { SGB(0x008, 1); SGB(0x002, 2); } \
        __builtin_amdgcn_sched_barrier(0); \
    } while (0)
#define AT_STEP_D(P0, P1, RM, N0, N1, RMN, t) do { \
          \
        if ((t) + 1 < NT) { if ((t) + 2 < NT) AT_WAIT1(); else asm volatile("s_waitcnt vmcnt(0)" ::: "memory"); } \
        asm volatile("s_barrier" ::: "memory"); \
        if ((t) + 3 < NT) AT_DMA((t) + 3, ((t) + 3) & 3); \
          \
        const bool first_ = ((t) == 0); \
        const float rrel_ = DIFF ? RM - mhat : RM;        \
        if (first_ || __any(rrel_ > 8.0f)) { \
            const float dl = first_ ? rrel_ : fmaxf(rrel_, 0.f); \
            mhat += dl; \
            if (!DIFF) { _Pragma("unroll") for (int r = 0; r < 16; ++r) { P0[r] -= dl; P1[r] -= dl; negm[r] = -mhat; } } \
            if (!first_) { \
                const float f = __builtin_amdgcn_exp2f(-dl); lsum *= f; \
                { int rq_ = r32; asm volatile("" : "+v"(rq_)); if (hi == 0) wsf[rq_] = f; } \
                asm volatile("s_waitcnt lgkmcnt(0)" ::: "memory"); \
                _Pragma("unroll") for (int r = 0; r < 16; ++r) { const float fr_ = wsf[(r & 3) + 8 * (r >> 2) + 4 * hi]; \
                    _Pragma("unroll") for (int d = 0; d < NDB; ++d) o[d][r] *= fr_; } \
            } \
        } \
          \
        if ((t) + 1 < NT) AT_QK(N0, N1, ((t) + 1) & 3); \
        float sacc = 0.f; \
        _Pragma("unroll") for (int r = 0; r < 16; ++r) { P0[r] = __builtin_amdgcn_exp2f(DIFF ? P0[r] - mhat : P0[r]); P1[r] = __builtin_amdgcn_exp2f(DIFF ? P1[r] - mhat : P1[r]); sacc += P0[r] + P1[r]; } \
        lsum += sacc; \
        bf16x8 pa[4]; \
        { u32x4 w; \
          w.x = pk2(P0[0], P0[1]); w.y = pk2(P0[2], P0[3]); w.z = pk2(P0[4], P0[5]); w.w = pk2(P0[6], P0[7]); pa[0] = __builtin_bit_cast(bf16x8, w); \
          w.x = pk2(P0[8], P0[9]); w.y = pk2(P0[10], P0[11]); w.z = pk2(P0[12], P0[13]); w.w = pk2(P0[14], P0[15]); pa[1] = __builtin_bit_cast(bf16x8, w); \
          w.x = pk2(P1[0], P1[1]); w.y = pk2(P1[2], P1[3]); w.z = pk2(P1[4], P1[5]); w.w = pk2(P1[6], P1[7]); pa[2] = __builtin_bit_cast(bf16x8, w); \
          w.x = pk2(P1[8], P1[9]); w.y = pk2(P1[10], P1[11]); w.z = pk2(P1[12], P1[13]); w.w = pk2(P1[14], P1[15]); pa[3] = __builtin_bit_cast(bf16x8, w); } \
          \
        { unsigned vb_ = (unsigned)((t) & 3) * SLOT; asm volatile("" : "+v"(vb_)); const LAS unsigned char* vs = lds + vb_; \
          _Pragma("unroll") for (int d = 0; d < NDB; ++d) { \
            _Pragma("unroll") for (int s4 = 0; s4 < 4; ++s4) { \
                const bf16x8 vf = *(const LAS bf16x8*)(vs + AT_VOFF(s4) + d * 4096); \
                o[d] = __builtin_amdgcn_mfma_f32_32x32x16_bf16(pa[s4], vf, o[d], 0, 0, 0); } \
          } } \
        if ((t) + 1 < NT) AT_ROWMAX(RMN, N0, N1); \
    } while (0)
    if constexpr (DIFF) {
        for (int t = 0; t < NT; t += 2) { AT_STEP_D(pA0, pA1, rmA, pB0, pB1, rmB, t); AT_STEP_D(pB0, pB1, rmB, pA0, pA1, rmA, t + 1); }
    } else {
        int t = 0;
        for (; t + 2 < NT; t += 2) {
            AT_STEP(pA0, pA1, rmA, pB0, pB1, rmB, t, true);
            AT_STEP(pB0, pB1, rmB, pA0, pA1, rmA, t + 1, true);
        }
        AT_STEP(pA0, pA1, rmA, pB0, pB1, rmB, t, true);
        AT_STEP(pB0, pB1, rmB, pA0, pA1, rmA, t + 1, false);
    }
#undef AT_STEP
#undef AT_STEP_D
#undef SGB
#undef AT_QK
#undef AT_KOFF
#undef AT_KROW32
#undef AT_VOFF
#undef AT_ROWMAX
    lsum += __shfl_xor(lsum, 32);
    { int rq_ = r32; asm volatile("" : "+v"(rq_)); if (hi == 0) wsf[32 + rq_] = lsum; }
    asm volatile("s_waitcnt lgkmcnt(0)" ::: "memory");
    float rl[16];
#pragma unroll
    for (int r = 0; r < 16; ++r) rl[r] = 1.f / wsf[32 + (r & 3) + 8 * (r >> 2) + 4 * hi];
    LAS unsigned char* xch = DIFF ? lds : lds + 4 * SLOT + 8 * 512;
    asm volatile("s_barrier" ::: "memory");
    if constexpr (DIFF) {
        LAS float* x1 = (LAS float*)xch + wq * 4096;
        if (map == 1) {
#pragma unroll
            for (int d = 0; d < NDB; ++d)
#pragma unroll
                for (int r = 0; r < 16; ++r) x1[((r & 3) + 8 * (r >> 2) + 4 * hi) * 128 + d * 32 + r32] = o[d][r] * rl[r] * lam;
        }
        asm volatile("s_waitcnt lgkmcnt(0)\n\ts_barrier" ::: "memory");
        if (map == 0) {
            float ss[16];
#pragma unroll
            for (int r = 0; r < 16; ++r) ss[r] = 0.f;
#pragma unroll
            for (int d = 0; d < NDB; ++d)
#pragma unroll
                for (int r = 0; r < 16; ++r) { const float v = o[d][r] * rl[r] - x1[((r & 3) + 8 * (r >> 2) + 4 * hi) * 128 + d * 32 + r32]; o[d][r] = v; ss[r] += v * v; }
#pragma unroll
            for (int r = 0; r < 16; ++r) { float v = ss[r]; v += __shfl_xor(v, 1); v += __shfl_xor(v, 2); v += __shfl_xor(v, 4); v += __shfl_xor(v, 8); v += __shfl_xor(v, 16); ss[r] = (1.f - lam_init) * __builtin_amdgcn_rsqf(v * (1.f / 128.f) + EPSN); }
            float g[NDB];
#pragma unroll
            for (int d = 0; d < NDB; ++d) g[d] = INP(c, I_GSUBLN)[l * 128 + d * 32 + r32];
            asm volatile("s_waitcnt lgkmcnt(0)" ::: "memory");
            LAS bf16_t* stg = (LAS bf16_t*)x1;
#pragma unroll
            for (int d = 0; d < NDB; ++d)
#pragma unroll
                for (int r = 0; r < 16; ++r) stg[((r & 3) + 8 * (r >> 2) + 4 * hi) * 128 + d * 32 + r32] = (bf16_t)f2bf(o[d][r] * ss[r] * g[d]);
            asm volatile("s_waitcnt lgkmcnt(0)" ::: "memory");
            unsigned char* op = (unsigned char*)(c.ws + A_OD8) + (size_t)(q0 + wq * 32) * 512 + h * 128;
#pragma unroll
            for (int i = 0; i < 8; ++i) { const int row = i * 4 + (lane >> 4), ch = lane & 15; f32x4 a_, b_; unpack8(*(const LAS u32x4*)(stg + row * 128 + ch * 8), a_, b_);
                *(u32x2*)(op + (size_t)row * 512 + ch * 8) = (u32x2){pack4_fp8c(a_, BR8_SCALE), pack4_fp8c(b_, BR8_SCALE)}; }
        }
        asm volatile("s_waitcnt lgkmcnt(0)\n\ts_barrier" ::: "memory");
    } else {
        LAS bf16_t* stg = (LAS bf16_t*)xch + wid * 2048;
#pragma unroll
        for (int d = 0; d < NDB; ++d)
#pragma unroll
            for (int r = 0; r < 16; ++r) stg[((r & 3) + 8 * (r >> 2) + 4 * hi) * 64 + d * 32 + r32] = (bf16_t)f2bf(o[d][r] * rl[r]);
        asm volatile("s_waitcnt lgkmcnt(0)" ::: "memory");
        unsigned char* op = (unsigned char*)(c.ws + A_OM) + (size_t)(q0 + wid * 32) * 512 + h * 64;
#pragma unroll
        for (int i = 0; i < 4; ++i) { const int row = i * 8 + (lane >> 3), ch = lane & 7; f32x4 a_, b_; unpack8(*(const LAS u32x4*)(stg + row * 64 + ch * 8), a_, b_);
            *(u32x2*)(op + (size_t)row * 512 + ch * 8) = (u32x2){pack4_fp8c(a_, BR8_SCALE), pack4_fp8c(b_, BR8_SCALE)}; }
        asm volatile("s_waitcnt lgkmcnt(0)" ::: "memory");
    }
#undef AT_DMA
#undef AT_WAIT1
}
__device__ __forceinline__ void ph_attn_mla(const Ctx& c, int l) {
    const int n_mla = ATT_TEST_NOMLA ? 0 : 1024 + (l == 0 ? 128 : 0);
    for (int rep = 0; rep < NREP(16); ++rep)
    for (int u = c.blk; u < n_mla; u += c.G) {
        if (u < 1024) {
            int b = u >> 6, h = (u >> 3) & 7, qt = u & 7;
            if (c.G == 256) { const int x = c.blk & 7, s = c.blk >> 3, pair = (u >> 8) * 32 + x * 4 + (s >> 3); b = pair >> 3; h = pair & 7; qt = s & 7; }
            attn_unit<false>(c, l, b, h, b * RPB + CTXL + qt * 256, RPB, 0.f, 0.f); }
        else { const int q = u - 1024, b = q >> 3, h = q & 7; attn_unit<false>(c, l, b, h, b * RPB, CTXL, 0.f, 0.f); }
    }
}
__device__ __forceinline__ void ph_attn_diff(const Ctx& c, int l) {
    float lam = lam_of(c, l); const float lam_init = 0.8f - 0.6f * expf(-0.3f * (float)l);
    lam = __builtin_bit_cast(float, __builtin_amdgcn_readfirstlane(__builtin_bit_cast(int, lam)));
    const int n_diff = ATT_TEST_NODIFF ? 0 : 1024 + (l == 0 ? 128 : 0);
    for (int u0 = c.blk; u0 < 1024 + 256; u0 += c.G) {
        int u = u0;
        if (u0 >= 1024) { u = (c.G == 256) ? u0 - 128 : u0; if (u < 1024 || u >= n_diff) continue; }
        if (u < 1024) {
            int b = u >> 6, h = (u >> 4) & 3, qt = u & 15;
            if (c.G == 256) { const int x = c.blk & 7, s = c.blk >> 3, pair = (u >> 8) * 16 + x * 2 + (s >> 4); b = pair >> 2; h = pair & 3; qt = s & 15; }
            attn_unit<true>(c, l, b, h, b * RPB + CTXL + qt * 128, RPB, lam, lam_init); }
        else { const int q = u - 1024, b = q >> 3, h = (q >> 1) & 3, qt = q & 1; attn_unit<true>(c, l, b, h, b * RPB + qt * 128, CTXL, lam, lam_init); }
    }
}

struct SchedMerge1 {
    static constexpr bool GATHER = false;
    const Ctx* c; int l, n_units;
    __device__ void init(const Ctx* cc, int ll) { c = cc; l = ll; n_units = (l == 0 ? 144 : 128) * 4; }
    __device__ bool next(int i, Unit& u) const {
        const int U = deal_xcd(*c, i / 3), br = i % 3; if (U >= n_units) return false;
        const int rt = U >> 2; u.pn = U & 3; u.pm = (l == 0) ? rt : ((rt >> 3) * 9 + 1 + (rt & 7));
        u.rows = nullptr; u.nrows = 256; u.aux = l; u.aux2 = 0; u.bperm = 0; u.kind = br; u.K = 256;
        u.a = wsb(*c, br == 0 ? A_OM : (br == 1 ? A_PD : A_OD8)) + (size_t)u.pm * 256 * 256;
        u.b = wt(*c, br == 0 ? WO_BM : (br == 1 ? WO_PP : WO_BD)) + (size_t)u.pn * 256 * 256;
        return true;
    }
};
struct EpiMerge1 {
    static constexpr bool PAIR = false; static constexpr bool FP8 = true;
    const Ctx* c;
    static constexpr int GROUP = 4; static constexpr bool EARLY = false; static constexpr bool CHAIN = true; static constexpr bool ROWTAB = false; struct Pre { u32x2 a0, a1, b0, b1; };
    struct UState {}; __device__ __forceinline__ void unit_begin(const Unit&, int, UState&) const {}
    __device__ __forceinline__ bool keep_acc(const Unit& u) const { return u.kind < 2; }
    __device__ __forceinline__ void pre(const Unit& u, int row, int c8, Pre& p) const {
        const unsigned char* gp = (const unsigned char*)c->p->out + (size_t)(u.pm * 256 + row) * 3072 + u.kind * 1024 + u.pn * 256 + c8;
        p.a0 = *(const u32x2*)gp; p.a1 = *(const u32x2*)(gp + 128);
        const unsigned char* gn = gp + (u.kind < 2 ? 1024 : 0);
        p.b0 = *(const u32x2*)gn; p.b1 = *(const u32x2*)(gn + 128);
    }
    __device__ __forceinline__ static f32x4 gate4(unsigned w) { return (f32x4){(float)max(w & 255u, 1u), (float)max((w >> 8) & 255u, 1u), (float)max((w >> 16) & 255u, 1u), (float)max(w >> 24, 1u)}; }
    __device__ __forceinline__ static f32x4 rcp4(f32x4 v) { return (f32x4){__builtin_amdgcn_rcpf(v.x), __builtin_amdgcn_rcpf(v.y), __builtin_amdgcn_rcpf(v.z), __builtin_amdgcn_rcpf(v.w)}; }
    __device__ __forceinline__ void apply_rw(const Unit& u, int row, int c8, const Pre& p, const UState&, f32x4& v0l, f32x4& v0h, f32x4& v1l, f32x4& v1h) const {
        const Ctx& C = *c;
        if (u.kind < 2) {
            v0l *= gate4(p.a0.x) * rcp4(gate4(p.b0.x)); v0h *= gate4(p.a0.y) * rcp4(gate4(p.b0.y));
            v1l *= gate4(p.a1.x) * rcp4(gate4(p.b1.x)); v1h *= gate4(p.a1.y) * rcp4(gate4(p.b1.y));
        } else {
            constexpr float sc_ = W8_INV * BR8_INV / 255.f;
            const f32x4 s = (f32x4){sc_, sc_, sc_, sc_};
            unsigned char* o = (unsigned char*)(C.ws + A_MG) + (size_t)(u.pm * 256 + row) * 1024 + u.pn * 256 + c8;
            *(u32x2*)o = (u32x2){pack4_fp8c(v0l * gate4(p.a0.x) * s, MG8_SCALE), pack4_fp8c(v0h * gate4(p.a0.y) * s, MG8_SCALE)};
            *(u32x2*)(o + 128) = (u32x2){pack4_fp8c(v1l * gate4(p.a1.x) * s, MG8_SCALE), pack4_fp8c(v1h * gate4(p.a1.y) * s, MG8_SCALE)};
        }
    }
    __device__ __forceinline__ void apply(const Unit&, int, int, const Pre&, const UState&, f32x4, f32x4, f32x4, f32x4) const {}
};
struct SchedMerge2 {
    static constexpr bool GATHER = false;
    const Ctx* c; int l, n_units;
    __device__ void init(const Ctx* cc, int ll) { c = cc; l = ll; n_units = (l == 0 ? 144 : 128) * 4; }
    __device__ bool next(int i, Unit& u) const {
        const int U = deal_xcd(*c, i); if (U >= n_units) return false;
        const int rt = U >> 2; u.pn = U & 3; u.pm = (l == 0) ? rt : ((rt >> 3) * 9 + 1 + (rt & 7));
        u.rows = nullptr; u.nrows = 256; u.aux = l; u.aux2 = 0; u.bperm = 0; u.kind = 0; u.K = 512;
        u.a = wsb(*c, A_MG) + (size_t)u.pm * 256 * 512; u.b = wt(*c, WO_O) + (size_t)u.pn * 256 * 512; return true;
    }
};
struct EpiMerge2 {
    const Ctx* c;
    static constexpr bool PAIR = false; static constexpr bool FP8 = true;
    static constexpr int GROUP = 4; static constexpr bool EARLY = false; static constexpr bool CHAIN = false; static constexpr bool ROWTAB = false; struct Pre {}; struct UState {}; __device__ __forceinline__ void unit_begin(const Unit&, int, UState&) const {} __device__ __forceinline__ void pre(const Unit&, int, int, Pre&) const {}
    __device__ __forceinline__ void apply(const Unit& u, int row, int c8, const Pre&, const UState&, f32x4 v0l, f32x4 v0h, f32x4 v1l, f32x4 v1h) const {
        bf16_t* o = wsb(*c, A_Y1) + (size_t)(u.pm * 256 + row) * 1024 + u.pn * 256; constexpr float sc_ = W8_INV * MG8_INV;
        *(u32x4*)(o + c8) = pack8(v0l * sc_, v0h * sc_); *(u32x4*)(o + 128 + c8) = pack8(v1l * sc_, v1h * sc_);
    }
};

struct T4Raw { u32x2 y[4]; u32x4 h[4]; };
__device__ __forceinline__ void t4_load(const Ctx& c, int l, int R, int lane, T4Raw& d) {
    const bf16_t* yp = wsb(c, A_Y1) + (size_t)R * 1024;
#pragma unroll
    for (int q = 0; q < 4; ++q) d.y[q] = *((const u32x2*)yp + lane + 64 * q);
    if (l == 0) {
#pragma unroll
        for (int q = 0; q < 4; ++q) d.h[q] = *((const u32x4*)res_rd(c, 0, R) + lane + 64 * q);
    } else {
#pragma unroll
        for (int q = 0; q < 4; ++q) { const u32x2 w = *((const u32x2*)hb_row(c, R) + lane + 64 * q); d.h[q].x = w.x; d.h[q].y = w.y; }
    }
}
__device__ __forceinline__ void ph_t4_router(const Ctx& c, int l) {
    LAS bf16_t* wr = (LAS bf16_t*)c.lds; constexpr int WRP = 1032;
    {
        const GAS unsigned char* src = c.ws + WS_W + (size_t)WO_R * 2;
#pragma unroll
        for (int q = 0; q < 16; ++q) { const int e = c.wave * 8 + (q >> 1), hf = q & 1, m_ = e & 31;
            const int ex = (e & 32) + ((m_ >> 2) & 1) * 16 + (m_ >> 3) * 4 + (m_ & 3);
            __builtin_amdgcn_global_load_lds((const GAS unsigned*)(src + (size_t)ex * 2048 + hf * 1024 + c.lane * 16), (LAS unsigned*)((LAS unsigned char*)wr + e * (WRP * 2) + hf * 1024), 16, 0, 0); }
    }
    LAS unsigned* hist = (LAS unsigned*)(c.lds + 64 * WRP * 2 + c.wave * 512);
    LAS unsigned* stash = (LAS unsigned*)(c.lds + 64 * WRP * 2 + 4096 + c.wave * 2048);
    LAS float* brl = (LAS float*)(c.lds + 64 * WRP * 2 + 4096 + 8 * 2048);
    static_assert(64 * WRP * 2 + 4096 + 8 * 2048 + 256 <= LDS_MISC, "router LDS map");
    if (c.tid < 64) brl[c.tid] = INP(c, I_BROUTER)[l * 64 + c.tid];
    LAS unsigned* wgh = (LAS unsigned*)(c.lds + 64 * WRP * 2 + 4096 + 8 * 2048 + 256);
    LAS unsigned* wgb = wgh + 64;
    static_assert(64 * WRP * 2 + 4096 + 8 * 2048 + 768 <= LDS_MISC && NCHUNK == 1, "router LDS map (workgroup-level position allocation assumes one token chunk)");
    if (c.tid < 64) wgh[c.tid] = 0u;
    const int r32 = c.lane & 31, hi = c.lane >> 5;
    unsigned* CNT = (unsigned*)(c.ws + CTL_CNT);
    const int NGV = (l == 0) ? NR / 32 : NB * (SEQ / 32);
#define T4_GROUP(q) ((l == 0) ? (q) : (((q) >> 6) * 72 + 8 + ((q) & 63)))
    const bool even_ = (l == 0) && (c.G == 256);
    const int gq0 = (c.blk * NGV) / c.G, ngrp = even_ ? 5 : ((c.blk + 1) * NGV) / c.G - gq0;
    {
        const int nrow = even_ ? 144 : ngrp * 32;
#define T4_ROW(j) (even_ ? (c.blk * 144 + (j)) : (T4_GROUP(gq0 + ((j) >> 5)) * 32 + ((j) & 31)))
        T4Raw ra, rb, rc; f32x4 h[4], am[4], mul[4], add[4]; int key = -1;
#pragma unroll
        for (int q = 0; q < 4; ++q) { ra.y[q] = (u32x2){0u, 0u}; ra.h[q] = (u32x4){0u, 0u, 0u, 0u}; rb.y[q] = ra.y[q]; rb.h[q] = ra.h[q]; rc.y[q] = ra.y[q]; rc.h[q] = ra.h[q]; }
        int j = c.wave;
        if (j < nrow) t4_load(c, l, T4_ROW(j), c.lane, ra);
        if (j + 8 < nrow) t4_load(c, l, T4_ROW(j + 8), c.lane, rb);
#pragma unroll 1
        for (; j < nrow; j += 8) { const int R = T4_ROW(j);
            if (j + 16 < nrow) t4_load(c, l, T4_ROW(j + 16), c.lane, rc);
            f32x4 y[4];
#pragma unroll
            for (int q = 0; q < 4; ++q) { y[q] = (f32x4){bflo(ra.y[q].x), bfhi(ra.y[q].x), bflo(ra.y[q].y), bfhi(ra.y[q].y)};
                if (l == 0) h[q] = __builtin_bit_cast(f32x4, ra.h[q]);
                else h[q] = (f32x4){bflo(ra.h[q].x), bfhi(ra.h[q].x), bflo(ra.h[q].y), bfhi(ra.h[q].y)}; }
            if (batch_key(R) != key) { key = batch_key(R); const float* g1 = INP(c, I_GPOSTMIX) + l * DM; const float* m2 = modvec(c, l, R, 2);
#pragma unroll
                for (int q = 0; q < 4; ++q) { const int o = c.lane + 64 * q; am[q] = *((const f32x4*)m2 + o) * *((const f32x4*)g1 + o); }
                mod_fold(c, INP(c, I_GPREFFN) + l * DM, l, R, 3, 4, c.lane, mul, add); }
            const float rs1 = 1.f / sqrtf(row_sumsq(y) * (1.f / DM) + EPSN);
#pragma unroll
            for (int q = 0; q < 4; ++q) h[q] += am[q] * (y[q] * rs1);
            bf16_t* hw = hb_row(c, R);
#pragma unroll
            for (int q = 0; q < 4; ++q) { u32x2 w_; w_.x = pk2(h[q].x, h[q].y); w_.y = pk2(h[q].z, h[q].w); *((u32x2*)hw + c.lane + 64 * q) = w_; }
            const float rs2 = 1.f / sqrtf(row_sumsq(h) * (1.f / DM) + EPSN);
            { bf16_t* orow = wsb(c, A_FXR) + (size_t)R * DM; unsigned char* o8 = (unsigned char*)(c.ws + A_HX) + (size_t)R * DM;
#pragma unroll
              for (int q = 0; q < 4; ++q) { const f32x4 yy = (h[q] * rs2) * mul[q] + add[q]; u32x2 w_; w_.x = pk2(yy.x, yy.y); w_.y = pk2(yy.z, yy.w); *((u32x2*)orow + c.lane + 64 * q) = w_;
                  *((unsigned*)o8 + c.lane + 64 * q) = pack4_fp8c(yy, 1.f); } }
#pragma unroll
            for (int q = 0; q < 4; ++q) { ra.y[q] = rb.y[q]; ra.h[q] = rb.h[q]; rb.y[q] = rc.y[q]; rb.h[q] = rc.h[q]; }
        }
#undef T4_ROW
    }
    asm volatile("s_waitcnt vmcnt(0)" ::: "memory");
    __syncthreads();
#define T4SLOT(i) (((volatile LAS unsigned long long*)(c.lds + LDS_MISC + 128))[i])
    if (TMASK & 4096) T4SLOT(65) = __builtin_amdgcn_s_memrealtime();
    int ei[8]; float ew[8]; unsigned rk[8]; float wn = 0.f; int R = 0; bool tok_ok = true;
#pragma unroll
    for (int k = 0; k < 8; ++k) { ei[k] = 0; ew[k] = 0.f; rk[k] = 0u; }
    if (c.wave < ngrp) {
        const int R0 = even_ ? c.blk * 144 + c.wave * 32 : T4_GROUP(gq0 + c.wave) * 32;
#undef T4_GROUP
        typedef float f32x16 __attribute__((ext_vector_type(16)));
        f32x16 a0 = {}, a1 = {};
        const bf16_t* fxp = wsb(c, A_FXR) + (size_t)(R0 + r32) * 1024 + hi * 8;
        bf16x8 fb[2][16];
#pragma unroll
        for (int i = 0; i < 16; ++i) fb[0][i] = *(const bf16x8*)(fxp + i * 16);
#pragma unroll
        for (int bt = 0; bt < 4; ++bt) {
            if (bt + 1 < 4) {
#pragma unroll
                for (int i = 0; i < 16; ++i) fb[(bt + 1) & 1][i] = *(const bf16x8*)(fxp + ((bt + 1) * 16 + i) * 16); }
#pragma unroll
            for (int i = 0; i < 16; ++i) { const int s = bt * 16 + i;
                const bf16x8 w0 = *(const LAS bf16x8*)(wr + r32 * WRP + s * 16 + hi * 8), w1 = *(const LAS bf16x8*)(wr + (32 + r32) * WRP + s * 16 + hi * 8);
                a0 = __builtin_amdgcn_mfma_f32_32x32x16_bf16(w0, fb[bt & 1][i], a0, 0, 0, 0); a1 = __builtin_amdgcn_mfma_f32_32x32x16_bf16(w1, fb[bt & 1][i], a1, 0, 0, 0); }
        }
        if (TMASK & 8192) { asm volatile("" :: "v"(a0), "v"(a1)); if (c.wave == 0) T4SLOT(42 + l) = __builtin_amdgcn_s_memrealtime() - T4SLOT(65); }
        float sel[32];
        { const LAS float* bl0 = brl + hi * 16; const LAS float* bl1 = brl + 32 + hi * 16;
#pragma unroll
          for (int i = 0; i < 16; ++i) { sel[i] = sigmoidf_(a0[i]) + bl0[i]; sel[16 + i] = sigmoidf_(a1[i]) + bl1[i]; } }
        float gsm[4], gso[4];
#pragma unroll
        for (int G = 0; G < 4; ++G) { float m1 = -INFINITY, m2 = -INFINITY;
#pragma unroll
            for (int q = 0; q < 8; ++q) { const float v = sel[G * 8 + q]; if (v > m1) { m2 = m1; m1 = v; } else if (v > m2) m2 = v; }
            gsm[G] = m1 + m2; }
#pragma unroll
        for (int G = 0; G < 4; ++G) gso[G] = __shfl_xor(gsm[G], 32);
#pragma unroll
        for (int G = 0; G < 4; ++G) { const int gi = (G >> 1) * 4 + 2 * hi + (G & 1); int rank = 0;
#pragma unroll
            for (int q = 0; q < 4; ++q) { const int qm = (q >> 1) * 4 + 2 * hi + (q & 1), qo = (q >> 1) * 4 + 2 * (1 - hi) + (q & 1);
                rank += (gsm[q] > gsm[G] || (gsm[q] == gsm[G] && qm < gi)) ? 1 : 0;
                rank += (gso[q] > gsm[G] || (gso[q] == gsm[G] && qo < gi)) ? 1 : 0; }
#pragma unroll
            for (int q = 0; q < 8; ++q) { const int i = G * 8 + q; const int e = (i < 16) ? hi * 16 + i : 32 + hi * 16 + (i - 16);
                const float key = __builtin_bit_cast(float, (__builtin_bit_cast(unsigned, sel[i]) & ~63u) | (unsigned)(63 - e)); sel[i] = (rank >= 4) ? -1e30f : key; } }
        float wsum = 0.f;
#pragma unroll 1
        for (int k = 0; k < 8; ++k) { float best = sel[0];
#pragma unroll
            for (int e = 1; e < 32; ++e) best = fmaxf(best, sel[e]);
            best = fmaxf(best, __shfl_xor(best, 32));
#pragma unroll
            for (int e = 0; e < 32; ++e) sel[e] = (sel[e] == best) ? -1e30f : sel[e];
            const int bi = 63 - (int)(__builtin_bit_cast(unsigned, best) & 63u); const float bs = best - brl[bi];
            stash[k * 64 + c.lane] = (__builtin_bit_cast(unsigned, bs) & ~63u) | (unsigned)bi; wsum += bs; }
        asm volatile("s_waitcnt lgkmcnt(0)" ::: "memory");
#pragma unroll
        for (int k = 0; k < 8; ++k) { const unsigned w_ = stash[k * 64 + c.lane]; ei[k] = (int)(w_ & 63u); ew[k] = __builtin_bit_cast(float, w_ & ~63u); }
        wn = 2.5f / wsum;
        R = R0 + r32;
        hist[c.lane] = 0u; asm volatile("s_waitcnt lgkmcnt(0)" ::: "memory");
        tok_ok = !(even_ && c.wave == 4 && r32 >= 16);
#pragma unroll
        for (int k = 0; k < 8; ++k) { rk[k] = 0u; if (hi == 0 && tok_ok) rk[k] = atomicAdd((unsigned*)&hist[ei[k]], 1u); }
        asm volatile("s_waitcnt lgkmcnt(0)" ::: "memory");
        { const unsigned cnt = hist[c.lane]; unsigned off = 0u; if (cnt) off = atomicAdd((unsigned*)&wgh[c.lane], cnt); hist[64 + c.lane] = off; }
        asm volatile("s_waitcnt lgkmcnt(0)" ::: "memory");
    }
    __syncthreads();
    if (c.tid < 64) { const unsigned tot = wgh[c.tid]; unsigned base = 0u; if (tot) base = atomicAdd(CNT + (l * 2) * 128 + c.tid, tot); wgb[c.tid] = base; asm volatile("s_waitcnt vmcnt(0) lgkmcnt(0)" ::: "memory"); }
    __syncthreads();
    if (c.wave < ngrp && hi == 0 && tok_ok) {
        unsigned* rt_ = (unsigned*)(c.ws + WS_REGT); float* rw_ = (float*)(c.ws + WS_REGW);
#pragma unroll
        for (int k = 0; k < 8; ++k) { const unsigned pos = wgb[ei[k]] + hist[64 + ei[k]] + rk[k]; const size_t o = (size_t)ei[k] * CAP + pos;
            rt_[o] = ((unsigned)R << 4) | (unsigned)k; rw_[o] = ew[k] * wn; }
    }
    __syncthreads();
    if (TMASK & 4096) T4SLOT(40 + l) = __builtin_amdgcn_s_memrealtime() - T4SLOT(65);
#undef T4SLOT
}

struct MoeTab { LAS int* tstart; int TR, nsh, ch, l; };
__device__ __forceinline__ MoeTab moe_table(const Ctx& c, int l, int ch) {
    MoeTab T; T.tstart = (LAS int*)(c.lds + LDS_RING + 1024 + ch * 4096); T.ch = ch; T.l = l;
    LAS int* tile_e = (LAS int*)(c.lds + LDS_RING + 2048 + ch * 4096);
    __syncthreads();
    if (c.tid < 64) {
        unsigned* CNT = (unsigned*)(c.ws + CTL_CNT) + (l * 2 + ch) * 128;
        const int n = (int)__hip_atomic_load(CNT + c.tid, __ATOMIC_RELAXED, __HIP_MEMORY_SCOPE_AGENT); const int tiles = (n + 255) >> 8;
        int x = tiles;
#pragma unroll
        for (int d = 1; d < 64; d <<= 1) { const int y = __shfl_up(x, d); if (c.tid >= d) x += y; }
        T.tstart[c.tid] = x - tiles; T.tstart[65 + c.tid] = n; if (c.tid == 63) T.tstart[64] = x; }
    __syncthreads();
    T.TR = T.tstart[64]; T.nsh = (l == 0) ? CHROWS / 256 : (NB / NCHUNK) * SEQ / 256;
    for (int t = c.tid; t < T.TR; t += 512) { int lo = 0;
#pragma unroll 1
        for (int st = 32; st >= 1; st >>= 1) { const int q = lo + st; if (q < 64 && T.tstart[q] <= t) lo = q; }
        tile_e[t] = lo; }
    __syncthreads();
    return T;
}
__device__ __forceinline__ void moe_tile(const Ctx& c, const MoeTab& T, int t, int& e, int& j, int& nrows, const unsigned*& rows, int& pm_sh) {
    if (t < T.TR) { e = ((LAS int*)(c.lds + LDS_RING + 2048 + T.ch * 4096))[t]; j = t - T.tstart[e]; const int n = T.tstart[65 + e]; nrows = min(256, n - 256 * j);
        rows = (const unsigned*)(c.ws + WS_REGT) + ((size_t)T.ch * 64 + e) * CAP + 256 * j; pm_sh = 0; }
    else { const int s = t - T.TR; e = 64; j = s; nrows = 256; rows = nullptr;
        const int bl = (T.l == 0) ? s / 9 : s / 8, r9 = (T.l == 0) ? s % 9 : 1 + (s % 8); pm_sh = (T.ch * (NB / NCHUNK) + bl) * 9 + r9; }
}
struct SchedGU {
    static constexpr bool GATHER = true;
    const Ctx* c; MoeTab T0, T1;
    __device__ bool next(int i, Unit& u) const {
        const int L = deal_xcd(*c, i); int t = L >> 1; const int n0 = T0.TR + T0.nsh;
        const bool second = t >= n0; if (second) t -= n0;
        const MoeTab& T = second ? T1 : T0;
        if (t >= T.TR + T.nsh) return false;
        int e, j, nrows, pm_sh; const unsigned* rows; moe_tile(*c, T, t, e, j, nrows, rows, pm_sh);
        u.pn = L & 1; u.pm = T.ch * ACT_TILES + t; u.kind = (e < 64) ? 0 : 1; u.bperm = 0; u.K = 512  ; u.rows = rows; u.nrows = nrows; u.aux = e; u.aux2 = T.ch * CHROWS + CTXL;
        u.a = (e < 64) ? wsb(*c, A_HX) : wsb(*c, A_HX) + (size_t)pm_sh * 256 * 512;
        u.b = wt(*c, WO_GU) + (size_t)e * 262144 + (size_t)u.pn * 256 * 512; return true;
    }
};
struct EpiGU {
    const Ctx* c; int ch;
    static constexpr bool PAIR = true; static constexpr bool FP8 = true;
    static constexpr int GROUP = 4; static constexpr bool EARLY = false; static constexpr bool CHAIN = false; static constexpr bool ROWTAB = false; struct Pre { float w; };
    struct UState {}; __device__ __forceinline__ void unit_begin(const Unit&, int, UState&) const {}
    __device__ __forceinline__ void pre(const Unit& u, int row, int c8, Pre& p) const {
        p.w = 1.f;
        if (u.kind == 0) { p.w = 0.f; if (row < u.nrows) p.w = ((const float*)(c->ws + WS_REGW))[(u.rows - (const unsigned*)(c->ws + WS_REGT)) + row]; }
    }
    __device__ __forceinline__ u32x2 act8(const Pre& p, f32x4 gl, f32x4 gh, f32x4 ul, f32x4 uh) const {
        const float w = p.w * W8_INV; gl *= W8_INV; gh *= W8_INV;
#pragma unroll
        for (int i = 0; i < 4; ++i) { gl[i] = gl[i] * sigmoidf_(gl[i]) * ul[i] * w; gh[i] = gh[i] * sigmoidf_(gh[i]) * uh[i] * w; }
        return (u32x2){pack4_fp8c(gl, ACT8_SCALE), pack4_fp8c(gh, ACT8_SCALE)};
    }
    __device__ __forceinline__ void apply2(const Unit& u, int rowA, int rowB, int c8, const Pre& pA, const Pre& pB, const UState&, f32x4 gAl, f32x4 gAh, f32x4 uAl, f32x4 uAh, f32x4 gBl, f32x4 gBh, f32x4 uBl, f32x4 uBh) const {
        u32x2 a = act8(pA, gAl, gAh, uAl, uAh), b = act8(pB, gBl, gBh, uBl, uBh);
        { auto r = __builtin_amdgcn_permlane16_swap(a.x, b.x, false, false); a.x = r[0]; b.x = r[1]; }
        { auto r = __builtin_amdgcn_permlane16_swap(a.y, b.y, false, false); a.y = r[0]; b.y = r[1]; }
        const bool odd = (c8 >> 3) & 1;
        const int row = odd ? rowB : rowA, col = odd ? c8 - 8 : c8;
        *(u32x4*)((unsigned char*)(c->ws + A_ACT) + ((size_t)u.pm * 256 + row) * 256 + u.pn * 128 + col) = (u32x4){a.x, a.y, b.x, b.y};
    }
    __device__ __forceinline__ void apply(const Unit& u, int row, int c8, const Pre& p, const UState&, f32x4 gl, f32x4 gh, f32x4 ul, f32x4 uh) const {
        const float w = p.w * W8_INV;
        gl *= W8_INV; gh *= W8_INV;
#pragma unroll
        for (int i = 0; i < 4; ++i) { gl[i] = gl[i] * sigmoidf_(gl[i]) * ul[i] * w; gh[i] = gh[i] * sigmoidf_(gh[i]) * uh[i] * w; }
#pragma unroll
        for (int i = 0; i < 4; ++i) { gl[i] = __builtin_amdgcn_fmed3f(gl[i] * ACT8_SCALE, -448.f, 448.f); gh[i] = __builtin_amdgcn_fmed3f(gh[i] * ACT8_SCALE, -448.f, 448.f); }
        *(u32x2*)((unsigned char*)(c->ws + A_ACT) + ((size_t)u.pm * 256 + row) * 256 + u.pn * 128 + c8) = (u32x2){pack4_fp8s(gl.x, gl.y, gl.z, gl.w, 1.f), pack4_fp8s(gh.x, gh.y, gh.z, gh.w, 1.f)};
    }
};
struct SchedD {
    static constexpr bool GATHER = false;
    const Ctx* c; MoeTab T;
    __device__ bool next(int i, Unit& u) const {
        const int L = deal_xcd(*c, i); const int t = L >> 2; if (t >= T.TR + T.nsh) return false;
        int e, j, nrows, pm_sh; const unsigned* rows; moe_tile(*c, T, t, e, j, nrows, rows, pm_sh);
        u.pn = L & 3; u.pm = t; u.kind = (e < 64) ? 0 : 1; u.bperm = 2; { int k_ = 128  ; asm volatile("" : "+s"(k_)); u.K = k_; }     u.rows = nullptr; u.nrows = nrows; u.aux = pm_sh;
        u.a = wsb(*c, A_ACT) + (size_t)(T.ch * ACT_TILES + t) * 256 * 128; u.b = wt(*c, WO_D) + (size_t)e * 131072 + (size_t)u.pn * 256 * 128;
        u.aux2 = (e < 64) ? (int)(rows - (const unsigned*)(c->ws + WS_REGT)) : -1;
        return true;
    }
};
struct EpiD {
    const Ctx* c; int ch;
    static constexpr bool PAIR = false; static constexpr bool FP8 = true;
    static constexpr int GROUP = 8; static constexpr bool EARLY = false; static constexpr bool CHAIN = false; static constexpr bool ROWTAB = true; struct Pre { unsigned ent; };
    static constexpr int TAB_OFF = LDS_RING + 12288;
    __device__ __forceinline__ void rowtab_dma(const Unit& u, LAS unsigned char* lds, int wid, int lane, int par) const {
        if (u.kind == 0 && wid < 4)
            __builtin_amdgcn_global_load_lds((const GAS unsigned*)(c->ws + WS_REGT) + (size_t)u.aux2 + wid * 64 + lane, (LAS unsigned*)(lds + TAB_OFF + par * 1024 + wid * 256), 4, 0, 0);
    }
    __device__ __forceinline__ void pre_tab(const Unit& u, int row, LAS unsigned char* lds, int par, Pre& p) const { p.ent = ((const LAS unsigned*)(lds + TAB_OFF + par * 1024))[row]; }
    struct UState {}; __device__ __forceinline__ void unit_begin(const Unit&, int, UState&) const {}
    __device__ __forceinline__ void pre(const Unit& u, int row, int c8, Pre& p) const {
        p.ent = 0u; if (u.kind == 0 && row < u.nrows) p.ent = ((const unsigned*)(c->ws + WS_REGT))[(size_t)u.aux2 + row];
    }
    __device__ __forceinline__ void apply(const Unit& u, int row, int c8, const Pre& p, const UState& us, f32x4 v0l, f32x4 v0h, f32x4 v1l, f32x4 v1h) const {
        if (row >= u.nrows) return;
        size_t slot;
        if (u.kind == 0) { const unsigned ent = p.ent; slot = (size_t)((int)(ent >> 4) - ch * CHROWS) * 9 + (ent & 15u); }
        else slot = (size_t)(u.aux * 256 + row - ch * CHROWS) * 9 + 8;
        unsigned char* o = (unsigned char*)(c->ws + A_Y) + slot * 1024 + u.pn * 256 + 2 * c8;
        constexpr float SC = Y_SCALE * W8_INV * ACT8_INV;
        *(u32x4*)o = (u32x4){pack4_fp8c(v0l, SC), pack4_fp8c(v0h, SC), pack4_fp8c(v1l, SC), pack4_fp8c(v1h, SC)};
    }
};
struct CombRow { u32x4 y[9]; u32x4 h[2]; };
__device__ __forceinline__ void comb_load(const Ctx& c, int rr, int R, CombRow& d) {
    const unsigned char* yp = (const unsigned char*)(c.ws + A_Y) + (size_t)rr * 9 * 1024 + c.lane * 16;
#pragma unroll
    for (int k = 0; k < 9; ++k) d.y[k] = *(const u32x4*)(yp + k * 1024);
    const bf16_t* hp = hb_row(c, R) + c.lane * 16;
    d.h[0] = *(const u32x4*)hp; d.h[1] = *(const u32x4*)(hp + 8);
}
__device__ __forceinline__ void ph_combine(const Ctx& c, int l, int ch) {
    const int gw = c.blk * 8 + c.wave, NGW = c.G * 8;
    const int nv = (l == 0) ? CHROWS : (NB / NCHUNK) * SEQ;
#define COMB_RR(v) ((l == 0) ? (v) : (((v) >> 11) * RPB + CTXL + ((v) & 2047)))
    const int per = (nv + NGW - 1) / NGW, v0 = gw * per, v1 = min(nv, v0 + per);
    CombRow cur, nxt;
    f32x4 am[4], mul[4], add[4]; int key = -1;
    int v = v0;
    if (v < v1) comb_load(c, COMB_RR(v), ch * CHROWS + COMB_RR(v), cur);
    for (; v < v1; ++v) {
        const int rr = COMB_RR(v), R = ch * CHROWS + rr;
        const int v2 = v + 1;
        if (v2 < v1) comb_load(c, COMB_RR(v2), ch * CHROWS + COMB_RR(v2), nxt);
        if (batch_key(R) != key) { key = batch_key(R);
            const float* g = INP(c, I_GPOSTFFN) + l * DM + c.lane * 16; const float* m5 = modvec(c, l, R, 5) + c.lane * 16;
#pragma unroll
            for (int j = 0; j < 4; ++j) am[j] = *((const f32x4*)m5 + j) * *((const f32x4*)g + j);
            if (l == 0) { const float* g2 = INP(c, I_GPREMIX) + 1 * DM + c.lane * 16; const float* sh = modvec(c, 1, R, 0) + c.lane * 16; const float* sc = modvec(c, 1, R, 1) + c.lane * 16;
#pragma unroll
                for (int j = 0; j < 4; ++j) { mul[j] = *((const f32x4*)g2 + j) * (*((const f32x4*)sc + j) + 1.0f); add[j] = *((const f32x4*)sh + j); } } }
        f32x4 f[4];
#pragma unroll
        for (int j = 0; j < 4; ++j) f[j] = (f32x4){0.f, 0.f, 0.f, 0.f};
#pragma unroll
        for (int k = 0; k < 9; ++k) { f[0] += unpack4_fp8(cur.y[k].x); f[1] += unpack4_fp8(cur.y[k].y); f[2] += unpack4_fp8(cur.y[k].z); f[3] += unpack4_fp8(cur.y[k].w); }
#pragma unroll
        for (int j = 0; j < 4; ++j) f[j] *= Y_INV;
        const float rs = 1.f / sqrtf(row_sumsq(f) * (1.f / DM) + EPSN);
        f32x4 h[4];
        { f32x4 ha, hb2; unpack8(cur.h[0], ha, hb2); h[0] = ha; h[1] = hb2; unpack8(cur.h[1], ha, hb2); h[2] = ha; h[3] = hb2; }
#pragma unroll
        for (int j = 0; j < 4; ++j) h[j] += am[j] * (f[j] * rs);
        LAS unsigned char* rowb = (l == 0) ? c.lds + 131072 + c.wave * 2048 : c.lds + c.wave * 4096;
        static_assert(131072 + 8 * 2048 <= LDS_MISC, "combine row buffers");
        if (l == 0) { *(LAS u32x4*)(rowb + c.lane * 32) = pack8(h[0], h[1]); *(LAS u32x4*)(rowb + c.lane * 32 + 16) = pack8(h[2], h[3]);
            asm volatile("s_waitcnt lgkmcnt(0)" ::: "memory");
            const u32x4 w0 = *(const LAS u32x4*)(rowb + c.lane * 16), w1 = *(const LAS u32x4*)(rowb + 1024 + c.lane * 16);
            unsigned char* hw = (unsigned char*)hb_row(c, R); *(u32x4*)(hw + c.lane * 16) = w0; *(u32x4*)(hw + 1024 + c.lane * 16) = w1; }
        else {
#pragma unroll
            for (int j = 0; j < 4; ++j) *(LAS f32x4*)(rowb + c.lane * 64 + j * 16) = h[j];
            asm volatile("s_waitcnt lgkmcnt(0)" ::: "memory");
            unsigned char* hw = (unsigned char*)out_row(c, R);
#pragma unroll
            for (int j = 0; j < 4; ++j) { const f32x4 w_ = *(const LAS f32x4*)(rowb + j * 1024 + c.lane * 16); *(f32x4*)(hw + j * 1024 + c.lane * 16) = w_; } }
        asm volatile("s_waitcnt lgkmcnt(0)" ::: "memory");
        if (l == 0) { const float rs2 = 1.f / sqrtf(row_sumsq(h) * (1.f / DM) + EPSN);
            f32x4 y[4];
#pragma unroll
            for (int j = 0; j < 4; ++j) y[j] = (h[j] * rs2) * mul[j] + add[j];
            unsigned char* op = (unsigned char*)(c.ws + A_HX) + (size_t)R * DM + c.lane * 16;
            *(u32x4*)op = (u32x4){pack4_fp8c(y[0], 1.f), pack4_fp8c(y[1], 1.f), pack4_fp8c(y[2], 1.f), pack4_fp8c(y[3], 1.f)}; }
        if (v2 < v1) cur = nxt;
    }
#undef COMB_RR
}

__global__ void __launch_bounds__(512, 2) fwd_kernel(Params prm) {
    extern __shared__ __attribute__((aligned(16))) unsigned char lds_raw[];
    Ctx c; c.p = (ParamsK)__builtin_amdgcn_kernarg_segment_ptr(); c.lds = (LAS unsigned char*)lds_raw; c.tid = threadIdx.x; c.lane = c.tid & 63; c.wave = __builtin_amdgcn_readfirstlane(c.tid >> 6);
    c.G = gridDim.x; c.blk = blockIdx.x; c.ws = (GAS unsigned char*)prm.ws; c.z = 0;
    volatile LAS unsigned* MISC = (volatile LAS unsigned*)(c.lds + LDS_MISC);
    if (c.tid < 16) MISC[c.tid] = 0u;
    if (TMASK) { if (c.tid < 160) ((volatile LAS unsigned*)(c.lds + LDS_MISC + 128))[c.tid] = 0u; }
    __syncthreads();
    XcdBarrier bar; bar.bar = (unsigned*)(c.ws + CTL_BAR); bar.x = 0; bar.st = nullptr;
    const int lo = prm.step_lo, hi = prm.step_hi;
    if (hi - lo > 1) bar = xcd_barrier_post((unsigned*)(c.ws + CTL_BAR), MISC + 8);
    int step = 0;
#define TSLOT(i) (((volatile LAS unsigned long long*)((LAS unsigned char*)lds_raw + LDS_MISC + 128))[i])
#define TB(bit) do { if ((TMASK) & (bit)) TSLOT(64) = __builtin_amdgcn_s_memrealtime(); } while (0)
#define TE(bit) do { if ((TMASK) & (bit)) TSLOT(step & 63) = __builtin_amdgcn_s_memrealtime() - TSLOT(64); } while (0)
#define RUN() (step >= lo && step < hi)
#define SEAM() do { if (step >= lo && step + 1 < hi) { XcdBarrier b2_ = bar; asm volatile("" : "+s"(b2_.bar), "+s"(b2_.x)); b2_.bar = (unsigned*)rfl64((unsigned long long)b2_.bar); b2_.x = (unsigned)__builtin_amdgcn_readfirstlane((int)b2_.x); TB(2048); int w_ = c.wave; asm volatile("" : "+s"(w_)); unsigned on_ = ~0u; asm volatile("" : "+s"(on_)); const bool ldr_ = (w_ == 0) && (__builtin_amdgcn_mbcnt_hi(on_, __builtin_amdgcn_mbcnt_lo(on_, 0u)) == 0u); xcd_barrier(b2_, ldr_); TE(2048); } ++step; } while (0)
    { constexpr int l = 0;
        if (RUN()) { TB(1); if (PHM & 1) for (int rep = 0; rep < NREP(1); ++rep) { PHASE_CTX(cl); ph_prologue(cl, l); }  TE(1); }
        SEAM();
        if (l == 0) { if (RUN()) { TB(2); if (PHM & 2) { PHASE_CTX(cl); ph_t1(cl, 0); } } SEAM();  TE(2); }
        if (RUN()) { TB(4); if (PHM & 4) { PHASE_CTX(cl); SchedProj S; S.init(&cl, l); EpiProj E{&cl, l}; GEMM_UNITS(cl, S, E); }  TE(4); }
        SEAM();
        if (RUN()) { TB(8); if (PHM & 8) for (int rep = 0; rep < NREP(8); ++rep) { { PHASE_CTX(cl); SchedUp S; S.init(&cl, l); EpiUp E{&cl, l}; GEMM_UNITS(cl, S, E); } { PHASE_CTX(cl); ph_pool(cl, l); } }  TE(8); }
        SEAM();
        if (RUN()) { TB(16); if (PHM & 16) { { PHASE_CTX(cl); ph_attn_mla(cl, l); } { PHASE_CTX(cl); ph_attn_diff(cl, l); } }  TE(16); }
        SEAM();
        if (RUN()) { TB(32); if (PHM & 32) for (int rep = 0; rep < NREP(32); ++rep) { PHASE_CTX(cl); SchedMerge1 S; S.init(&cl, l); EpiMerge1 E{&cl}; GEMM_UNITS(cl, S, E); }  TE(32); }
        SEAM();
        if (RUN()) { TB(64); if (PHM & 64) for (int rep = 0; rep < NREP(64); ++rep) { PHASE_CTX(cl); SchedMerge2 S; S.init(&cl, l); EpiMerge2 E{&cl}; GEMM_UNITS(cl, S, E); }  TE(64); }
        SEAM();
        if (RUN()) { TB(128); if (PHM & 128) { PHASE_CTX(cl); ph_t4_router(cl, l); }  TE(128); }
        SEAM();
        if (RUN()) { TB(256); if (PHM & 256) for (int rep = 0; rep < NREP(256); ++rep) { PHASE_CTX(cl); SchedGU S; S.c = &cl; S.T0 = moe_table(cl, l, 0); if (NCHUNK > 1) S.T1 = moe_table(cl, l, NCHUNK - 1); else { S.T1 = S.T0; S.T1.TR = 0; S.T1.nsh = 0; } EpiGU E{&cl, 0}; GEMM_UNITS(cl, S, E); }  TE(256); }
        SEAM();
        { constexpr int ch = 0;
            if (RUN()) { TB(512); if (PHM & 512) for (int rep = 0; rep < NREP(512); ++rep) { PHASE_CTX(cl); SchedD S; S.c = &cl; S.T = moe_table(cl, l, ch); EpiD E{&cl, ch}; GEMM_UNITS(cl, S, E); }  TE(512); }
            SEAM();
            if (RUN()) { TB(1024); if (PHM & 1024) { { PHASE_CTX(cl); ph_combine(cl, l, ch); } if (NCHUNK == 1) { PHASE_CTX(cl); ph_prologue(cl, 1); } }  TE(1024); }
            SEAM();

        }
        if constexpr (NCHUNK > 1) { constexpr int ch = 1;
            if (RUN()) { TB(512); if (PHM & 512) for (int rep = 0; rep < NREP(512); ++rep) { PHASE_CTX(cl); SchedD S; S.c = &cl; S.T = moe_table(cl, l, ch); EpiD E{&cl, ch}; GEMM_UNITS(cl, S, E); }  TE(512); }
            SEAM();
            if (RUN()) { TB(1024); if (PHM & 1024) { { PHASE_CTX(cl); ph_combine(cl, l, ch); } { PHASE_CTX(cl); ph_prologue(cl, 1); } }  TE(1024); }
            SEAM();

        }
    }
    { constexpr int l = 1;
        if (l == 0) { if (RUN()) { TB(2); if (PHM & 2) { PHASE_CTX(cl); ph_t1(cl, 0); } } SEAM();  TE(2); }
        if (RUN()) { TB(4); if (PHM & 4) { PHASE_CTX(cl); SchedProj S; S.init(&cl, l); EpiProj E{&cl, l}; GEMM_UNITS(cl, S, E); }  TE(4); }
        SEAM();
        if (RUN()) { TB(8); if (PHM & 8) for (int rep = 0; rep < NREP(8); ++rep) { { PHASE_CTX(cl); SchedUp S; S.init(&cl, l); EpiUp E{&cl, l}; GEMM_UNITS(cl, S, E); } { PHASE_CTX(cl); ph_pool(cl, l); } }  TE(8); }
        SEAM();
        if (RUN()) { TB(16); if (PHM & 16) { { PHASE_CTX(cl); ph_attn_mla(cl, l); } { PHASE_CTX(cl); ph_attn_diff(cl, l); } }  TE(16); }
        SEAM();
        if (RUN()) { TB(32); if (PHM & 32) for (int rep = 0; rep < NREP(32); ++rep) { PHASE_CTX(cl); SchedMerge1 S; S.init(&cl, l); EpiMerge1 E{&cl}; GEMM_UNITS(cl, S, E); }  TE(32); }
        SEAM();
        if (RUN()) { TB(64); if (PHM & 64) for (int rep = 0; rep < NREP(64); ++rep) { PHASE_CTX(cl); SchedMerge2 S; S.init(&cl, l); EpiMerge2 E{&cl}; GEMM_UNITS(cl, S, E); }  TE(64); }
        SEAM();
        if (RUN()) { TB(128); if (PHM & 128) { PHASE_CTX(cl); ph_t4_router(cl, l); }  TE(128); }
        SEAM();
        if (RUN()) { TB(256); if (PHM & 256) for (int rep = 0; rep < NREP(256); ++rep) { PHASE_CTX(cl); SchedGU S; S.c = &cl; S.T0 = moe_table(cl, l, 0); if (NCHUNK > 1) S.T1 = moe_table(cl, l, NCHUNK - 1); else { S.T1 = S.T0; S.T1.TR = 0; S.T1.nsh = 0; } EpiGU E{&cl, 0}; GEMM_UNITS(cl, S, E); }  TE(256); }
        SEAM();
        { constexpr int ch = 0;
            if (RUN()) { TB(512); if (PHM & 512) for (int rep = 0; rep < NREP(512); ++rep) { PHASE_CTX(cl); SchedD S; S.c = &cl; S.T = moe_table(cl, l, ch); EpiD E{&cl, ch}; GEMM_UNITS(cl, S, E); }  TE(512); }
            SEAM();
            if (RUN()) { TB(1024); if (PHM & 1024) { PHASE_CTX(cl); ph_combine(cl, l, ch); }  TE(1024); }
            SEAM();

        }
        if constexpr (NCHUNK > 1) { constexpr int ch = 1;
            if (RUN()) { TB(512); if (PHM & 512) for (int rep = 0; rep < NREP(512); ++rep) { PHASE_CTX(cl); SchedD S; S.c = &cl; S.T = moe_table(cl, l, ch); EpiD E{&cl, ch}; GEMM_UNITS(cl, S, E); }  TE(512); }
            SEAM();
            if (RUN()) { TB(1024); if (PHM & 1024) { PHASE_CTX(cl); ph_combine(cl, l, ch); }  TE(1024); }
            SEAM();

        }
    }
    if (TMASK) { __syncthreads(); if (blockIdx.x == 0) { unsigned long long tacc_ = 0ull; for (int i = 0; i < 64; ++i) tacc_ += TSLOT(i);
        const unsigned long long ts_ = __builtin_amdgcn_s_memrealtime(); while (__builtin_amdgcn_s_memrealtime() - ts_ < tacc_) __builtin_amdgcn_s_sleep(8); } }
#undef RUN
#undef SEAM
}
constexpr int N_STEPS = 2 * (8 + 2 * NCHUNK);

extern "C" void kernel_launch(void* const* d_in, const int* in_sizes, int n_in, void* d_out, int out_size, void* d_ws, size_t ws_size, hipStream_t stream) {
    static int grid = 0;
    if (grid == 0) {
        if (n_in != 34 || out_size != NB * SEQ * DM || ws_size < WS_END) { fprintf(stderr, "kernel_launch: unexpected shapes (n_in %d out %d ws %zu need %zu)\n", n_in, out_size, ws_size, (size_t)WS_END); grid = -1; return; }
        int dev = 0, cus = 0;
        if (hipGetDevice(&dev) != hipSuccess || hipDeviceGetAttribute(&cus, hipDeviceAttributeMultiprocessorCount, dev) != hipSuccess) { grid = -1; return; }
        if (hipFuncSetAttribute((const void*)fwd_kernel, hipFuncAttributeMaxDynamicSharedMemorySize, LDS_BYTES) != hipSuccess) { fprintf(stderr, "kernel_launch: hipFuncSetAttribute failed\n"); grid = -1; return; }
        int per_cu = 0; (void)hipOccupancyMaxActiveBlocksPerMultiprocessor(&per_cu, (const void*)fwd_kernel, 512, LDS_BYTES); (void)hipGetLastError();
        if (per_cu < 1) fprintf(stderr, "kernel_launch: occupancy query says %d\n", per_cu);
        grid = cus;
    }
    if (grid < 0) return;
    (void)hipMemsetAsync((char*)d_ws + WS_CTL, 0, CTL_BYTES, stream);
    Params p{};
    for (int i = 0; i < 34; ++i) p.in[i] = (const float*)d_in[i];
    p.out = (float*)d_out; p.ws = (unsigned char*)d_ws;
#if N_LAUNCH_MODE == 1
    p.step_lo = 0; p.step_hi = N_STEPS;
    hipLaunchKernelGGL(fwd_kernel, dim3(grid), dim3(512), LDS_BYTES, stream, p);
#else
    for (int s = 0; s < N_STEPS; ++s) { p.step_lo = s; p.step_hi = s + 1; hipLaunchKernelGGL(fwd_kernel, dim3(grid), dim3(512), LDS_BYTES, stream, p); }
#endif
}
```

```cpp
#include <hip/hip_runtime.h>
#include <cstdio>
#include <cstdint>
#include <cmath>

#ifndef PHM
#define PHM 0xFFFF
#endif
#ifndef USE_FAST_ATTN
#define USE_FAST_ATTN 1
#endif
#if USE_FAST_ATTN
#define ATTN_PHASE ph_attn_fast
#else
#define ATTN_PHASE ph_attn_naive
#endif
#ifndef REP
#define REP 0
#endif
#define NREP(bit) (((REP) & (bit)) ? 2 : 1)
#ifndef TMASK
#define TMASK 0
#endif
#ifndef ATT_TEST_NODIFF
#define ATT_TEST_NODIFF 0
#endif
#ifndef ATT_TEST_NOMLA
#define ATT_TEST_NOMLA 0
#endif
#ifndef N_LAUNCH_MODE
#define N_LAUNCH_MODE 1
#endif

#define GAS __attribute__((address_space(1)))
#define LAS __attribute__((address_space(3)))
typedef unsigned short bf16_t;
typedef float f32x4 __attribute__((ext_vector_type(4)));
typedef float f32x2 __attribute__((ext_vector_type(2)));
typedef unsigned u32x4 __attribute__((ext_vector_type(4)));
typedef unsigned u32x2 __attribute__((ext_vector_type(2)));
typedef short bf16x8 __attribute__((ext_vector_type(8)));

constexpr int DM = 1024, NB = 16, SEQ = 2048, CTXL = 256, RPB = SEQ + CTXL  ;
constexpr int NR = NB * RPB;
constexpr int NTILE = NR / 256;
constexpr int IN_COLS = 5792, KV_COLS = 1312;
constexpr int NEXP = 64, EFF = 256;
constexpr int NCHUNK = 1, CHROWS = NR / NCHUNK, CAP = CHROWS;
constexpr float EPSN = 1e-6f;
constexpr float LOG2E = 1.4426950408889634f;
constexpr float C2M = 0.10206207261596577f * LOG2E;
constexpr float C2D = 0.125f * LOG2E;

constexpr size_t WO_IN = 0;
constexpr size_t WO_VD = WO_IN + 2304ull * 1024 / 2;
constexpr size_t WO_G  = WO_VD + 512ull * 1024 / 2;
constexpr size_t WO_UK = WO_G + 3072ull * 1024 / 2;
constexpr size_t WO_UV = WO_UK + 512ull * 256;
constexpr size_t WO_UQ = WO_UV + 512ull * 256;
constexpr size_t WO_BM = WO_UQ + 768ull * 384;
constexpr size_t WO_PP = WO_BM + 1024ull * 512 / 2;
constexpr size_t WO_BD = WO_PP + 1024ull * 512 / 2;
constexpr size_t WO_O  = WO_BD + 1024ull * 512 / 2;
constexpr size_t WO_R  = WO_O + 1024ull * 1024 / 2;
constexpr size_t WO_GU = WO_R + 64ull * 1024;
constexpr size_t WO_D  = WO_GU + 65ull * 512 * 1024 / 2;
constexpr size_t W_ELEMS = WO_D + 65ull * 1024 * 256 / 2;

constexpr size_t WS_CTL = 0, CTL_BYTES = 3u << 20;
constexpr size_t CTL_BAR = 16384;
constexpr size_t CTL_CNT = 65536;
constexpr size_t CTL_SSKV = 131072;
constexpr size_t CTL_SSQ = CTL_SSKV + 2ull * NR * 8;
constexpr size_t CTL_MOD = CTL_SSQ + 2ull * NR * 8;
static_assert(CTL_MOD + 2ull * 17 * 6144 * 4 <= CTL_BYTES, "ctl");
constexpr size_t WS_TAB64 = CTL_BYTES;
constexpr size_t WS_TAB32 = WS_TAB64 + 2048ull * 32 * 8;
constexpr size_t WS_W = WS_TAB32 + 2048ull * 16 * 8;
constexpr size_t WS_REGT = WS_W + W_ELEMS * 2;
constexpr size_t WS_REGW = WS_REGT + (size_t)NCHUNK * 64 * CAP * 4;
constexpr size_t WS_ACT0 = WS_REGW + (size_t)NCHUNK * 64 * CAP * 4;
constexpr size_t SZ_ROW2K = (size_t)NR * 2048, SZ_ROW1K = (size_t)NR * 1024;
constexpr size_t A_HB = WS_ACT0;
constexpr size_t A_HX = A_HB + SZ_ROW2K;
constexpr size_t A_PD = A_HX;
constexpr size_t A_VMT = A_HX + SZ_ROW1K;
constexpr size_t A_KD = A_HX + SZ_ROW2K;
constexpr size_t A_VDT = A_KD + SZ_ROW1K;
constexpr size_t A_QD = A_VDT + SZ_ROW1K;
constexpr size_t A_OM = A_QD + SZ_ROW1K;
constexpr size_t A_PL = A_OM + SZ_ROW1K;
constexpr size_t A_CKV = A_PL + SZ_ROW1K;
constexpr size_t A_CQ = A_CKV + (size_t)NR * 512;
constexpr size_t A_KN = A_CQ + (size_t)NR * 768;
constexpr size_t A_KR = A_KN + SZ_ROW1K;
constexpr size_t A_QM = A_KR + (size_t)NR * 64;
constexpr size_t A_MIXEND = A_QM + (size_t)NR * 1536;
static_assert((size_t)NR * 3072 <= (size_t)NB * SEQ * DM * 4, "gates fit in d_out");
constexpr size_t A_MG = A_PL;
constexpr size_t A_Y1 = A_KN;
constexpr size_t A_SCR = A_KD;
static_assert(A_MG + SZ_ROW2K <= A_KN && A_Y1 + SZ_ROW2K <= A_MIXEND && 256ull * 131072 <= 2 * SZ_ROW1K, "overlays");
constexpr int ACT_TILES = (CHROWS * 8) / 256 + 64 + CHROWS / 256;
constexpr size_t A_ACT = A_KD;
constexpr size_t A_Y = A_ACT + (size_t)NCHUNK * ACT_TILES * 256 * 256;
constexpr size_t A_FXR = A_KD;
constexpr size_t A_YEND = (A_Y + (size_t)CHROWS * 9 * 1024) > A_MIXEND ? (A_Y + (size_t)CHROWS * 9 * 1024) : A_MIXEND;
constexpr size_t A_OD8 = A_HX + (size_t)NR * 512;
constexpr size_t WS_END = A_YEND;
static_assert(WS_END <= 684360192ull, "workspace budget");

__device__ __forceinline__ unsigned f2bf(float f) { unsigned u = __builtin_bit_cast(unsigned, f); return (u + 0x7fffu + ((u >> 16) & 1u)) >> 16; }
typedef __bf16 bf16x2_hw __attribute__((ext_vector_type(2)));
__device__ __forceinline__ unsigned pk2(float lo, float hi) { const f32x2 v = {lo, hi}; return __builtin_bit_cast(unsigned, __builtin_convertvector(v, bf16x2_hw)); }
__device__ __forceinline__ float bf2f(unsigned short b) { return __builtin_bit_cast(float, (unsigned)b << 16); }
__device__ __forceinline__ float bflo(unsigned w) { return __builtin_bit_cast(float, w << 16); }
__device__ __forceinline__ float bfhi(unsigned w) { return __builtin_bit_cast(float, w & 0xffff0000u); }
__device__ __forceinline__ u32x4 pack8(f32x4 lo, f32x4 hi) { u32x4 w; w.x = pk2(lo[0], lo[1]); w.y = pk2(lo[2], lo[3]); w.z = pk2(hi[0], hi[1]); w.w = pk2(hi[2], hi[3]); return w; }
__device__ __forceinline__ void unpack8(u32x4 w, f32x4& lo, f32x4& hi) { lo = (f32x4){bflo(w.x), bfhi(w.x), bflo(w.y), bfhi(w.y)}; hi = (f32x4){bflo(w.z), bfhi(w.z), bflo(w.w), bfhi(w.w)}; }
constexpr float Y_SCALE = 4.f, Y_INV = 1.f / 4.f;
constexpr float BR8_SCALE = 8.f, BR8_INV = 0.125f;
constexpr float MG8_SCALE = 4.f, MG8_INV = 0.25f;
constexpr float ACT8_SCALE = 1.f, ACT8_INV = 1.f;
constexpr float W8_SCALE = 32.f, W8_INV = 1.f / 32.f;
__device__ __forceinline__ unsigned pack4_fp8s(float a, float b, float c_, float d, float sc) { int p = __builtin_amdgcn_cvt_pk_fp8_f32(a * sc, b * sc, 0, false); p = __builtin_amdgcn_cvt_pk_fp8_f32(c_ * sc, d * sc, p, true); return (unsigned)p; }
__device__ __forceinline__ unsigned pack4_fp8c(f32x4 v, float sc) { return pack4_fp8s(__builtin_amdgcn_fmed3f(v.x * sc, -448.f, 448.f), __builtin_amdgcn_fmed3f(v.y * sc, -448.f, 448.f), __builtin_amdgcn_fmed3f(v.z * sc, -448.f, 448.f), __builtin_amdgcn_fmed3f(v.w * sc, -448.f, 448.f), 1.f); }
typedef int i32x4 __attribute__((ext_vector_type(4)));
typedef int i32x8 __attribute__((ext_vector_type(8)));

__device__ __forceinline__ u32x2 pack8_fp8(f32x4 lo, f32x4 hi) {
    u32x2 w; int p = __builtin_amdgcn_cvt_pk_fp8_f32(lo[0] * Y_SCALE, lo[1] * Y_SCALE, 0, false); p = __builtin_amdgcn_cvt_pk_fp8_f32(lo[2] * Y_SCALE, lo[3] * Y_SCALE, p, true); w.x = (unsigned)p;
    p = __builtin_amdgcn_cvt_pk_fp8_f32(hi[0] * Y_SCALE, hi[1] * Y_SCALE, 0, false); p = __builtin_amdgcn_cvt_pk_fp8_f32(hi[2] * Y_SCALE, hi[3] * Y_SCALE, p, true); w.y = (unsigned)p; return w; }
__device__ __forceinline__ f32x4 unpack4_fp8(unsigned w) { const f32x2 a = __builtin_amdgcn_cvt_pk_f32_fp8((int)w, false), b = __builtin_amdgcn_cvt_pk_f32_fp8((int)w, true); return (f32x4){a.x, a.y, b.x, b.y}; }
__device__ __forceinline__ float wave_sum(float v) {
#pragma unroll
    for (int o = 1; o < 64; o <<= 1) v += __shfl_xor(v, o);
    return v;
}
constexpr float SS_SCALE = 16777216.f, SS_INV = 1.f / 16777216.f;
__device__ __forceinline__ void ss_add(unsigned long long* p, float s) { atomicAdd(p, (unsigned long long)(s * SS_SCALE)); }
__device__ __forceinline__ float ss_get(const unsigned long long* p) { return (float)(*p) * SS_INV; }
__device__ __forceinline__ float sigmoidf_(float x) { return __builtin_amdgcn_rcpf(1.f + __builtin_amdgcn_exp2f(x * -LOG2E)); }
__host__ __device__ __forceinline__ int pos2tok(int q) { const int fq = q >> 3, n = (q >> 2) & 1, i = q & 3; return 16 * (fq >> 1) + 4 * (fq & 1) + 8 * n + i; }
__host__ __device__ __forceinline__ int tok2pos(int t) { const int A = t >> 4, n = (t >> 3) & 1, B = (t >> 2) & 1, i = t & 3; return 8 * (2 * A + B) + 4 * n + i; }
__host__ __device__ __forceinline__ int ropedim(int RD, int p) { const int Q = p >> 3, n = (p >> 2) & 1, i = p & 3, P = 4 * Q + i, half = RD / 4; return (P < half ? 0 : RD / 2) + (P % half) + (n ? half : 0); }

#define XB_TMO      128
#define XB_XCNT(j)  (256  + 64 * (j))
#define XB_XSUB(j)  (1280 + 64 * (j))
#define XB_XGEN(j)  (2304 + 64 * (j))
#define XB_TOP      3328
#define XB_TOPGEN   3392
#define XCD_BAR_WORDS 3456
#define XB_SPIN_CAP (1u << 20)
__device__ __forceinline__ unsigned xb_ld(unsigned* p)              { return __hip_atomic_load(p, __ATOMIC_RELAXED, __HIP_MEMORY_SCOPE_AGENT); }
__device__ __forceinline__ unsigned xb_add(unsigned* p, unsigned v) { return __hip_atomic_fetch_add(p, v, __ATOMIC_RELAXED, __HIP_MEMORY_SCOPE_AGENT); }
__device__ __forceinline__ unsigned xb_xcc_id() { return (unsigned)__builtin_amdgcn_s_getreg((3 << 11) | 20) & 0xFu; }
#define XB_SPIN(cond, bar) do { unsigned _sp = 0; while (cond) { __builtin_amdgcn_s_sleep(1); \
    if ((++_sp & 255u) == 0u) { if (xb_ld(&(bar)[XB_TMO])) break; if (_sp > XB_SPIN_CAP) { atomicAdd(&(bar)[XB_TMO], 1u); break; } } } } while (0)
struct XcdBarrier { unsigned* bar; unsigned x; volatile LAS unsigned* st; };
__device__ __forceinline__ XcdBarrier xcd_barrier_post(unsigned* bar, volatile LAS unsigned* st) {
    XcdBarrier b; b.bar = bar; b.x = xb_xcc_id(); b.st = st;
    if (threadIdx.x == 0) (void)xb_add(&bar[XB_XCNT(b.x)], 1u);
    return b;
}
__device__ __forceinline__ void xcd_barrier_complete(unsigned* bar, unsigned x, unsigned& nloc, unsigned& nx) {
    const unsigned G = gridDim.x * gridDim.y * gridDim.z;
    unsigned sum, cnt, mine, sp = 0u;
    for (;;) {
        sum = 0u; cnt = 0u; mine = 0u;
#pragma unroll
        for (unsigned j = 0; j < 16; ++j) { const unsigned c = xb_ld(&bar[XB_XCNT(j)]); sum += c; cnt += (c > 0u) ? 1u : 0u; mine = (j == x) ? c : mine; }
        if (sum == G) break;
        __builtin_amdgcn_s_sleep(1);
        if ((++sp & 255u) == 0u) { if (xb_ld(&bar[XB_TMO])) break; if (sp > XB_SPIN_CAP) { atomicAdd(&bar[XB_TMO], 1u); break; } }
    }
    nloc = mine > 0u ? mine : 1u; nx = cnt > 0u ? cnt : 1u;
}
__device__ __forceinline__ void xcd_barrier(const XcdBarrier& b, bool leader  ) {
    asm volatile("s_waitcnt vmcnt(0)" ::: "memory");
    __syncthreads();
    if (leader) {
        unsigned* bar = b.bar;
        __builtin_amdgcn_s_waitcnt(0);
        unsigned nloc = b.st[0], nx = b.st[1];
        if (nloc == 0u) { xcd_barrier_complete(bar, b.x, nloc, nx); b.st[0] = nloc; b.st[1] = nx; }
        const unsigned old = xb_add(&bar[XB_XSUB(b.x)], 1u);
        const unsigned gen = old / nloc;
        if (old + 1u == (gen + 1u) * nloc) {
            __builtin_amdgcn_fence(__ATOMIC_RELEASE, "agent");
            asm volatile("s_waitcnt vmcnt(0)" ::: "memory");
            const unsigned og = xb_add(&bar[XB_TOP], 1u);
            const unsigned tg = og / nx;
            if (og + 1u == (tg + 1u) * nx) xb_add(&bar[XB_TOPGEN], 1u);
            else XB_SPIN(xb_ld(&bar[XB_TOPGEN]) == tg, bar);
            __builtin_amdgcn_fence(__ATOMIC_ACQUIRE, "agent");
            xb_add(&bar[XB_XGEN(b.x)], 1u);
            asm volatile("s_waitcnt vmcnt(0)" ::: "memory");
        } else {
            XB_SPIN(xb_ld(&bar[XB_XGEN(b.x)]) == gen, bar);
            __builtin_amdgcn_fence(__ATOMIC_ACQUIRE, "agent");
            asm volatile("s_waitcnt vmcnt(0)" ::: "memory");
        }
    }
    __syncthreads();
}

struct Params {
    const float* in[34];
    float* out; unsigned char* ws;
    int step_lo, step_hi;
};
enum { I_X = 0, I_C, I_CTX, I_CCTX, I_WMOD, I_BMOD, I_GPREMIX, I_GPOSTMIX, I_GPREFFN, I_GPOSTFFN, I_WIN, I_GCQ, I_WUQ, I_GCKV, I_WUKV, I_WPOOL, I_PSCALE,
       I_LQ1, I_LK1, I_LQ2, I_LK2, I_GSUBLN, I_WBMLA, I_WBPOOL, I_WBDIFF, I_WOUT, I_WROUTER, I_BROUTER, I_WEGATE, I_WEUP, I_WEDOWN, I_WSGATE, I_WSUP, I_WSDOWN };

typedef const __attribute__((address_space(4))) Params* ParamsK;
struct Ctx {
    ParamsK p;
    LAS unsigned char* lds;
    int tid, lane, wave, G, blk;
    GAS unsigned char* ws;
    size_t z;
};
#define INP(cx, I) ((const float*)((const GAS float*)(cx).p->in[I] + (cx).z))
__device__ __forceinline__ unsigned long long rfl64(unsigned long long v) { return ((unsigned long long)(unsigned)__builtin_amdgcn_readfirstlane((int)(unsigned)(v >> 32)) << 32) | (unsigned)__builtin_amdgcn_readfirstlane((int)(unsigned)v); }
#define PHASE_CTX(cl) Ctx cl = c; asm volatile("" : "+s"(cl.ws), "+s"(cl.z), "+s"(cl.blk), "+s"(cl.G), "+s"(cl.wave)); cl.wave = __builtin_amdgcn_readfirstlane(cl.wave); \
    { unsigned ones_ = ~0u; asm volatile("" : "+s"(ones_)); cl.lane = (int)__builtin_amdgcn_mbcnt_hi(ones_, __builtin_amdgcn_mbcnt_lo(ones_, 0u)); } cl.tid = cl.wave * 64 + cl.lane; \
    cl.blk = __builtin_amdgcn_readfirstlane(cl.blk); cl.G = __builtin_amdgcn_readfirstlane(cl.G); cl.ws = (GAS unsigned char*)rfl64((unsigned long long)cl.ws); cl.z = (size_t)rfl64((unsigned long long)cl.z)
constexpr int LDS_RING = 131072;
constexpr int LDS_BYTES = 163840;
constexpr int LDS_MISC = LDS_BYTES - 1024;

__device__ __forceinline__ bf16_t* wsb(const Ctx& c, size_t off) { return (bf16_t*)(c.ws + off); }
__device__ __forceinline__ bf16_t* wt(const Ctx& c, size_t eoff) { return (bf16_t*)(c.ws + WS_W) + eoff; }

__device__ __forceinline__ const float* res_rd(const Ctx& c, int l, int R) {
    const int b = R / RPB, j = R % RPB;
    if (j < CTXL) return INP(c, I_CTX) + (size_t)(b * CTXL + j) * DM;
    return INP(c, I_X) + (size_t)(b * SEQ + (j - CTXL)) * DM;
}
__device__ __forceinline__ bf16_t* hb_row(const Ctx& c, int R) { return (bf16_t*)(c.ws + A_HB) + (size_t)R * DM; }
__device__ __forceinline__ float* out_row(const Ctx& c, int R) { const int b = R / RPB, j = R % RPB; return c.p->out + (size_t)(b * SEQ + (j - CTXL)) * DM; }
__device__ __forceinline__ void load_res(const Ctx& c, int l, int R, int lane, f32x4 (&v)[4]) {
    if (l == 0) {
#pragma unroll
        for (int j = 0; j < 4; ++j) v[j] = *((const f32x4*)res_rd(c, 0, R) + lane + 64 * j);
    } else {
#pragma unroll
        for (int j = 0; j < 4; ++j) { const u32x2 w = *((const u32x2*)hb_row(c, R) + lane + 64 * j); v[j] = (f32x4){__builtin_bit_cast(float, w.x << 16), __builtin_bit_cast(float, w.x & 0xffff0000u), __builtin_bit_cast(float, w.y << 16), __builtin_bit_cast(float, w.y & 0xffff0000u)}; }
    }
}
__device__ __forceinline__ const float* modvec(const Ctx& c, int l, int R, int which) {
    const int b = R / RPB, j = R % RPB; const int bb = (j < CTXL) ? 16 : b;
    return (const float*)(c.ws + CTL_MOD) + ((size_t)(l * 17 + bb) * 6144 + which * 1024);
}

struct SrcCol { const float* p; int ld; bool ok; };
template <class Map>
__device__ __forceinline__ void cvt_item(const Map& map, const float* kscale, int K, bf16_t* Dst, int nblk_n, LAS float* scr, int item, int lane, bool q8 = false  ) {
    const int kb = item / nblk_n, nb = item % nblk_n, k0 = 64 * kb, n0 = 32 * nb;
    const SrcCol s = map(n0 + (lane & 31));
    float vv[32];
#pragma unroll
    for (int i = 0; i < 32; ++i) { const int kk = 2 * i + (lane >> 5); vv[i] = s.ok ? s.p[(size_t)(k0 + kk) * s.ld] : 0.f; }
#pragma unroll
    for (int i = 0; i < 32; ++i) { const int kk = 2 * i + (lane >> 5); float v = vv[i]; if (kscale) v *= kscale[k0 + kk]; scr[kk * 33 + (lane & 31)] = v; }
    asm volatile("s_waitcnt lgkmcnt(0)" ::: "memory");
    const int cch = lane & 7;
#pragma unroll
    for (int j = 0; j < 4; ++j) { const int n = (lane >> 3) + 8 * j; const LAS float* sp = scr + (8 * cch) * 33 + n;
        if (q8) { u32x2 o8; o8.x = pack4_fp8s(sp[0 * 33], sp[1 * 33], sp[2 * 33], sp[3 * 33], W8_SCALE); o8.y = pack4_fp8s(sp[4 * 33], sp[5 * 33], sp[6 * 33], sp[7 * 33], W8_SCALE);
            *(u32x2*)((unsigned char*)Dst + (size_t)(n0 + n) * K + k0 + 8 * cch) = o8; continue; }
        u32x4 o; o.x = pk2(sp[0 * 33], sp[1 * 33]); o.y = pk2(sp[2 * 33], sp[3 * 33]); o.z = pk2(sp[4 * 33], sp[5 * 33]); o.w = pk2(sp[6 * 33], sp[7 * 33]);
        *(u32x4*)(Dst + (size_t)(n0 + n) * K + k0 + 8 * cch) = o; }
    asm volatile("s_waitcnt lgkmcnt(0)" ::: "memory");
}
struct MapLin { const float* W; int ld; int off; __device__ SrcCol operator()(int n) const { return SrcCol{W + off + n, ld, true}; } };
struct MapWin { const float* W; __device__ SrcCol operator()(int n) const {
    int col; bool ok = true;
    if (n < 512) col = 288 + (n & ~63) + ropedim(64, n & 63);
    else if (n < 1024) { const int m = n - 512; col = KV_COLS + 384 + (m & ~63) + ropedim(64, m & 63); }
    else if (n < 1536) col = KV_COLS + 896 + (n - 1024);
    else if (n < 1792) col = n - 1536;
    else if (n < 2176) col = KV_COLS + (n - 1792);
    else if (n < 2208) col = 256 + ropedim(32, n - 2176);
    else { col = 0; ok = false; }
    return SrcCol{W + col, IN_COLS, ok}; } };
struct MapUkv { const float* W; int voff; __device__ SrcCol operator()(int n) const { return SrcCol{W + (n >> 6) * 128 + voff + (n & 63), 1024, true}; } };
struct MapUq { const float* W; __device__ SrcCol operator()(int n) const { const int h = n / 96, p = n % 96; return SrcCol{W + h * 96 + (p < 64 ? p : 64 + ropedim(32, p - 64)), 768, true}; } };
struct MapGU { const float* Wg; const float* Wu; __device__ SrcCol operator()(int n) const { const int pn = n >> 8, r = n & 255; return SrcCol{(r < 128 ? Wg + pn * 128 + r : Wu + pn * 128 + (r - 128)), 256, true}; } };


struct EItem { const float* p; int ld; bf16_t* dst; int K, k0, n0; bool q8; };
__device__ __forceinline__ EItem eitem_decode(const Ctx& ci, int l, int x, int lane) {
    constexpr int IT10 = 65 * 16 * 16;
    EItem it;
    if (x < IT10) { const int e = x / 256, ri = x % 256, kb = ri / 16, nb = ri % 16; it.k0 = 64 * kb; it.n0 = 32 * nb; it.K = 1024; it.ld = 256;
        const float* wg = (e < 64) ? INP(ci, I_WEGATE) + ((size_t)l * 64 + e) * 262144 : INP(ci, I_WSGATE) + (size_t)l * 262144;
        const float* wu = (e < 64) ? INP(ci, I_WEUP) + ((size_t)l * 64 + e) * 262144 : INP(ci, I_WSUP) + (size_t)l * 262144;
        const int n = it.n0 + (lane & 31), pn = n >> 8, r = n & 255; it.p = (r < 128 ? wg + pn * 128 + r : wu + pn * 128 + (r - 128));
        it.dst = wt(ci, WO_GU) + (size_t)e * 262144; it.q8 = true; }
    else { const int y = x - IT10, e = y / 128, ri = y % 128, kb = ri / 32, nb = ri % 32; it.k0 = 64 * kb; it.n0 = 32 * nb; it.K = 256; it.ld = 1024;
        const float* wd = (e < 64) ? INP(ci, I_WEDOWN) + ((size_t)l * 64 + e) * 262144 : INP(ci, I_WSDOWN) + (size_t)l * 262144;
        it.p = wd + it.n0 + (lane & 31); it.dst = wt(ci, WO_D) + (size_t)e * 131072; it.q8 = true; }
    return it;
}
__device__ __forceinline__ void eitem_load(const EItem& it, int lane, float (&vv)[32]) {
#pragma unroll
    for (int i = 0; i < 32; ++i) { const int kk = 2 * i + (lane >> 5); vv[i] = it.p[(size_t)(it.k0 + kk) * it.ld]; }
}
__device__ __forceinline__ void eitem_finish(const EItem& it, int lane, const float (&vv)[32], LAS float* scr) {
#pragma unroll
    for (int i = 0; i < 32; ++i) { const int kk = 2 * i + (lane >> 5); scr[kk * 33 + (lane & 31)] = vv[i]; }
    asm volatile("s_waitcnt lgkmcnt(0)" ::: "memory");
    const int cch = lane & 7;
#pragma unroll
    for (int j = 0; j < 4; ++j) { const int n = (lane >> 3) + 8 * j; const LAS float* sp = scr + (8 * cch) * 33 + n;
        if (it.q8) { u32x2 o8; o8.x = pack4_fp8s(sp[0 * 33], sp[1 * 33], sp[2 * 33], sp[3 * 33], W8_SCALE); o8.y = pack4_fp8s(sp[4 * 33], sp[5 * 33], sp[6 * 33], sp[7 * 33], W8_SCALE);
            *(u32x2*)((unsigned char*)it.dst + (size_t)(it.n0 + n) * it.K + it.k0 + 8 * cch) = o8; continue; }
        u32x4 o; o.x = pk2(sp[0 * 33], sp[1 * 33]); o.y = pk2(sp[2 * 33], sp[3 * 33]); o.z = pk2(sp[4 * 33], sp[5 * 33]); o.w = pk2(sp[6 * 33], sp[7 * 33]);
        *(u32x4*)(it.dst + (size_t)(it.n0 + n) * it.K + it.k0 + 8 * cch) = o; }
    asm volatile("s_waitcnt lgkmcnt(0)" ::: "memory");
}
__device__ __forceinline__ void ph_prologue(const Ctx& c, int l) {
    LAS float* scr = (LAS float*)(c.lds + c.wave * 16384);
    const int gw = c.blk * 8 + c.wave, NGW = c.G * 8;
    constexpr int IT0 = 72 * 16, IT1 = 16 * 16, IT2 = 96 * 16, IT3 = 16 * 4, IT4 = 16 * 4, IT5 = 24 * 6, IT6 = 32 * 8, IT7 = 32 * 8, IT8 = 32 * 16, IT9 = 2 * 16;
    constexpr int IT10 = 65 * 16 * 16, IT11 = 65 * 32 * 4, IT12 = 4 * 16 * 16;
    constexpr int NIT = IT0 + IT1 + IT2 + IT3 + IT4 + IT5 + IT6 + IT7 + IT8 + IT9 + IT12;
    for (int it = gw; it < NIT; it += NGW) {
        Ctx ci = c; asm volatile("" : "+s"(ci.z)); ci.z = (size_t)rfl64((unsigned long long)ci.z);
        int r = it; const float* w_in = INP(ci, I_WIN) + (size_t)l * DM * IN_COLS;
        if (r < IT0) { cvt_item(MapWin{w_in}, nullptr, 1024, wt(c, WO_IN), 72, scr, r, c.lane, true); continue; } r -= IT0;
        if (r < IT1) { cvt_item(MapLin{w_in, IN_COLS, 800}, nullptr, 1024, wt(c, WO_VD), 16, scr, r, c.lane, true); continue; } r -= IT1;
        if (r < IT2) { cvt_item(MapLin{w_in, IN_COLS, KV_COLS + 1408}, nullptr, 1024, wt(c, WO_G), 96, scr, r, c.lane, true); continue; } r -= IT2;
        if (r < IT3) { cvt_item(MapUkv{INP(ci, I_WUKV) + (size_t)l * 256 * 1024, 0}, INP(ci, I_GCKV) + l * 256, 256, wt(c, WO_UK), 16, scr, r, c.lane); continue; } r -= IT3;
        if (r < IT4) { cvt_item(MapUkv{INP(ci, I_WUKV) + (size_t)l * 256 * 1024, 64}, INP(ci, I_GCKV) + l * 256, 256, wt(c, WO_UV), 16, scr, r, c.lane); continue; } r -= IT4;
        if (r < IT5) { cvt_item(MapUq{INP(ci, I_WUQ) + (size_t)l * 384 * 768}, INP(ci, I_GCQ) + l * 384, 384, wt(c, WO_UQ), 24, scr, r, c.lane); continue; } r -= IT5;
        if (r < IT6) { cvt_item(MapLin{INP(ci, I_WBMLA) + (size_t)l * 512 * 1024, 1024, 0}, nullptr, 512, wt(c, WO_BM), 32, scr, r, c.lane, true); continue; } r -= IT6;
        if (r < IT7) { cvt_item(MapLin{INP(ci, I_WBDIFF) + (size_t)l * 512 * 1024, 1024, 0}, nullptr, 512, wt(c, WO_BD), 32, scr, r, c.lane, true); continue; } r -= IT7;
        if (r < IT8) { cvt_item(MapLin{INP(ci, I_WOUT) + (size_t)l * 1024 * 1024, 1024, 0}, nullptr, 1024, wt(c, WO_O), 32, scr, r, c.lane, true); continue; } r -= IT8;
        if (r < IT9) { cvt_item(MapLin{INP(ci, I_WROUTER) + (size_t)l * 1024 * 64, 64, 0}, nullptr, 1024, wt(c, WO_R), 2, scr, r, c.lane); continue; } r -= IT9;
        {
            const int g = r / 256, cb = (r / 16) % 16, db = r % 16, d = db * 64 + c.lane;
            const float* wp = INP(ci, I_WPOOL) + ((size_t)l * 4 + g) * 16384 + (size_t)(cb * 8) * 128;
            const float* ps = INP(ci, I_PSCALE) + l * 512 + g * 128;
            const float* wb = INP(ci, I_WBPOOL) + (size_t)l * 512 * 1024 + (size_t)(g * 128) * 1024 + d;
            float acc[8];
#pragma unroll
            for (int q = 0; q < 8; ++q) acc[q] = 0.f;
            for (int j = 0; j < 128; ++j) { const float bv = wb[(size_t)j * 1024] * ps[j];
#pragma unroll
                for (int q = 0; q < 8; ++q) acc[q] += wp[q * 128 + j] * bv; }
            *(u32x2*)((unsigned char*)wt(c, WO_PP) + (size_t)d * 512 + g * 128 + cb * 8) = (u32x2){pack4_fp8s(acc[0], acc[1], acc[2], acc[3], W8_SCALE), pack4_fp8s(acc[4], acc[5], acc[6], acc[7], W8_SCALE)};
        }
    }
    {
        constexpr int NE = IT10 + IT11;
        Ctx ci = c; asm volatile("" : "+s"(ci.z)); ci.z = (size_t)rfl64((unsigned long long)ci.z);
        float va[32], vb[32];
        int x = gw;
        EItem cur{}; if (x < NE) { cur = eitem_decode(ci, l, x, c.lane); eitem_load(cur, c.lane, va); }
        for (; x < NE; x += NGW) {
            EItem nxt{}; const bool hn = x + NGW < NE;
            if (hn) { nxt = eitem_decode(ci, l, x + NGW, c.lane); eitem_load(nxt, c.lane, vb); }
            eitem_finish(cur, c.lane, va, scr);
            if (hn) { cur = nxt;
#pragma unroll
                for (int i = 0; i < 32; ++i) va[i] = vb[i]; }
        }
    }
    if (l == 0) {
        const int gt = c.blk * 512 + c.tid, NT = c.G * 512;
        f32x2* t64 = (f32x2*)(c.ws + WS_TAB64); f32x2* t32 = (f32x2*)(c.ws + WS_TAB32);
        for (int i = gt; i < 2048 * 32; i += NT) { const int t = i >> 5, Pp = i & 31; const float pos = (float)(Pp < 16 ? (t >> 6) : (t & 63));
            const float inv = powf(10000.f, -(float)(2 * (Pp & 15)) / 32.f); const float a = pos * inv; t64[i] = (f32x2){cosf(a), sinf(a)}; }
        for (int i = gt; i < 2048 * 16; i += NT) { const int t = i >> 4, Pp = i & 15; const float pos = (float)(Pp < 8 ? (t >> 6) : (t & 63));
            const float inv = powf(10000.f, -(float)(2 * (Pp & 7)) / 16.f); const float a = pos * inv; t32[i] = (f32x2){cosf(a), sinf(a)}; }
        __syncthreads();
        if (c.blk < 192) {
            LAS float* sb = (LAS float*)(c.lds + c.wave * 10240);
            LAS float* part = (LAS float*)(c.lds + 81920);
            const int ll = c.blk / 96, cb = c.blk % 96, col = cb * 64 + c.lane, k0 = c.wave * 128;
#pragma unroll
            for (int qi = 0; qi < 34; ++qi) { const int q = c.lane + 64 * qi; const int b = q >> 7, k = q & 127; const float v = (b < 16) ? INP(c, I_C)[b * 1024 + k0 + k] : INP(c, I_CCTX)[k0 + k]; sb[k * 20 + b] = v / (1.f + __expf(-v)); }
            asm volatile("s_waitcnt lgkmcnt(0)" ::: "memory");
            float acc[17];
#pragma unroll
            for (int b = 0; b < 17; ++b) acc[b] = 0.f;
            const float* wm = INP(c, I_WMOD) + (size_t)ll * 1024 * 6144 + (size_t)k0 * 6144 + col;
#pragma unroll 32
            for (int k = 0; k < 128; ++k) { const float w = wm[(size_t)k * 6144];
#pragma unroll
                for (int b = 0; b < 17; ++b) acc[b] += sb[k * 20 + b] * w; }
#pragma unroll
            for (int b = 0; b < 17; ++b) part[(c.wave * 17 + b) * 64 + c.lane] = acc[b];
            __syncthreads();
            float* MOD = (float*)(c.ws + CTL_MOD);
            for (int q = c.tid; q < 17 * 64; q += 512) { const int b = q >> 6, cc = q & 63; float sum = INP(c, I_BMOD)[ll * 6144 + cb * 64 + cc];
#pragma unroll
                for (int w = 0; w < 8; ++w) sum += part[(w * 17 + b) * 64 + cc];
                MOD[(size_t)(ll * 17 + b) * 6144 + cb * 64 + cc] = sum; }
        }
    }
}

__device__ __forceinline__ void load_row_f32(const float* row, int lane, f32x4 (&v)[4]) {
#pragma unroll
    for (int j = 0; j < 4; ++j) v[j] = *((const f32x4*)row + lane + 64 * j);
}
__device__ __forceinline__ float row_sumsq(const f32x4 (&v)[4]) {
    float s = 0.f;
#pragma unroll
    for (int j = 0; j < 4; ++j) s += (v[j].x * v[j].x + v[j].y * v[j].y) + (v[j].z * v[j].z + v[j].w * v[j].w);
    return wave_sum(s);
}
__device__ __forceinline__ void norm_mod_store(const f32x4 (&v)[4], float rstd, const float* g, const float* shift, const float* scale, bf16_t* orow, int lane) {
#pragma unroll
    for (int j = 0; j < 4; ++j) { const int o = lane + 64 * j; const f32x4 gg = *((const f32x4*)g + o), sh = *((const f32x4*)shift + o), sc = *((const f32x4*)scale + o);
        const f32x4 y = (v[j] * rstd * gg) * (sc + 1.0f) + sh;
        u32x2 w; w.x = pk2(y.x, y.y); w.y = pk2(y.z, y.w); *((u32x2*)orow + o) = w; }
}
__device__ __forceinline__ void mod_fold(const Ctx& c, const float* g, int l, int R, int w_shift, int w_scale, int lane, f32x4 (&mul)[4], f32x4 (&add)[4]) {
    const float* sh = modvec(c, l, R, w_shift); const float* sc = modvec(c, l, R, w_scale);
#pragma unroll
    for (int j = 0; j < 4; ++j) { const int o = lane + 64 * j; mul[j] = *((const f32x4*)g + o) * (*((const f32x4*)sc + o) + 1.0f); add[j] = *((const f32x4*)sh + o); }
}
__device__ __forceinline__ int batch_key(int R) { return (R % RPB) < CTXL ? 16 + 32 * (R / RPB) : R / RPB; }
__device__ __forceinline__ void ph_t1(const Ctx& c, int l) {
    const int gw = c.blk * 8 + c.wave, NGW = c.G * 8;
    const int per = (NR + NGW - 1) / NGW, r0 = gw * per, r1 = min(NR, r0 + per);
    f32x4 v[4], vn[4], vn2[4], mul[4], add[4]; int key = -1;
#pragma unroll
    for (int j = 0; j < 4; ++j) { v[j] = (f32x4){0.f, 0.f, 0.f, 0.f}; vn[j] = v[j]; vn2[j] = v[j]; }
    int R = r0;
    if (R < r1) load_row_f32(res_rd(c, l, R), c.lane, v);
    if (R + 1 < r1) load_row_f32(res_rd(c, l, R + 1), c.lane, vn);
    for (; R < r1; ++R) {
        if (R + 2 < r1) load_row_f32(res_rd(c, l, R + 2), c.lane, vn2);
        if (batch_key(R) != key) { key = batch_key(R); mod_fold(c, INP(c, I_GPREMIX) + l * DM, l, R, 0, 1, c.lane, mul, add); }
        const float rstd = 1.f / sqrtf(row_sumsq(v) * (1.f / DM) + EPSN);
        unsigned char* orow = (unsigned char*)(c.ws + A_HX) + (size_t)R * DM;
#pragma unroll
        for (int j = 0; j < 4; ++j) { const f32x4 y = (v[j] * rstd) * mul[j] + add[j]; *((unsigned*)orow + c.lane + 64 * j) = pack4_fp8c(y, 1.f); }
#pragma unroll
        for (int j = 0; j < 4; ++j) { v[j] = vn[j]; vn[j] = vn2[j]; }
    }
}

struct Unit {
    const bf16_t* a;
    const bf16_t* b;
    const unsigned* rows;
    int K, kind, pm, pn, bperm, nrows, aux, aux2;
};
__device__ __forceinline__ int b_srcrow(int q, int bperm) { return (q & ~31) + (bperm ? pos2tok(q & 31) : (q & 31)); }

template <class Sched, class Epi>
__device__ __forceinline__ void gemm_units_naive(const Ctx& c, const Sched& S, const Epi& E) {
    Unit u;
    for (int i = 0; S.next(i, u); ++i) {
        for (int it = c.tid; it < 256 * 16; it += 512) {
            const int row = it >> 4, c8 = (it & 15) * 8;
            const bf16_t* ar;
            if (u.rows) { const int rr = (row < u.nrows) ? (int)(u.rows[row] >> 4) : u.aux2; ar = u.a + (size_t)rr * u.K; } else ar = u.a + (size_t)row * u.K;
            float acc[16];
#pragma unroll
            for (int q = 0; q < 16; ++q) acc[q] = 0.f;
            const bf16_t* br[16];
#pragma unroll
            for (int q = 0; q < 16; ++q) br[q] = u.b + (size_t)b_srcrow((q < 8 ? c8 + q : 128 + c8 + (q - 8)), u.bperm) * u.K;
            for (int k = 0; k < u.K; k += 8) {
                f32x4 alo, ahi; unpack8(*(const u32x4*)(ar + k), alo, ahi);
#pragma unroll
                for (int q = 0; q < 16; ++q) { f32x4 blo, bhi; unpack8(*(const u32x4*)(br[q] + k), blo, bhi);
                    acc[q] += (alo.x * blo.x + alo.y * blo.y) + (alo.z * blo.z + alo.w * blo.w) + (ahi.x * bhi.x + ahi.y * bhi.y) + (ahi.z * bhi.z + ahi.w * bhi.w); }
            }
            { typename Epi::UState ust_; E.unit_begin(u, c8, ust_); typename Epi::Pre pre_; E.pre(u, row, c8, pre_);
              E.apply(u, row, c8, pre_, ust_, (f32x4){acc[0], acc[1], acc[2], acc[3]}, (f32x4){acc[4], acc[5], acc[6], acc[7]}, (f32x4){acc[8], acc[9], acc[10], acc[11]}, (f32x4){acc[12], acc[13], acc[14], acc[15]}); }
        }
        asm volatile("s_waitcnt vmcnt(0)" ::: "memory");
        __syncthreads();
    }
}

namespace mm {
constexpr int BK = 64, HALF = 128, HTB = HALF * BK * 2;
__device__ __forceinline__ int lds_byte(int r, int c) { const int st = (r >> 4) * 2 + (c >> 5), rr = r & 15, cc = c & 31, ob = rr * 64 + cc * 2; return st * 1024 + (ob ^ (((ob >> 9) & 1) << 5)); }
__device__ __forceinline__ void stage_rc(int b, int& R, int& C) { const int st = b / 1024, sb = b % 1024, swz = sb ^ (((sb >> 9) & 1) << 5); R = (st >> 1) * 16 + swz / 64; C = (st & 1) * 32 + (swz % 64) / 2; }
__device__ __forceinline__ int perm32(int rho) { const int n = rho >> 4, i = rho & 15; return 8 * (i >> 2) + 4 * n + (i & 3); }
__device__ __forceinline__ int permtau(int rho) { const int n = rho >> 4, fq = (rho >> 2) & 3, i = rho & 3; return 16 * (fq >> 1) + 4 * (fq & 1) + 8 * n + i; }
template <bool GATHER> struct LaneOffT { unsigned a0[2], a1[GATHER ? 2 : 1], b[2]; };
template <bool GATHER> __device__ __forceinline__ void lane_offsets(const Unit& u, const GAS unsigned char* ws, int tid, LaneOffT<GATHER>& o) {
    int Rl[2], Cl[2]; asm volatile("" : "+v"(tid));
#pragma unroll
    for (int i = 0; i < 2; ++i) stage_rc(tid * 16 + i * 8192, Rl[i], Cl[i]);
    const unsigned K2 = (unsigned)u.K * 2u; const unsigned ab = (unsigned)((unsigned long long)u.a - (unsigned long long)ws), bb = (unsigned)((unsigned long long)u.b - (unsigned long long)ws);
#pragma unroll
    for (int i = 0; i < 2; ++i) {
        if constexpr (GATHER) {
            if (u.rows) { const int r0 = Rl[i], r1 = 128 + Rl[i];
                const unsigned t0 = (r0 < u.nrows) ? (u.rows[r0] >> 4) : (unsigned)u.aux2, t1 = (r1 < u.nrows) ? (u.rows[r1] >> 4) : (unsigned)u.aux2;
                o.a0[i] = ab + t0 * K2 + (unsigned)Cl[i] * 2u; o.a1[i] = ab + t1 * K2 + (unsigned)Cl[i] * 2u; }
            else { o.a0[i] = ab + (unsigned)Rl[i] * K2 + (unsigned)Cl[i] * 2u; o.a1[i] = o.a0[i] + 128u * K2; }
        } else o.a0[i] = ab + (unsigned)Rl[i] * K2 + (unsigned)Cl[i] * 2u;
        const int rho_ = Rl[i] & 31; const int Rb = (u.bperm == 2) ? (64 * (Rl[i] >> 5) + 16 * ((rho_ >> 2) & 3) + 4 * (rho_ >> 4) + (rho_ & 3)) : ((Rl[i] & ~31) + (u.bperm ? permtau(rho_) : perm32(rho_)));
        o.b[i] = bb + (unsigned)Rb * K2 + (unsigned)Cl[i] * 2u;
    }
}
}

template <class Sched, class Epi>
__device__ __forceinline__ void gemm_units_mfma(const Ctx& c, const Sched& S, const Epi& E) {
    constexpr bool GATHER = Sched::GATHER;
    using namespace mm;
    LAS unsigned char* lds = c.lds;
    const int tid = c.tid, wid = c.wave, lane = c.lane, wr = wid >> 2, wc = wid & 3, fr = lane & 15, fq = lane >> 4;
    const unsigned ldsw = (unsigned)wid * 1024u;
    const int aoff = lds_byte(wr * 64 + fr, fq * 8), boff = lds_byte(wc * 32 + fr, fq * 8);
    const GAS unsigned char* wsb_ = c.ws;
#define MM_SA(b, h) (((b) * 2 + (h)) * HTB)
#define MM_SB(b, h) ((4 + (b) * 2 + (h)) * HTB)
#define MM_STAGE(bufoff, o0, o1, kofs) do { const GAS unsigned char* kb_ = wsb_ + (size_t)(kofs);   \
        __builtin_amdgcn_global_load_lds((const GAS unsigned*)(kb_ + (o0)), (LAS unsigned*)(lds + (bufoff) + ldsw), 16, 0, 0); \
        __builtin_amdgcn_global_load_lds((const GAS unsigned*)(kb_ + (o1)), (LAS unsigned*)(lds + (bufoff) + ldsw + 8192), 16, 0, 0); } while (0)
#define MM_LDA(dst, b, h) do { _Pragma("unroll") for (int m = 0; m < 4; ++m) _Pragma("unroll") for (int k = 0; k < 2; ++k) dst[m][k] = *(const LAS bf16x8*)(lds + MM_SA(b, h) + aoff + m * 2048 + k * 1024); } while (0)
#define MM_LDB(dst, b, h) do { _Pragma("unroll") for (int n = 0; n < 2; ++n) _Pragma("unroll") for (int k = 0; k < 2; ++k) dst[n][k] = *(const LAS bf16x8*)(lds + MM_SB(b, h) + boff + n * 2048 + k * 1024); } while (0)
#define MM_CAT8(x) __builtin_shufflevector(__builtin_bit_cast(i32x4, (x)[0]), __builtin_bit_cast(i32x4, (x)[1]), 0, 1, 2, 3, 4, 5, 6, 7)
#define MM_MMA(ai, bj, At, Bt) do { __builtin_amdgcn_s_setprio(1); \
        if constexpr (Epi::FP8) {   \
            _Pragma("unroll") for (int m = 0; m < 4; ++m) _Pragma("unroll") for (int n = 0; n < 2; ++n) \
                acc[ai][bj][m][n] = __builtin_amdgcn_mfma_scale_f32_16x16x128_f8f6f4(MM_CAT8(Bt[n]), MM_CAT8(At[m]), acc[ai][bj][m][n], 0, 0, 0, 0, 0, 0); \
        } else { _Pragma("unroll") for (int m = 0; m < 4; ++m) _Pragma("unroll") for (int n = 0; n < 2; ++n) _Pragma("unroll") for (int k = 0; k < 2; ++k) \
            acc[ai][bj][m][n] = __builtin_amdgcn_mfma_f32_16x16x32_bf16(Bt[n][k], At[m][k], acc[ai][bj][m][n], 0, 0, 0); } \
        __builtin_amdgcn_s_setprio(0); } while (0)
#define MM_WAIT_V(n) asm volatile("s_waitcnt vmcnt(" #n ")" ::: "memory")
#define MM_WAIT_L(n) asm volatile("s_waitcnt lgkmcnt(" #n ")" ::: "memory")
#define MM_BAR __builtin_amdgcn_s_barrier()
#define MM_SCHED __builtin_amdgcn_sched_barrier(0)
    Unit cur, nxt; int ui = 0;
    if (!S.next(0, cur)) return;
    LaneOffT<GATHER> co; lane_offsets<GATHER>(cur, wsb_, tid, co);
#define MM_A1(i) (GATHER ? co.a1[GATHER ? (i) : 0] : co.a0[i] + hs)
    f32x4 acc[2][2][4][2];
#pragma unroll
    for (int a = 0; a < 2; ++a)
#pragma unroll
        for (int b = 0; b < 2; ++b)
#pragma unroll
            for (int m = 0; m < 4; ++m)
#pragma unroll
                for (int n = 0; n < 2; ++n) acc[a][b][m][n] = (f32x4){0.f, 0.f, 0.f, 0.f};
    bf16x8 At[4][2], B0[2][2], B1[2][2];
    typename Epi::Pre epre_[Epi::EARLY ? Epi::GROUP : 1];
    {
        const unsigned hs = 256u * (unsigned)cur.K, hsb = (cur.bperm == 2 ? 16u : 256u) * (unsigned)cur.K;
        MM_STAGE(MM_SB(0, 0), co.b[0], co.b[1], 0); MM_STAGE(MM_SB(0, 1), co.b[0] + hsb, co.b[1] + hsb, 0); MM_STAGE(MM_SA(0, 0), co.a0[0], co.a0[1], 0); MM_STAGE(MM_SA(0, 1), MM_A1(0), MM_A1(1), 0);
        if (wr == 1) MM_BAR;
        MM_WAIT_V(2); MM_BAR;
        MM_STAGE(MM_SB(1, 0), co.b[0], co.b[1], 128); MM_STAGE(MM_SA(1, 0), co.a0[0], co.a0[1], 128); MM_STAGE(MM_SB(1, 1), co.b[0] + hsb, co.b[1] + hsb, 128);
        MM_WAIT_V(6); MM_BAR;
    }
    for (;;) {
        const bool has_next = S.next(ui + 1, nxt);
        if (!has_next) nxt = cur;
        LaneOffT<GATHER> nco;
        if constexpr (GATHER) lane_offsets<GATHER>(nxt, wsb_, tid, nco);
        const int nt = cur.K / BK; unsigned hs = 256u * (unsigned)cur.K, hsb = (cur.bperm == 2 ? 16u : 256u) * (unsigned)cur.K;
        for (int t = 0; t < nt; t += 2) {
            const bool last = (t == nt - 2);
            const unsigned k1 = (unsigned)(t + 1) * 128u, k2 = last ? 0u : (unsigned)(t + 2) * 128u; unsigned k3 = k2 + 128u;
            asm volatile("" : "+s"(k3)); k3 = (unsigned)__builtin_amdgcn_readfirstlane((int)k3);
            MM_LDB(B0, 0, 0); MM_LDB(B1, 0, 1); MM_SCHED; MM_LDA(At, 0, 0); MM_STAGE(MM_SA(1, 1), MM_A1(0), MM_A1(1), k1);
            MM_WAIT_V(8); MM_WAIT_L(0); MM_BAR; MM_MMA(0, 0, At, B0); MM_MMA(0, 1, At, B1); MM_BAR; MM_SCHED;
            if constexpr (Epi::ROWTAB) { if (last) E.rowtab_dma(cur, lds, wid, lane, ui & 1); }
            if (Epi::EARLY && last) { int c8e_ = wc * 32 + fq * 8; asm volatile("" : "+v"(c8e_));
                _Pragma("unroll") for (int q = 0; q < Epi::GROUP; ++q) { int re_ = (q >> 2) * 128 + wr * 64 + (q & 3) * 16 + fr; asm volatile("" : "+v"(re_)); E.pre(cur, re_, c8e_, epre_[q]); } }
            if (last) { if constexpr (GATHER) co = nco; else lane_offsets<GATHER>(nxt, wsb_, tid, co); hs = 256u * (unsigned)nxt.K; hsb = (nxt.bperm == 2 ? 16u : 256u) * (unsigned)nxt.K; }
            MM_LDA(At, 0, 1); MM_STAGE(MM_SB(0, 0), co.b[0], co.b[1], k2); MM_STAGE(MM_SB(0, 1), co.b[0] + hsb, co.b[1] + hsb, k2); MM_STAGE(MM_SA(0, 0), co.a0[0], co.a0[1], k2);
            MM_WAIT_V(8); MM_WAIT_L(0); MM_BAR; MM_MMA(1, 0, At, B0); MM_MMA(1, 1, At, B1); MM_BAR; MM_SCHED;
            MM_LDB(B0, 1, 0); MM_LDB(B1, 1, 1); MM_SCHED; MM_LDA(At, 1, 0); MM_STAGE(MM_SA(0, 1), MM_A1(0), MM_A1(1), k2);
            MM_WAIT_V(8); MM_WAIT_L(0); MM_BAR; MM_MMA(0, 0, At, B0); MM_MMA(0, 1, At, B1); MM_BAR; MM_SCHED;
            MM_LDA(At, 1, 1); MM_STAGE(MM_SB(1, 0), co.b[0], co.b[1], k3); MM_STAGE(MM_SB(1, 1), co.b[0] + hsb, co.b[1] + hsb, k3); MM_STAGE(MM_SA(1, 0), co.a0[0], co.a0[1], k3);
            MM_WAIT_V(8); MM_WAIT_L(0); MM_BAR; MM_MMA(1, 0, At, B0); MM_MMA(1, 1, At, B1); MM_BAR; MM_SCHED;
        }
        if (wr == 0) MM_BAR;
        typename Epi::UState ust_; E.unit_begin(cur, wc * 32 + fq * 8, ust_); const int par_ = ui & 1;
        constexpr int GRP = Epi::GROUP;
#pragma unroll
        for (int g0 = 0; g0 < 8; g0 += GRP) {
            int rows_[GRP]; typename Epi::Pre pre_[GRP]; int c8_ = wc * 32 + fq * 8; asm volatile("" : "+v"(c8_));
            int frx_ = wr * 64 + fr; asm volatile("" : "+v"(frx_));
#pragma unroll
            for (int q = 0; q < GRP; ++q) { const int ai = (g0 + q) >> 2, m = (g0 + q) & 3; rows_[q] = ai * 128 + m * 16 + frx_; asm volatile("" : "+v"(rows_[q]));
                if (Epi::EARLY && g0 == 0) pre_[q] = epre_[q]; else if constexpr (Epi::ROWTAB) E.pre_tab(cur, rows_[q], lds, par_, pre_[q]); else E.pre(cur, rows_[q], c8_, pre_[q]); }
            MM_SCHED;
            if constexpr (Epi::PAIR) {
#pragma unroll
                for (int q = 0; q < GRP; q += 2) { const int ai = (g0 + q) >> 2, m = (g0 + q) & 3;
                    E.apply2(cur, rows_[q], rows_[q + 1], c8_, pre_[q], pre_[q + 1], ust_, acc[ai][0][m][0], acc[ai][0][m][1], acc[ai][1][m][0], acc[ai][1][m][1],
                             acc[ai][0][m + 1][0], acc[ai][0][m + 1][1], acc[ai][1][m + 1][0], acc[ai][1][m + 1][1]); }
            } else
#pragma unroll
            for (int q = 0; q < GRP; ++q) { const int ai = (g0 + q) >> 2, m = (g0 + q) & 3;
                if constexpr (Epi::CHAIN) E.apply_rw(cur, rows_[q], c8_, pre_[q], ust_, acc[ai][0][m][0], acc[ai][0][m][1], acc[ai][1][m][0], acc[ai][1][m][1]);
                else E.apply(cur, rows_[q], c8_, pre_[q], ust_, acc[ai][0][m][0], acc[ai][0][m][1], acc[ai][1][m][0], acc[ai][1][m][1]); }
            MM_SCHED;
        }
        if (!has_next) break;
        bool keep_ = false; if constexpr (Epi::CHAIN) keep_ = E.keep_acc(cur);
        if (!keep_) {
#pragma unroll
        for (int a = 0; a < 2; ++a)
#pragma unroll
            for (int b = 0; b < 2; ++b)
#pragma unroll
                for (int m = 0; m < 4; ++m)
#pragma unroll
                    for (int n = 0; n < 2; ++n) acc[a][b][m][n] = (f32x4){0.f, 0.f, 0.f, 0.f};
        }
        cur = nxt; ++ui;
        if (wr == 1) MM_BAR;
    }
    MM_WAIT_V(0);
    MM_BAR;
#undef MM_SA
#undef MM_A1
#undef MM_SB
#undef MM_STAGE
#undef MM_LDA
#undef MM_LDB
#undef MM_MMA
#undef MM_CAT8
#undef MM_WAIT_V
#undef MM_WAIT_L
#undef MM_BAR
#undef MM_SCHED
}

#ifndef USE_MFMA_GEMM
#define USE_MFMA_GEMM 1
#endif
#if USE_MFMA_GEMM
#define GEMM_UNITS gemm_units_mfma
#else
#define GEMM_UNITS gemm_units_naive
#endif

__device__ __forceinline__ void rope4(f32x4& lo, f32x4& hi, const f32x2* cs) {
#pragma unroll
    for (int i = 0; i < 4; ++i) { const f32x2 t = cs[i]; const float a = lo[i], b = hi[i]; lo[i] = a * t.x - b * t.y; hi[i] = a * t.y + b * t.x; }
}

__device__ __forceinline__ int deal_xcd(const Ctx& c, int i) { return (c.G == 256) ? ((i * 8 + (c.blk & 7)) * 32 + (c.blk >> 3)) : (i * c.G + c.blk); }
struct SchedProj {
    static constexpr bool GATHER = false;
    const Ctx* c; int l, n_main, n_ctx, n_tot;
    __device__ void init(const Ctx* cc, int ll) { c = cc; l = ll; n_main = 128 * 21; n_ctx = 16 * (l == 0 ? 21 : 4); n_tot = n_main + n_ctx + 288; }
    __device__ bool next(int i, Unit& u) const {
        const int L = (c->G == 256) ? ((i * 8 + (c->blk & 7)) * 32 + (c->blk >> 3)) : (i * c->G + c->blk); if (L >= n_tot) return false;
        u.rows = nullptr; u.nrows = 256; u.aux = l; u.aux2 = 0; u.K = 512;
        if (L < n_main + n_ctx) {
            int pm, pn;
            if (L < n_main) { const int rg = L / 168, q = L % 168; pn = q >> 3; const int lt = rg * 8 + (q & 7); pm = (lt >> 3) * 9 + 1 + (lt & 7); }
            else { const int q = L - n_main; if (l == 0) { pm = (q / 21) * 9; pn = q % 21; } else { pm = (q >> 2) * 9; const int s = q & 3; pn = (s < 2) ? s : (s == 2 ? 6 : 8); } }
            u.pm = pm; u.pn = pn; u.kind = 0; u.bperm = (pn >= 9) ? 2 : 0;
            u.a = wsb(*c, A_HX) + (size_t)pm * 256 * 512; u.b = (pn < 9) ? wt(*c, WO_IN) + (size_t)pn * 256 * 512 : wt(*c, WO_G) + (size_t)(pn - 9) * 256 * 512;
        } else {
            const int q = L - n_main - n_ctx; u.pm = q / 144; u.pn = q % 144; u.kind = 1; u.bperm = 1;
            u.a = wt(*c, WO_VD) + (size_t)u.pm * 256 * 512; u.b = wsb(*c, A_HX) + (size_t)u.pn * 256 * 512;
        }
        return true;
    }
};
struct EpiProj {
    const Ctx* c; int l;
    __device__ __forceinline__ float one(const Unit& u, int R, bool lat, int t, int colp, f32x4 lo, f32x4 hi) const {
        const Ctx& C = *c;
        if (u.pn >= 9) {
            unsigned w0 = 0u, w1 = 0u;
#pragma unroll
            for (int i = 0; i < 4; ++i) { w0 = __builtin_amdgcn_cvt_pk_u8_f32(sigmoidf_(lo[i]) * 255.f, i, w0); w1 = __builtin_amdgcn_cvt_pk_u8_f32(sigmoidf_(hi[i]) * 255.f, i, w1); }
            *(u32x2*)((unsigned char*)C.p->out + (size_t)R * 3072 + (u.pn - 9) * 256 + colp) = (u32x2){w0, w1}; return 0.f; }
        switch (u.pn) {
        case 0: case 1: case 2: case 3: {
            const int col = (u.pn & 1) * 256 + colp;
            if (lat) rope4(lo, hi, (const f32x2*)(C.ws + WS_TAB64) + t * 32 + ((col & 63) >> 3) * 4);
            if (u.pn >= 2) { lo *= C2D; hi *= C2D; }
            *(u32x4*)(wsb(C, u.pn < 2 ? A_KD : A_QD) + (size_t)R * 512 + col) = pack8(lo, hi); break; }
        case 4: case 5: *(u32x4*)(wsb(C, A_PL) + (size_t)R * 512 + (u.pn - 4) * 256 + colp) = pack8(lo, hi); break;
        case 6: { *(u32x4*)(wsb(C, A_CKV) + (size_t)R * 256 + colp) = pack8(lo, hi);
            const float s = (lo.x * lo.x + lo.y * lo.y) + (lo.z * lo.z + lo.w * lo.w) + (hi.x * hi.x + hi.y * hi.y) + (hi.z * hi.z + hi.w * hi.w);
            return s; }
        case 7: { *(u32x4*)(wsb(C, A_CQ) + (size_t)R * 384 + colp) = pack8(lo, hi);
            const float s = (lo.x * lo.x + lo.y * lo.y) + (lo.z * lo.z + lo.w * lo.w) + (hi.x * hi.x + hi.y * hi.y) + (hi.z * hi.z + hi.w * hi.w);
            return s; }
        default: {
            if (colp < 128) { *(u32x4*)(wsb(C, A_CQ) + (size_t)R * 384 + 256 + colp) = pack8(lo, hi);
                const float s = (lo.x * lo.x + lo.y * lo.y) + (lo.z * lo.z + lo.w * lo.w) + (hi.x * hi.x + hi.y * hi.y) + (hi.z * hi.z + hi.w * hi.w);
                return s; }
            else if (colp < 160) { const int p = colp - 128;
                if (lat) rope4(lo, hi, (const f32x2*)(C.ws + WS_TAB32) + t * 16 + (p >> 3) * 4);
                *(u32x4*)(wsb(C, A_KR) + (size_t)R * 32 + p) = pack8(lo, hi); }
            break; }
        }
        return 0.f;
    }
    static constexpr int GROUP = 4; static constexpr bool EARLY = false; static constexpr bool CHAIN = false; static constexpr bool ROWTAB = false; struct Pre {}; struct UState {}; __device__ __forceinline__ void unit_begin(const Unit&, int, UState&) const {} __device__ __forceinline__ void pre(const Unit&, int, int, Pre&) const {}
    static constexpr bool PAIR = false; static constexpr bool FP8 = true;
    __device__ __forceinline__ void apply(const Unit& u, int row, int c8, const Pre&, const UState&, f32x4 v0l, f32x4 v0h, f32x4 v1l, f32x4 v1h) const {
        const Ctx& C = *c;
        v0l *= W8_INV; v0h *= W8_INV; v1l *= W8_INV; v1h *= W8_INV;
        if (u.kind == 1) {
            bf16_t* o = wsb(C, A_VDT) + (size_t)(u.pm * 256 + row) * NR + (size_t)u.pn * 256;
            *(u32x4*)(o + c8) = pack8(v0l, v0h); *(u32x4*)(o + 128 + c8) = pack8(v1l, v1h); return; }
        const int R = u.pm * 256 + row; const bool lat = (u.pm % 9) != 0; const int t = (R % RPB) - CTXL;
        if (u.pn >= 9) {
            u32x4 w = (u32x4){0u, 0u, 0u, 0u};
#pragma unroll
            for (int i = 0; i < 4; ++i) { w.x = __builtin_amdgcn_cvt_pk_u8_f32(sigmoidf_(v0l[i]) * 255.f, i, w.x); w.y = __builtin_amdgcn_cvt_pk_u8_f32(sigmoidf_(v0h[i]) * 255.f, i, w.y);
                                          w.z = __builtin_amdgcn_cvt_pk_u8_f32(sigmoidf_(v1l[i]) * 255.f, i, w.z); w.w = __builtin_amdgcn_cvt_pk_u8_f32(sigmoidf_(v1h[i]) * 255.f, i, w.w); }
            *(u32x4*)((unsigned char*)C.p->out + (size_t)R * 3072 + (u.pn - 9) * 256 + 2 * c8) = w; return; }
        float ssq = one(u, R, lat, t, c8, v0l, v0h) + one(u, R, lat, t, 128 + c8, v1l, v1h);
        if (u.pn >= 6 && u.pn <= 8) {
            ssq += __shfl_xor(ssq, 16); ssq += __shfl_xor(ssq, 32);
            if ((c8 & 24) == 0) ss_add((unsigned long long*)(C.ws + (u.pn == 6 ? CTL_SSKV : CTL_SSQ)) + (size_t)l * NR + R, ssq); }
    }
};

struct SchedUp {
    static constexpr bool GATHER = false;
    const Ctx* c; int l, n_kn, n_vm, n_uq, n_tot;
    __device__ void init(const Ctx* cc, int ll) { c = cc; l = ll; n_kn = 144 * 2; n_vm = 2 * 144; n_uq = (l == 0 ? 144 : 128) * 3; n_tot = n_kn + n_vm + n_uq; }
    __device__ bool next(int i, Unit& u) const {
        const int L = i * c->G + c->blk; if (L >= n_tot) return false;
        u.rows = nullptr; u.nrows = 256; u.aux = l; u.aux2 = 0;
        if (L < n_kn) { u.pm = L >> 1; u.pn = L & 1; u.kind = 0; u.bperm = 0; u.K = 256; u.a = wsb(*c, A_CKV) + (size_t)u.pm * 256 * 256; u.b = wt(*c, WO_UK) + (size_t)u.pn * 256 * 256; }
        else if (L < n_kn + n_vm) { const int q = L - n_kn; u.pm = q / 144; u.pn = q % 144; u.kind = 1; u.bperm = 1; u.K = 256; u.a = wt(*c, WO_UV) + (size_t)u.pm * 256 * 256; u.b = wsb(*c, A_CKV) + (size_t)u.pn * 256 * 256; }
        else { const int q = L - n_kn - n_vm; const int rt = q / 3; u.pn = q % 3; u.pm = (l == 0) ? rt : ((rt >> 3) * 9 + 1 + (rt & 7)); u.kind = 2; u.bperm = 0; u.K = 384;
            u.a = wsb(*c, A_CQ) + (size_t)u.pm * 256 * 384; u.b = wt(*c, WO_UQ) + (size_t)u.pn * 256 * 384; }
        return true;
    }
};
struct EpiUp {
    const Ctx* c; int l;
    static constexpr bool PAIR = false; static constexpr bool FP8 = false;
    struct UState { float rsv[16]; };
    __device__ __forceinline__ float rstd_kv(int R) const { return __builtin_amdgcn_rsqf(ss_get((const unsigned long long*)(c->ws + CTL_SSKV) + (size_t)l * NR + R) * (1.f / 256.f) + EPSN); }
    static constexpr int GROUP = 4; static constexpr bool EARLY = false; static constexpr bool CHAIN = false; static constexpr bool ROWTAB = false; struct Pre { unsigned long long ss; };
    __device__ __forceinline__ void unit_begin(const Unit& u, int c8, UState& us) const {
#pragma unroll
        for (int i = 0; i < 16; ++i) us.rsv[i] = 0.f;
        if (u.kind == 1) {
#pragma unroll
            for (int h = 0; h < 2; ++h) { const int q0 = h * 128 + c8;
#pragma unroll
                for (int i = 0; i < 8; ++i) us.rsv[h * 8 + i] = rstd_kv(u.pn * 256 + (q0 & ~31) + pos2tok((q0 & 31) + i)); } }
    }
    __device__ __forceinline__ void pre(const Unit& u, int row, int c8, Pre& p) const {
        p.ss = 0ull;
        if (u.kind == 0) p.ss = *((const unsigned long long*)(c->ws + CTL_SSKV) + (size_t)l * NR + u.pm * 256 + row);
        else if (u.kind == 2) p.ss = *((const unsigned long long*)(c->ws + CTL_SSQ) + (size_t)l * NR + u.pm * 256 + row);
    }
    __device__ __forceinline__ void apply(const Unit& u, int row, int c8, const Pre& p, const UState& us, f32x4 v0l, f32x4 v0h, f32x4 v1l, f32x4 v1h) const {
        const Ctx& C = *c;
        if (u.kind == 0) { const int R = u.pm * 256 + row; const float rs = __builtin_amdgcn_rsqf((float)p.ss * SS_INV * (1.f / 256.f) + EPSN);
            bf16_t* o = wsb(C, A_KN) + (size_t)R * 512 + u.pn * 256;
            *(u32x4*)(o + c8) = pack8(v0l * rs, v0h * rs); *(u32x4*)(o + 128 + c8) = pack8(v1l * rs, v1h * rs); }
        else if (u.kind == 1) {
            bf16_t* o = wsb(C, A_VMT) + (size_t)(u.pm * 256 + row) * NR + (size_t)u.pn * 256;
#pragma unroll
            for (int h = 0; h < 2; ++h) { const int q0 = h * 128 + c8; f32x4 lo = h ? v1l : v0l, hi = h ? v1h : v0h;
#pragma unroll
                for (int i = 0; i < 4; ++i) { lo[i] *= us.rsv[h * 8 + i]; hi[i] *= us.rsv[h * 8 + 4 + i]; }
                *(u32x4*)(o + q0) = pack8(lo, hi); } }
        else { const int R = u.pm * 256 + row; const bool lat = (u.pm % 9) != 0; const int t = (R % RPB) - CTXL;
            const float rs = C2M * __builtin_amdgcn_rsqf((float)p.ss * SS_INV * (1.f / 384.f) + EPSN);
#pragma unroll
            for (int h = 0; h < 2; ++h) { const int col = u.pn * 256 + h * 128 + c8; const int pp = col % 96; f32x4 lo = h ? v1l : v0l, hi = h ? v1h : v0h;
                if (lat && pp >= 64) rope4(lo, hi, (const f32x2*)(C.ws + WS_TAB32) + t * 16 + ((pp - 64) >> 3) * 4);
                *(u32x4*)(wsb(C, A_QM) + (size_t)R * 768 + col) = pack8(lo * rs, hi * rs); } }
    }
};
__device__ __forceinline__ void ph_pool(const Ctx& c, int l) {
    LAS bf16_t* tile = (LAS bf16_t*)c.lds;
    const int nitems = 16 * 32 + (l == 0 ? 16 * 4 : 0);
    for (int it = c.G - 1 - c.blk; it < nitems; it += c.G) {
        int b, s0, n, rbase;
        if (it < 512) { b = it >> 5; s0 = (it & 31) * 64; n = SEQ; rbase = b * RPB + CTXL; } else { const int q = it - 512; b = q >> 2; s0 = (q & 3) * 64; n = CTXL; rbase = b * RPB; }
        __syncthreads();
        for (int q = c.tid; q < 80 * 64; q += 512) { const int rr = q >> 6, ch = q & 63; const int t = s0 - 8 + rr;
            u32x4 v = (u32x4){0u, 0u, 0u, 0u}; if (t >= 0 && t < n) v = *(const u32x4*)(wsb(c, A_PL) + (size_t)(rbase + t) * 512 + ch * 8);
            *(LAS u32x4*)(tile + rr * 512 + ch * 8) = v; }
        __syncthreads();
        const int ch = c.tid & 63, g = ch >> 4, w = 2 << g;
        for (int rr = c.tid >> 6; rr < 64; rr += 8) { const int t = s0 + rr; const int lo = max(t - w / 2, 0), hi = min(t + w / 2, n);
            float acc[8];
#pragma unroll
            for (int q = 0; q < 8; ++q) acc[q] = 0.f;
            for (int j = lo; j < hi; ++j) { f32x4 a, bq; unpack8(*(const LAS u32x4*)(tile + (j - s0 + 8) * 512 + ch * 8), a, bq);
                acc[0] += a.x; acc[1] += a.y; acc[2] += a.z; acc[3] += a.w; acc[4] += bq.x; acc[5] += bq.y; acc[6] += bq.z; acc[7] += bq.w; }
            f32x4 xa, xb; unpack8(*(const LAS u32x4*)(tile + (rr + 8) * 512 + ch * 8), xa, xb);
            const float inv = 1.f / (float)(hi - lo);
            const f32x4 oa = (f32x4){acc[0], acc[1], acc[2], acc[3]} * inv - xa, ob = (f32x4){acc[4], acc[5], acc[6], acc[7]} * inv - xb;
            *(u32x2*)((unsigned char*)(c.ws + A_PD) + (size_t)(rbase + t) * 512 + ch * 8) = (u32x2){pack4_fp8c(oa, BR8_SCALE), pack4_fp8c(ob, BR8_SCALE)}; }
    }
    __syncthreads();
}

__device__ __forceinline__ float lam_of(const Ctx& c, int l) {
    float s1 = 0.f, s2 = 0.f;
    for (int i = 0; i < 64; ++i) { s1 += INP(c, I_LQ1)[l * 64 + i] * INP(c, I_LK1)[l * 64 + i]; s2 += INP(c, I_LQ2)[l * 64 + i] * INP(c, I_LK2)[l * 64 + i]; }
    const float lam_init = 0.8f - 0.6f * expf(-0.3f * (float)l);
    return expf(s1) - expf(s2) + lam_init;
}
__device__ __forceinline__ void ph_attn_naive(const Ctx& c, int l) {
    const long gt = (long)c.blk * 512 + c.tid, NT = (long)c.G * 512;
    for (long it = gt; it < (long)NR * 16; it += NT) {
        const int dc = (int)(it & 1), h = (int)((it >> 1) & 7), R = (int)(it >> 4);
        const int b = R / RPB, j = R % RPB; const bool lat = j >= CTXL;
        if (!lat && l != 0) continue;
        const int nk = lat ? RPB : CTXL; const int kb = b * RPB;
        const bf16_t* qp = wsb(c, A_QM) + (size_t)R * 768 + h * 96;
        float m = -INFINITY, ls = 0.f, o[32];
#pragma unroll
        for (int i = 0; i < 32; ++i) o[i] = 0.f;
        for (int k = 0; k < nk; ++k) {
            const int Rk = kb + k; const bf16_t* kp = wsb(c, A_KN) + (size_t)Rk * 512 + h * 64; const bf16_t* rp = wsb(c, A_KR) + (size_t)Rk * 32;
            float s = 0.f;
            for (int i = 0; i < 96; i += 8) { f32x4 qa, qb, ka, kbb; unpack8(*(const u32x4*)(qp + i), qa, qb); unpack8(*(const u32x4*)(i < 64 ? kp + i : rp + (i - 64)), ka, kbb);
                s += (qa.x * ka.x + qa.y * ka.y) + (qa.z * ka.z + qa.w * ka.w) + (qb.x * kbb.x + qb.y * kbb.y) + (qb.z * kbb.z + qb.w * kbb.w); }
            const float mn = fmaxf(m, s), f = exp2f(m - mn), pv = exp2f(s - mn);
            ls = ls * f + pv; m = mn;
            const size_t vcol = (size_t)(Rk & ~31) + tok2pos(Rk & 31);
            const float pb = bf2f((unsigned short)f2bf(pv));
#pragma unroll
            for (int i = 0; i < 32; ++i) o[i] = o[i] * f + pb * bf2f(wsb(c, A_VMT)[(size_t)(h * 64 + dc * 32 + i) * NR + vcol]);
        }
        const float inv = 1.f / ls;
        bf16_t* op = wsb(c, A_OM) + (size_t)R * 512 + h * 64 + dc * 32;
#pragma unroll
        for (int i = 0; i < 32; i += 2) *(unsigned*)(op + i) = pk2(o[i] * inv, o[i + 1] * inv);
    }
    const float lam = lam_of(c, l); const float lam_init = 0.8f - 0.6f * expf(-0.3f * (float)l);
    for (long it = gt; it < (long)NR * 32; it += NT) {
        const int dc = (int)(it & 7), h = (int)((it >> 3) & 3), R = (int)(it >> 5);
        const int b = R / RPB, j = R % RPB; const bool lat = j >= CTXL;
        const bool act = lat || l == 0;
        const int nk = act ? (lat ? RPB : CTXL) : 0; const int kb = b * RPB;
        const bf16_t* qp = wsb(c, A_QD) + (size_t)R * 512 + h * 128;
        float m0 = -INFINITY, m1 = -INFINITY, l0 = 0.f, l1 = 0.f, o0[16], o1[16];
#pragma unroll
        for (int i = 0; i < 16; ++i) { o0[i] = 0.f; o1[i] = 0.f; }
        for (int k = 0; k < nk; ++k) {
            const int Rk = kb + k; const bf16_t* kp = wsb(c, A_KD) + (size_t)Rk * 512 + h * 128;
            float s0 = 0.f, s1 = 0.f;
#pragma unroll 2
            for (int i = 0; i < 64; i += 8) { f32x4 qa, qb, ka, kbb; unpack8(*(const u32x4*)(qp + i), qa, qb); unpack8(*(const u32x4*)(kp + i), ka, kbb);
                s0 += (qa.x * ka.x + qa.y * ka.y) + (qa.z * ka.z + qa.w * ka.w) + (qb.x * kbb.x + qb.y * kbb.y) + (qb.z * kbb.z + qb.w * kbb.w);
                unpack8(*(const u32x4*)(qp + 64 + i), qa, qb); unpack8(*(const u32x4*)(kp + 64 + i), ka, kbb);
                s1 += (qa.x * ka.x + qa.y * ka.y) + (qa.z * ka.z + qa.w * ka.w) + (qb.x * kbb.x + qb.y * kbb.y) + (qb.z * kbb.z + qb.w * kbb.w); }
            const float mn0 = fmaxf(m0, s0), f0 = exp2f(m0 - mn0), p0 = exp2f(s0 - mn0); l0 = l0 * f0 + p0; m0 = mn0;
            const float mn1 = fmaxf(m1, s1), f1 = exp2f(m1 - mn1), p1 = exp2f(s1 - mn1); l1 = l1 * f1 + p1; m1 = mn1;
            const size_t vcol = (size_t)(Rk & ~31) + tok2pos(Rk & 31);
            const float pb0 = bf2f((unsigned short)f2bf(p0)), pb1 = bf2f((unsigned short)f2bf(p1));
#pragma unroll
            for (int i = 0; i < 16; ++i) { const float v = bf2f(wsb(c, A_VDT)[(size_t)(h * 128 + dc * 16 + i) * NR + vcol]); o0[i] = o0[i] * f0 + pb0 * v; o1[i] = o1[i] * f1 + pb1 * v; }
        }
        float ss = 0.f; const float i0 = act ? 1.f / l0 : 0.f, i1 = act ? lam / l1 : 0.f;
#pragma unroll
        for (int i = 0; i < 16; ++i) { o0[i] = o0[i] * i0 - o1[i] * i1; ss += o0[i] * o0[i]; }
        ss += __shfl_xor(ss, 1); ss += __shfl_xor(ss, 2); ss += __shfl_xor(ss, 4);
        const float rs = (1.f - lam_init) / sqrtf(ss * (1.f / 128.f) + EPSN);
        if (act) { bf16_t* op = wsb(c, A_QD) + (size_t)R * 512 + h * 128 + dc * 16; const float* g = INP(c, I_GSUBLN) + l * 128 + dc * 16;
#pragma unroll
            for (int i = 0; i < 16; i += 2) *(unsigned*)(op + i) = pk2(o0[i] * rs * g[i], o0[i + 1] * rs * g[i + 1]); }
    }
}


typedef float f32x16 __attribute__((ext_vector_type(16)));
template <bool DIFF>
__device__ __forceinline__ void attn_unit(const Ctx& c, int l, int b, int h, int q0  , int nk  , float lam, float lam_init) {
    constexpr int DQ = DIFF ? 64 : 96, DV = DIFF ? 128 : 64, NCK = DIFF ? 16 : 12  , KB = NCK * 1024, VB = 8 * DV * 16, SLOT = KB + VB;
    constexpr int NDS = DQ / 16, NDB = DV / 32;
    static_assert(4 * SLOT + 8 * 512 + (DIFF ? 0 : 32768) <= LDS_MISC && (!DIFF || 65536 <= 4 * SLOT), "attention LDS map");
    LAS unsigned char* lds = c.lds;
    const int lane = c.lane, wid = c.wave, r32 = lane & 31, hi = lane >> 5;
    const int map = DIFF ? (wid >> 2) : 0, wq = DIFF ? (wid & 3) : wid;
    const int kb = b * RPB, NT = nk / 64;
    LAS float* wsf = (LAS float*)(lds + 4 * SLOT + wid * 512);
    unsigned ko0, ko1, vo0, vo1;
    unsigned kstep0, kstep1, kdb0, kdb1, vdb0, vdb1; bool has_k1;
    if constexpr (DIFF) {
        { const int row = 4 * wid + (lane >> 4), ch = (lane & 15) ^ (row & 15); ko0 = (unsigned)(A_KD + ((size_t)(kb + row) * 512 + h * 128 + ch * 8) * 2); }
        { const int row = 4 * (wid + 8) + (lane >> 4), ch = (lane & 15) ^ (row & 15); ko1 = (unsigned)(A_KD + ((size_t)(kb + row) * 512 + h * 128 + ch * 8) * 2); }
        kstep0 = kstep1 = 64 * 512 * 2; kdb0 = wid * 1024; kdb1 = (wid + 8) * 1024; has_k1 = true;
        { const int d = 8 * wid + (lane >> 3), ch = (lane & 7) ^ ((d >> 1) & 7); vo0 = (unsigned)(A_VDT + ((size_t)(h * 128 + d) * NR + kb + ch * 8) * 2); }
        { const int d = 8 * (wid + 8) + (lane >> 3), ch = (lane & 7) ^ ((d >> 1) & 7); vo1 = (unsigned)(A_VDT + ((size_t)(h * 128 + d) * NR + kb + ch * 8) * 2); }
        vdb0 = KB + wid * 1024; vdb1 = KB + (wid + 8) * 1024;
    } else {
        { const int row = 8 * wid + (lane >> 3), ch = (lane & 7) ^ ((row >> 1) & 7); ko0 = (unsigned)(A_KN + ((size_t)(kb + row) * 512 + h * 64 + ch * 8) * 2); }
        { const int w4 = wid & 3, row = 16 * w4 + (lane >> 2), ch = (lane & 3) ^ ((row >> 2) & 3); ko1 = (unsigned)(A_KR + ((size_t)(kb + row) * 32 + ch * 8) * 2); }
        kstep0 = 64 * 512 * 2; kstep1 = 64 * 32 * 2; kdb0 = wid * 1024; kdb1 = 8192 + (wid & 3) * 1024; has_k1 = wid < 4;
        { const int d = 8 * wid + (lane >> 3), ch = (lane & 7) ^ ((d >> 1) & 7); vo0 = (unsigned)(A_VMT + ((size_t)(h * 64 + d) * NR + kb + ch * 8) * 2); }
        vo1 = vo0; vdb0 = KB + wid * 1024; vdb1 = vdb0;
    }
    const GAS unsigned char* wsg_ = c.ws;
#define AT_DMA(t, slot) do { const unsigned so_ = (unsigned)(slot) * SLOT; \
        __builtin_amdgcn_global_load_lds((const GAS unsigned*)(wsg_ + (size_t)((unsigned)(t) * kstep0) + ko0), (LAS unsigned*)(lds + so_ + kdb0), 16, 0, 0); \
        if (has_k1) __builtin_amdgcn_global_load_lds((const GAS unsigned*)(wsg_ + (size_t)((unsigned)(t) * kstep1) + ko1), (LAS unsigned*)(lds + so_ + kdb1), 16, 0, 0); \
        __builtin_amdgcn_global_load_lds((const GAS unsigned*)(wsg_ + (size_t)((unsigned)(t) * 128u) + vo0), (LAS unsigned*)(lds + so_ + vdb0), 16, 0, 0); \
        if (DIFF) __builtin_amdgcn_global_load_lds((const GAS unsigned*)(wsg_ + (size_t)((unsigned)(t) * 128u) + vo1), (LAS unsigned*)(lds + so_ + vdb1), 16, 0, 0); } while (0)
#define AT_WAIT1() do { if (DIFF) asm volatile("s_waitcnt vmcnt(4)" ::: "memory"); else if (has_k1) asm volatile("s_waitcnt vmcnt(3)" ::: "memory"); else asm volatile("s_waitcnt vmcnt(2)" ::: "memory"); } while (0)
    const int qrow = q0 + wq * 32 + r32;
    const bf16_t* qp = DIFF ? (wsb(c, A_QD) + (size_t)qrow * 512 + h * 128 + map * 64) : (wsb(c, A_QM) + (size_t)qrow * 768 + h * 96);
    bf16x8 qr[NDS];
#pragma unroll
    for (int ds = 0; ds < NDS; ++ds) qr[ds] = *(const bf16x8*)(qp + ds * 16 + hi * 8);
    AT_DMA(0, 0); AT_DMA(1, 1); AT_DMA(2, 2);
    f32x16 o[NDB];
#pragma unroll
    for (int d = 0; d < NDB; ++d) o[d] = f32x16{};
    float mhat = 0.f, lsum = 0.f; f32x16 negm = f32x16{};
    const int kchunk0 = DIFF ? map * 8 : 0;
    const unsigned swk_ = (unsigned)((r32 >> 1) & 7), swr_ = (unsigned)((r32 >> 2) & 3), swd_ = (unsigned)(r32 & 15);
#define AT_KOFF(ds) (DIFF ? ((unsigned)r32 * 256u + ((((unsigned)(kchunk0 + 2 * (ds)) ^ swd_) ^ (unsigned)hi) << 4)) \
                          : ((ds) < 4 ? ((unsigned)r32 * 128u + ((((unsigned)(2 * (ds)) ^ swk_) ^ (unsigned)hi) << 4)) : (8192u + (unsigned)r32 * 64u + ((((unsigned)(2 * ((ds) - 4)) ^ swr_) ^ (unsigned)hi) << 4))))
#define AT_KROW32(ds) (DIFF ? 8192 : ((ds) < 4 ? 4096 : 2048))
#define AT_VOFF(s4) ((unsigned)KB + (unsigned)r32 * 128u + ((((unsigned)(2 * (s4)) ^ swk_) ^ (unsigned)hi) << 4))
#define AT_QK(P0, P1, slot_) do { unsigned kb_ = (unsigned)(slot_) * SLOT; asm volatile("" : "+v"(kb_)); const LAS unsigned char* ks_ = lds + kb_; \
        if (DIFF) { P0 = f32x16{}; P1 = f32x16{}; } else { P0 = negm; P1 = negm; } \
        _Pragma("unroll") for (int ds = 0; ds < NDS; ++ds) { \
            const bf16x8 k0 = *(const LAS bf16x8*)(ks_ + AT_KOFF(ds)); \
            const bf16x8 k1 = *(const LAS bf16x8*)(ks_ + AT_KOFF(ds) + AT_KROW32(ds)); \
            P0 = __builtin_amdgcn_mfma_f32_32x32x16_bf16(k0, qr[ds], P0, 0, 0, 0); \
            P1 = __builtin_amdgcn_mfma_f32_32x32x16_bf16(k1, qr[ds], P1, 0, 0, 0); } } while (0)
#define AT_ROWMAX(RM, P0, P1) do { float a_ = fmaxf(fmaxf(P0[0], P1[0]), P0[1]), b_ = fmaxf(fmaxf(P1[1], P0[2]), P1[2]); \
        _Pragma("unroll") for (int r = 3; r < 15; r += 2) { a_ = fmaxf(fmaxf(a_, P0[r]), P1[r]); b_ = fmaxf(fmaxf(b_, P0[r + 1]), P1[r + 1]); } \
        a_ = fmaxf(fmaxf(a_, P0[15]), P1[15]); RM = fmaxf(a_, b_); RM = fmaxf(RM, __shfl_xor(RM, 32)); } while (0)
    if (DIFF) asm volatile("s_waitcnt vmcnt(8)" ::: "memory"); else if (has_k1) asm volatile("s_waitcnt vmcnt(6)" ::: "memory"); else asm volatile("s_waitcnt vmcnt(4)" ::: "memory");
    asm volatile("s_barrier" ::: "memory");
    f32x16 pA0, pA1, pB0, pB1; float rmA, rmB = 0.f;
    AT_QK(pA0, pA1, 0);
    AT_ROWMAX(rmA, pA0, pA1);
#define SGB(mask, n) __builtin_amdgcn_sched_group_barrier(mask, n, 0)
#define AT_STEP(P0, P1, RM, N0, N1, RMN, t, HN) do { \
          \
        if (HN) { if ((t) + 2 < NT) AT_WAIT1(); else asm volatile("s_waitcnt vmcnt(0)" ::: "memory"); } \
        asm volatile("s_barrier" ::: "memory"); \
        if ((t) + 3 < NT) AT_DMA((t) + 3, ((t) + 3) & 3); \
          \
        const bool first_ = ((t) == 0); \
        const float rrel_ = DIFF ? RM - mhat : RM;        \
        if (first_ || __any(rrel_ > 8.0f)) { \
            const float dl = first_ ? rrel_ : fmaxf(rrel_, 0.f); \
            mhat += dl; \
            if (!DIFF) { _Pragma("unroll") for (int r = 0; r < 16; ++r) { P0[r] -= dl; P1[r] -= dl; negm[r] = -mhat; } } \
            if (!first_) { \
                const float f = __builtin_amdgcn_exp2f(-dl); lsum *= f; \
                { int rq_ = r32; asm volatile("" : "+v"(rq_)); if (hi == 0) wsf[rq_] = f; } \
                asm volatile("s_waitcnt lgkmcnt(0)" ::: "memory"); \
                _Pragma("unroll") for (int r = 0; r < 16; ++r) { const float fr_ = wsf[(r & 3) + 8 * (r >> 2) + 4 * hi]; \
                    _Pragma("unroll") for (int d = 0; d < NDB; ++d) o[d][r] *= fr_; } \
            } \
        } \
        __builtin_amdgcn_sched_barrier(0); \
          \
        unsigned kb_ = (unsigned)(((t) + 1) & 3) * SLOT; asm volatile("" : "+v"(kb_)); const LAS unsigned char* ks_ = lds + kb_; \
        unsigned vb_ = (unsigned)((t) & 3) * SLOT; asm volatile("" : "+v"(vb_)); const LAS unsigned char* vs_ = lds + vb_; \
        bf16x8 kf_[2 * NDS], vf_[4], vg_[4]; \
        if (HN) { _Pragma("unroll") for (int ds = 0; ds < NDS; ++ds) { kf_[2 * ds] = *(const LAS bf16x8*)(ks_ + AT_KOFF(ds)); kf_[2 * ds + 1] = *(const LAS bf16x8*)(ks_ + AT_KOFF(ds) + AT_KROW32(ds)); } } \
        if (HN) { if (DIFF) { N0 = f32x16{}; N1 = f32x16{}; } else { N0 = negm; N1 = negm; } \
            _Pragma("unroll") for (int ds = 0; ds < NDS; ++ds) { \
                N0 = __builtin_amdgcn_mfma_f32_32x32x16_bf16(kf_[2 * ds], qr[ds], N0, 0, 0, 0); \
                N1 = __builtin_amdgcn_mfma_f32_32x32x16_bf16(kf_[2 * ds + 1], qr[ds], N1, 0, 0, 0); } } \
        float sacc = 0.f; \
        _Pragma("unroll") for (int r = 0; r < 16; ++r) { P0[r] = __builtin_amdgcn_exp2f(DIFF ? P0[r] - mhat : P0[r]); P1[r] = __builtin_amdgcn_exp2f(DIFF ? P1[r] - mhat : P1[r]); sacc += P0[r] + P1[r]; } \
        lsum += sacc; \
        bf16x8 pa[4]; \
        { u32x4 w; \
          w.x = pk2(P0[0], P0[1]); w.y = pk2(P0[2], P0[3]); w.z = pk2(P0[4], P0[5]); w.w = pk2(P0[6], P0[7]); pa[0] = __builtin_bit_cast(bf16x8, w); \
          w.x = pk2(P0[8], P0[9]); w.y = pk2(P0[10], P0[11]); w.z = pk2(P0[12], P0[13]); w.w = pk2(P0[14], P0[15]); pa[1] = __builtin_bit_cast(bf16x8, w); \
          w.x = pk2(P1[0], P1[1]); w.y = pk2(P1[2], P1[3]); w.z = pk2(P1[4], P1[5]); w.w = pk2(P1[6], P1[7]); pa[2] = __builtin_bit_cast(bf16x8, w); \
          w.x = pk2(P1[8], P1[9]); w.y = pk2(P1[10], P1[11]); w.z = pk2(P1[12], P1[13]); w.w = pk2(P1[14], P1[15]); pa[3] = __builtin_bit_cast(bf16x8, w); } \
        _Pragma("unroll") for (int s4 = 0; s4 < 4; ++s4) vf_[s4] = *(const LAS bf16x8*)(vs_ + AT_VOFF(s4)); \
        _Pragma("unroll") for (int s4 = 0; s4 < 4; ++s4) vg_[s4] = *(const LAS bf16x8*)(vs_ + AT_VOFF(s4) + 4096); \
        _Pragma("unroll") for (int s4 = 0; s4 < 4; ++s4) o[0] = __builtin_amdgcn_mfma_f32_32x32x16_bf16(pa[s4], vf_[s4], o[0], 0, 0, 0); \
        _Pragma("unroll") for (int s4 = 0; s4 < 4; ++s4) o[1] = __builtin_amdgcn_mfma_f32_32x32x16_bf16(pa[s4], vg_[s4], o[1], 0, 0, 0); \
        if (HN) AT_ROWMAX(RMN, N0, N1); \
          \
        SGB(0x100, (HN ? 2 * NDS : 8)); \
        _Pragma("unroll") for (int i_ = 0; i_ < (HN ? 2 * NDS : 0); ++i_) { SGB(0x008, 1); SGB(0x002, 6); } \
        if (HN) SGB(0x100, 8); \
        SGB(0x002, 64); \
        _Pragma("unroll") for (int i_ = 0; i_ < 8; ++i_) { SGB(0x008, 1); SGB(0x002, 2); } \
        __builtin_amdgcn_sched_barrier(0); \
    } while (0)
#define AT_STEP_D(P0, P1, RM, N0, N1, RMN, t) do { \
          \
        if ((t) + 1 < NT) { if ((t) + 2 < NT) AT_WAIT1(); else asm volatile("s_waitcnt vmcnt(0)" ::: "memory"); } \
        asm volatile("s_barrier" ::: "memory"); \
        if ((t) + 3 < NT) AT_DMA((t) + 3, ((t) + 3) & 3); \
          \
        const bool first_ = ((t) == 0); \
        const float rrel_ = DIFF ? RM - mhat : RM;        \
        if (first_ || __any(rrel_ > 8.0f)) { \
            const float dl = first_ ? rrel_ : fmaxf(rrel_, 0.f); \
            mhat += dl; \
            if (!DIFF) { _Pragma("unroll") for (int r = 0; r < 16; ++r) { P0[r] -= dl; P1[r] -= dl; negm[r] = -mhat; } } \
            if (!first_) { \
                const float f = __builtin_amdgcn_exp2f(-dl); lsum *= f; \
                { int rq_ = r32; asm volatile("" : "+v"(rq_)); if (hi == 0) wsf[rq_] = f; } \
                asm volatile("s_waitcnt lgkmcnt(0)" ::: "memory"); \
                _Pragma("unroll") for (int r = 0; r < 16; ++r) { const float fr_ = wsf[(r & 3) + 8 * (r >> 2) + 4 * hi]; \
                    _Pragma("unroll") for (int d = 0; d < NDB; ++d) o[d][r] *= fr_; } \
            } \
        } \
          \
        if ((t) + 1 < NT) AT_QK(N0, N1, ((t) + 1) & 3); \
        float sacc = 0.f; \
        _Pragma("unroll") for (int r = 0; r < 16; ++r) { P0[r] = __builtin_amdgcn_exp2f(DIFF ? P0[r] - mhat : P0[r]); P1[r] = __builtin_amdgcn_exp2f(DIFF ? P1[r] - mhat : P1[r]); sacc += P0[r] + P1[r]; } \
        lsum += sacc; \
        bf16x8 pa[4]; \
        { u32x4 w; \
          w.x = pk2(P0[0], P0[1]); w.y = pk2(P0[2], P0[3]); w.z = pk2(P0[4], P0[5]); w.w = pk2(P0[6], P0[7]); pa[0] = __builtin_bit_cast(bf16x8, w); \
          w.x = pk2(P0[8], P0[9]); w.y = pk2(P0[10], P0[11]); w.z = pk2(P0[12], P0[13]); w.w = pk2(P0[14], P0[15]); pa[1] = __builtin_bit_cast(bf16x8, w); \
          w.x = pk2(P1[0], P1[1]); w.y = pk2(P1[2], P1[3]); w.z = pk2(P1[4], P1[5]); w.w = pk2(P1[6], P1[7]); pa[2] = __builtin_bit_cast(bf16x8, w); \
          w.x = pk2(P1[8], P1[9]); w.y = pk2(P1[10], P1[11]); w.z = pk2(P1[12], P1[13]); w.w = pk2(P1[14], P1[15]); pa[3] = __builtin_bit_cast(bf16x8, w); } \
          \
        { unsigned vb_ = (unsigned)((t) & 3) * SLOT; asm volatile("" : "+v"(vb_)); const LAS unsigned char* vs = lds + vb_; \
          _Pragma("unroll") for (int d = 0; d < NDB; ++d) { \
            _Pragma("unroll") for (int s4 = 0; s4 < 4; ++s4) { \
                const bf16x8 vf = *(const LAS bf16x8*)(vs + AT_VOFF(s4) + d * 4096); \
                o[d] = __builtin_amdgcn_mfma_f32_32x32x16_bf16(pa[s4], vf, o[d], 0, 0, 0); } \
          } } \
        if ((t) + 1 < NT) AT_ROWMAX(RMN, N0, N1); \
    } while (0)
    if constexpr (DIFF) {
        for (int t = 0; t < NT; t += 2) { AT_STEP_D(pA0, pA1, rmA, pB0, pB1, rmB, t); AT_STEP_D(pB0, pB1, rmB, pA0, pA1, rmA, t + 1); }
    } else {
        int t = 0;
        for (; t + 2 < NT; t += 2) {
            AT_STEP(pA0, pA1, rmA, pB0, pB1, rmB, t, true);
            AT_STEP(pB0, pB1, rmB, pA0, pA1, rmA, t + 1, true);
        }
        AT_STEP(pA0, pA1, rmA, pB0, pB1, rmB, t, true);
        AT_STEP(pB0, pB1, rmB, pA0, pA1, rmA, t + 1, false);
    }
#undef AT_STEP
#undef AT_STEP_D
#undef SGB
#undef AT_QK
#undef AT_KOFF
#undef AT_KROW32
#undef AT_VOFF
#undef AT_ROWMAX
    lsum += __shfl_xor(lsum, 32);
    { int rq_ = r32; asm volatile("" : "+v"(rq_)); if (hi == 0) wsf[32 + rq_] = lsum; }
    asm volatile("s_waitcnt lgkmcnt(0)" ::: "memory");
    float rl[16];
#pragma unroll
    for (int r = 0; r < 16; ++r) rl[r] = 1.f / wsf[32 + (r & 3) + 8 * (r >> 2) + 4 * hi];
    LAS unsigned char* xch = DIFF ? lds : lds + 4 * SLOT + 8 * 512;
    asm volatile("s_barrier" ::: "memory");
    if constexpr (DIFF) {
        LAS float* x1 = (LAS float*)xch + wq * 4096;
        if (map == 1) {
#pragma unroll
            for (int d = 0; d < NDB; ++d)
#pragma unroll
                for (int r = 0; r < 16; ++r) x1[((r & 3) + 8 * (r >> 2) + 4 * hi) * 128 + d * 32 + r32] = o[d][r] * rl[r] * lam;
        }
        asm volatile("s_waitcnt lgkmcnt(0)\n\ts_barrier" ::: "memory");
        if (map == 0) {
            float ss[16];
#pragma unroll
            for (int r = 0; r < 16; ++r) ss[r] = 0.f;
#pragma unroll
            for (int d = 0; d < NDB; ++d)
#pragma unroll
                for (int r = 0; r < 16; ++r) { const float v = o[d][r] * rl[r] - x1[((r & 3) + 8 * (r >> 2) + 4 * hi) * 128 + d * 32 + r32]; o[d][r] = v; ss[r] += v * v; }
#pragma unroll
            for (int r = 0; r < 16; ++r) { float v = ss[r]; v += __shfl_xor(v, 1); v += __shfl_xor(v, 2); v += __shfl_xor(v, 4); v += __shfl_xor(v, 8); v += __shfl_xor(v, 16); ss[r] = (1.f - lam_init) * __builtin_amdgcn_rsqf(v * (1.f / 128.f) + EPSN); }
            float g[NDB];
#pragma unroll
            for (int d = 0; d < NDB; ++d) g[d] = INP(c, I_GSUBLN)[l * 128 + d * 32 + r32];
            asm volatile("s_waitcnt lgkmcnt(0)" ::: "memory");
            LAS bf16_t* stg = (LAS bf16_t*)x1;
#pragma unroll
            for (int d = 0; d < NDB; ++d)
#pragma unroll
                for (int r = 0; r < 16; ++r) stg[((r & 3) + 8 * (r >> 2) + 4 * hi) * 128 + d * 32 + r32] = (bf16_t)f2bf(o[d][r] * ss[r] * g[d]);
            asm volatile("s_waitcnt lgkmcnt(0)" ::: "memory");
            unsigned char* op = (unsigned char*)(c.ws + A_OD8) + (size_t)(q0 + wq * 32) * 512 + h * 128;
#pragma unroll
            for (int i = 0; i < 8; ++i) { const int row = i * 4 + (lane >> 4), ch = lane & 15; f32x4 a_, b_; unpack8(*(const LAS u32x4*)(stg + row * 128 + ch * 8), a_, b_);
                *(u32x2*)(op + (size_t)row * 512 + ch * 8) = (u32x2){pack4_fp8c(a_, BR8_SCALE), pack4_fp8c(b_, BR8_SCALE)}; }
        }
        asm volatile("s_waitcnt lgkmcnt(0)\n\ts_barrier" ::: "memory");
    } else {
        LAS bf16_t* stg = (LAS bf16_t*)xch + wid * 2048;
#pragma unroll
        for (int d = 0; d < NDB; ++d)
#pragma unroll
            for (int r = 0; r < 16; ++r) stg[((r & 3) + 8 * (r >> 2) + 4 * hi) * 64 + d * 32 + r32] = (bf16_t)f2bf(o[d][r] * rl[r]);
        asm volatile("s_waitcnt lgkmcnt(0)" ::: "memory");
        unsigned char* op = (unsigned char*)(c.ws + A_OM) + (size_t)(q0 + wid * 32) * 512 + h * 64;
#pragma unroll
        for (int i = 0; i < 4; ++i) { const int row = i * 8 + (lane >> 3), ch = lane & 7; f32x4 a_, b_; unpack8(*(const LAS u32x4*)(stg + row * 64 + ch * 8), a_, b_);
            *(u32x2*)(op + (size_t)row * 512 + ch * 8) = (u32x2){pack4_fp8c(a_, BR8_SCALE), pack4_fp8c(b_, BR8_SCALE)}; }
        asm volatile("s_waitcnt lgkmcnt(0)" ::: "memory");
    }
#undef AT_DMA
#undef AT_WAIT1
}
__device__ __forceinline__ void ph_attn_mla(const Ctx& c, int l) {
    const int n_mla = ATT_TEST_NOMLA ? 0 : 1024 + (l == 0 ? 128 : 0);
    for (int rep = 0; rep < NREP(16); ++rep)
    for (int u = c.blk; u < n_mla; u += c.G) {
        if (u < 1024) {
            int b = u >> 6, h = (u >> 3) & 7, qt = u & 7;
            if (c.G == 256) { const int x = c.blk & 7, s = c.blk >> 3, pair = (u >> 8) * 32 + x * 4 + (s >> 3); b = pair >> 3; h = pair & 7; qt = s & 7; }
            attn_unit<false>(c, l, b, h, b * RPB + CTXL + qt * 256, RPB, 0.f, 0.f); }
        else { const int q = u - 1024, b = q >> 3, h = q & 7; attn_unit<false>(c, l, b, h, b * RPB, CTXL, 0.f, 0.f); }
    }
}
__device__ __forceinline__ void ph_attn_diff(const Ctx& c, int l) {
    float lam = lam_of(c, l); const float lam_init = 0.8f - 0.6f * expf(-0.3f * (float)l);
    lam = __builtin_bit_cast(float, __builtin_amdgcn_readfirstlane(__builtin_bit_cast(int, lam)));
    const int n_diff = ATT_TEST_NODIFF ? 0 : 1024 + (l == 0 ? 128 : 0);
    for (int u0 = c.blk; u0 < 1024 + 256; u0 += c.G) {
        int u = u0;
        if (u0 >= 1024) { u = (c.G == 256) ? u0 - 128 : u0; if (u < 1024 || u >= n_diff) continue; }
        if (u < 1024) {
            int b = u >> 6, h = (u >> 4) & 3, qt = u & 15;
            if (c.G == 256) { const int x = c.blk & 7, s = c.blk >> 3, pair = (u >> 8) * 16 + x * 2 + (s >> 4); b = pair >> 2; h = pair & 3; qt = s & 15; }
            attn_unit<true>(c, l, b, h, b * RPB + CTXL + qt * 128, RPB, lam, lam_init); }
        else { const int q = u - 1024, b = q >> 3, h = (q >> 1) & 3, qt = q & 1; attn_unit<true>(c, l, b, h, b * RPB + qt * 128, CTXL, lam, lam_init); }
    }
}

struct SchedMerge1 {
    static constexpr bool GATHER = false;
    const Ctx* c; int l, n_units;
    __device__ void init(const Ctx* cc, int ll) { c = cc; l = ll; n_units = (l == 0 ? 144 : 128) * 4; }
    __device__ bool next(int i, Unit& u) const {
        const int U = deal_xcd(*c, i / 3), br = i % 3; if (U >= n_units) return false;
        const int rt = U >> 2; u.pn = U & 3; u.pm = (l == 0) ? rt : ((rt >> 3) * 9 + 1 + (rt & 7));
        u.rows = nullptr; u.nrows = 256; u.aux = l; u.aux2 = 0; u.bperm = 0; u.kind = br; u.K = 256;
        u.a = wsb(*c, br == 0 ? A_OM : (br == 1 ? A_PD : A_OD8)) + (size_t)u.pm * 256 * 256;
        u.b = wt(*c, br == 0 ? WO_BM : (br == 1 ? WO_PP : WO_BD)) + (size_t)u.pn * 256 * 256;
        return true;
    }
};
struct EpiMerge1 {
    static constexpr bool PAIR = false; static constexpr bool FP8 = true;
    const Ctx* c;
    static constexpr int GROUP = 4; static constexpr bool EARLY = false; static constexpr bool CHAIN = true; static constexpr bool ROWTAB = false; struct Pre { u32x2 a0, a1, b0, b1; };
    struct UState {}; __device__ __forceinline__ void unit_begin(const Unit&, int, UState&) const {}
    __device__ __forceinline__ bool keep_acc(const Unit& u) const { return u.kind < 2; }
    __device__ __forceinline__ void pre(const Unit& u, int row, int c8, Pre& p) const {
        const unsigned char* gp = (const unsigned char*)c->p->out + (size_t)(u.pm * 256 + row) * 3072 + u.kind * 1024 + u.pn * 256 + c8;
        p.a0 = *(const u32x2*)gp; p.a1 = *(const u32x2*)(gp + 128);
        const unsigned char* gn = gp + (u.kind < 2 ? 1024 : 0);
        p.b0 = *(const u32x2*)gn; p.b1 = *(const u32x2*)(gn + 128);
    }
    __device__ __forceinline__ static f32x4 gate4(unsigned w) { return (f32x4){(float)max(w & 255u, 1u), (float)max((w >> 8) & 255u, 1u), (float)max((w >> 16) & 255u, 1u), (float)max(w >> 24, 1u)}; }
    __device__ __forceinline__ static f32x4 rcp4(f32x4 v) { return (f32x4){__builtin_amdgcn_rcpf(v.x), __builtin_amdgcn_rcpf(v.y), __builtin_amdgcn_rcpf(v.z), __builtin_amdgcn_rcpf(v.w)}; }
    __device__ __forceinline__ void apply_rw(const Unit& u, int row, int c8, const Pre& p, const UState&, f32x4& v0l, f32x4& v0h, f32x4& v1l, f32x4& v1h) const {
        const Ctx& C = *c;
        if (u.kind < 2) {
            v0l *= gate4(p.a0.x) * rcp4(gate4(p.b0.x)); v0h *= gate4(p.a0.y) * rcp4(gate4(p.b0.y));
            v1l *= gate4(p.a1.x) * rcp4(gate4(p.b1.x)); v1h *= gate4(p.a1.y) * rcp4(gate4(p.b1.y));
        } else {
            constexpr float sc_ = W8_INV * BR8_INV / 255.f;
            const f32x4 s = (f32x4){sc_, sc_, sc_, sc_};
            unsigned char* o = (unsigned char*)(C.ws + A_MG) + (size_t)(u.pm * 256 + row) * 1024 + u.pn * 256 + c8;
            *(u32x2*)o = (u32x2){pack4_fp8c(v0l * gate4(p.a0.x) * s, MG8_SCALE), pack4_fp8c(v0h * gate4(p.a0.y) * s, MG8_SCALE)};
            *(u32x2*)(o + 128) = (u32x2){pack4_fp8c(v1l * gate4(p.a1.x) * s, MG8_SCALE), pack4_fp8c(v1h * gate4(p.a1.y) * s, MG8_SCALE)};
        }
    }
    __device__ __forceinline__ void apply(const Unit&, int, int, const Pre&, const UState&, f32x4, f32x4, f32x4, f32x4) const {}
};
struct SchedMerge2 {
    static constexpr bool GATHER = false;
    const Ctx* c; int l, n_units;
    __device__ void init(const Ctx* cc, int ll) { c = cc; l = ll; n_units = (l == 0 ? 144 : 128) * 4; }
    __device__ bool next(int i, Unit& u) const {
        const int U = deal_xcd(*c, i); if (U >= n_units) return false;
        const int rt = U >> 2; u.pn = U & 3; u.pm = (l == 0) ? rt : ((rt >> 3) * 9 + 1 + (rt & 7));
        u.rows = nullptr; u.nrows = 256; u.aux = l; u.aux2 = 0; u.bperm = 0; u.kind = 0; u.K = 512;
        u.a = wsb(*c, A_MG) + (size_t)u.pm * 256 * 512; u.b = wt(*c, WO_O) + (size_t)u.pn * 256 * 512; return true;
    }
};
struct EpiMerge2 {
    const Ctx* c;
    static constexpr bool PAIR = false; static constexpr bool FP8 = true;
    static constexpr int GROUP = 4; static constexpr bool EARLY = false; static constexpr bool CHAIN = false; static constexpr bool ROWTAB = false; struct Pre {}; struct UState {}; __device__ __forceinline__ void unit_begin(const Unit&, int, UState&) const {} __device__ __forceinline__ void pre(const Unit&, int, int, Pre&) const {}
    __device__ __forceinline__ void apply(const Unit& u, int row, int c8, const Pre&, const UState&, f32x4 v0l, f32x4 v0h, f32x4 v1l, f32x4 v1h) const {
        bf16_t* o = wsb(*c, A_Y1) + (size_t)(u.pm * 256 + row) * 1024 + u.pn * 256; constexpr float sc_ = W8_INV * MG8_INV;
        *(u32x4*)(o + c8) = pack8(v0l * sc_, v0h * sc_); *(u32x4*)(o + 128 + c8) = pack8(v1l * sc_, v1h * sc_);
    }
};

struct T4Raw { u32x2 y[4]; u32x4 h[4]; };
__device__ __forceinline__ void t4_load(const Ctx& c, int l, int R, int lane, T4Raw& d) {
    const bf16_t* yp = wsb(c, A_Y1) + (size_t)R * 1024;
#pragma unroll
    for (int q = 0; q < 4; ++q) d.y[q] = *((const u32x2*)yp + lane + 64 * q);
    if (l == 0) {
#pragma unroll
        for (int q = 0; q < 4; ++q) d.h[q] = *((const u32x4*)res_rd(c, 0, R) + lane + 64 * q);
    } else {
#pragma unroll
        for (int q = 0; q < 4; ++q) { const u32x2 w = *((const u32x2*)hb_row(c, R) + lane + 64 * q); d.h[q].x = w.x; d.h[q].y = w.y; }
    }
}
__device__ __forceinline__ void ph_t4_router(const Ctx& c, int l) {
    LAS bf16_t* wr = (LAS bf16_t*)c.lds; constexpr int WRP = 1032;
    {
        const GAS unsigned char* src = c.ws + WS_W + (size_t)WO_R * 2;
#pragma unroll
        for (int q = 0; q < 16; ++q) { const int e = c.wave * 8 + (q >> 1), hf = q & 1, m_ = e & 31;
            const int ex = (e & 32) + ((m_ >> 2) & 1) * 16 + (m_ >> 3) * 4 + (m_ & 3);
            __builtin_amdgcn_global_load_lds((const GAS unsigned*)(src + (size_t)ex * 2048 + hf * 1024 + c.lane * 16), (LAS unsigned*)((LAS unsigned char*)wr + e * (WRP * 2) + hf * 1024), 16, 0, 0); }
    }
    LAS unsigned* hist = (LAS unsigned*)(c.lds + 64 * WRP * 2 + c.wave * 512);
    LAS unsigned* stash = (LAS unsigned*)(c.lds + 64 * WRP * 2 + 4096 + c.wave * 2048);
    LAS float* brl = (LAS float*)(c.lds + 64 * WRP * 2 + 4096 + 8 * 2048);
    static_assert(64 * WRP * 2 + 4096 + 8 * 2048 + 256 <= LDS_MISC, "router LDS map");
    if (c.tid < 64) brl[c.tid] = INP(c, I_BROUTER)[l * 64 + c.tid];
    LAS unsigned* wgh = (LAS unsigned*)(c.lds + 64 * WRP * 2 + 4096 + 8 * 2048 + 256);
    LAS unsigned* wgb = wgh + 64;
    static_assert(64 * WRP * 2 + 4096 + 8 * 2048 + 768 <= LDS_MISC && NCHUNK == 1, "router LDS map (workgroup-level position allocation assumes one token chunk)");
    if (c.tid < 64) wgh[c.tid] = 0u;
    const int r32 = c.lane & 31, hi = c.lane >> 5;
    unsigned* CNT = (unsigned*)(c.ws + CTL_CNT);
    const int NGV = (l == 0) ? NR / 32 : NB * (SEQ / 32);
#define T4_GROUP(q) ((l == 0) ? (q) : (((q) >> 6) * 72 + 8 + ((q) & 63)))
    const bool even_ = (l == 0) && (c.G == 256);
    const int gq0 = (c.blk * NGV) / c.G, ngrp = even_ ? 5 : ((c.blk + 1) * NGV) / c.G - gq0;
    {
        const int nrow = even_ ? 144 : ngrp * 32;
#define T4_ROW(j) (even_ ? (c.blk * 144 + (j)) : (T4_GROUP(gq0 + ((j) >> 5)) * 32 + ((j) & 31)))
        T4Raw ra, rb, rc; f32x4 h[4], am[4], mul[4], add[4]; int key = -1;
#pragma unroll
        for (int q = 0; q < 4; ++q) { ra.y[q] = (u32x2){0u, 0u}; ra.h[q] = (u32x4){0u, 0u, 0u, 0u}; rb.y[q] = ra.y[q]; rb.h[q] = ra.h[q]; rc.y[q] = ra.y[q]; rc.h[q] = ra.h[q]; }
        int j = c.wave;
        if (j < nrow) t4_load(c, l, T4_ROW(j), c.lane, ra);
        if (j + 8 < nrow) t4_load(c, l, T4_ROW(j + 8), c.lane, rb);
#pragma unroll 1
        for (; j < nrow; j += 8) { const int R = T4_ROW(j);
            if (j + 16 < nrow) t4_load(c, l, T4_ROW(j + 16), c.lane, rc);
            f32x4 y[4];
#pragma unroll
            for (int q = 0; q < 4; ++q) { y[q] = (f32x4){bflo(ra.y[q].x), bfhi(ra.y[q].x), bflo(ra.y[q].y), bfhi(ra.y[q].y)};
                if (l == 0) h[q] = __builtin_bit_cast(f32x4, ra.h[q]);
                else h[q] = (f32x4){bflo(ra.h[q].x), bfhi(ra.h[q].x), bflo(ra.h[q].y), bfhi(ra.h[q].y)}; }
            if (batch_key(R) != key) { key = batch_key(R); const float* g1 = INP(c, I_GPOSTMIX) + l * DM; const float* m2 = modvec(c, l, R, 2);
#pragma unroll
                for (int q = 0; q < 4; ++q) { const int o = c.lane + 64 * q; am[q] = *((const f32x4*)m2 + o) * *((const f32x4*)g1 + o); }
                mod_fold(c, INP(c, I_GPREFFN) + l * DM, l, R, 3, 4, c.lane, mul, add); }
            const float rs1 = 1.f / sqrtf(row_sumsq(y) * (1.f / DM) + EPSN);
#pragma unroll
            for (int q = 0; q < 4; ++q) h[q] += am[q] * (y[q] * rs1);
            bf16_t* hw = hb_row(c, R);
#pragma unroll
            for (int q = 0; q < 4; ++q) { u32x2 w_; w_.x = pk2(h[q].x, h[q].y); w_.y = pk2(h[q].z, h[q].w); *((u32x2*)hw + c.lane + 64 * q) = w_; }
            const float rs2 = 1.f / sqrtf(row_sumsq(h) * (1.f / DM) + EPSN);
            { bf16_t* orow = wsb(c, A_FXR) + (size_t)R * DM; unsigned char* o8 = (unsigned char*)(c.ws + A_HX) + (size_t)R * DM;
#pragma unroll
              for (int q = 0; q < 4; ++q) { const f32x4 yy = (h[q] * rs2) * mul[q] + add[q]; u32x2 w_; w_.x = pk2(yy.x, yy.y); w_.y = pk2(yy.z, yy.w); *((u32x2*)orow + c.lane + 64 * q) = w_;
                  *((unsigned*)o8 + c.lane + 64 * q) = pack4_fp8c(yy, 1.f); } }
#pragma unroll
            for (int q = 0; q < 4; ++q) { ra.y[q] = rb.y[q]; ra.h[q] = rb.h[q]; rb.y[q] = rc.y[q]; rb.h[q] = rc.h[q]; }
        }
#undef T4_ROW
    }
    asm volatile("s_waitcnt vmcnt(0)" ::: "memory");
    __syncthreads();
#define T4SLOT(i) (((volatile LAS unsigned long long*)(c.lds + LDS_MISC + 128))[i])
    if (TMASK & 4096) T4SLOT(65) = __builtin_amdgcn_s_memrealtime();
    int ei[8]; float ew[8]; unsigned rk[8]; float wn = 0.f; int R = 0; bool tok_ok = true;
#pragma unroll
    for (int k = 0; k < 8; ++k) { ei[k] = 0; ew[k] = 0.f; rk[k] = 0u; }
    if (c.wave < ngrp) {
        const int R0 = even_ ? c.blk * 144 + c.wave * 32 : T4_GROUP(gq0 + c.wave) * 32;
#undef T4_GROUP
        typedef float f32x16 __attribute__((ext_vector_type(16)));
        f32x16 a0 = {}, a1 = {};
        const bf16_t* fxp = wsb(c, A_FXR) + (size_t)(R0 + r32) * 1024 + hi * 8;
        bf16x8 fb[2][16];
#pragma unroll
        for (int i = 0; i < 16; ++i) fb[0][i] = *(const bf16x8*)(fxp + i * 16);
#pragma unroll
        for (int bt = 0; bt < 4; ++bt) {
            if (bt + 1 < 4) {
#pragma unroll
                for (int i = 0; i < 16; ++i) fb[(bt + 1) & 1][i] = *(const bf16x8*)(fxp + ((bt + 1) * 16 + i) * 16); }
#pragma unroll
            for (int i = 0; i < 16; ++i) { const int s = bt * 16 + i;
                const bf16x8 w0 = *(const LAS bf16x8*)(wr + r32 * WRP + s * 16 + hi * 8), w1 = *(const LAS bf16x8*)(wr + (32 + r32) * WRP + s * 16 + hi * 8);
                a0 = __builtin_amdgcn_mfma_f32_32x32x16_bf16(w0, fb[bt & 1][i], a0, 0, 0, 0); a1 = __builtin_amdgcn_mfma_f32_32x32x16_bf16(w1, fb[bt & 1][i], a1, 0, 0, 0); }
        }
        if (TMASK & 8192) { asm volatile("" :: "v"(a0), "v"(a1)); if (c.wave == 0) T4SLOT(42 + l) = __builtin_amdgcn_s_memrealtime() - T4SLOT(65); }
        float sel[32];
        { const LAS float* bl0 = brl + hi * 16; const LAS float* bl1 = brl + 32 + hi * 16;
#pragma unroll
          for (int i = 0; i < 16; ++i) { sel[i] = sigmoidf_(a0[i]) + bl0[i]; sel[16 + i] = sigmoidf_(a1[i]) + bl1[i]; } }
        float gsm[4], gso[4];
#pragma unroll
        for (int G = 0; G < 4; ++G) { float m1 = -INFINITY, m2 = -INFINITY;
#pragma unroll
            for (int q = 0; q < 8; ++q) { const float v = sel[G * 8 + q]; if (v > m1) { m2 = m1; m1 = v; } else if (v > m2) m2 = v; }
            gsm[G] = m1 + m2; }
#pragma unroll
        for (int G = 0; G < 4; ++G) gso[G] = __shfl_xor(gsm[G], 32);
#pragma unroll
        for (int G = 0; G < 4; ++G) { const int gi = (G >> 1) * 4 + 2 * hi + (G & 1); int rank = 0;
#pragma unroll
            for (int q = 0; q < 4; ++q) { const int qm = (q >> 1) * 4 + 2 * hi + (q & 1), qo = (q >> 1) * 4 + 2 * (1 - hi) + (q & 1);
                rank += (gsm[q] > gsm[G] || (gsm[q] == gsm[G] && qm < gi)) ? 1 : 0;
                rank += (gso[q] > gsm[G] || (gso[q] == gsm[G] && qo < gi)) ? 1 : 0; }
#pragma unroll
            for (int q = 0; q < 8; ++q) { const int i = G * 8 + q; const int e = (i < 16) ? hi * 16 + i : 32 + hi * 16 + (i - 16);
                const float key = __builtin_bit_cast(float, (__builtin_bit_cast(unsigned, sel[i]) & ~63u) | (unsigned)(63 - e)); sel[i] = (rank >= 4) ? -1e30f : key; } }
        float wsum = 0.f;
#pragma unroll 1
        for (int k = 0; k < 8; ++k) { float best = sel[0];
#pragma unroll
            for (int e = 1; e < 32; ++e) best = fmaxf(best, sel[e]);
            best = fmaxf(best, __shfl_xor(best, 32));
#pragma unroll
            for (int e = 0; e < 32; ++e) sel[e] = (sel[e] == best) ? -1e30f : sel[e];
            const int bi = 63 - (int)(__builtin_bit_cast(unsigned, best) & 63u); const float bs = best - brl[bi];
            stash[k * 64 + c.lane] = (__builtin_bit_cast(unsigned, bs) & ~63u) | (unsigned)bi; wsum += bs; }
        asm volatile("s_waitcnt lgkmcnt(0)" ::: "memory");
#pragma unroll
        for (int k = 0; k < 8; ++k) { const unsigned w_ = stash[k * 64 + c.lane]; ei[k] = (int)(w_ & 63u); ew[k] = __builtin_bit_cast(float, w_ & ~63u); }
        wn = 2.5f / wsum;
        R = R0 + r32;
        hist[c.lane] = 0u; asm volatile("s_waitcnt lgkmcnt(0)" ::: "memory");
        tok_ok = !(even_ && c.wave == 4 && r32 >= 16);
#pragma unroll
        for (int k = 0; k < 8; ++k) { rk[k] = 0u; if (hi == 0 && tok_ok) rk[k] = atomicAdd((unsigned*)&hist[ei[k]], 1u); }
        asm volatile("s_waitcnt lgkmcnt(0)" ::: "memory");
        { const unsigned cnt = hist[c.lane]; unsigned off = 0u; if (cnt) off = atomicAdd((unsigned*)&wgh[c.lane], cnt); hist[64 + c.lane] = off; }
        asm volatile("s_waitcnt lgkmcnt(0)" ::: "memory");
    }
    __syncthreads();
    if (c.tid < 64) { const unsigned tot = wgh[c.tid]; unsigned base = 0u; if (tot) base = atomicAdd(CNT + (l * 2) * 128 + c.tid, tot); wgb[c.tid] = base; asm volatile("s_waitcnt vmcnt(0) lgkmcnt(0)" ::: "memory"); }
    __syncthreads();
    if (c.wave < ngrp && hi == 0 && tok_ok) {
        unsigned* rt_ = (unsigned*)(c.ws + WS_REGT); float* rw_ = (float*)(c.ws + WS_REGW);
#pragma unroll
        for (int k = 0; k < 8; ++k) { const unsigned pos = wgb[ei[k]] + hist[64 + ei[k]] + rk[k]; const size_t o = (size_t)ei[k] * CAP + pos;
            rt_[o] = ((unsigned)R << 4) | (unsigned)k; rw_[o] = ew[k] * wn; }
    }
    __syncthreads();
    if (TMASK & 4096) T4SLOT(40 + l) = __builtin_amdgcn_s_memrealtime() - T4SLOT(65);
#undef T4SLOT
}

struct MoeTab { LAS int* tstart; int TR, nsh, ch, l; };
__device__ __forceinline__ MoeTab moe_table(const Ctx& c, int l, int ch) {
    MoeTab T; T.tstart = (LAS int*)(c.lds + LDS_RING + 1024 + ch * 4096); T.ch = ch; T.l = l;
    LAS int* tile_e = (LAS int*)(c.lds + LDS_RING + 2048 + ch * 4096);
    __syncthreads();
    if (c.tid < 64) {
        unsigned* CNT = (unsigned*)(c.ws + CTL_CNT) + (l * 2 + ch) * 128;
        const int n = (int)__hip_atomic_load(CNT + c.tid, __ATOMIC_RELAXED, __HIP_MEMORY_SCOPE_AGENT); const int tiles = (n + 255) >> 8;
        int x = tiles;
#pragma unroll
        for (int d = 1; d < 64; d <<= 1) { const int y = __shfl_up(x, d); if (c.tid >= d) x += y; }
        T.tstart[c.tid] = x - tiles; T.tstart[65 + c.tid] = n; if (c.tid == 63) T.tstart[64] = x; }
    __syncthreads();
    T.TR = T.tstart[64]; T.nsh = (l == 0) ? CHROWS / 256 : (NB / NCHUNK) * SEQ / 256;
    for (int t = c.tid; t < T.TR; t += 512) { int lo = 0;
#pragma unroll 1
        for (int st = 32; st >= 1; st >>= 1) { const int q = lo + st; if (q < 64 && T.tstart[q] <= t) lo = q; }
        tile_e[t] = lo; }
    __syncthreads();
    return T;
}
__device__ __forceinline__ void moe_tile(const Ctx& c, const MoeTab& T, int t, int& e, int& j, int& nrows, const unsigned*& rows, int& pm_sh) {
    if (t < T.TR) { e = ((LAS int*)(c.lds + LDS_RING + 2048 + T.ch * 4096))[t]; j = t - T.tstart[e]; const int n = T.tstart[65 + e]; nrows = min(256, n - 256 * j);
        rows = (const unsigned*)(c.ws + WS_REGT) + ((size_t)T.ch * 64 + e) * CAP + 256 * j; pm_sh = 0; }
    else { const int s = t - T.TR; e = 64; j = s; nrows = 256; rows = nullptr;
        const int bl = (T.l == 0) ? s / 9 : s / 8, r9 = (T.l == 0) ? s % 9 : 1 + (s % 8); pm_sh = (T.ch * (NB / NCHUNK) + bl) * 9 + r9; }
}
struct SchedGU {
    static constexpr bool GATHER = true;
    const Ctx* c; MoeTab T0, T1;
    __device__ bool next(int i, Unit& u) const {
        const int L = deal_xcd(*c, i); int t = L >> 1; const int n0 = T0.TR + T0.nsh;
        const bool second = t >= n0; if (second) t -= n0;
        const MoeTab& T = second ? T1 : T0;
        if (t >= T.TR + T.nsh) return false;
        int e, j, nrows, pm_sh; const unsigned* rows; moe_tile(*c, T, t, e, j, nrows, rows, pm_sh);
        u.pn = L & 1; u.pm = T.ch * ACT_TILES + t; u.kind = (e < 64) ? 0 : 1; u.bperm = 0; u.K = 512  ; u.rows = rows; u.nrows = nrows; u.aux = e; u.aux2 = T.ch * CHROWS + CTXL;
        u.a = (e < 64) ? wsb(*c, A_HX) : wsb(*c, A_HX) + (size_t)pm_sh * 256 * 512;
        u.b = wt(*c, WO_GU) + (size_t)e * 262144 + (size_t)u.pn * 256 * 512; return true;
    }
};
struct EpiGU {
    const Ctx* c; int ch;
    static constexpr bool PAIR = true; static constexpr bool FP8 = true;
    static constexpr int GROUP = 4; static constexpr bool EARLY = false; static constexpr bool CHAIN = false; static constexpr bool ROWTAB = false; struct Pre { float w; };
    struct UState {}; __device__ __forceinline__ void unit_begin(const Unit&, int, UState&) const {}
    __device__ __forceinline__ void pre(const Unit& u, int row, int c8, Pre& p) const {
        p.w = 1.f;
        if (u.kind == 0) { p.w = 0.f; if (row < u.nrows) p.w = ((const float*)(c->ws + WS_REGW))[(u.rows - (const unsigned*)(c->ws + WS_REGT)) + row]; }
    }
    __device__ __forceinline__ u32x2 act8(const Pre& p, f32x4 gl, f32x4 gh, f32x4 ul, f32x4 uh) const {
        const float w = p.w * (W8_INV * W8_INV * ACT8_SCALE); constexpr float KE = -LOG2E * W8_INV;
#pragma unroll
        for (int i = 0; i < 4; ++i) { gl[i] = gl[i] * __builtin_amdgcn_rcpf(1.f + __builtin_amdgcn_exp2f(gl[i] * KE)) * (ul[i] * w); gh[i] = gh[i] * __builtin_amdgcn_rcpf(1.f + __builtin_amdgcn_exp2f(gh[i] * KE)) * (uh[i] * w); }
        return (u32x2){pack4_fp8s(gl.x, gl.y, gl.z, gl.w, 1.f), pack4_fp8s(gh.x, gh.y, gh.z, gh.w, 1.f)};
    }
    __device__ __forceinline__ void apply2(const Unit& u, int rowA, int rowB, int c8, const Pre& pA, const Pre& pB, const UState&, f32x4 gAl, f32x4 gAh, f32x4 uAl, f32x4 uAh, f32x4 gBl, f32x4 gBh, f32x4 uBl, f32x4 uBh) const {
        u32x2 a = act8(pA, gAl, gAh, uAl, uAh), b = act8(pB, gBl, gBh, uBl, uBh);
        { auto r = __builtin_amdgcn_permlane16_swap(a.x, b.x, false, false); a.x = r[0]; b.x = r[1]; }
        { auto r = __builtin_amdgcn_permlane16_swap(a.y, b.y, false, false); a.y = r[0]; b.y = r[1]; }
        const bool odd = (c8 >> 3) & 1;
        const int row = odd ? rowB : rowA, col = odd ? c8 - 8 : c8;
        *(u32x4*)((unsigned char*)(c->ws + A_ACT) + ((size_t)u.pm * 256 + row) * 256 + u.pn * 128 + col) = (u32x4){a.x, a.y, b.x, b.y};
    }
    __device__ __forceinline__ void apply(const Unit& u, int row, int c8, const Pre& p, const UState&, f32x4 gl, f32x4 gh, f32x4 ul, f32x4 uh) const {
        const float w = p.w * W8_INV;
        gl *= W8_INV; gh *= W8_INV;
#pragma unroll
        for (int i = 0; i < 4; ++i) { gl[i] = gl[i] * sigmoidf_(gl[i]) * ul[i] * w; gh[i] = gh[i] * sigmoidf_(gh[i]) * uh[i] * w; }
#pragma unroll
        for (int i = 0; i < 4; ++i) { gl[i] = __builtin_amdgcn_fmed3f(gl[i] * ACT8_SCALE, -448.f, 448.f); gh[i] = __builtin_amdgcn_fmed3f(gh[i] * ACT8_SCALE, -448.f, 448.f); }
        *(u32x2*)((unsigned char*)(c->ws + A_ACT) + ((size_t)u.pm * 256 + row) * 256 + u.pn * 128 + c8) = (u32x2){pack4_fp8s(gl.x, gl.y, gl.z, gl.w, 1.f), pack4_fp8s(gh.x, gh.y, gh.z, gh.w, 1.f)};
    }
};
struct SchedD {
    static constexpr bool GATHER = false;
    const Ctx* c; MoeTab T;
    __device__ bool next(int i, Unit& u) const {
        const int L = deal_xcd(*c, i); const int t = L >> 2; if (t >= T.TR + T.nsh) return false;
        int e, j, nrows, pm_sh; const unsigned* rows; moe_tile(*c, T, t, e, j, nrows, rows, pm_sh);
        u.pn = L & 3; u.pm = t; u.kind = (e < 64) ? 0 : 1; u.bperm = 2; { int k_ = 128  ; asm volatile("" : "+s"(k_)); u.K = k_; }     u.rows = nullptr; u.nrows = nrows; u.aux = pm_sh;
        u.a = wsb(*c, A_ACT) + (size_t)(T.ch * ACT_TILES + t) * 256 * 128; u.b = wt(*c, WO_D) + (size_t)e * 131072 + (size_t)u.pn * 256 * 128;
        u.aux2 = (e < 64) ? (int)(rows - (const unsigned*)(c->ws + WS_REGT)) : -1;
        return true;
    }
};
struct EpiD {
    const Ctx* c; int ch;
    static constexpr bool PAIR = false; static constexpr bool FP8 = true;
    static constexpr int GROUP = 8; static constexpr bool EARLY = false; static constexpr bool CHAIN = false; static constexpr bool ROWTAB = true; struct Pre { unsigned ent; };
    static constexpr int TAB_OFF = LDS_RING + 12288;
    __device__ __forceinline__ void rowtab_dma(const Unit& u, LAS unsigned char* lds, int wid, int lane, int par) const {
        if (u.kind == 0 && wid < 4)
            __builtin_amdgcn_global_load_lds((const GAS unsigned*)(c->ws + WS_REGT) + (size_t)u.aux2 + wid * 64 + lane, (LAS unsigned*)(lds + TAB_OFF + par * 1024 + wid * 256), 4, 0, 0);
    }
    __device__ __forceinline__ void pre_tab(const Unit& u, int row, LAS unsigned char* lds, int par, Pre& p) const { p.ent = ((const LAS unsigned*)(lds + TAB_OFF + par * 1024))[row]; }
    struct UState {}; __device__ __forceinline__ void unit_begin(const Unit&, int, UState&) const {}
    __device__ __forceinline__ void pre(const Unit& u, int row, int c8, Pre& p) const {
        p.ent = 0u; if (u.kind == 0 && row < u.nrows) p.ent = ((const unsigned*)(c->ws + WS_REGT))[(size_t)u.aux2 + row];
    }
    __device__ __forceinline__ void apply(const Unit& u, int row, int c8, const Pre& p, const UState& us, f32x4 v0l, f32x4 v0h, f32x4 v1l, f32x4 v1h) const {
        if (row >= u.nrows) return;
        size_t slot;
        if (u.kind == 0) { const unsigned ent = p.ent; slot = (size_t)((int)(ent >> 4) - ch * CHROWS) * 9 + (ent & 15u); }
        else slot = (size_t)(u.aux * 256 + row - ch * CHROWS) * 9 + 8;
        unsigned char* o = (unsigned char*)(c->ws + A_Y) + slot * 1024 + u.pn * 256 + 2 * c8;
        constexpr float SC = Y_SCALE * W8_INV * ACT8_INV;
        *(u32x4*)o = (u32x4){pack4_fp8s(v0l.x, v0l.y, v0l.z, v0l.w, SC), pack4_fp8s(v0h.x, v0h.y, v0h.z, v0h.w, SC), pack4_fp8s(v1l.x, v1l.y, v1l.z, v1l.w, SC), pack4_fp8s(v1h.x, v1h.y, v1h.z, v1h.w, SC)};
    }
};
struct CombRow { u32x4 y[9]; u32x4 h[2]; };
__device__ __forceinline__ void comb_load(const Ctx& c, int rr, int R, CombRow& d) {
    const unsigned char* yp = (const unsigned char*)(c.ws + A_Y) + (size_t)rr * 9 * 1024 + c.lane * 16;
#pragma unroll
    for (int k = 0; k < 9; ++k) d.y[k] = *(const u32x4*)(yp + k * 1024);
    const bf16_t* hp = hb_row(c, R) + c.lane * 16;
    d.h[0] = *(const u32x4*)hp; d.h[1] = *(const u32x4*)(hp + 8);
}
__device__ __forceinline__ void ph_combine(const Ctx& c, int l, int ch) {
    const int gw = c.blk * 8 + c.wave, NGW = c.G * 8;
    const int nv = (l == 0) ? CHROWS : (NB / NCHUNK) * SEQ;
#define COMB_RR(v) ((l == 0) ? (v) : (((v) >> 11) * RPB + CTXL + ((v) & 2047)))
    const int per = (nv + NGW - 1) / NGW, v0 = gw * per, v1 = min(nv, v0 + per);
    CombRow cur, nxt;
    f32x4 am[4], mul[4], add[4]; int key = -1;
    int v = v0;
    if (v < v1) comb_load(c, COMB_RR(v), ch * CHROWS + COMB_RR(v), cur);
    for (; v < v1; ++v) {
        const int rr = COMB_RR(v), R = ch * CHROWS + rr;
        const int v2 = v + 1;
        if (v2 < v1) comb_load(c, COMB_RR(v2), ch * CHROWS + COMB_RR(v2), nxt);
        if (batch_key(R) != key) { key = batch_key(R);
            const float* g = INP(c, I_GPOSTFFN) + l * DM + c.lane * 16; const float* m5 = modvec(c, l, R, 5) + c.lane * 16;
#pragma unroll
            for (int j = 0; j < 4; ++j) am[j] = *((const f32x4*)m5 + j) * *((const f32x4*)g + j);
            if (l == 0) { const float* g2 = INP(c, I_GPREMIX) + 1 * DM + c.lane * 16; const float* sh = modvec(c, 1, R, 0) + c.lane * 16; const float* sc = modvec(c, 1, R, 1) + c.lane * 16;
#pragma unroll
                for (int j = 0; j < 4; ++j) { mul[j] = *((const f32x4*)g2 + j) * (*((const f32x4*)sc + j) + 1.0f); add[j] = *((const f32x4*)sh + j); } } }
        f32x4 f[4];
#pragma unroll
        for (int j = 0; j < 4; ++j) f[j] = (f32x4){0.f, 0.f, 0.f, 0.f};
#pragma unroll
        for (int k = 0; k < 9; ++k) { f[0] += unpack4_fp8(cur.y[k].x); f[1] += unpack4_fp8(cur.y[k].y); f[2] += unpack4_fp8(cur.y[k].z); f[3] += unpack4_fp8(cur.y[k].w); }
#pragma unroll
        for (int j = 0; j < 4; ++j) f[j] *= Y_INV;
        const float rs = 1.f / sqrtf(row_sumsq(f) * (1.f / DM) + EPSN);
        f32x4 h[4];
        { f32x4 ha, hb2; unpack8(cur.h[0], ha, hb2); h[0] = ha; h[1] = hb2; unpack8(cur.h[1], ha, hb2); h[2] = ha; h[3] = hb2; }
#pragma unroll
        for (int j = 0; j < 4; ++j) h[j] += am[j] * (f[j] * rs);
        LAS unsigned char* rowb = (l == 0) ? c.lds + 131072 + c.wave * 2048 : c.lds + c.wave * 4096;
        static_assert(131072 + 8 * 2048 <= LDS_MISC, "combine row buffers");
        if (l == 0) { *(LAS u32x4*)(rowb + c.lane * 32) = pack8(h[0], h[1]); *(LAS u32x4*)(rowb + c.lane * 32 + 16) = pack8(h[2], h[3]);
            asm volatile("s_waitcnt lgkmcnt(0)" ::: "memory");
            const u32x4 w0 = *(const LAS u32x4*)(rowb + c.lane * 16), w1 = *(const LAS u32x4*)(rowb + 1024 + c.lane * 16);
            unsigned char* hw = (unsigned char*)hb_row(c, R); *(u32x4*)(hw + c.lane * 16) = w0; *(u32x4*)(hw + 1024 + c.lane * 16) = w1; }
        else {
#pragma unroll
            for (int j = 0; j < 4; ++j) *(LAS f32x4*)(rowb + c.lane * 64 + j * 16) = h[j];
            asm volatile("s_waitcnt lgkmcnt(0)" ::: "memory");
            unsigned char* hw = (unsigned char*)out_row(c, R);
#pragma unroll
            for (int j = 0; j < 4; ++j) { const f32x4 w_ = *(const LAS f32x4*)(rowb + j * 1024 + c.lane * 16); *(f32x4*)(hw + j * 1024 + c.lane * 16) = w_; } }
        asm volatile("s_waitcnt lgkmcnt(0)" ::: "memory");
        if (l == 0) { const float rs2 = 1.f / sqrtf(row_sumsq(h) * (1.f / DM) + EPSN);
            f32x4 y[4];
#pragma unroll
            for (int j = 0; j < 4; ++j) y[j] = (h[j] * rs2) * mul[j] + add[j];
            unsigned char* op = (unsigned char*)(c.ws + A_HX) + (size_t)R * DM + c.lane * 16;
            *(u32x4*)op = (u32x4){pack4_fp8c(y[0], 1.f), pack4_fp8c(y[1], 1.f), pack4_fp8c(y[2], 1.f), pack4_fp8c(y[3], 1.f)}; }
        if (v2 < v1) cur = nxt;
    }
#undef COMB_RR
}

__global__ void __launch_bounds__(512, 2) fwd_kernel(Params prm) {
    extern __shared__ __attribute__((aligned(16))) unsigned char lds_raw[];
    Ctx c; c.p = (ParamsK)__builtin_amdgcn_kernarg_segment_ptr(); c.lds = (LAS unsigned char*)lds_raw; c.tid = threadIdx.x; c.lane = c.tid & 63; c.wave = __builtin_amdgcn_readfirstlane(c.tid >> 6);
    c.G = gridDim.x; c.blk = blockIdx.x; c.ws = (GAS unsigned char*)prm.ws; c.z = 0;
    volatile LAS unsigned* MISC = (volatile LAS unsigned*)(c.lds + LDS_MISC);
    if (c.tid < 16) MISC[c.tid] = 0u;
    if (TMASK) { if (c.tid < 160) ((volatile LAS unsigned*)(c.lds + LDS_MISC + 128))[c.tid] = 0u; }
    __syncthreads();
    XcdBarrier bar; bar.bar = (unsigned*)(c.ws + CTL_BAR); bar.x = 0; bar.st = nullptr;
    const int lo = prm.step_lo, hi = prm.step_hi;
    if (hi - lo > 1) bar = xcd_barrier_post((unsigned*)(c.ws + CTL_BAR), MISC + 8);
    int step = 0;
#define TSLOT(i) (((volatile LAS unsigned long long*)((LAS unsigned char*)lds_raw + LDS_MISC + 128))[i])
#define TB(bit) do { if ((TMASK) & (bit)) TSLOT(64) = __builtin_amdgcn_s_memrealtime(); } while (0)
#define TE(bit) do { if ((TMASK) & (bit)) TSLOT(step & 63) = __builtin_amdgcn_s_memrealtime() - TSLOT(64); } while (0)
#define RUN() (step >= lo && step < hi)
#define SEAM() do { if (step >= lo && step + 1 < hi) { XcdBarrier b2_ = bar; asm volatile("" : "+s"(b2_.bar), "+s"(b2_.x)); b2_.bar = (unsigned*)rfl64((unsigned long long)b2_.bar); b2_.x = (unsigned)__builtin_amdgcn_readfirstlane((int)b2_.x); TB(2048); int w_ = c.wave; asm volatile("" : "+s"(w_)); unsigned on_ = ~0u; asm volatile("" : "+s"(on_)); const bool ldr_ = (w_ == 0) && (__builtin_amdgcn_mbcnt_hi(on_, __builtin_amdgcn_mbcnt_lo(on_, 0u)) == 0u); xcd_barrier(b2_, ldr_); TE(2048); } ++step; } while (0)
    { constexpr int l = 0;
        if (RUN()) { TB(1); if (PHM & 1) for (int rep = 0; rep < NREP(1); ++rep) { PHASE_CTX(cl); ph_prologue(cl, l); }  TE(1); }
        SEAM();
        if (l == 0) { if (RUN()) { TB(2); if (PHM & 2) { PHASE_CTX(cl); ph_t1(cl, 0); } } SEAM();  TE(2); }
        if (RUN()) { TB(4); if (PHM & 4) { PHASE_CTX(cl); SchedProj S; S.init(&cl, l); EpiProj E{&cl, l}; GEMM_UNITS(cl, S, E); }  TE(4); }
        SEAM();
        if (RUN()) { TB(8); if (PHM & 8) for (int rep = 0; rep < NREP(8); ++rep) { { PHASE_CTX(cl); SchedUp S; S.init(&cl, l); EpiUp E{&cl, l}; GEMM_UNITS(cl, S, E); } { PHASE_CTX(cl); ph_pool(cl, l); } }  TE(8); }
        SEAM();
        if (RUN()) { TB(16); if (PHM & 16) { { PHASE_CTX(cl); ph_attn_mla(cl, l); } { PHASE_CTX(cl); ph_attn_diff(cl, l); } }  TE(16); }
        SEAM();
        if (RUN()) { TB(32); if (PHM & 32) for (int rep = 0; rep < NREP(32); ++rep) { PHASE_CTX(cl); SchedMerge1 S; S.init(&cl, l); EpiMerge1 E{&cl}; GEMM_UNITS(cl, S, E); }  TE(32); }
        SEAM();
        if (RUN()) { TB(64); if (PHM & 64) for (int rep = 0; rep < NREP(64); ++rep) { PHASE_CTX(cl); SchedMerge2 S; S.init(&cl, l); EpiMerge2 E{&cl}; GEMM_UNITS(cl, S, E); }  TE(64); }
        SEAM();
        if (RUN()) { TB(128); if (PHM & 128) { PHASE_CTX(cl); ph_t4_router(cl, l); }  TE(128); }
        SEAM();
        if (RUN()) { TB(256); if (PHM & 256) for (int rep = 0; rep < NREP(256); ++rep) { PHASE_CTX(cl); SchedGU S; S.c = &cl; S.T0 = moe_table(cl, l, 0); if (NCHUNK > 1) S.T1 = moe_table(cl, l, NCHUNK - 1); else { S.T1 = S.T0; S.T1.TR = 0; S.T1.nsh = 0; } EpiGU E{&cl, 0}; GEMM_UNITS(cl, S, E); }  TE(256); }
        SEAM();
        { constexpr int ch = 0;
            if (RUN()) { TB(512); if (PHM & 512) for (int rep = 0; rep < NREP(512); ++rep) { PHASE_CTX(cl); SchedD S; S.c = &cl; S.T = moe_table(cl, l, ch); EpiD E{&cl, ch}; GEMM_UNITS(cl, S, E); }  TE(512); }
            SEAM();
            if (RUN()) { TB(1024); if (PHM & 1024) { { PHASE_CTX(cl); ph_combine(cl, l, ch); } if (NCHUNK == 1) { PHASE_CTX(cl); ph_prologue(cl, 1); } }  TE(1024); }
            SEAM();

        }
        if constexpr (NCHUNK > 1) { constexpr int ch = 1;
            if (RUN()) { TB(512); if (PHM & 512) for (int rep = 0; rep < NREP(512); ++rep) { PHASE_CTX(cl); SchedD S; S.c = &cl; S.T = moe_table(cl, l, ch); EpiD E{&cl, ch}; GEMM_UNITS(cl, S, E); }  TE(512); }
            SEAM();
            if (RUN()) { TB(1024); if (PHM & 1024) { { PHASE_CTX(cl); ph_combine(cl, l, ch); } { PHASE_CTX(cl); ph_prologue(cl, 1); } }  TE(1024); }
            SEAM();

        }
    }
    { constexpr int l = 1;
        if (l == 0) { if (RUN()) { TB(2); if (PHM & 2) { PHASE_CTX(cl); ph_t1(cl, 0); } } SEAM();  TE(2); }
        if (RUN()) { TB(4); if (PHM & 4) { PHASE_CTX(cl); SchedProj S; S.init(&cl, l); EpiProj E{&cl, l}; GEMM_UNITS(cl, S, E); }  TE(4); }
        SEAM();
        if (RUN()) { TB(8); if (PHM & 8) for (int rep = 0; rep < NREP(8); ++rep) { { PHASE_CTX(cl); SchedUp S; S.init(&cl, l); EpiUp E{&cl, l}; GEMM_UNITS(cl, S, E); } { PHASE_CTX(cl); ph_pool(cl, l); } }  TE(8); }
        SEAM();
        if (RUN()) { TB(16); if (PHM & 16) { { PHASE_CTX(cl); ph_attn_mla(cl, l); } { PHASE_CTX(cl); ph_attn_diff(cl, l); } }  TE(16); }
        SEAM();
        if (RUN()) { TB(32); if (PHM & 32) for (int rep = 0; rep < NREP(32); ++rep) { PHASE_CTX(cl); SchedMerge1 S; S.init(&cl, l); EpiMerge1 E{&cl}; GEMM_UNITS(cl, S, E); }  TE(32); }
        SEAM();
        if (RUN()) { TB(64); if (PHM & 64) for (int rep = 0; rep < NREP(64); ++rep) { PHASE_CTX(cl); SchedMerge2 S; S.init(&cl, l); EpiMerge2 E{&cl}; GEMM_UNITS(cl, S, E); }  TE(64); }
        SEAM();
        if (RUN()) { TB(128); if (PHM & 128) { PHASE_CTX(cl); ph_t4_router(cl, l); }  TE(128); }
        SEAM();
        if (RUN()) { TB(256); if (PHM & 256) for (int rep = 0; rep < NREP(256); ++rep) { PHASE_CTX(cl); SchedGU S; S.c = &cl; S.T0 = moe_table(cl, l, 0); if (NCHUNK > 1) S.T1 = moe_table(cl, l, NCHUNK - 1); else { S.T1 = S.T0; S.T1.TR = 0; S.T1.nsh = 0; } EpiGU E{&cl, 0}; GEMM_UNITS(cl, S, E); }  TE(256); }
        SEAM();
        { constexpr int ch = 0;
            if (RUN()) { TB(512); if (PHM & 512) for (int rep = 0; rep < NREP(512); ++rep) { PHASE_CTX(cl); SchedD S; S.c = &cl; S.T = moe_table(cl, l, ch); EpiD E{&cl, ch}; GEMM_UNITS(cl, S, E); }  TE(512); }
            SEAM();
            if (RUN()) { TB(1024); if (PHM & 1024) { PHASE_CTX(cl); ph_combine(cl, l, ch); }  TE(1024); }
            SEAM();

        }
        if constexpr (NCHUNK > 1) { constexpr int ch = 1;
            if (RUN()) { TB(512); if (PHM & 512) for (int rep = 0; rep < NREP(512); ++rep) { PHASE_CTX(cl); SchedD S; S.c = &cl; S.T = moe_table(cl, l, ch); EpiD E{&cl, ch}; GEMM_UNITS(cl, S, E); }  TE(512); }
            SEAM();
            if (RUN()) { TB(1024); if (PHM & 1024) { PHASE_CTX(cl); ph_combine(cl, l, ch); }  TE(1024); }
            SEAM();

        }
    }
    if (TMASK) { __syncthreads(); if (blockIdx.x == 0) { unsigned long long tacc_ = 0ull; for (int i = 0; i < 64; ++i) tacc_ += TSLOT(i);
        const unsigned long long ts_ = __builtin_amdgcn_s_memrealtime(); while (__builtin_amdgcn_s_memrealtime() - ts_ < tacc_) __builtin_amdgcn_s_sleep(8); } }
#undef RUN
#undef SEAM
}
constexpr int N_STEPS = 2 * (8 + 2 * NCHUNK);

extern "C" void kernel_launch(void* const* d_in, const int* in_sizes, int n_in, void* d_out, int out_size, void* d_ws, size_t ws_size, hipStream_t stream) {
    static int grid = 0;
    if (grid == 0) {
        if (n_in != 34 || out_size != NB * SEQ * DM || ws_size < WS_END) { fprintf(stderr, "kernel_launch: unexpected shapes (n_in %d out %d ws %zu need %zu)\n", n_in, out_size, ws_size, (size_t)WS_END); grid = -1; return; }
        int dev = 0, cus = 0;
        if (hipGetDevice(&dev) != hipSuccess || hipDeviceGetAttribute(&cus, hipDeviceAttributeMultiprocessorCount, dev) != hipSuccess) { grid = -1; return; }
        if (hipFuncSetAttribute((const void*)fwd_kernel, hipFuncAttributeMaxDynamicSharedMemorySize, LDS_BYTES) != hipSuccess) { fprintf(stderr, "kernel_launch: hipFuncSetAttribute failed\n"); grid = -1; return; }
        int per_cu = 0; (void)hipOccupancyMaxActiveBlocksPerMultiprocessor(&per_cu, (const void*)fwd_kernel, 512, LDS_BYTES); (void)hipGetLastError();
        if (per_cu < 1) fprintf(stderr, "kernel_launch: occupancy query says %d\n", per_cu);
        grid = cus;
    }
    if (grid < 0) return;
    (void)hipMemsetAsync((char*)d_ws + WS_CTL, 0, CTL_BYTES, stream);
    Params p{};
    for (int i = 0; i < 34; ++i) p.in[i] = (const float*)d_in[i];
    p.out = (float*)d_out; p.ws = (unsigned char*)d_ws;
#if N_LAUNCH_MODE == 1
    p.step_lo = 0; p.step_hi = N_STEPS;
    hipLaunchKernelGGL(fwd_kernel, dim3(grid), dim3(512), LDS_BYTES, stream, p);
#else
    for (int s = 0; s < N_STEPS; ++s) { p.step_lo = s; p.step_hi = s + 1; hipLaunchKernelGGL(fwd_kernel, dim3(grid), dim3(512), LDS_BYTES, stream, p); }
#endif
}
```
